# Optimizing an MI355X kernel written in HIP

```python
import math
import jax, jax.numpy as jnp
from jax import lax
import numpy as np

D_MODEL = 1024
BATCH = 4
SEQ = 4096
DEPTH = 2

HEAD_DIM = 64
N_HEADS_A = 8
A_QK_DIM = 32
A_V_DIM = 2 * A_QK_DIM
N_HEADS_B = 8
N_HEADS_C = 8
N_HEADS_D = 8
A_QK_W = N_HEADS_A * 2 * A_QK_DIM
A_V_W = N_HEADS_A * A_V_DIM
B_W = N_HEADS_B * HEAD_DIM
C_W = N_HEADS_C * HEAD_DIM
D_W = N_HEADS_D * HEAD_DIM
AB_SPLITS = (A_QK_W, A_QK_W, A_V_W, B_W, B_W, B_W)
CD_SPLITS = (C_W, C_W, C_W, D_W, D_W, D_W, N_HEADS_D)
AB_IN = 2 * A_QK_W + A_V_W + 3 * B_W
AB_OUT = A_V_W + B_W
CD_IN = 3 * C_W + 3 * D_W + N_HEADS_D
CD_OUT = C_W + D_W
N_EVEN = (DEPTH + 1) // 2
N_ODD = DEPTH // 2
Q_BLOCK = 128
T5_BUCKETS = 32
T5_MAX_DIST = 128
N_T5_HEADS = 8
DILATED_PATTERNS = ((128, 1), (512, 4), (2048, 16))
PEER_HEADS = 8
PEER_NKEYS = 128
PEER_EXPERTS = PEER_NKEYS * PEER_NKEYS
PEER_DKEY = 256
PEER_TOPK = 16
PEER_TOKEN_BLOCK = 128
DN_ALPHA = (2 * DEPTH) ** 0.25
DN_BETA = (8 * DEPTH) ** -0.25
LN_EPS = 1e-5

kernel_name = "hybrid_diff_stickbreak_dilated_fox_peer"


def layer_norm(x, g, b):
    xf = x.astype(jnp.float32)
    mu = jnp.mean(xf, axis=-1, keepdims=True)
    var = jnp.mean(jnp.square(xf - mu), axis=-1, keepdims=True)
    return ((xf - mu) * lax.rsqrt(var + LN_EPS) * g + b).astype(x.dtype)


def split_cols(t, sizes):
    out, start = [], 0
    for n in sizes:
        out.append(t[..., start:start + n])
        start += n
    return out


def to_heads(t, n_heads):
    B, S, _ = t.shape
    return t.reshape(B, S, n_heads, -1).transpose(0, 2, 1, 3)


def merge_heads(o):
    B, H, S, d = o.shape
    return o.transpose(0, 2, 1, 3).reshape(B, S, H * d)


def to_q_blocks(t):
    B, H, S = t.shape[:3]
    t = t.reshape((B, H, S // Q_BLOCK, Q_BLOCK) + t.shape[3:])
    return jnp.moveaxis(t, 2, 0)


def from_q_blocks(o):
    o = jnp.moveaxis(o, 0, 2)
    return o.reshape(o.shape[0], o.shape[1], -1, o.shape[-1])


def t5_bucket(dist):
    max_exact = T5_BUCKETS // 2
    n = jnp.maximum(dist, 0)
    nf = jnp.maximum(n, 1).astype(jnp.float32)
    large = max_exact + (jnp.log(nf / max_exact) / math.log(T5_MAX_DIST / max_exact)
                         * (T5_BUCKETS - max_exact)).astype(jnp.int32)
    large = jnp.minimum(large, T5_BUCKETS - 1)
    return jnp.where(n < max_exact, n, large)


def diff_attention(q, k, v, t5_bias, lam, lambda_init, subln_g):
    S = q.shape[2]
    scale = A_QK_DIM ** -0.5
    kpos = jnp.arange(S)

    def block(args):
        i, qi = args
        qpos = i * Q_BLOCK + jnp.arange(Q_BLOCK)
        dist = qpos[:, None] - kpos[None, :]
        bias = jnp.moveaxis(t5_bias[t5_bucket(dist)], -1, 0).astype(jnp.float32)
        logits = jnp.einsum('bhqcd,bhscd->bhcqs', qi, k).astype(jnp.float32) * scale
        logits = logits + bias[None, :, None]
        logits = jnp.where(dist >= 0, logits, -jnp.inf)
        p = jax.nn.softmax(logits, axis=-1)
        w = p[:, :, 0] - lam * p[:, :, 1]
        return jnp.einsum('bhqs,bhsd->bhqd', w.astype(v.dtype), v)

    nb = S // Q_BLOCK
    o = from_q_blocks(lax.map(block, (jnp.arange(nb), to_q_blocks(q))))
    of = o.astype(jnp.float32)
    of = of * lax.rsqrt(jnp.mean(jnp.square(of), axis=-1, keepdims=True) + LN_EPS)
    return (of * subln_g * (1.0 - lambda_init)).astype(v.dtype)


def stick_breaking_attention(q, k, v):
    S, d = q.shape[2], q.shape[3]
    scale = d ** -0.5
    kpos = jnp.arange(S)

    def block(args):
        i, qi = args
        qpos = i * Q_BLOCK + jnp.arange(Q_BLOCK)
        past = kpos[None, :] < qpos[:, None]
        z = jnp.einsum('bhqd,bhsd->bhqs', qi, k).astype(jnp.float32) * scale
        log_beta = jax.nn.log_sigmoid(z)
        log_rem = jnp.where(past, jax.nn.log_sigmoid(-z), 0.0)
        after = lax.cumsum(log_rem, axis=3, reverse=True) - log_rem
        w = jnp.where(past, jnp.exp(log_beta + after), 0.0)
        return jnp.einsum('bhqs,bhsd->bhqd', w.astype(v.dtype), v)

    nb = S // Q_BLOCK
    return from_q_blocks(lax.map(block, (jnp.arange(nb), to_q_blocks(q))))


def dilated_attention(q, k, v, t5_bias):
    B, H, S, d = q.shape
    scale = d ** -0.5

    def block(args):
        i, qi = args
        qpos = i * Q_BLOCK + jnp.arange(Q_BLOCK)
        ms, ss, os_ = [], [], []
        for window, dil in DILATED_PATTERNS:
            n_keys = window // dil + 1
            dist = jnp.arange(n_keys) * dil
            kidx = qpos[:, None] - dist[None, :]
            valid = kidx >= 0
            kidx = jnp.maximum(kidx, 0).reshape(-1)
            kg = jnp.take(k, kidx, axis=2).reshape(B, H, Q_BLOCK, n_keys, d)
            vg = jnp.take(v, kidx, axis=2).reshape(B, H, Q_BLOCK, n_keys, d)
            bias = t5_bias[t5_bucket(dist)].T.astype(jnp.float32)
            logits = jnp.einsum('bhqd,bhqjd->bhqj', qi, kg).astype(jnp.float32) * scale
            logits = jnp.where(valid, logits + bias[None, :, None, :], -jnp.inf)
            m = jnp.max(logits, axis=-1)
            e = jnp.exp(logits - m[..., None])
            s = jnp.sum(e, axis=-1)
            o = jnp.einsum('bhqj,bhqjd->bhqd', e, vg.astype(jnp.float32)) / s[..., None]
            ms.append(m)
            ss.append(s)
            os_.append(o)
        m_all = jnp.maximum(jnp.maximum(ms[0], ms[1]), ms[2])
        wts = [s * jnp.exp(m - m_all) for m, s in zip(ms, ss)]
        num = sum(w[..., None] * o for w, o in zip(wts, os_))
        den = sum(wts)
        return (num / den[..., None]).astype(q.dtype)

    nb = S // Q_BLOCK
    return from_q_blocks(lax.map(block, (jnp.arange(nb), to_q_blocks(q))))


def forgetting_attention(q, k, v, log_f):
    S, d = q.shape[2], q.shape[3]
    scale = d ** -0.5
    kpos = jnp.arange(S)
    F = jnp.cumsum(log_f, axis=-1)

    def block(args):
        i, qi, Fi = args
        qpos = i * Q_BLOCK + jnp.arange(Q_BLOCK)
        causal = kpos[None, :] <= qpos[:, None]
        logits = jnp.einsum('bhqd,bhsd->bhqs', qi, k).astype(jnp.float32) * scale
        logits = logits + Fi[..., :, None] - F[:, :, None, :]
        logits = jnp.where(causal, logits, -jnp.inf)
        p = jax.nn.softmax(logits, axis=-1)
        return jnp.einsum('bhqs,bhsd->bhqd', p.astype(v.dtype), v)

    nb = S // Q_BLOCK
    return from_q_blocks(lax.map(block, (jnp.arange(nb), to_q_blocks(q), to_q_blocks(F))))


def ab_mixer(h, t5_bias, w_in, lam_vecs, subln_g, w_out, lambda_init):
    B, S, _ = h.shape
    aq, ak, av, bq, bk, bv = split_cols(h @ w_in, AB_SPLITS)
    aq = aq.reshape(B, S, N_HEADS_A, 2, A_QK_DIM).transpose(0, 2, 1, 3, 4)
    ak = ak.reshape(B, S, N_HEADS_A, 2, A_QK_DIM).transpose(0, 2, 1, 3, 4)
    lv = lam_vecs.astype(jnp.float32)
    lam = jnp.exp(jnp.sum(lv[0] * lv[1])) - jnp.exp(jnp.sum(lv[2] * lv[3])) + lambda_init
    oa = diff_attention(aq, ak, to_heads(av, N_HEADS_A), t5_bias, lam, lambda_init, subln_g)
    ob = stick_breaking_attention(to_heads(bq, N_HEADS_B), to_heads(bk, N_HEADS_B), to_heads(bv, N_HEADS_B))
    return jnp.concatenate([merge_heads(oa), merge_heads(ob)], axis=-1) @ w_out


def cd_mixer(h, t5_bias, w_in, b_f, w_out):
    cq, ck, cv, dq, dk, dv, fg = split_cols(h @ w_in, CD_SPLITS)
    oc = dilated_attention(to_heads(cq, N_HEADS_C), to_heads(ck, N_HEADS_C), to_heads(cv, N_HEADS_C), t5_bias)
    log_f = jax.nn.log_sigmoid(fg.astype(jnp.float32) + b_f).transpose(0, 2, 1)
    od = forgetting_attention(to_heads(dq, N_HEADS_D), to_heads(dk, N_HEADS_D), to_heads(dv, N_HEADS_D), log_f)
    return jnp.concatenate([merge_heads(oc), merge_heads(od)], axis=-1) @ w_out


def peer(x, w_q, sub_keys, u, v):
    B, S, D = x.shape
    xt = x.reshape(B * S // PEER_TOKEN_BLOCK, PEER_TOKEN_BLOCK, D)

    def block(xb):
        q = (xb @ w_q).reshape(PEER_TOKEN_BLOCK, PEER_HEADS, 2, PEER_DKEY // 2)
        sc = jnp.einsum('thcd,hckd->thck', q, sub_keys).astype(jnp.float32)
        top_s, top_i = lax.top_k(sc, PEER_TOPK)
        cand_s = top_s[:, :, 0, :, None] + top_s[:, :, 1, None, :]
        cand_i = top_i[:, :, 0, :, None] * PEER_NKEYS + top_i[:, :, 1, None, :]
        cand_s = cand_s.reshape(PEER_TOKEN_BLOCK, PEER_HEADS, PEER_TOPK * PEER_TOPK)
        cand_i = cand_i.reshape(PEER_TOKEN_BLOCK, PEER_HEADS, PEER_TOPK * PEER_TOPK)
        best_s, pos = lax.top_k(cand_s, PEER_TOPK)
        idx = jnp.take_along_axis(cand_i, pos, axis=-1)
        g = jax.nn.softmax(best_s, axis=-1)
        ug = jnp.take(u, idx, axis=0)
        vg = jnp.take(v, idx, axis=0)
        act = jax.nn.gelu(jnp.einsum('thkd,td->thk', ug, xb), approximate=False)
        return jnp.einsum('thk,thkd->td', (g * act.astype(jnp.float32)).astype(vg.dtype), vg)

    return lax.map(block, xt).reshape(B, S, D)


def _col_scale(sizes, value_slots):
    return jnp.concatenate([jnp.full((n,), DN_BETA if i in value_slots else 1.0, jnp.float32)
                            for i, n in enumerate(sizes)])


def setup_inputs(seed: int = 0) -> dict:
    key = jax.random.key(seed)
    ks = jax.random.split(key, 18)

    def nrm(k, shape, s):
        return jax.random.normal(k, shape, jnp.float32) * s

    x = nrm(ks[0], (BATCH, SEQ, D_MODEL), 1.0)
    t5_bias = nrm(ks[1], (T5_BUCKETS, N_T5_HEADS), 0.5)
    ab_w_in = nrm(ks[2], (N_EVEN, D_MODEL, AB_IN), D_MODEL ** -0.5) * _col_scale(AB_SPLITS, (2, 5))
    ab_lambda = nrm(ks[3], (N_EVEN, 4, A_QK_DIM), 0.1)
    ab_subln_g = 1.0 + nrm(ks[4], (N_EVEN, A_V_DIM), 0.02)
    ab_w_out = nrm(ks[5], (N_EVEN, AB_OUT, D_MODEL), AB_OUT ** -0.5 * DN_BETA)
    cd_w_in = nrm(ks[6], (N_ODD, D_MODEL, CD_IN), D_MODEL ** -0.5) * _col_scale(CD_SPLITS, (2, 5))
    cd_b_f = 3.0 + nrm(ks[7], (N_ODD, N_HEADS_D), 0.1)
    cd_w_out = nrm(ks[8], (N_ODD, CD_OUT, D_MODEL), CD_OUT ** -0.5 * DN_BETA)
    peer_w_q = nrm(ks[9], (DEPTH, D_MODEL, PEER_HEADS * PEER_DKEY), D_MODEL ** -0.5)
    peer_sub_keys = nrm(ks[10], (DEPTH, PEER_HEADS, 2, PEER_NKEYS, PEER_DKEY // 2), (PEER_DKEY // 2) ** -0.5)
    peer_u = nrm(ks[11], (DEPTH, PEER_EXPERTS, D_MODEL), D_MODEL ** -0.5)
    peer_v = nrm(ks[12], (DEPTH, PEER_EXPERTS, D_MODEL), DN_BETA)
    ln_g = 1.0 + nrm(ks[13], (DEPTH, 2, D_MODEL), 0.02)
    ln_b = nrm(ks[14], (DEPTH, 2, D_MODEL), 0.02)
    return {"x": x, "t5_bias": t5_bias, "ab_w_in": ab_w_in, "ab_lambda": ab_lambda,
            "ab_subln_g": ab_subln_g, "ab_w_out": ab_w_out, "cd_w_in": cd_w_in, "cd_b_f": cd_b_f,
            "cd_w_out": cd_w_out, "peer_w_q": peer_w_q, "peer_sub_keys": peer_sub_keys,
            "peer_u": peer_u, "peer_v": peer_v, "ln_g": ln_g, "ln_b": ln_b}


def reference(x, t5_bias, ab_w_in, ab_lambda, ab_subln_g, ab_w_out, cd_w_in, cd_b_f, cd_w_out,
              peer_w_q, peer_sub_keys, peer_u, peer_v, ln_g, ln_b):
    h = x
    for layer in range(DEPTH):
        j = layer // 2
        if layer % 2 == 0:
            lambda_init = 0.8 - 0.6 * math.exp(-0.3 * layer)
            mix = ab_mixer(h, t5_bias, ab_w_in[j], ab_lambda[j], ab_subln_g[j], ab_w_out[j], lambda_init)
        else:
            mix = cd_mixer(h, t5_bias, cd_w_in[j], cd_b_f[j], cd_w_out[j])
        h = layer_norm(DN_ALPHA * h + mix, ln_g[layer, 0], ln_b[layer, 0])
        ffn = peer(h, peer_w_q[layer], peer_sub_keys[layer], peer_u[layer], peer_v[layer])
        h = layer_norm(DN_ALPHA * h + ffn, ln_g[layer, 1], ln_b[layer, 1])
    return h
```

```cpp
#include <hip/hip_runtime.h>
#include <cstdio>
#include <cstdint>
#include <cmath>

#ifndef MK_ONE_LAUNCH
#define MK_ONE_LAUNCH 1
#endif

constexpr int BATCH = 4, SEQ = 4096, DM = 1024, NT = BATCH * SEQ;
constexpr int NH = 8, HD = 64;
constexpr int AB_IN = 3072, CD_IN = 3080;
constexpr int PEER_H = 8, PEER_NK = 128, PEER_TOPK = 16, PEER_QW = 2048;
constexpr float DN_ALPHA = 1.4142135623730951f;
constexpr float LN_EPS = 1e-5f;
constexpr int NTHREADS = 512, NWAVES = 8;

constexpr size_t MiB = 1u << 20;
constexpr size_t WS_CTL = 0;
constexpr size_t WS_PROJ = 1 * MiB;
constexpr size_t WS_ATT = 209 * MiB;
constexpr size_t WS_MIX = 273 * MiB;
constexpr size_t WS_H1 = 337 * MiB;
constexpr size_t WS_H2 = 401 * MiB;
constexpr size_t WS_F = 465 * MiB;
constexpr size_t WS_END = 466 * MiB;

#define XB_TMO      128
#define XB_XCNT(j)  (256  + 64 * (j))
#define XB_XSUB(j)  (1280 + 64 * (j))
#define XB_XGEN(j)  (2304 + 64 * (j))
#define XB_TOP      3328
#define XB_TOPGEN   3392
#define XCD_BAR_WORDS 3456
#define XB_SPIN_CAP (1u << 18)
#define LAS __attribute__((address_space(3)))

__device__ __forceinline__ unsigned xb_ld(unsigned* p)              { return __hip_atomic_load(p, __ATOMIC_RELAXED, __HIP_MEMORY_SCOPE_AGENT); }
__device__ __forceinline__ unsigned xb_add(unsigned* p, unsigned v) { return __hip_atomic_fetch_add(p, v, __ATOMIC_RELAXED, __HIP_MEMORY_SCOPE_AGENT); }
__device__ __forceinline__ unsigned xb_xcc_id() { return (unsigned)__builtin_amdgcn_s_getreg((3 << 11) | 20) & 0xFu; }
#define XB_SPIN(cond, bar) do { unsigned _sp = 0; while (cond) { __builtin_amdgcn_s_sleep(1); \
    if ((++_sp & 255u) == 0u) { if (xb_ld(&(bar)[XB_TMO])) break; if (_sp > XB_SPIN_CAP) { atomicAdd(&(bar)[XB_TMO], 1u); break; } } } } while (0)

struct XcdBarrier {
    unsigned* bar; unsigned x;
    volatile LAS unsigned* st;
};
__device__ __forceinline__ XcdBarrier xcd_barrier_post(unsigned* bar, volatile LAS unsigned* st) {
    XcdBarrier b; b.bar = bar; b.x = xb_xcc_id(); b.st = st;
    if (threadIdx.x == 0) (void)xb_add(&bar[XB_XCNT(b.x)], 1u);
    return b;
}
__device__ __forceinline__ void xcd_barrier_complete(unsigned* bar, unsigned x, unsigned& nloc, unsigned& nx) {
    const unsigned G = gridDim.x * gridDim.y * gridDim.z;
    unsigned sum, cnt, mine, sp = 0u;
    for (;;) {
        sum = 0u; cnt = 0u; mine = 0u;
#pragma unroll
        for (unsigned j = 0; j < 16; ++j) { const unsigned c = xb_ld(&bar[XB_XCNT(j)]); sum += c; cnt += (c > 0u) ? 1u : 0u; mine = (j == x) ? c : mine; }
        if (sum == G) break;
        __builtin_amdgcn_s_sleep(1);
        if ((++sp & 255u) == 0u) { if (xb_ld(&bar[XB_TMO])) break; if (sp > XB_SPIN_CAP) { atomicAdd(&bar[XB_TMO], 1u); break; } }
    }
    nloc = mine > 0u ? mine : 1u; nx = cnt > 0u ? cnt : 1u;
}
__device__ __forceinline__ void xcd_barrier(const XcdBarrier& b) {
    asm volatile("s_waitcnt vmcnt(0)" ::: "memory");
    __syncthreads();
    if (threadIdx.x == 0) {
        unsigned* bar = b.bar;
        __builtin_amdgcn_s_waitcnt(0);
        unsigned nloc = b.st[0], nx = b.st[1];
        if (nloc == 0u) { xcd_barrier_complete(bar, b.x, nloc, nx); b.st[0] = nloc; b.st[1] = nx; }
        const unsigned old = xb_add(&bar[XB_XSUB(b.x)], 1u);
        const unsigned gen = old / nloc;
        if (old + 1u == (gen + 1u) * nloc) {
            __builtin_amdgcn_fence(__ATOMIC_RELEASE, "agent");
            asm volatile("s_waitcnt vmcnt(0)" ::: "memory");
            const unsigned og = xb_add(&bar[XB_TOP], 1u);
            const unsigned tg = og / nx;
            if (og + 1u == (tg + 1u) * nx) xb_add(&bar[XB_TOPGEN], 1u);
            else XB_SPIN(xb_ld(&bar[XB_TOPGEN]) == tg, bar);
            __builtin_amdgcn_fence(__ATOMIC_ACQUIRE, "agent");
            xb_add(&bar[XB_XGEN(b.x)], 1u);
            asm volatile("s_waitcnt vmcnt(0)" ::: "memory");
        } else {
            XB_SPIN(xb_ld(&bar[XB_XGEN(b.x)]) == gen, bar);
            __builtin_amdgcn_fence(__ATOMIC_ACQUIRE, "agent");
            asm volatile("s_waitcnt vmcnt(0)" ::: "memory");
        }
    }
    __syncthreads();
}

struct Args {
    const float* in[15];
    float* out;
    unsigned char* ws;
    int ph_lo, ph_hi;
};

struct Ctx {
    const Args* a;
    int tid, lane, wave, gwave, nwaves;
    float* lds;
};

__device__ __forceinline__ float wave_sum(float v) {
#pragma unroll
    for (int o = 32; o >= 1; o >>= 1) v += __shfl_xor(v, o);
    return v;
}
__device__ __forceinline__ float log_sigmoid(float z) { return fminf(z, 0.f) - log1pf(expf(-fabsf(z))); }
__device__ __forceinline__ int t5_bucket(int n) {
    if (n < 16) return n;
    int large = 16 + (int)(logf((float)n / 16.f) / 2.0794415416798357f * 16.f);
    return large < 31 ? large : 31;
}

__device__ __forceinline__ void gemm_naive(const Ctx& c, const float* A, int lda, const float* W, int ldw, float* C, int ldc, int M, int N, int K) {
    float* As = c.lds;
    float* Bs = c.lds + 16 * 132;
    const int tid = c.tid, tx = tid & 31, ty = tid >> 5;
    const int ntn = (N + 127) / 128, ntm = M / 128, ntiles = ntn * ntm;
    for (int tile = blockIdx.x; tile < ntiles; tile += gridDim.x) {
        const int m0 = (tile / ntn) * 128, n0 = (tile % ntn) * 128;
        float acc[8][4];
#pragma unroll
        for (int i = 0; i < 8; ++i)
#pragma unroll
            for (int j = 0; j < 4; ++j) acc[i][j] = 0.f;
        for (int k0 = 0; k0 < K; k0 += 16) {
            {
                const int row = tid >> 2, k4 = (tid & 3) * 4;
                const float4 v = *(const float4*)(A + (size_t)(m0 + row) * lda + k0 + k4);
                As[(k4 + 0) * 132 + row] = v.x; As[(k4 + 1) * 132 + row] = v.y; As[(k4 + 2) * 132 + row] = v.z; As[(k4 + 3) * 132 + row] = v.w;
                const int kk = tid >> 5, c4 = (tid & 31) * 4;
                float4 w = make_float4(0.f, 0.f, 0.f, 0.f);
                if (n0 + c4 < N) w = *(const float4*)(W + (size_t)(k0 + kk) * ldw + n0 + c4);
                *(float4*)(Bs + kk * 132 + c4) = w;
            }
            __syncthreads();
#pragma unroll
            for (int kk = 0; kk < 16; ++kk) {
                const float4 a0 = *(const float4*)(As + kk * 132 + ty * 8), a1 = *(const float4*)(As + kk * 132 + ty * 8 + 4);
                const float4 b = *(const float4*)(Bs + kk * 132 + tx * 4);
                const float av[8] = {a0.x, a0.y, a0.z, a0.w, a1.x, a1.y, a1.z, a1.w};
                const float bv[4] = {b.x, b.y, b.z, b.w};
#pragma unroll
                for (int i = 0; i < 8; ++i)
#pragma unroll
                    for (int j = 0; j < 4; ++j) acc[i][j] = fmaf(av[i], bv[j], acc[i][j]);
            }
            __syncthreads();
        }
        if (n0 + tx * 4 < N) {
#pragma unroll
            for (int i = 0; i < 8; ++i)
                *(float4*)(C + (size_t)(m0 + ty * 8 + i) * ldc + n0 + tx * 4) = make_float4(acc[i][0], acc[i][1], acc[i][2], acc[i][3]);
        }
    }
}

template <int DQ, class BiasF>
__device__ __forceinline__ void causal_softmax_row(const float (&q)[DQ], const float* kbase, const float* vbase, int ld, int t, int smax, float scale, BiasF biasf, float (&O)[64]) {
    float m = -INFINITY;
    for (int s = 0; s <= smax; ++s) {
        const float* kr = kbase + (size_t)s * ld;
        float d = 0.f;
#pragma unroll
        for (int i = 0; i < DQ; ++i) d = fmaf(q[i], kr[i], d);
        const float lg = d * scale + biasf(s);
        m = (s <= t) ? fmaxf(m, lg) : m;
    }
    float l = 0.f;
#pragma unroll
    for (int i = 0; i < 64; ++i) O[i] = 0.f;
    for (int s = 0; s <= smax; ++s) {
        const float* kr = kbase + (size_t)s * ld;
        const float* vr = vbase + (size_t)s * ld;
        float d = 0.f;
#pragma unroll
        for (int i = 0; i < DQ; ++i) d = fmaf(q[i], kr[i], d);
        const float lg = d * scale + biasf(s);
        const float p = (s <= t) ? expf(lg - m) : 0.f;
        l += p;
#pragma unroll
        for (int i = 0; i < 64; ++i) O[i] = fmaf(p, vr[i], O[i]);
    }
    const float inv = 1.f / l;
#pragma unroll
    for (int i = 0; i < 64; ++i) O[i] *= inv;
}

__device__ __forceinline__ void attn_layer0_naive(const Ctx& c, const float* proj, float* out) {
    const float* t5 = c.a->in[1];
    const float* lamv = c.a->in[3];
    const float* subg = c.a->in[4];
    float* biasTab = c.lds;
    for (int i = c.tid; i < 8 * 129; i += NTHREADS) { const int h = i / 129, d = i % 129; biasTab[i] = t5[t5_bucket(d) * 8 + h]; }
    __syncthreads();
    float s01 = 0.f, s23 = 0.f;
    for (int i = 0; i < 32; ++i) { s01 += lamv[i] * lamv[32 + i]; s23 += lamv[64 + i] * lamv[96 + i]; }
    const float lambda_init = 0.2f;
    const float lam = expf(s01) - expf(s23) + lambda_init;
    const int lane = c.lane;
    for (int task = c.gwave; task < 2 * 32 * 32; task += c.nwaves) {
        const int p = task & 31, bh = (task >> 5) & 31, type = task >> 10;
        const int b = bh >> 3, h = bh & 7;
        for (int half = 0; half < 2; ++half) {
            const int tb = half ? 63 - p : p;
            const int t = tb * 64 + lane, smax = tb * 64 + 63;
            const size_t rowbase = (size_t)b * SEQ;
            if (type == 0) {
                float res0[64];
                {
                    float q[32];
                    const float* qr = proj + (rowbase + t) * AB_IN + h * 64;
#pragma unroll
                    for (int i = 0; i < 32; ++i) q[i] = qr[i];
                    causal_softmax_row<32>(q, proj + rowbase * AB_IN + 512 + h * 64, proj + rowbase * AB_IN + 1024 + h * 64, AB_IN, t, smax, 0.17677669529663687f,
                                           [=](int s) { int d = t - s; d = d < 0 ? 0 : (d > 128 ? 128 : d); return biasTab[h * 129 + d]; }, res0);
                }
                float res1[64];
                {
                    float q[32];
                    const float* qr = proj + (rowbase + t) * AB_IN + h * 64 + 32;
#pragma unroll
                    for (int i = 0; i < 32; ++i) q[i] = qr[i];
                    causal_softmax_row<32>(q, proj + rowbase * AB_IN + 512 + h * 64 + 32, proj + rowbase * AB_IN + 1024 + h * 64, AB_IN, t, smax, 0.17677669529663687f,
                                           [=](int s) { int d = t - s; d = d < 0 ? 0 : (d > 128 ? 128 : d); return biasTab[h * 129 + d]; }, res1);
                }
                float ms = 0.f;
#pragma unroll
                for (int i = 0; i < 64; ++i) { res0[i] = res0[i] - lam * res1[i]; ms = fmaf(res0[i], res0[i], ms); }
                const float r = rsqrtf(ms * (1.f / 64.f) + LN_EPS) * (1.f - lambda_init);
                float* orow = out + (rowbase + t) * DM + h * 64;
#pragma unroll
                for (int i = 0; i < 64; ++i) orow[i] = res0[i] * r * subg[i];
            } else {
                float q[64], O[64];
                const float* qr = proj + (rowbase + t) * AB_IN + 1536 + h * 64;
#pragma unroll
                for (int i = 0; i < 64; ++i) { q[i] = qr[i]; O[i] = 0.f; }
                const float* kbase = proj + rowbase * AB_IN + 2048 + h * 64;
                const float* vbase = proj + rowbase * AB_IN + 2560 + h * 64;
                float R = 0.f;
                for (int s = smax - 1; s >= 0; --s) {
                    const float* kr = kbase + (size_t)s * AB_IN;
                    const float* vr = vbase + (size_t)s * AB_IN;
                    float d = 0.f;
#pragma unroll
                    for (int i = 0; i < 64; ++i) d = fmaf(q[i], kr[i], d);
                    const float z = d * 0.125f;
                    const float lb = log_sigmoid(z), lr = lb - z;
                    const bool past = s < t;
                    const float w = past ? expf(lb + R) : 0.f;
                    R += past ? lr : 0.f;
#pragma unroll
                    for (int i = 0; i < 64; ++i) O[i] = fmaf(w, vr[i], O[i]);
                    if (__all(R < -150.f)) break;
                }
                float* orow = out + (rowbase + t) * DM + 512 + h * 64;
#pragma unroll
                for (int i = 0; i < 64; ++i) orow[i] = O[i];
            }
        }
    }
}

__device__ __forceinline__ void fscan_naive(const Ctx& c, const float* proj, float* F) {
    const float* bf = c.a->in[7];
    for (int task = c.gwave; task < 32; task += c.nwaves) {
        const int b = task >> 3, h = task & 7;
        const int lane = c.lane;
        float v[64]; float tot = 0.f;
#pragma unroll
        for (int i = 0; i < 64; ++i) { const int s = lane * 64 + i; v[i] = log_sigmoid(proj[((size_t)b * SEQ + s) * CD_IN + 3072 + h] + bf[h]); tot += v[i]; }
        float incl = tot;
#pragma unroll
        for (int o = 1; o < 64; o <<= 1) { const float n = __shfl_up(incl, o); if (lane >= o) incl += n; }
        float run = incl - tot;
#pragma unroll
        for (int i = 0; i < 64; ++i) { run += v[i]; F[(size_t)task * SEQ + lane * 64 + i] = run; }
    }
}

__device__ __forceinline__ void attn_layer1_naive(const Ctx& c, const float* proj, const float* F, float* out) {
    const float* t5 = c.a->in[1];
    float* biasTab = c.lds;
    for (int i = c.tid; i < 8 * 129; i += NTHREADS) { const int h = i / 129, d = i % 129; biasTab[i] = t5[t5_bucket(d) * 8 + h]; }
    __syncthreads();
    const int lane = c.lane;
    for (int task = c.gwave; task < 2 * 32 * 32; task += c.nwaves) {
        const int p = task & 31, bh = (task >> 5) & 31, type = task >> 10;
        const int b = bh >> 3, h = bh & 7;
        for (int half = 0; half < 2; ++half) {
            const int tb = half ? 63 - p : p;
            const int t = tb * 64 + lane, smax = tb * 64 + 63;
            const size_t rowbase = (size_t)b * SEQ;
            if (type == 0) {
                float q[64], O[64];
                const float* qr = proj + (rowbase + t) * CD_IN + h * 64;
#pragma unroll
                for (int i = 0; i < 64; ++i) { q[i] = qr[i]; O[i] = 0.f; }
                const float* kbase = proj + rowbase * CD_IN + 512 + h * 64;
                const float* vbase = proj + rowbase * CD_IN + 1024 + h * 64;
                float m = -INFINITY;
                for (int pat = 0; pat < 3; ++pat) {
                    const int dil = pat == 0 ? 1 : (pat == 1 ? 4 : 16);
                    for (int j = 0; j <= 128; ++j) {
                        const int dist = j * dil, s = t - dist;
                        if (s >= 0) {
                            const float* kr = kbase + (size_t)s * CD_IN;
                            float d = 0.f;
#pragma unroll
                            for (int i = 0; i < 64; ++i) d = fmaf(q[i], kr[i], d);
                            const float lg = d * 0.125f + biasTab[h * 129 + (dist > 128 ? 128 : dist)];
                            m = fmaxf(m, lg);
                        }
                    }
                }
                float l = 0.f;
                for (int pat = 0; pat < 3; ++pat) {
                    const int dil = pat == 0 ? 1 : (pat == 1 ? 4 : 16);
                    for (int j = 0; j <= 128; ++j) {
                        const int dist = j * dil, s = t - dist;
                        if (s >= 0) {
                            const float* kr = kbase + (size_t)s * CD_IN;
                            const float* vr = vbase + (size_t)s * CD_IN;
                            float d = 0.f;
#pragma unroll
                            for (int i = 0; i < 64; ++i) d = fmaf(q[i], kr[i], d);
                            const float lg = d * 0.125f + biasTab[h * 129 + (dist > 128 ? 128 : dist)];
                            const float pw = expf(lg - m);
                            l += pw;
#pragma unroll
                            for (int i = 0; i < 64; ++i) O[i] = fmaf(pw, vr[i], O[i]);
                        }
                    }
                }
                const float inv = 1.f / l;
                float* orow = out + (rowbase + t) * DM + h * 64;
#pragma unroll
                for (int i = 0; i < 64; ++i) orow[i] = O[i] * inv;
            } else {
                float q[64], O[64];
                const float* qr = proj + (rowbase + t) * CD_IN + 1536 + h * 64;
#pragma unroll
                for (int i = 0; i < 64; ++i) q[i] = qr[i];
                const float* Fb = F + (size_t)bh * SEQ;
                const float Ft = Fb[t];
                causal_softmax_row<64>(q, proj + rowbase * CD_IN + 2048 + h * 64, proj + rowbase * CD_IN + 2560 + h * 64, CD_IN, t, smax, 0.125f,
                                       [=](int s) { return Ft - Fb[s]; }, O);
                float* orow = out + (rowbase + t) * DM + 512 + h * 64;
#pragma unroll
                for (int i = 0; i < 64; ++i) orow[i] = O[i];
            }
        }
    }
}

__device__ __forceinline__ void ln_residual_naive(const Ctx& c, const float* hin, const float* add, const float* g, const float* bta, float* out) {
    for (int t = c.gwave; t < NT; t += c.nwaves) {
        float v[16];
        float s = 0.f;
#pragma unroll
        for (int r = 0; r < 4; ++r) {
            const int d = r * 256 + c.lane * 4;
            const float4 a = *(const float4*)(hin + (size_t)t * DM + d), m = *(const float4*)(add + (size_t)t * DM + d);
            v[r * 4 + 0] = DN_ALPHA * a.x + m.x; v[r * 4 + 1] = DN_ALPHA * a.y + m.y; v[r * 4 + 2] = DN_ALPHA * a.z + m.z; v[r * 4 + 3] = DN_ALPHA * a.w + m.w;
            s += v[r * 4] + v[r * 4 + 1] + v[r * 4 + 2] + v[r * 4 + 3];
        }
        const float mu = wave_sum(s) * (1.f / DM);
        float q = 0.f;
#pragma unroll
        for (int i = 0; i < 16; ++i) { v[i] -= mu; q = fmaf(v[i], v[i], q); }
        const float rs = rsqrtf(wave_sum(q) * (1.f / DM) + LN_EPS);
#pragma unroll
        for (int r = 0; r < 4; ++r) {
            const int d = r * 256 + c.lane * 4;
            const float4 gg = *(const float4*)(g + d), bb = *(const float4*)(bta + d);
            *(float4*)(out + (size_t)t * DM + d) = make_float4(v[r * 4] * rs * gg.x + bb.x, v[r * 4 + 1] * rs * gg.y + bb.y, v[r * 4 + 2] * rs * gg.z + bb.z, v[r * 4 + 3] * rs * gg.w + bb.w);
        }
    }
}

__device__ __forceinline__ void topk_insert(float (&tv)[16], int (&ti)[16], float v, int id) {
#pragma unroll
    for (int j = 15; j >= 1; --j) {
        const bool g = v > tv[j], gp = v > tv[j - 1];
        tv[j] = g ? (gp ? tv[j - 1] : v) : tv[j];
        ti[j] = g ? (gp ? ti[j - 1] : id) : ti[j];
    }
    const bool g0 = v > tv[0];
    tv[0] = g0 ? v : tv[0]; ti[0] = g0 ? id : ti[0];
}

__device__ __forceinline__ void peer_stage1_naive(const Ctx& c, const float* pq, const float* subk  , float* lv, int* li) {
    const int ntask = (NT / 64) * 16;
    for (int task = c.gwave; task < ntask; task += c.nwaves) {
        const int hc = task & 15, t = (task >> 4) * 64 + c.lane;
        float q[128];
        const float* qr = pq + (size_t)t * PEER_QW + hc * 128;
#pragma unroll
        for (int i = 0; i < 128; i += 4) { const float4 v = *(const float4*)(qr + i); q[i] = v.x; q[i + 1] = v.y; q[i + 2] = v.z; q[i + 3] = v.w; }
        float tv[16]; int ti[16];
#pragma unroll
        for (int j = 0; j < 16; ++j) { tv[j] = -INFINITY; ti[j] = 0; }
        for (int k = 0; k < 128; ++k) {
            const float* kr = subk + ((size_t)hc * 128 + k) * 128;
            float d = 0.f;
#pragma unroll
            for (int i = 0; i < 128; ++i) d = fmaf(q[i], kr[i], d);
            topk_insert(tv, ti, d, k);
        }
        float* ov = lv + ((size_t)t * 16 + hc) * 16; int* oi = li + ((size_t)t * 16 + hc) * 16;
#pragma unroll
        for (int j = 0; j < 16; ++j) { ov[j] = tv[j]; oi[j] = ti[j]; }
    }
}

__device__ __forceinline__ void peer_stage2_naive(const Ctx& c, const float* lv, const int* li, int* eidx, float* gate) {
    const int ntask = (NT / 64) * 8;
    for (int task = c.gwave; task < ntask; task += c.nwaves) {
        const int h = task & 7, t = (task >> 3) * 64 + c.lane;
        const float* av = lv + ((size_t)t * 16 + h * 2) * 16; const int* ai = li + ((size_t)t * 16 + h * 2) * 16;
        float tv[16]; int ti[16];
#pragma unroll
        for (int j = 0; j < 16; ++j) { tv[j] = -INFINITY; ti[j] = 0; }
#pragma unroll 1
        for (int ij = 0; ij < 256; ++ij) {
            const int i = ij >> 4, jj = ij & 15;
            topk_insert(tv, ti, av[i] + av[16 + jj], ai[i] * 128 + ai[16 + jj]);
        }
        float sum = 0.f, e[16];
#pragma unroll
        for (int j = 0; j < 16; ++j) { e[j] = expf(tv[j] - tv[0]); sum += e[j]; }
        const float inv = 1.f / sum;
        int* oi = eidx + ((size_t)t * 8 + h) * 16; float* og = gate + ((size_t)t * 8 + h) * 16;
#pragma unroll
        for (int j = 0; j < 16; ++j) { oi[j] = ti[j]; og[j] = e[j] * inv; }
    }
}

__device__ __forceinline__ void peer_gather_naive(const Ctx& c, const float* h1, const int* eidx, const float* gate, const float* U, const float* V, const float* g, const float* bta, float* out) {
    for (int t = c.gwave; t < NT; t += c.nwaves) {
        float x[16], acc[16];
#pragma unroll
        for (int r = 0; r < 4; ++r) {
            const float4 a = *(const float4*)(h1 + (size_t)t * DM + r * 256 + c.lane * 4);
            x[r * 4] = a.x; x[r * 4 + 1] = a.y; x[r * 4 + 2] = a.z; x[r * 4 + 3] = a.w;
            acc[r * 4] = 0.f; acc[r * 4 + 1] = 0.f; acc[r * 4 + 2] = 0.f; acc[r * 4 + 3] = 0.f;
        }
        for (int k = 0; k < 128; ++k) {
            const int e = eidx[(size_t)t * 128 + k];
            const float gk = gate[(size_t)t * 128 + k];
            const float* ur = U + (size_t)e * DM;
            float d = 0.f;
#pragma unroll
            for (int r = 0; r < 4; ++r) {
                const float4 u = *(const float4*)(ur + r * 256 + c.lane * 4);
                d = fmaf(u.x, x[r * 4], d); d = fmaf(u.y, x[r * 4 + 1], d); d = fmaf(u.z, x[r * 4 + 2], d); d = fmaf(u.w, x[r * 4 + 3], d);
            }
            d = wave_sum(d);
            const float act = 0.5f * d * (1.f + erff(d * 0.70710678118654752f));
            const float cf = gk * act;
            const float* vr = V + (size_t)e * DM;
#pragma unroll
            for (int r = 0; r < 4; ++r) {
                const float4 v = *(const float4*)(vr + r * 256 + c.lane * 4);
                acc[r * 4] = fmaf(cf, v.x, acc[r * 4]); acc[r * 4 + 1] = fmaf(cf, v.y, acc[r * 4 + 1]); acc[r * 4 + 2] = fmaf(cf, v.z, acc[r * 4 + 2]); acc[r * 4 + 3] = fmaf(cf, v.w, acc[r * 4 + 3]);
            }
        }
        float s = 0.f;
#pragma unroll
        for (int i = 0; i < 16; ++i) { acc[i] = DN_ALPHA * x[i] + acc[i]; s += acc[i]; }
        const float mu = wave_sum(s) * (1.f / DM);
        float q = 0.f;
#pragma unroll
        for (int i = 0; i < 16; ++i) { acc[i] -= mu; q = fmaf(acc[i], acc[i], q); }
        const float rs = rsqrtf(wave_sum(q) * (1.f / DM) + LN_EPS);
#pragma unroll
        for (int r = 0; r < 4; ++r) {
            const int d = r * 256 + c.lane * 4;
            const float4 gg = *(const float4*)(g + d), bb = *(const float4*)(bta + d);
            *(float4*)(out + (size_t)t * DM + d) = make_float4(acc[r * 4] * rs * gg.x + bb.x, acc[r * 4 + 1] * rs * gg.y + bb.y, acc[r * 4 + 2] * rs * gg.z + bb.z, acc[r * 4 + 3] * rs * gg.w + bb.w);
        }
    }
}

extern __shared__ __attribute__((aligned(16))) unsigned char dyn_lds[];
__device__ __forceinline__ Ctx make_ctx(const Args* a) {
    Ctx c; c.a = a; c.tid = threadIdx.x; c.lane = threadIdx.x & 63; c.wave = threadIdx.x >> 6;
    c.gwave = blockIdx.x * NWAVES + c.wave; c.nwaves = gridDim.x * NWAVES; c.lds = (float*)(dyn_lds + 64);
    return c;
}
struct Ptrs { float *PROJ, *ATT, *MIX, *H1, *H2, *FF, *PQ, *LV, *GATE; int *LI, *EIDX; };
__device__ __forceinline__ Ptrs make_ptrs(const Args& args) {
    Ptrs p;
    p.PROJ = (float*)(args.ws + WS_PROJ); p.ATT = (float*)(args.ws + WS_ATT); p.MIX = (float*)(args.ws + WS_MIX);
    p.H1 = (float*)(args.ws + WS_H1); p.H2 = (float*)(args.ws + WS_H2); p.FF = (float*)(args.ws + WS_F);
    p.PQ = p.PROJ; p.LV = p.ATT; p.LI = (int*)(p.ATT + (size_t)NT * 256); p.EIDX = (int*)p.MIX; p.GATE = p.MIX + (size_t)NT * 128;
    return p;
}
__global__ void __launch_bounds__(NTHREADS, 2) k_gemm(Args args, int layer, int which) {
    Ctx c = make_ctx(&args); Ptrs p = make_ptrs(args);
    const float* hin = layer == 0 ? args.in[0] : p.H2;
    const float* A; const float* W; float* C; int n;
    if (which == 0) { A = hin; W = layer == 0 ? args.in[2] : args.in[6]; n = layer == 0 ? AB_IN : CD_IN; C = p.PROJ; }
    else if (which == 1) { A = p.ATT; W = layer == 0 ? args.in[5] : args.in[8]; n = DM; C = p.MIX; }
    else { A = p.H1; W = args.in[9] + (size_t)layer * DM * PEER_QW; n = PEER_QW; C = p.PQ; }
    gemm_naive(c, A, DM, W, n, C, n, NT, n, DM);
}
__global__ void __launch_bounds__(NTHREADS, 2) k_attn0(Args args) { Ctx c = make_ctx(&args); Ptrs p = make_ptrs(args); attn_layer0_naive(c, p.PROJ, p.ATT); }
__global__ void __launch_bounds__(NTHREADS, 2) k_fscan(Args args) { Ctx c = make_ctx(&args); Ptrs p = make_ptrs(args); fscan_naive(c, p.PROJ, p.FF); }
__global__ void __launch_bounds__(NTHREADS, 2) k_attn1(Args args) { Ctx c = make_ctx(&args); Ptrs p = make_ptrs(args); attn_layer1_naive(c, p.PROJ, p.FF, p.ATT); }
__global__ void __launch_bounds__(NTHREADS, 2) k_ln1(Args args, int layer) {
    Ctx c = make_ctx(&args); Ptrs p = make_ptrs(args);
    const float* hin = layer == 0 ? args.in[0] : p.H2;
    ln_residual_naive(c, hin, p.MIX, args.in[13] + (size_t)layer * 2 * DM, args.in[14] + (size_t)layer * 2 * DM, p.H1);
}
__global__ void __launch_bounds__(NTHREADS, 2) k_stage1(Args args, int layer) { Ctx c = make_ctx(&args); Ptrs p = make_ptrs(args); peer_stage1_naive(c, p.PQ, args.in[10] + (size_t)layer * 16 * 128 * 128, p.LV, p.LI); }
__global__ void __launch_bounds__(NTHREADS, 2) k_stage2(Args args) { Ctx c = make_ctx(&args); Ptrs p = make_ptrs(args); peer_stage2_naive(c, p.LV, p.LI, p.EIDX, p.GATE); }
__global__ void __launch_bounds__(NTHREADS, 2) k_gather(Args args, int layer) {
    Ctx c = make_ctx(&args); Ptrs p = make_ptrs(args);
    float* hout = layer == 0 ? p.H2 : args.out;
    peer_gather_naive(c, p.H1, p.EIDX, p.GATE, args.in[11] + (size_t)layer * 16384 * DM, args.in[12] + (size_t)layer * 16384 * DM,
                      args.in[13] + (size_t)(layer * 2 + 1) * DM, args.in[14] + (size_t)(layer * 2 + 1) * DM, hout);
}

extern "C" void kernel_launch(void* const* d_in, const int* in_sizes, int n_in, void* d_out, int out_size, void* d_ws, size_t ws_size, hipStream_t stream) {
    (void)in_sizes; (void)n_in; (void)out_size;
    constexpr size_t kDynLds = 32 * 1024;
    const int grid = 256 * 2;
    if (ws_size < WS_END) fprintf(stderr, "workspace too small: %zu < %zu\n", ws_size, (size_t)WS_END);
    Args a{};
    for (int i = 0; i < 15; ++i) a.in[i] = (const float*)d_in[i];
    a.out = (float*)d_out; a.ws = (unsigned char*)d_ws; a.ph_lo = 0; a.ph_hi = 0;
    for (int layer = 0; layer < 2; ++layer) {
        hipLaunchKernelGGL(k_gemm, dim3(grid), dim3(NTHREADS), kDynLds, stream, a, layer, 0);
        if (layer == 0) hipLaunchKernelGGL(k_attn0, dim3(grid), dim3(NTHREADS), kDynLds, stream, a);
        else { hipLaunchKernelGGL(k_fscan, dim3(grid), dim3(NTHREADS), kDynLds, stream, a); hipLaunchKernelGGL(k_attn1, dim3(grid), dim3(NTHREADS), kDynLds, stream, a); }
        hipLaunchKernelGGL(k_gemm, dim3(grid), dim3(NTHREADS), kDynLds, stream, a, layer, 1);
        hipLaunchKernelGGL(k_ln1, dim3(grid), dim3(NTHREADS), kDynLds, stream, a, layer);
        hipLaunchKernelGGL(k_gemm, dim3(grid), dim3(NTHREADS), kDynLds, stream, a, layer, 2);
        hipLaunchKernelGGL(k_stage1, dim3(grid), dim3(NTHREADS), kDynLds, stream, a, layer);
        hipLaunchKernelGGL(k_stage2, dim3(grid), dim3(NTHREADS), kDynLds, stream, a);
        hipLaunchKernelGGL(k_gather, dim3(grid), dim3(NTHREADS), kDynLds, stream, a, layer);
    }
}
```

```cpp
#include <hip/hip_runtime.h>
#include <cstdio>
#include <cstdint>
#include <cmath>

#ifndef MK_ONE_LAUNCH
#define MK_ONE_LAUNCH 1
#endif

constexpr int BATCH = 4, SEQ = 4096, DM = 1024, NT = BATCH * SEQ;
constexpr int NH = 8, HD = 64;
constexpr int AB_IN = 3072, CD_IN = 3080;
constexpr int PEER_H = 8, PEER_NK = 128, PEER_TOPK = 16, PEER_QW = 2048;
constexpr float DN_ALPHA = 1.4142135623730951f;
constexpr float LN_EPS = 1e-5f;
constexpr int NTHREADS = 512, NWAVES = 8;

constexpr size_t MiB = 1u << 20;
constexpr size_t WS_CTL = 0;
constexpr size_t WS_PROJ = 1 * MiB;
constexpr size_t WS_ATT = 209 * MiB;
constexpr size_t WS_MIX = 273 * MiB;
constexpr size_t WS_H1 = 337 * MiB;
constexpr size_t WS_H2 = 401 * MiB;
constexpr size_t WS_F = 465 * MiB;
constexpr size_t WS_END = 466 * MiB;

#define XB_TMO      128
#define XB_XCNT(j)  (256  + 64 * (j))
#define XB_XSUB(j)  (1280 + 64 * (j))
#define XB_XGEN(j)  (2304 + 64 * (j))
#define XB_TOP      3328
#define XB_TOPGEN   3392
#define XCD_BAR_WORDS 3456
#define XB_SPIN_CAP (1u << 18)
#define LAS __attribute__((address_space(3)))

__device__ __forceinline__ unsigned xb_ld(unsigned* p)              { return __hip_atomic_load(p, __ATOMIC_RELAXED, __HIP_MEMORY_SCOPE_AGENT); }
__device__ __forceinline__ unsigned xb_add(unsigned* p, unsigned v) { return __hip_atomic_fetch_add(p, v, __ATOMIC_RELAXED, __HIP_MEMORY_SCOPE_AGENT); }
__device__ __forceinline__ unsigned xb_xcc_id() { return (unsigned)__builtin_amdgcn_s_getreg((3 << 11) | 20) & 0xFu; }
#define XB_SPIN(cond, bar) do { unsigned _sp = 0; while (cond) { __builtin_amdgcn_s_sleep(1); \
    if ((++_sp & 255u) == 0u) { if (xb_ld(&(bar)[XB_TMO])) break; if (_sp > XB_SPIN_CAP) { atomicAdd(&(bar)[XB_TMO], 1u); break; } } } } while (0)

struct XcdBarrier {
    unsigned* bar; unsigned x;
    volatile LAS unsigned* st;
};
__device__ __forceinline__ XcdBarrier xcd_barrier_post(unsigned* bar, volatile LAS unsigned* st) {
    XcdBarrier b; b.bar = bar; b.x = xb_xcc_id(); b.st = st;
    if (threadIdx.x == 0) (void)xb_add(&bar[XB_XCNT(b.x)], 1u);
    return b;
}
__device__ __forceinline__ void xcd_barrier_complete(unsigned* bar, unsigned x, unsigned& nloc, unsigned& nx) {
    const unsigned G = gridDim.x * gridDim.y * gridDim.z;
    unsigned sum, cnt, mine, sp = 0u;
    for (;;) {
        sum = 0u; cnt = 0u; mine = 0u;
#pragma unroll
        for (unsigned j = 0; j < 16; ++j) { const unsigned c = xb_ld(&bar[XB_XCNT(j)]); sum += c; cnt += (c > 0u) ? 1u : 0u; mine = (j == x) ? c : mine; }
        if (sum == G) break;
        __builtin_amdgcn_s_sleep(1);
        if ((++sp & 255u) == 0u) { if (xb_ld(&bar[XB_TMO])) break; if (sp > XB_SPIN_CAP) { atomicAdd(&bar[XB_TMO], 1u); break; } }
    }
    nloc = mine > 0u ? mine : 1u; nx = cnt > 0u ? cnt : 1u;
}
__device__ __forceinline__ void xcd_barrier(const XcdBarrier& b) {
    asm volatile("s_waitcnt vmcnt(0)" ::: "memory");
    __syncthreads();
    if (threadIdx.x == 0) {
        unsigned* bar = b.bar;
        __builtin_amdgcn_s_waitcnt(0);
        unsigned nloc = b.st[0], nx = b.st[1];
        if (nloc == 0u) { xcd_barrier_complete(bar, b.x, nloc, nx); b.st[0] = nloc; b.st[1] = nx; }
        const unsigned old = xb_add(&bar[XB_XSUB(b.x)], 1u);
        const unsigned gen = old / nloc;
        if (old + 1u == (gen + 1u) * nloc) {
            __builtin_amdgcn_fence(__ATOMIC_RELEASE, "agent");
            asm volatile("s_waitcnt vmcnt(0)" ::: "memory");
            const unsigned og = xb_add(&bar[XB_TOP], 1u);
            const unsigned tg = og / nx;
            if (og + 1u == (tg + 1u) * nx) xb_add(&bar[XB_TOPGEN], 1u);
            else XB_SPIN(xb_ld(&bar[XB_TOPGEN]) == tg, bar);
            __builtin_amdgcn_fence(__ATOMIC_ACQUIRE, "agent");
            xb_add(&bar[XB_XGEN(b.x)], 1u);
            asm volatile("s_waitcnt vmcnt(0)" ::: "memory");
        } else {
            XB_SPIN(xb_ld(&bar[XB_XGEN(b.x)]) == gen, bar);
            __builtin_amdgcn_fence(__ATOMIC_ACQUIRE, "agent");
            asm volatile("s_waitcnt vmcnt(0)" ::: "memory");
        }
    }
    __syncthreads();
}

struct Args {
    const float* in[15];
    float* out;
    unsigned char* ws;
    int ph_lo, ph_hi;
};

struct Ctx {
    const Args* a;
    int tid, lane, wave, gwave, nwaves;
    float* lds;
};

__device__ __forceinline__ float wave_sum(float v) {
#pragma unroll
    for (int o = 32; o >= 1; o >>= 1) v += __shfl_xor(v, o);
    return v;
}
__device__ __forceinline__ float log_sigmoid(float z) { return fminf(z, 0.f) - log1pf(expf(-fabsf(z))); }
__device__ __forceinline__ int t5_bucket(int n) {
    if (n < 16) return n;
    int large = 16 + (int)(logf((float)n / 16.f) / 2.0794415416798357f * 16.f);
    return large < 31 ? large : 31;
}

__device__ __forceinline__ void gemm_naive(const Ctx& c, const float* A, int lda, const float* W, int ldw, float* C, int ldc, int M, int N, int K) {
    float* As = c.lds;
    float* Bs = c.lds + 16 * 132;
    const int tid = c.tid, tx = tid & 31, ty = tid >> 5;
    const int ntn = (N + 127) / 128, ntm = M / 128, ntiles = ntn * ntm;
    for (int tile = c.gwave / NWAVES; tile < ntiles; tile += c.nwaves / NWAVES) {
        const int m0 = (tile / ntn) * 128, n0 = (tile % ntn) * 128;
        float acc[8][4];
#pragma unroll
        for (int i = 0; i < 8; ++i)
#pragma unroll
            for (int j = 0; j < 4; ++j) acc[i][j] = 0.f;
        for (int k0 = 0; k0 < K; k0 += 16) {
            {
                const int row = tid >> 2, k4 = (tid & 3) * 4;
                const float4 v = *(const float4*)(A + (size_t)(m0 + row) * lda + k0 + k4);
                As[(k4 + 0) * 132 + row] = v.x; As[(k4 + 1) * 132 + row] = v.y; As[(k4 + 2) * 132 + row] = v.z; As[(k4 + 3) * 132 + row] = v.w;
                const int kk = tid >> 5, c4 = (tid & 31) * 4;
                float4 w = make_float4(0.f, 0.f, 0.f, 0.f);
                if (n0 + c4 < N) w = *(const float4*)(W + (size_t)(k0 + kk) * ldw + n0 + c4);
                *(float4*)(Bs + kk * 132 + c4) = w;
            }
            __syncthreads();
#pragma unroll
            for (int kk = 0; kk < 16; ++kk) {
                const float4 a0 = *(const float4*)(As + kk * 132 + ty * 8), a1 = *(const float4*)(As + kk * 132 + ty * 8 + 4);
                const float4 b = *(const float4*)(Bs + kk * 132 + tx * 4);
                const float av[8] = {a0.x, a0.y, a0.z, a0.w, a1.x, a1.y, a1.z, a1.w};
                const float bv[4] = {b.x, b.y, b.z, b.w};
#pragma unroll
                for (int i = 0; i < 8; ++i)
#pragma unroll
                    for (int j = 0; j < 4; ++j) acc[i][j] = fmaf(av[i], bv[j], acc[i][j]);
            }
            __syncthreads();
        }
        if (n0 + tx * 4 < N) {
#pragma unroll
            for (int i = 0; i < 8; ++i)
                *(float4*)(C + (size_t)(m0 + ty * 8 + i) * ldc + n0 + tx * 4) = make_float4(acc[i][0], acc[i][1], acc[i][2], acc[i][3]);
        }
    }
}

template <int DQ, class BiasF>
__device__ __forceinline__ void causal_softmax_row(const float (&q)[DQ], const float* kbase, const float* vbase, int ld, int t, int smax, float scale, BiasF biasf, float (&O)[64]) {
    float m = -INFINITY;
    for (int s = 0; s <= smax; ++s) {
        const float* kr = kbase + (size_t)s * ld;
        float d = 0.f;
#pragma unroll
        for (int i = 0; i < DQ; ++i) d = fmaf(q[i], kr[i], d);
        const float lg = d * scale + biasf(s);
        m = (s <= t) ? fmaxf(m, lg) : m;
    }
    float l = 0.f;
#pragma unroll
    for (int i = 0; i < 64; ++i) O[i] = 0.f;
    for (int s = 0; s <= smax; ++s) {
        const float* kr = kbase + (size_t)s * ld;
        const float* vr = vbase + (size_t)s * ld;
        float d = 0.f;
#pragma unroll
        for (int i = 0; i < DQ; ++i) d = fmaf(q[i], kr[i], d);
        const float lg = d * scale + biasf(s);
        const float p = (s <= t) ? expf(lg - m) : 0.f;
        l += p;
#pragma unroll
        for (int i = 0; i < 64; ++i) O[i] = fmaf(p, vr[i], O[i]);
    }
    const float inv = 1.f / l;
#pragma unroll
    for (int i = 0; i < 64; ++i) O[i] *= inv;
}

__device__ __forceinline__ void attn_layer0_naive(const Ctx& c, const float* proj, float* out, const float* t5, const float* lamv, const float* subg) {
    float* biasTab = c.lds;
    for (int i = c.tid; i < 8 * 129; i += NTHREADS) { const int h = i / 129, d = i % 129; biasTab[i] = t5[t5_bucket(d) * 8 + h]; }
    __syncthreads();
    float s01 = 0.f, s23 = 0.f;
    for (int i = 0; i < 32; ++i) { s01 += lamv[i] * lamv[32 + i]; s23 += lamv[64 + i] * lamv[96 + i]; }
    const float lambda_init = 0.2f;
    const float lam = expf(s01) - expf(s23) + lambda_init;
    const int lane = c.lane;
    for (int task = c.gwave; task < 2 * 32 * 32; task += c.nwaves) {
        const int p = task & 31, bh = (task >> 5) & 31, type = task >> 10;
        const int b = bh >> 3, h = bh & 7;
        for (int half = 0; half < 2; ++half) {
            const int tb = half ? 63 - p : p;
            const int t = tb * 64 + lane, smax = tb * 64 + 63;
            const size_t rowbase = (size_t)b * SEQ;
            if (type == 0) {
                float* orow = out + (rowbase + t) * DM + h * 64;
                {
                    float res0[64];
                    float q[32];
                    const float* qr = proj + (rowbase + t) * AB_IN + h * 64;
#pragma unroll
                    for (int i = 0; i < 32; ++i) q[i] = qr[i];
                    causal_softmax_row<32>(q, proj + rowbase * AB_IN + 512 + h * 64, proj + rowbase * AB_IN + 1024 + h * 64, AB_IN, t, smax, 0.17677669529663687f,
                                           [=](int s) { int d = t - s; d = d < 0 ? 0 : (d > 128 ? 128 : d); return biasTab[h * 129 + d]; }, res0);
#pragma unroll
                    for (int i = 0; i < 64; ++i) orow[i] = res0[i];
                }
                float res1[64];
                {
                    float q[32];
                    const float* qr = proj + (rowbase + t) * AB_IN + h * 64 + 32;
#pragma unroll
                    for (int i = 0; i < 32; ++i) q[i] = qr[i];
                    causal_softmax_row<32>(q, proj + rowbase * AB_IN + 512 + h * 64 + 32, proj + rowbase * AB_IN + 1024 + h * 64, AB_IN, t, smax, 0.17677669529663687f,
                                           [=](int s) { int d = t - s; d = d < 0 ? 0 : (d > 128 ? 128 : d); return biasTab[h * 129 + d]; }, res1);
                }
                float ms = 0.f;
#pragma unroll
                for (int i = 0; i < 64; ++i) { res1[i] = orow[i] - lam * res1[i]; ms = fmaf(res1[i], res1[i], ms); }
                const float r = rsqrtf(ms * (1.f / 64.f) + LN_EPS) * (1.f - lambda_init);
#pragma unroll
                for (int i = 0; i < 64; ++i) orow[i] = res1[i] * r * subg[i];
            } else {
                float q[64], O[64];
                const float* qr = proj + (rowbase + t) * AB_IN + 1536 + h * 64;
#pragma unroll
                for (int i = 0; i < 64; ++i) { q[i] = qr[i]; O[i] = 0.f; }
                const float* kbase = proj + rowbase * AB_IN + 2048 + h * 64;
                const float* vbase = proj + rowbase * AB_IN + 2560 + h * 64;
                float R = 0.f;
                for (int s = smax - 1; s >= 0; --s) {
                    const float* kr = kbase + (size_t)s * AB_IN;
                    const float* vr = vbase + (size_t)s * AB_IN;
                    float d = 0.f;
#pragma unroll
                    for (int i = 0; i < 64; ++i) d = fmaf(q[i], kr[i], d);
                    const float z = d * 0.125f;
                    const float lb = log_sigmoid(z), lr = lb - z;
                    const bool past = s < t;
                    const float w = past ? expf(lb + R) : 0.f;
                    R += past ? lr : 0.f;
#pragma unroll
                    for (int i = 0; i < 64; ++i) O[i] = fmaf(w, vr[i], O[i]);
                    if (__all(R < -150.f)) break;
                }
                float* orow = out + (rowbase + t) * DM + 512 + h * 64;
#pragma unroll
                for (int i = 0; i < 64; ++i) orow[i] = O[i];
            }
        }
    }
}

__device__ __forceinline__ void fscan_naive(const Ctx& c, const float* proj, float* F, const float* bf) {
    for (int task = c.gwave; task < 32; task += c.nwaves) {
        const int b = task >> 3, h = task & 7;
        const int lane = c.lane;
        float v[64]; float tot = 0.f;
#pragma unroll
        for (int i = 0; i < 64; ++i) { const int s = lane * 64 + i; v[i] = log_sigmoid(proj[((size_t)b * SEQ + s) * CD_IN + 3072 + h] + bf[h]); tot += v[i]; }
        float incl = tot;
#pragma unroll
        for (int o = 1; o < 64; o <<= 1) { const float n = __shfl_up(incl, o); if (lane >= o) incl += n; }
        float run = incl - tot;
#pragma unroll
        for (int i = 0; i < 64; ++i) { run += v[i]; F[(size_t)task * SEQ + lane * 64 + i] = run; }
    }
}

__device__ __forceinline__ void attn_layer1_naive(const Ctx& c, const float* proj, const float* F, float* out, const float* t5) {
    float* biasTab = c.lds;
    for (int i = c.tid; i < 8 * 129; i += NTHREADS) { const int h = i / 129, d = i % 129; biasTab[i] = t5[t5_bucket(d) * 8 + h]; }
    __syncthreads();
    const int lane = c.lane;
    for (int task = c.gwave; task < 2 * 32 * 32; task += c.nwaves) {
        const int p = task & 31, bh = (task >> 5) & 31, type = task >> 10;
        const int b = bh >> 3, h = bh & 7;
        for (int half = 0; half < 2; ++half) {
            const int tb = half ? 63 - p : p;
            const int t = tb * 64 + lane, smax = tb * 64 + 63;
            const size_t rowbase = (size_t)b * SEQ;
            if (type == 0) {
                float q[64], O[64];
                const float* qr = proj + (rowbase + t) * CD_IN + h * 64;
#pragma unroll
                for (int i = 0; i < 64; ++i) { q[i] = qr[i]; O[i] = 0.f; }
                const float* kbase = proj + rowbase * CD_IN + 512 + h * 64;
                const float* vbase = proj + rowbase * CD_IN + 1024 + h * 64;
                float m = -INFINITY;
                for (int pat = 0; pat < 3; ++pat) {
                    const int dil = pat == 0 ? 1 : (pat == 1 ? 4 : 16);
                    for (int j = 0; j <= 128; ++j) {
                        const int dist = j * dil, s = t - dist;
                        if (s >= 0) {
                            const float* kr = kbase + (size_t)s * CD_IN;
                            float d = 0.f;
#pragma unroll
                            for (int i = 0; i < 64; ++i) d = fmaf(q[i], kr[i], d);
                            const float lg = d * 0.125f + biasTab[h * 129 + (dist > 128 ? 128 : dist)];
                            m = fmaxf(m, lg);
                        }
                    }
                }
                float l = 0.f;
                for (int pat = 0; pat < 3; ++pat) {
                    const int dil = pat == 0 ? 1 : (pat == 1 ? 4 : 16);
                    for (int j = 0; j <= 128; ++j) {
                        const int dist = j * dil, s = t - dist;
                        if (s >= 0) {
                            const float* kr = kbase + (size_t)s * CD_IN;
                            const float* vr = vbase + (size_t)s * CD_IN;
                            float d = 0.f;
#pragma unroll
                            for (int i = 0; i < 64; ++i) d = fmaf(q[i], kr[i], d);
                            const float lg = d * 0.125f + biasTab[h * 129 + (dist > 128 ? 128 : dist)];
                            const float pw = expf(lg - m);
                            l += pw;
#pragma unroll
                            for (int i = 0; i < 64; ++i) O[i] = fmaf(pw, vr[i], O[i]);
                        }
                    }
                }
                const float inv = 1.f / l;
                float* orow = out + (rowbase + t) * DM + h * 64;
#pragma unroll
                for (int i = 0; i < 64; ++i) orow[i] = O[i] * inv;
            } else {
                float q[64], O[64];
                const float* qr = proj + (rowbase + t) * CD_IN + 1536 + h * 64;
#pragma unroll
                for (int i = 0; i < 64; ++i) q[i] = qr[i];
                const float* Fb = F + (size_t)bh * SEQ;
                const float Ft = Fb[t];
                causal_softmax_row<64>(q, proj + rowbase * CD_IN + 2048 + h * 64, proj + rowbase * CD_IN + 2560 + h * 64, CD_IN, t, smax, 0.125f,
                                       [=](int s) { return Ft - Fb[s]; }, O);
                float* orow = out + (rowbase + t) * DM + 512 + h * 64;
#pragma unroll
                for (int i = 0; i < 64; ++i) orow[i] = O[i];
            }
        }
    }
}

__device__ __forceinline__ void ln_residual_naive(const Ctx& c, const float* hin, const float* add, const float* g, const float* bta, float* out) {
    for (int t = c.gwave; t < NT; t += c.nwaves) {
        float v[16];
        float s = 0.f;
#pragma unroll
        for (int r = 0; r < 4; ++r) {
            const int d = r * 256 + c.lane * 4;
            const float4 a = *(const float4*)(hin + (size_t)t * DM + d), m = *(const float4*)(add + (size_t)t * DM + d);
            v[r * 4 + 0] = DN_ALPHA * a.x + m.x; v[r * 4 + 1] = DN_ALPHA * a.y + m.y; v[r * 4 + 2] = DN_ALPHA * a.z + m.z; v[r * 4 + 3] = DN_ALPHA * a.w + m.w;
            s += v[r * 4] + v[r * 4 + 1] + v[r * 4 + 2] + v[r * 4 + 3];
        }
        const float mu = wave_sum(s) * (1.f / DM);
        float q = 0.f;
#pragma unroll
        for (int i = 0; i < 16; ++i) { v[i] -= mu; q = fmaf(v[i], v[i], q); }
        const float rs = rsqrtf(wave_sum(q) * (1.f / DM) + LN_EPS);
#pragma unroll
        for (int r = 0; r < 4; ++r) {
            const int d = r * 256 + c.lane * 4;
            const float4 gg = *(const float4*)(g + d), bb = *(const float4*)(bta + d);
            *(float4*)(out + (size_t)t * DM + d) = make_float4(v[r * 4] * rs * gg.x + bb.x, v[r * 4 + 1] * rs * gg.y + bb.y, v[r * 4 + 2] * rs * gg.z + bb.z, v[r * 4 + 3] * rs * gg.w + bb.w);
        }
    }
}

__device__ __forceinline__ void topk_insert(float (&tv)[16], int (&ti)[16], float v, int id) {
#pragma unroll
    for (int j = 15; j >= 1; --j) {
        const bool g = v > tv[j], gp = v > tv[j - 1];
        tv[j] = g ? (gp ? tv[j - 1] : v) : tv[j];
        ti[j] = g ? (gp ? ti[j - 1] : id) : ti[j];
    }
    const bool g0 = v > tv[0];
    tv[0] = g0 ? v : tv[0]; ti[0] = g0 ? id : ti[0];
}

__device__ __forceinline__ void peer_stage1_naive(const Ctx& c, const float* pq, const float* subk  , float* lv, int* li) {
    const int ntask = (NT / 64) * 16;
    for (int task = c.gwave; task < ntask; task += c.nwaves) {
        const int hc = task & 15, t = (task >> 4) * 64 + c.lane;
        float q[128];
        const float* qr = pq + (size_t)t * PEER_QW + hc * 128;
#pragma unroll
        for (int i = 0; i < 128; i += 4) { const float4 v = *(const float4*)(qr + i); q[i] = v.x; q[i + 1] = v.y; q[i + 2] = v.z; q[i + 3] = v.w; }
        float tv[16]; int ti[16];
#pragma unroll
        for (int j = 0; j < 16; ++j) { tv[j] = -INFINITY; ti[j] = 0; }
        for (int k = 0; k < 128; ++k) {
            const float* kr = subk + ((size_t)hc * 128 + k) * 128;
            float d = 0.f;
#pragma unroll
            for (int i = 0; i < 128; ++i) d = fmaf(q[i], kr[i], d);
            topk_insert(tv, ti, d, k);
        }
        float* ov = lv + ((size_t)t * 16 + hc) * 16; int* oi = li + ((size_t)t * 16 + hc) * 16;
#pragma unroll
        for (int j = 0; j < 16; ++j) { ov[j] = tv[j]; oi[j] = ti[j]; }
    }
}

__device__ __forceinline__ void peer_stage2_naive(const Ctx& c, const float* lv, const int* li, int* eidx, float* gate) {
    const int ntask = (NT / 64) * 8;
    for (int task = c.gwave; task < ntask; task += c.nwaves) {
        const int h = task & 7, t = (task >> 3) * 64 + c.lane;
        const float* av = lv + ((size_t)t * 16 + h * 2) * 16; const int* ai = li + ((size_t)t * 16 + h * 2) * 16;
        float tv[16]; int ti[16];
#pragma unroll
        for (int j = 0; j < 16; ++j) { tv[j] = -INFINITY; ti[j] = 0; }
#pragma unroll 1
        for (int ij = 0; ij < 256; ++ij) {
            const int i = ij >> 4, jj = ij & 15;
            topk_insert(tv, ti, av[i] + av[16 + jj], ai[i] * 128 + ai[16 + jj]);
        }
        float sum = 0.f, e[16];
#pragma unroll
        for (int j = 0; j < 16; ++j) { e[j] = expf(tv[j] - tv[0]); sum += e[j]; }
        const float inv = 1.f / sum;
        int* oi = eidx + ((size_t)t * 8 + h) * 16; float* og = gate + ((size_t)t * 8 + h) * 16;
#pragma unroll
        for (int j = 0; j < 16; ++j) { oi[j] = ti[j]; og[j] = e[j] * inv; }
    }
}

__device__ __forceinline__ void peer_gather_naive(const Ctx& c, const float* h1, const int* eidx, const float* gate, const float* U, const float* V, const float* g, const float* bta, float* out) {
    for (int t = c.gwave; t < NT; t += c.nwaves) {
        float x[16], acc[16];
#pragma unroll
        for (int r = 0; r < 4; ++r) {
            const float4 a = *(const float4*)(h1 + (size_t)t * DM + r * 256 + c.lane * 4);
            x[r * 4] = a.x; x[r * 4 + 1] = a.y; x[r * 4 + 2] = a.z; x[r * 4 + 3] = a.w;
            acc[r * 4] = 0.f; acc[r * 4 + 1] = 0.f; acc[r * 4 + 2] = 0.f; acc[r * 4 + 3] = 0.f;
        }
        for (int k = 0; k < 128; ++k) {
            const int e = eidx[(size_t)t * 128 + k];
            const float gk = gate[(size_t)t * 128 + k];
            const float* ur = U + (size_t)e * DM;
            float d = 0.f;
#pragma unroll
            for (int r = 0; r < 4; ++r) {
                const float4 u = *(const float4*)(ur + r * 256 + c.lane * 4);
                d = fmaf(u.x, x[r * 4], d); d = fmaf(u.y, x[r * 4 + 1], d); d = fmaf(u.z, x[r * 4 + 2], d); d = fmaf(u.w, x[r * 4 + 3], d);
            }
            d = wave_sum(d);
            const float act = 0.5f * d * (1.f + erff(d * 0.70710678118654752f));
            const float cf = gk * act;
            const float* vr = V + (size_t)e * DM;
#pragma unroll
            for (int r = 0; r < 4; ++r) {
                const float4 v = *(const float4*)(vr + r * 256 + c.lane * 4);
                acc[r * 4] = fmaf(cf, v.x, acc[r * 4]); acc[r * 4 + 1] = fmaf(cf, v.y, acc[r * 4 + 1]); acc[r * 4 + 2] = fmaf(cf, v.z, acc[r * 4 + 2]); acc[r * 4 + 3] = fmaf(cf, v.w, acc[r * 4 + 3]);
            }
        }
        float s = 0.f;
#pragma unroll
        for (int i = 0; i < 16; ++i) { acc[i] = DN_ALPHA * x[i] + acc[i]; s += acc[i]; }
        const float mu = wave_sum(s) * (1.f / DM);
        float q = 0.f;
#pragma unroll
        for (int i = 0; i < 16; ++i) { acc[i] -= mu; q = fmaf(acc[i], acc[i], q); }
        const float rs = rsqrtf(wave_sum(q) * (1.f / DM) + LN_EPS);
#pragma unroll
        for (int r = 0; r < 4; ++r) {
            const int d = r * 256 + c.lane * 4;
            const float4 gg = *(const float4*)(g + d), bb = *(const float4*)(bta + d);
            *(float4*)(out + (size_t)t * DM + d) = make_float4(acc[r * 4] * rs * gg.x + bb.x, acc[r * 4 + 1] * rs * gg.y + bb.y, acc[r * 4 + 2] * rs * gg.z + bb.z, acc[r * 4 + 3] * rs * gg.w + bb.w);
        }
    }
}

extern __shared__ __attribute__((aligned(16))) unsigned char dyn_lds[];
__device__ __forceinline__ Ctx make_ctx(const Args* a) {
    int t = threadIdx.x, b = blockIdx.x, g = gridDim.x;
    asm volatile("" : "+v"(t));
    asm volatile("" : "+s"(b), "+s"(g));
    Ctx c; c.a = a; c.tid = t; c.lane = t & 63; c.wave = t >> 6;
    c.gwave = b * NWAVES + c.wave; c.nwaves = g * NWAVES; c.lds = (float*)(dyn_lds + 64);
    return c;
}
struct Ptrs { float *PROJ, *ATT, *MIX, *H1, *H2, *FF, *PQ, *LV, *GATE; int *LI, *EIDX; };
__device__ __forceinline__ Ptrs make_ptrs(const Args& args) {
    Ptrs p;
    p.PROJ = (float*)(args.ws + WS_PROJ); p.ATT = (float*)(args.ws + WS_ATT); p.MIX = (float*)(args.ws + WS_MIX);
    p.H1 = (float*)(args.ws + WS_H1); p.H2 = (float*)(args.ws + WS_H2); p.FF = (float*)(args.ws + WS_F);
    p.PQ = p.PROJ; p.LV = p.ATT; p.LI = (int*)(p.ATT + (size_t)NT * 256); p.EIDX = (int*)p.MIX; p.GATE = p.MIX + (size_t)NT * 128;
    return p;
}
__device__ __forceinline__ unsigned char* launder_ptr(unsigned char* p) {
    unsigned lo = __builtin_amdgcn_readfirstlane((unsigned)(uintptr_t)p), hi = __builtin_amdgcn_readfirstlane((unsigned)((uintptr_t)p >> 32));
    asm volatile("" : "+s"(lo), "+s"(hi));
    return (unsigned char*)(((uintptr_t)hi << 32) | (uintptr_t)lo);
}
constexpr int NPHASE = 18;
__global__ void __launch_bounds__(NTHREADS, 2) fwd(Args args) {
    unsigned* ctl = (unsigned*)(args.ws + WS_CTL);
    volatile LAS unsigned* xbw = (volatile LAS unsigned*)dyn_lds;
    if (threadIdx.x == 0) { xbw[0] = 0u; xbw[1] = 0u; xbw[2] = 0u; xbw[3] = 0u; }
    __syncthreads();
    const int lo = args.ph_lo, hi = args.ph_hi;
    XcdBarrier bar = xcd_barrier_post(ctl + 4096, xbw);
#define IN(k) (lo <= (k) && (k) < hi)
#define SEAM(k) do { if (IN(k) && IN((k) + 1)) xcd_barrier(bar); } while (0)
#define LAUNDER(ptr) ptr = launder_ptr(ptr)
#define PIN(k) ((const float*)launder_ptr((unsigned char*)args.in[k]))
#pragma unroll 1
    for (int layer = 0; layer < 2; ++layer) {
        const int pb = layer * 9;
        const int n_in = layer == 0 ? AB_IN : CD_IN;
        if (IN(pb + 0)) {
            unsigned char* ws = args.ws; LAUNDER(ws); const Ctx c = make_ctx(&args);
            const float* hin = layer == 0 ? PIN(0) : (const float*)(ws + WS_H2);
            const float* w_in = layer == 0 ? PIN(2) : PIN(6);
            gemm_naive(c, hin, DM, w_in, n_in, (float*)(ws + WS_PROJ), n_in, NT, n_in, DM);
        }
        SEAM(pb + 0);
        if (IN(pb + 1) && layer == 1) { unsigned char* ws = args.ws; LAUNDER(ws); const Ctx c = make_ctx(&args); fscan_naive(c, (const float*)(ws + WS_PROJ), (float*)(ws + WS_F), PIN(7)); }
        SEAM(pb + 1);
        if (IN(pb + 2)) {
            unsigned char* ws = args.ws; LAUNDER(ws); const Ctx c = make_ctx(&args);
            if (layer == 0) attn_layer0_naive(c, (const float*)(ws + WS_PROJ), (float*)(ws + WS_ATT), PIN(1), PIN(3), PIN(4));
            else attn_layer1_naive(c, (const float*)(ws + WS_PROJ), (const float*)(ws + WS_F), (float*)(ws + WS_ATT), PIN(1));
        }
        SEAM(pb + 2);
        if (IN(pb + 3)) {
            unsigned char* ws = args.ws; LAUNDER(ws); const Ctx c = make_ctx(&args);
            const float* w_out = layer == 0 ? PIN(5) : PIN(8);
            gemm_naive(c, (const float*)(ws + WS_ATT), DM, w_out, DM, (float*)(ws + WS_MIX), DM, NT, DM, DM);
        }
        SEAM(pb + 3);
        if (IN(pb + 4)) {
            unsigned char* ws = args.ws; LAUNDER(ws); const Ctx c = make_ctx(&args);
            const float* hin = layer == 0 ? PIN(0) : (const float*)(ws + WS_H2);
            ln_residual_naive(c, hin, (const float*)(ws + WS_MIX), PIN(13) + (size_t)layer * 2 * DM, PIN(14) + (size_t)layer * 2 * DM, (float*)(ws + WS_H1));
        }
        SEAM(pb + 4);
        if (IN(pb + 5)) {
            unsigned char* ws = args.ws; LAUNDER(ws); const Ctx c = make_ctx(&args);
            gemm_naive(c, (const float*)(ws + WS_H1), DM, PIN(9) + (size_t)layer * DM * PEER_QW, PEER_QW, (float*)(ws + WS_PROJ), PEER_QW, NT, PEER_QW, DM);
        }
        SEAM(pb + 5);
        if (IN(pb + 6)) {
            unsigned char* ws = args.ws; LAUNDER(ws); const Ctx c = make_ctx(&args);
            float* LV = (float*)(ws + WS_ATT);
            peer_stage1_naive(c, (const float*)(ws + WS_PROJ), PIN(10) + (size_t)layer * 16 * 128 * 128, LV, (int*)(LV + (size_t)NT * 256));
        }
        SEAM(pb + 6);
        if (IN(pb + 7)) {
            unsigned char* ws = args.ws; LAUNDER(ws); const Ctx c = make_ctx(&args);
            float* LV = (float*)(ws + WS_ATT); float* MIXp = (float*)(ws + WS_MIX);
            peer_stage2_naive(c, LV, (const int*)(LV + (size_t)NT * 256), (int*)MIXp, MIXp + (size_t)NT * 128);
        }
        SEAM(pb + 7);
        if (IN(pb + 8)) {
            unsigned char* ws = args.ws; LAUNDER(ws); const Ctx c = make_ctx(&args);
            float* MIXp = (float*)(ws + WS_MIX);
            float* hout = layer == 0 ? (float*)(ws + WS_H2) : (float*)launder_ptr((unsigned char*)args.out);
            peer_gather_naive(c, (const float*)(ws + WS_H1), (const int*)MIXp, MIXp + (size_t)NT * 128, PIN(11) + (size_t)layer * 16384 * DM, PIN(12) + (size_t)layer * 16384 * DM,
                              PIN(13) + (size_t)(layer * 2 + 1) * DM, PIN(14) + (size_t)(layer * 2 + 1) * DM, hout);
        }
        SEAM(pb + 8);
    }
}

extern "C" void kernel_launch(void* const* d_in, const int* in_sizes, int n_in, void* d_out, int out_size, void* d_ws, size_t ws_size, hipStream_t stream) {
    (void)in_sizes; (void)n_in; (void)out_size;
    constexpr size_t kDynLds = 96 * 1024;
    static int grid = 0;
    if (!grid) {
        int dev = 0, cus = 0, per_cu = 0;
        (void)hipGetDevice(&dev);
        (void)hipDeviceGetAttribute(&cus, hipDeviceAttributeMultiprocessorCount, dev);
        (void)hipFuncSetAttribute((const void*)fwd, hipFuncAttributeMaxDynamicSharedMemorySize, (int)kDynLds);
        (void)hipOccupancyMaxActiveBlocksPerMultiprocessor(&per_cu, fwd, NTHREADS, kDynLds);
        if (per_cu < 1) fprintf(stderr, "occupancy query says %d blocks per CU\n", per_cu);
        grid = cus;
        if (ws_size < WS_END) fprintf(stderr, "workspace too small: %zu < %zu\n", ws_size, (size_t)WS_END);
    }
    (void)hipMemsetAsync((unsigned char*)d_ws + WS_CTL, 0, 1 * MiB, stream);
    Args a{};
    for (int i = 0; i < 15; ++i) a.in[i] = (const float*)d_in[i];
    a.out = (float*)d_out; a.ws = (unsigned char*)d_ws;
    a.ph_lo = 0; a.ph_hi = NPHASE;
    hipLaunchKernelGGL(fwd, dim3(grid), dim3(NTHREADS), kDynLds, stream, a);
}
```

```cpp
#include <hip/hip_runtime.h>
#include <cstdio>
#include <cstdint>
#include <cmath>

constexpr int BATCH = 4, SEQ = 4096, DM = 1024, NT = BATCH * SEQ;
constexpr int NH = 8, HD = 64;
constexpr int QKV_W = 3072, CD_IN = 3080;
constexpr int PEER_QW = 2048;
constexpr float DN_ALPHA = 1.4142135623730951f;
constexpr float LN_EPS = 1e-5f;
constexpr int NTHREADS = 512, NWAVES = 8;
typedef unsigned short bf16_t;

constexpr size_t MiB = 1u << 20;
constexpr size_t WS_CTL = 0;
constexpr size_t WS_WT = 1 * MiB;
constexpr size_t WT_ABIN = WS_WT, WT_ABOUT = WS_WT + 6 * MiB, WT_CDIN = WS_WT + 8 * MiB, WT_CDOUT = WS_WT + 14 * MiB, WT_WQ = WS_WT + 16 * MiB;
constexpr size_t WS_ACTIN = 25 * MiB;
constexpr size_t WS_ATTB = 57 * MiB;
constexpr size_t WS_H1B = 89 * MiB;
constexpr size_t WS_QKV = 121 * MiB;
constexpr size_t WS_LISTS = 217 * MiB;
constexpr size_t WS_MIX = 249 * MiB;
constexpr size_t WS_H1 = 313 * MiB;
constexpr size_t WS_H2 = 377 * MiB;
constexpr size_t WS_F = 441 * MiB;
constexpr size_t WS_FG = 442 * MiB;
constexpr size_t WS_END = 443 * MiB;
constexpr int LDS_BYTES = 147456;
constexpr int RING_OFF = 0, MISC_OFF = 131072;

#define XB_TMO      128
#define XB_XCNT(j)  (256  + 64 * (j))
#define XB_XSUB(j)  (1280 + 64 * (j))
#define XB_XGEN(j)  (2304 + 64 * (j))
#define XB_TOP      3328
#define XB_TOPGEN   3392
#define XCD_BAR_WORDS 3456
#define XB_SPIN_CAP (1u << 18)
#define LAS __attribute__((address_space(3)))

__device__ __forceinline__ unsigned xb_ld(unsigned* p)              { return __hip_atomic_load(p, __ATOMIC_RELAXED, __HIP_MEMORY_SCOPE_AGENT); }
__device__ __forceinline__ unsigned xb_add(unsigned* p, unsigned v) { return __hip_atomic_fetch_add(p, v, __ATOMIC_RELAXED, __HIP_MEMORY_SCOPE_AGENT); }
__device__ __forceinline__ unsigned xb_xcc_id() { return (unsigned)__builtin_amdgcn_s_getreg((3 << 11) | 20) & 0xFu; }
#define XB_SPIN(cond, bar) do { unsigned _sp = 0; while (cond) { __builtin_amdgcn_s_sleep(1); \
    if ((++_sp & 255u) == 0u) { if (xb_ld(&(bar)[XB_TMO])) break; if (_sp > XB_SPIN_CAP) { atomicAdd(&(bar)[XB_TMO], 1u); break; } } } } while (0)

struct XcdBarrier {
    unsigned* bar; unsigned x;
    volatile LAS unsigned* st;
};
__device__ __forceinline__ XcdBarrier xcd_barrier_post(unsigned* bar, volatile LAS unsigned* st) {
    XcdBarrier b; b.bar = bar; b.x = xb_xcc_id(); b.st = st;
    if (threadIdx.x == 0) (void)xb_add(&bar[XB_XCNT(b.x)], 1u);
    return b;
}
__device__ __forceinline__ void xcd_barrier_complete(unsigned* bar, unsigned x, unsigned& nloc, unsigned& nx) {
    const unsigned G = gridDim.x * gridDim.y * gridDim.z;
    unsigned sum, cnt, mine, sp = 0u;
    for (;;) {
        sum = 0u; cnt = 0u; mine = 0u;
#pragma unroll
        for (unsigned j = 0; j < 16; ++j) { const unsigned c = xb_ld(&bar[XB_XCNT(j)]); sum += c; cnt += (c > 0u) ? 1u : 0u; mine = (j == x) ? c : mine; }
        if (sum == G) break;
        __builtin_amdgcn_s_sleep(1);
        if ((++sp & 255u) == 0u) { if (xb_ld(&bar[XB_TMO])) break; if (sp > XB_SPIN_CAP) { atomicAdd(&bar[XB_TMO], 1u); break; } }
    }
    nloc = mine > 0u ? mine : 1u; nx = cnt > 0u ? cnt : 1u;
}
__device__ __forceinline__ void xcd_barrier(const XcdBarrier& b) {
    asm volatile("s_waitcnt vmcnt(0)" ::: "memory");
    __syncthreads();
    if (threadIdx.x == 0) {
        unsigned* bar = b.bar;
        __builtin_amdgcn_s_waitcnt(0);
        unsigned nloc = b.st[0], nx = b.st[1];
        if (nloc == 0u) { xcd_barrier_complete(bar, b.x, nloc, nx); b.st[0] = nloc; b.st[1] = nx; }
        const unsigned old = xb_add(&bar[XB_XSUB(b.x)], 1u);
        const unsigned gen = old / nloc;
        if (old + 1u == (gen + 1u) * nloc) {
            __builtin_amdgcn_fence(__ATOMIC_RELEASE, "agent");
            asm volatile("s_waitcnt vmcnt(0)" ::: "memory");
            const unsigned og = xb_add(&bar[XB_TOP], 1u);
            const unsigned tg = og / nx;
            if (og + 1u == (tg + 1u) * nx) xb_add(&bar[XB_TOPGEN], 1u);
            else XB_SPIN(xb_ld(&bar[XB_TOPGEN]) == tg, bar);
            __builtin_amdgcn_fence(__ATOMIC_ACQUIRE, "agent");
            xb_add(&bar[XB_XGEN(b.x)], 1u);
            asm volatile("s_waitcnt vmcnt(0)" ::: "memory");
        } else {
            XB_SPIN(xb_ld(&bar[XB_XGEN(b.x)]) == gen, bar);
            __builtin_amdgcn_fence(__ATOMIC_ACQUIRE, "agent");
            asm volatile("s_waitcnt vmcnt(0)" ::: "memory");
        }
    }
    __syncthreads();
}

struct Args {
    const float* in[15];
    float* out;
    unsigned char* ws;
    int ph_lo, ph_hi;
};
struct Ctx {
    int tid, lane, wave, gwave, nwaves, bid, nblk;
    float* lds;
};
extern __shared__ __attribute__((aligned(16))) unsigned char dyn_lds[];
__device__ __forceinline__ Ctx make_ctx() {
    int t = threadIdx.x, b = blockIdx.x, g = gridDim.x;
    asm volatile("" : "+v"(t));
    asm volatile("" : "+s"(b), "+s"(g));
    Ctx c; c.tid = t; c.lane = t & 63; c.wave = t >> 6; c.bid = b; c.nblk = g;
    c.gwave = b * NWAVES + c.wave; c.nwaves = g * NWAVES; c.lds = (float*)(dyn_lds + RING_OFF);
    return c;
}
__device__ __forceinline__ unsigned char* launder_ptr(unsigned char* p) {
    unsigned lo = __builtin_amdgcn_readfirstlane((unsigned)(uintptr_t)p), hi = __builtin_amdgcn_readfirstlane((unsigned)((uintptr_t)p >> 32));
    asm volatile("" : "+s"(lo), "+s"(hi));
    return (unsigned char*)(((uintptr_t)hi << 32) | (uintptr_t)lo);
}
__device__ __forceinline__ float wave_sum(float v) {
#pragma unroll
    for (int o = 32; o >= 1; o >>= 1) v += __shfl_xor(v, o);
    return v;
}
__device__ __forceinline__ float log_sigmoid(float z) { return fminf(z, 0.f) - log1pf(expf(-fabsf(z))); }
__device__ __forceinline__ int t5_bucket(int n) {
    if (n < 16) return n;
    int large = 16 + (int)(logf((float)n / 16.f) / 2.0794415416798357f * 16.f);
    return large < 31 ? large : 31;
}
__device__ __forceinline__ float bf2f(bf16_t v) { return __builtin_bit_cast(float, (unsigned)v << 16); }
__device__ __forceinline__ unsigned f2bf(float f) { unsigned u = __builtin_bit_cast(unsigned, f); return (u + 0x7fffu + ((u >> 16) & 1u)) >> 16; }
__device__ __forceinline__ unsigned pk2(float lo, float hi) { return f2bf(lo) | (f2bf(hi) << 16); }

namespace pg8 {
#define PG8_LAS __attribute__((address_space(3)))
typedef unsigned short bf16_t;
typedef short bf16x8 __attribute__((ext_vector_type(8)));
typedef float f32x4 __attribute__((ext_vector_type(4)));
typedef unsigned u32x4 __attribute__((ext_vector_type(4)));
constexpr int BM = 256, BK = 64, HALF = 128, HTB = HALF * BK * 2  , STAGE_BYTES = 8 * HTB, NXCD = 8, WGM = 8;

__host__ __device__ __forceinline__ int lds_byte(int r, int c) { const int st = (r >> 4) * 2 + (c >> 5), rr = r & 15, cc = c & 31, ob = rr * 64 + cc * 2; return st * 1024 + (ob ^ (((ob >> 9) & 1) << 5)); }
__host__ __device__ __forceinline__ void stage_rc(int b, int& R, int& C) { const int st = b / 1024, sb = b % 1024, swz = sb ^ (((sb >> 9) & 1) << 5); R = (st >> 1) * 16 + swz / 64; C = (st & 1) * 32 + (swz % 64) / 2; }
__host__ __device__ __forceinline__ int perm32(int rho) { const int n = rho >> 4, i = rho & 15; return 8 * (i >> 2) + 4 * n + (i & 3); }

struct Unit { int pm, pn; };
struct Gemm { const bf16_t* A; const bf16_t* Bt; int M, N, K; };

struct StaticOrder {
    int nM, nN, nwg, G, c;
    __host__ __device__ void init(int M, int N, int G_, int c_) { nM = M / BM; nN = N / BM; nwg = nM * nN; G = G_; c = c_; }
    __host__ __device__ bool next(int i, Unit& u) const {
        const long L = (long)i * G + c; if (L >= nwg) return false;
        int wgid = (int)L; { const int q = nwg / NXCD, r = nwg % NXCD, xcd = wgid % NXCD, off = wgid / NXCD; wgid = (xcd < r ? xcd * (q + 1) : r * (q + 1) + (xcd - r) * q) + off; }
        const int nig = WGM * nN, gid = wgid / nig, fm = gid * WGM, gsz = (nM - fm) < WGM ? (nM - fm) : WGM;
        u.pm = fm + ((wgid % nig) % gsz); u.pn = (wgid % nig) / gsz; return true;
    }
    __device__ __forceinline__ void a_ready(const Unit&) const {}
    __device__ __forceinline__ void done(const Unit&) const {}
};

__device__ __forceinline__ unsigned cvt_pk_bf16(float lo, float hi) { unsigned r; asm volatile("v_cvt_pk_bf16_f32 %0, %1, %2" : "=v"(r) : "v"(lo), "v"(hi)); return r; }
template <class Epi, class Sched, bool ALIGN_EPI = false, bool SP2 = false>
__device__ __forceinline__ void gemm_phase(PG8_LAS unsigned char* lds, const Gemm g, const Sched& S, const Epi& E) {
    const int tid = threadIdx.x, wid = __builtin_amdgcn_readfirstlane(tid >> 6), lane = tid & 63, wr = wid >> 2, wc = wid & 3, fr = lane & 15, fq = lane >> 4;
    const int K = g.K, nt = K / BK;
    unsigned voffA[2], voffB[2];
#pragma unroll
    for (int i = 0; i < 2; ++i) { int R, C; stage_rc(tid * 16 + i * 8192, R, C); const int Rb = Epi::PERM ? ((R & ~31) + perm32(R & 31)) : R;
        voffA[i] = (unsigned)(R * K + C) * 2u; voffB[i] = (unsigned)(Rb * K + C) * 2u; }
    const size_t kstep = (size_t)(BK * 2);
    const size_t hstep = (size_t)HALF * K * 2;
    const size_t tstep = 2 * hstep;
    const unsigned ldsw = (unsigned)wid * 1024u;
    const int aoff = lds_byte(wr * 64 + fr, fq * 8), boff = lds_byte(wc * 32 + fr, fq * 8);
#define PG8_SA(b, h) (((b) * 2 + (h)) * HTB)
#define PG8_SB(b, h) ((4 + (b) * 2 + (h)) * HTB)
#define PG8_STAGE(bufoff, gbase, voff) do { _Pragma("unroll") for (int _i = 0; _i < 2; ++_i) \
        __builtin_amdgcn_global_load_lds((const unsigned*)((const char*)(gbase) + (voff)[_i]), (PG8_LAS unsigned*)(lds + (bufoff) + ldsw + _i * 8192), 16, 0, 0); } while (0)
#define PG8_LDA(dst, b, h) do { _Pragma("unroll") for (int m = 0; m < 4; ++m) _Pragma("unroll") for (int k = 0; k < 2; ++k) dst[m][k] = *(const PG8_LAS bf16x8*)(lds + PG8_SA(b, h) + aoff + m * 2048 + k * 1024); } while (0)
#define PG8_LDB(dst, b, h) do { _Pragma("unroll") for (int n = 0; n < 2; ++n) _Pragma("unroll") for (int k = 0; k < 2; ++k) dst[n][k] = *(const PG8_LAS bf16x8*)(lds + PG8_SB(b, h) + boff + n * 2048 + k * 1024); } while (0)
#define PG8_MMA(ai, bj, At, Bt) do { __builtin_amdgcn_s_setprio(1); _Pragma("unroll") for (int m = 0; m < 4; ++m) _Pragma("unroll") for (int n = 0; n < 2; ++n) _Pragma("unroll") for (int k = 0; k < 2; ++k) \
        acc[ai][bj][m][n] = __builtin_amdgcn_mfma_f32_16x16x32_bf16(Bt[n][k], At[m][k], acc[ai][bj][m][n], 0, 0, 0); __builtin_amdgcn_s_setprio(0); } while (0)
#define PG8_WAIT_V(n) asm volatile("s_waitcnt vmcnt(" #n ")" ::: "memory")
#define PG8_WAIT_L(n) asm volatile("s_waitcnt lgkmcnt(" #n ")" ::: "memory")
#define PG8_BAR __builtin_amdgcn_s_barrier()
#define PG8_SCHED __builtin_amdgcn_sched_barrier(0)
    Unit cur, nxt; int ui = 0;
    if (!S.next(0, cur)) return;
    f32x4 acc[2][2][4][2];
#pragma unroll
    for (int a = 0; a < 2; ++a)
#pragma unroll
        for (int b = 0; b < 2; ++b)
#pragma unroll
            for (int m = 0; m < 4; ++m)
#pragma unroll
                for (int n = 0; n < 2; ++n) acc[a][b][m][n] = (f32x4){0.f, 0.f, 0.f, 0.f};
    bf16x8 At[4][2], B0[2][2], B1[2][2];
    const char* cA = (const char*)g.A + (size_t)cur.pm * tstep; const char* cB = (const char*)g.Bt + (size_t)cur.pn * tstep;
    S.a_ready(cur);
    if constexpr (SP2) {
        PG8_STAGE(PG8_SB(0, 0), cB, voffB); PG8_STAGE(PG8_SB(0, 1), cB + hstep, voffB); PG8_STAGE(PG8_SA(0, 0), cA, voffA); PG8_STAGE(PG8_SA(0, 1), cA + hstep, voffA);
        if (wr == 1) PG8_BAR;
        PG8_WAIT_V(2); PG8_BAR;
        PG8_STAGE(PG8_SB(1, 0), cB + kstep, voffB); PG8_STAGE(PG8_SA(1, 0), cA + kstep, voffA); PG8_STAGE(PG8_SB(1, 1), cB + hstep + kstep, voffB);
        PG8_WAIT_V(6); PG8_BAR;
    } else {
        PG8_STAGE(PG8_SB(0, 0), cB, voffB); PG8_STAGE(PG8_SA(0, 0), cA, voffA); PG8_STAGE(PG8_SB(0, 1), cB + hstep, voffB); PG8_STAGE(PG8_SA(0, 1), cA + hstep, voffA);
        if (wr == 1) PG8_BAR;
        PG8_WAIT_V(4); PG8_BAR;
        PG8_STAGE(PG8_SB(1, 0), cB + kstep, voffB); PG8_STAGE(PG8_SA(1, 0), cA + kstep, voffA); PG8_STAGE(PG8_SB(1, 1), cB + hstep + kstep, voffB);
        PG8_WAIT_V(6); PG8_BAR;
    }
    for (;;) {
        const bool has_next = S.next(ui + 1, nxt);
        const char* nA = has_next ? (const char*)g.A + (size_t)nxt.pm * tstep : cA; const char* nB = has_next ? (const char*)g.Bt + (size_t)nxt.pn * tstep : cB;
        for (int t = 0; t < nt; t += 2) {
            const bool last = (t == nt - 2);
            const char* a1 = cA + (size_t)(t + 1) * kstep;
            const char* a2 = last ? nA : cA + (size_t)(t + 2) * kstep; const char* b2 = last ? nB : cB + (size_t)(t + 2) * kstep;
            const char* a3 = a2 + kstep; const char* b3 = b2 + kstep;
            if (last && has_next) S.a_ready(nxt);
            if constexpr (SP2) {
            PG8_LDB(B0, 0, 0); PG8_LDB(B1, 0, 1); PG8_SCHED; PG8_LDA(At, 0, 0); PG8_STAGE(PG8_SA(1, 1), a1 + hstep, voffA);
            PG8_WAIT_V(8); PG8_WAIT_L(0); PG8_BAR; PG8_MMA(0, 0, At, B0); PG8_MMA(0, 1, At, B1); PG8_BAR; PG8_SCHED;
            PG8_LDA(At, 0, 1); PG8_STAGE(PG8_SB(0, 0), b2, voffB); PG8_STAGE(PG8_SB(0, 1), b2 + hstep, voffB); PG8_STAGE(PG8_SA(0, 0), a2, voffA);
            PG8_WAIT_V(8); PG8_WAIT_L(0); PG8_BAR; PG8_MMA(1, 0, At, B0); PG8_MMA(1, 1, At, B1); PG8_BAR; PG8_SCHED;
            PG8_LDB(B0, 1, 0); PG8_LDB(B1, 1, 1); PG8_SCHED; PG8_LDA(At, 1, 0); PG8_STAGE(PG8_SA(0, 1), a2 + hstep, voffA);
            PG8_WAIT_V(8); PG8_WAIT_L(0); PG8_BAR; PG8_MMA(0, 0, At, B0); PG8_MMA(0, 1, At, B1); PG8_BAR; PG8_SCHED;
            PG8_LDA(At, 1, 1); PG8_STAGE(PG8_SB(1, 0), b3, voffB); PG8_STAGE(PG8_SB(1, 1), b3 + hstep, voffB); PG8_STAGE(PG8_SA(1, 0), a3, voffA);
            PG8_WAIT_V(8); PG8_WAIT_L(0); PG8_BAR; PG8_MMA(1, 0, At, B0); PG8_MMA(1, 1, At, B1); PG8_BAR; PG8_SCHED;
            } else {
            PG8_LDB(B0, 0, 0); PG8_SCHED; PG8_LDA(At, 0, 0); PG8_STAGE(PG8_SA(1, 1), a1 + hstep, voffA);
            PG8_WAIT_L(8); PG8_BAR; PG8_WAIT_L(0); PG8_MMA(0, 0, At, B0); PG8_BAR; PG8_SCHED;
            PG8_LDB(B1, 0, 1); PG8_STAGE(PG8_SB(0, 0), b2, voffB);
            PG8_BAR; PG8_WAIT_L(0); PG8_MMA(0, 1, At, B1); PG8_BAR;
            PG8_LDA(At, 0, 1); PG8_STAGE(PG8_SA(0, 0), a2, voffA);
            PG8_BAR; PG8_WAIT_L(0); PG8_MMA(1, 0, At, B0); PG8_BAR; PG8_SCHED;
            PG8_STAGE(PG8_SB(0, 1), b2 + hstep, voffB);
            PG8_WAIT_V(6); PG8_BAR; PG8_MMA(1, 1, At, B1); PG8_BAR;
            PG8_LDB(B0, 1, 0); PG8_SCHED; PG8_LDA(At, 1, 0); PG8_STAGE(PG8_SA(0, 1), a2 + hstep, voffA);
            PG8_WAIT_L(8); PG8_BAR; PG8_WAIT_L(0); PG8_MMA(0, 0, At, B0); PG8_BAR; PG8_SCHED;
            PG8_LDB(B1, 1, 1); PG8_STAGE(PG8_SB(1, 0), b3, voffB);
            PG8_BAR; PG8_WAIT_L(0); PG8_MMA(0, 1, At, B1); PG8_BAR;
            PG8_LDA(At, 1, 1); PG8_STAGE(PG8_SA(1, 0), a3, voffA);
            PG8_BAR; PG8_WAIT_L(0); PG8_MMA(1, 0, At, B0); PG8_BAR; PG8_SCHED;
            PG8_STAGE(PG8_SB(1, 1), b3 + hstep, voffB);
            PG8_WAIT_V(6); PG8_BAR; PG8_MMA(1, 1, At, B1); PG8_BAR;
            }
        }
        if constexpr (ALIGN_EPI) { if (wr == 0) PG8_BAR; }
        if constexpr (!Epi::AFTER_DRAIN) { E(acc, cur, wr, wc, fr, fq); S.done(cur); }
        if (!has_next) break;
#pragma unroll
        for (int a = 0; a < 2; ++a)
#pragma unroll
            for (int b = 0; b < 2; ++b)
#pragma unroll
                for (int m = 0; m < 4; ++m)
#pragma unroll
                    for (int n = 0; n < 2; ++n) acc[a][b][m][n] = (f32x4){0.f, 0.f, 0.f, 0.f};
        cur = nxt; cA = nA; cB = nB; ++ui;
        if constexpr (ALIGN_EPI) { if (wr == 1) PG8_BAR; }
    }
    PG8_WAIT_V(0);
    if constexpr (!ALIGN_EPI) { if (wr == 0) PG8_BAR; }
    PG8_BAR;
    if constexpr (Epi::AFTER_DRAIN) { E.fused(acc, cur, wr, wc, fr, fq, lds, wid, lane); S.done(cur); }
#undef PG8_SA
#undef PG8_SB
#undef PG8_STAGE
#undef PG8_LDA
#undef PG8_LDB
#undef PG8_MMA
#undef PG8_WAIT_V
#undef PG8_WAIT_L
#undef PG8_BAR
#undef PG8_SCHED
}
}

namespace pg8 {
struct EpiStoreBf16 {
    static constexpr bool PERM = true, AFTER_DRAIN = false;
    bf16_t* O; int ldc; float s01, s67;
    __device__ __forceinline__ void operator()(const f32x4 (&acc)[2][2][4][2], const Unit& u, int wr, int wc, int fr, int fq) const {
        const int row0 = u.pm * BM + wr * 64 + fr, col0 = u.pn * BM + wc * 32 + 8 * fq;
        const float sc = u.pn < 2 ? s01 : ((u.pn == 6 || u.pn == 7) ? s67 : 1.f);
#pragma unroll
        for (int ai = 0; ai < 2; ++ai)
#pragma unroll
            for (int m = 0; m < 4; ++m) { bf16_t* rowp = O + (size_t)(row0 + ai * HALF + m * 16) * ldc + col0;
#pragma unroll
                for (int bj = 0; bj < 2; ++bj) { const f32x4 v0 = acc[ai][bj][m][0] * sc, v1 = acc[ai][bj][m][1] * sc;
                    u32x4 w; w.x = cvt_pk_bf16(v0[0], v0[1]); w.y = cvt_pk_bf16(v0[2], v0[3]); w.z = cvt_pk_bf16(v1[0], v1[1]); w.w = cvt_pk_bf16(v1[2], v1[3]);
                    *(u32x4*)(rowp + bj * HALF) = w; } }
    }
};
struct EpiStoreF32 {
    static constexpr bool PERM = true, AFTER_DRAIN = false;
    float* C; int ldc;
    __device__ __forceinline__ void operator()(const f32x4 (&acc)[2][2][4][2], const Unit& u, int wr, int wc, int fr, int fq) const {
        const int row0 = u.pm * BM + wr * 64 + fr, col0 = u.pn * BM + wc * 32 + 8 * fq;
#pragma unroll
        for (int ai = 0; ai < 2; ++ai)
#pragma unroll
            for (int m = 0; m < 4; ++m) { float* rowp = C + (size_t)(row0 + ai * HALF + m * 16) * ldc + col0;
#pragma unroll
                for (int bj = 0; bj < 2; ++bj) { *(f32x4*)(rowp + bj * HALF) = acc[ai][bj][m][0]; *(f32x4*)(rowp + bj * HALF + 4) = acc[ai][bj][m][1]; } }
    }
};
}

__device__ __forceinline__ void transpose_item(const float* W, int ldw, int K, int ncols, bf16_t* WT, float* scr, int item, int lane) {
    const int nblk = ncols / 32, kb = item / nblk, nb = item % nblk, k0 = 64 * kb, n0 = 32 * nb;
#pragma unroll 8
    for (int i = 0; i < 32; ++i) { const int kk = 2 * i + (lane >> 5); scr[kk * 33 + (lane & 31)] = W[(size_t)(k0 + kk) * ldw + n0 + (lane & 31)]; }
    asm volatile("s_waitcnt lgkmcnt(0)" ::: "memory");
    const int c = lane & 7;
#pragma unroll
    for (int j = 0; j < 4; ++j) { const int n = (lane >> 3) + 8 * j; const float* s = scr + (8 * c) * 33 + n;
        uint4 o; o.x = pk2(s[0 * 33], s[1 * 33]); o.y = pk2(s[2 * 33], s[3 * 33]); o.z = pk2(s[4 * 33], s[5 * 33]); o.w = pk2(s[6 * 33], s[7 * 33]);
        *(uint4*)(WT + (size_t)(n0 + n) * K + k0 + 8 * c) = o; }
    asm volatile("s_waitcnt lgkmcnt(0)" ::: "memory");
}
__device__ __forceinline__ void prologue_phase(const Ctx& c, const float* x, const float* ab_in, const float* ab_out, const float* cd_in, const float* cd_out, const float* wq, unsigned char* ws) {
    float* scr = c.lds + c.wave * 4096;
    constexpr int I_IN = 16 * 96, I_OUT = 16 * 32, I_WQ = 16 * 64;
    constexpr int NITEMS = 2 * I_IN + 2 * I_OUT + 2 * I_WQ;
    for (int it = c.gwave; it < NITEMS; it += c.nwaves) {
        int r = it;
        if (r < I_IN) { transpose_item(ab_in, QKV_W, DM, QKV_W, (bf16_t*)(ws + WT_ABIN), scr, r, c.lane); continue; } r -= I_IN;
        if (r < I_IN) { transpose_item(cd_in, CD_IN, DM, QKV_W, (bf16_t*)(ws + WT_CDIN), scr, r, c.lane); continue; } r -= I_IN;
        if (r < I_OUT) { transpose_item(ab_out, DM, DM, DM, (bf16_t*)(ws + WT_ABOUT), scr, r, c.lane); continue; } r -= I_OUT;
        if (r < I_OUT) { transpose_item(cd_out, DM, DM, DM, (bf16_t*)(ws + WT_CDOUT), scr, r, c.lane); continue; } r -= I_OUT;
        if (r < I_WQ) { transpose_item(wq, PEER_QW, DM, PEER_QW, (bf16_t*)(ws + WT_WQ), scr, r, c.lane); continue; } r -= I_WQ;
        transpose_item(wq + (size_t)DM * PEER_QW, PEER_QW, DM, PEER_QW, (bf16_t*)(ws + WT_WQ + 4 * MiB), scr, r, c.lane);
    }
    bf16_t* xb = (bf16_t*)(ws + WS_ACTIN);
    for (size_t i = (size_t)c.gwave * 64 + c.lane; i < (size_t)NT * DM / 8; i += (size_t)c.nwaves * 64) {
        const float4 a = *(const float4*)(x + i * 8), b = *(const float4*)(x + i * 8 + 4);
        uint4 o; o.x = pk2(a.x, a.y); o.y = pk2(a.z, a.w); o.z = pk2(b.x, b.y); o.w = pk2(b.z, b.w);
        *(uint4*)(xb + i * 8) = o;
    }
}

template <int DQ, class BiasF>
__device__ __forceinline__ void causal_softmax_row(const float (&q)[DQ], const bf16_t* kbase, const bf16_t* vbase, int ld, int t, int smax, float scale, BiasF biasf, float (&O)[64]) {
    float m = -INFINITY;
    for (int s = 0; s <= smax; ++s) {
        const bf16_t* kr = kbase + (size_t)s * ld;
        float d = 0.f;
#pragma unroll
        for (int i = 0; i < DQ; ++i) d = fmaf(q[i], bf2f(kr[i]), d);
        const float lg = d * scale + biasf(s);
        m = (s <= t) ? fmaxf(m, lg) : m;
    }
    float l = 0.f;
#pragma unroll
    for (int i = 0; i < 64; ++i) O[i] = 0.f;
    for (int s = 0; s <= smax; ++s) {
        const bf16_t* kr = kbase + (size_t)s * ld;
        const bf16_t* vr = vbase + (size_t)s * ld;
        float d = 0.f;
#pragma unroll
        for (int i = 0; i < DQ; ++i) d = fmaf(q[i], bf2f(kr[i]), d);
        const float lg = d * scale + biasf(s);
        const float p = (s <= t) ? expf(lg - m) : 0.f;
        l += p;
#pragma unroll
        for (int i = 0; i < 64; ++i) O[i] = fmaf(p, bf2f(vr[i]), O[i]);
    }
    const float inv = 1.f / l;
#pragma unroll
    for (int i = 0; i < 64; ++i) O[i] *= inv;
}
__device__ __forceinline__ void store_row64_bf16(bf16_t* orow, const float (&v)[64]) {
#pragma unroll
    for (int i = 0; i < 64; i += 8) { uint4 o; o.x = pk2(v[i], v[i + 1]); o.y = pk2(v[i + 2], v[i + 3]); o.z = pk2(v[i + 4], v[i + 5]); o.w = pk2(v[i + 6], v[i + 7]); *(uint4*)(orow + i) = o; }
}

__device__ __forceinline__ void fg_phase(const Ctx& c, const float* hin, const float* cd_in, float* fg) {
    for (int t = c.gwave; t < NT; t += c.nwaves) {
        float acc[8];
#pragma unroll
        for (int j = 0; j < 8; ++j) acc[j] = 0.f;
        for (int r = 0; r < 16; ++r) {
            const int d = r * 64 + c.lane;
            const float xv = hin[(size_t)t * DM + d];
            const float4 w0 = *(const float4*)(cd_in + (size_t)d * CD_IN + 3072), w1 = *(const float4*)(cd_in + (size_t)d * CD_IN + 3076);
            acc[0] = fmaf(xv, w0.x, acc[0]); acc[1] = fmaf(xv, w0.y, acc[1]); acc[2] = fmaf(xv, w0.z, acc[2]); acc[3] = fmaf(xv, w0.w, acc[3]);
            acc[4] = fmaf(xv, w1.x, acc[4]); acc[5] = fmaf(xv, w1.y, acc[5]); acc[6] = fmaf(xv, w1.z, acc[6]); acc[7] = fmaf(xv, w1.w, acc[7]);
        }
#pragma unroll
        for (int j = 0; j < 8; ++j) acc[j] = wave_sum(acc[j]);
        if (c.lane == 0) { *(float4*)(fg + (size_t)t * 8) = make_float4(acc[0], acc[1], acc[2], acc[3]); *(float4*)(fg + (size_t)t * 8 + 4) = make_float4(acc[4], acc[5], acc[6], acc[7]); }
    }
}
__device__ __forceinline__ void fscan_naive(const Ctx& c, const float* fg, float* F, const float* bf) {
    for (int task = c.gwave; task < 32; task += c.nwaves) {
        const int b = task >> 3, h = task & 7;
        const int lane = c.lane;
        float v[64]; float tot = 0.f;
#pragma unroll
        for (int i = 0; i < 64; ++i) { const int s = lane * 64 + i; v[i] = log_sigmoid(fg[((size_t)b * SEQ + s) * 8 + h] + bf[h]); tot += v[i]; }
        float incl = tot;
#pragma unroll
        for (int o = 1; o < 64; o <<= 1) { const float n = __shfl_up(incl, o); if (lane >= o) incl += n; }
        float run = incl - tot;
#pragma unroll
        for (int i = 0; i < 64; ++i) { run += v[i]; F[(size_t)task * SEQ + lane * 64 + i] = run; }
    }
}

__device__ __forceinline__ void attn_dilated_naive(const Ctx& c, const bf16_t* qkv, bf16_t* out, const float* t5) {
    float* biasTab = c.lds;
    for (int i = c.tid; i < 8 * 129; i += NTHREADS) { const int h = i / 129, d = i % 129; biasTab[i] = t5[t5_bucket(d) * 8 + h]; }
    __syncthreads();
    const int lane = c.lane;
    for (int task = c.gwave; task < 32 * 32; task += c.nwaves) {
        const int p = task & 31, bh = (task >> 5) & 31;
        const int b = bh >> 3, h = bh & 7;
        for (int half = 0; half < 2; ++half) {
            const int tb = half ? 63 - p : p;
            const int t = tb * 64 + lane, smax = tb * 64 + 63;
            const size_t rowbase = (size_t)b * SEQ;
            {
                float q[64], O[64];
                const bf16_t* qr = qkv + (rowbase + t) * QKV_W + h * 64;
#pragma unroll
                for (int i = 0; i < 64; ++i) { q[i] = bf2f(qr[i]); O[i] = 0.f; }
                const bf16_t* kbase = qkv + rowbase * QKV_W + 512 + h * 64;
                const bf16_t* vbase = qkv + rowbase * QKV_W + 1024 + h * 64;
                float m = -INFINITY;
                for (int pat = 0; pat < 3; ++pat) {
                    const int dil = pat == 0 ? 1 : (pat == 1 ? 4 : 16);
                    for (int j = 0; j <= 128; ++j) {
                        const int dist = j * dil, s = t - dist;
                        if (s >= 0) {
                            const bf16_t* kr = kbase + (size_t)s * QKV_W;
                            float d = 0.f;
#pragma unroll
                            for (int i = 0; i < 64; ++i) d = fmaf(q[i], bf2f(kr[i]), d);
                            const float lg = d * 0.125f + biasTab[h * 129 + (dist > 128 ? 128 : dist)];
                            m = fmaxf(m, lg);
                        }
                    }
                }
                float l = 0.f;
                for (int pat = 0; pat < 3; ++pat) {
                    const int dil = pat == 0 ? 1 : (pat == 1 ? 4 : 16);
                    for (int j = 0; j <= 128; ++j) {
                        const int dist = j * dil, s = t - dist;
                        if (s >= 0) {
                            const bf16_t* kr = kbase + (size_t)s * QKV_W;
                            const bf16_t* vr = vbase + (size_t)s * QKV_W;
                            float d = 0.f;
#pragma unroll
                            for (int i = 0; i < 64; ++i) d = fmaf(q[i], bf2f(kr[i]), d);
                            const float lg = d * 0.125f + biasTab[h * 129 + (dist > 128 ? 128 : dist)];
                            const float pw = expf(lg - m);
                            l += pw;
#pragma unroll
                            for (int i = 0; i < 64; ++i) O[i] = fmaf(pw, bf2f(vr[i]), O[i]);
                        }
                    }
                }
                const float inv = 1.f / l;
#pragma unroll
                for (int i = 0; i < 64; ++i) O[i] *= inv;
                store_row64_bf16(out + (rowbase + t) * DM + h * 64, O);
            }
        }
    }
}

namespace att {
typedef short bf16x8 __attribute__((ext_vector_type(8)));
typedef short s16x4 __attribute__((ext_vector_type(4)));
typedef float f32x16 __attribute__((ext_vector_type(16)));
typedef float f32x4 __attribute__((ext_vector_type(4)));
typedef short v4i16_t __attribute__((ext_vector_type(4)));
constexpr float LOG2E = 1.4426950408889634f;
constexpr float NEG = -1e30f;
constexpr int KBUF = 0, VBUF = 16384, FBUF = 32768, TBUF = 33792, CNT = 34816;

__device__ __forceinline__ int tile_off(int row, int ch) { return 1024 * (row >> 3) + 512 * (ch >> 2) + 64 * (row & 7) + 16 * ((ch & 3) ^ ((row >> 2) & 3)); }
__device__ __forceinline__ s16x4 vtr(const LAS unsigned char* p) { return __builtin_bit_cast(s16x4, __builtin_amdgcn_ds_read_tr16_b64_v4i16((LAS v4i16_t*)p)); }
__device__ __forceinline__ unsigned cvtpk(float lo, float hi) { unsigned r; asm("v_cvt_pk_bf16_f32 %0, %1, %2" : "=v"(r) : "v"(lo), "v"(hi)); return r; }
__device__ __forceinline__ float xhalf(float v) { return __shfl_xor(v, 32); }
__device__ __forceinline__ int key_of(int i, int hh) { return 8 * (i >> 2) + 4 * hh + (i & 3); }

__device__ __forceinline__ bf16x8 pfrag(const f32x16& p, int ks2) {
    unsigned w[4];
#pragma unroll
    for (int j = 0; j < 4; ++j) w[j] = cvtpk(p[8 * ks2 + 2 * j], p[8 * ks2 + 2 * j + 1]);
    typedef unsigned u32x4 __attribute__((ext_vector_type(4)));
    u32x4 v = {w[0], w[1], w[2], w[3]};
    return __builtin_bit_cast(bf16x8, v);
}
__device__ __forceinline__ void pv_block(f32x16 (&O)[2], const LAS unsigned char* vbuf, int kb, const f32x16& p, int lane) {
    const int hh = lane >> 5, q_ = (lane & 15) >> 2, p_ = lane & 3, cg = (lane >> 4) & 1;
#pragma unroll
    for (int ks2 = 0; ks2 < 2; ++ks2) {
        const bf16x8 pb = pfrag(p, ks2);
#pragma unroll
        for (int db = 0; db < 2; ++db) {
            const int c0 = 32 * db + 16 * cg, ch = (c0 >> 3) + (p_ >> 1);
            const int r0 = 32 * kb + 16 * ks2 + 4 * hh;
            const s16x4 a0 = vtr(vbuf + tile_off(r0 + q_, ch) + 8 * (p_ & 1));
            const s16x4 a1 = vtr(vbuf + tile_off(r0 + 8 + q_, ch) + 8 * (p_ & 1));
            const bf16x8 a = {a0[0], a0[1], a0[2], a0[3], a1[0], a1[1], a1[2], a1[3]};
            O[db] = __builtin_amdgcn_mfma_f32_32x32x16_bf16(a, pb, O[db], 0, 0, 0);
        }
    }
}
template <int S0, int NS>
__device__ __forceinline__ f32x16 qk_block(const LAS unsigned char* kbuf, int kb, const bf16x8 (&Qf)[4], int lane) {
    const int r = lane & 31, hh = lane >> 5;
    f32x16 s = {0.f, 0.f, 0.f, 0.f, 0.f, 0.f, 0.f, 0.f, 0.f, 0.f, 0.f, 0.f, 0.f, 0.f, 0.f, 0.f};
#pragma unroll
    for (int ks = S0; ks < S0 + NS; ++ks) {
        const bf16x8 a = *(const LAS bf16x8*)(kbuf + tile_off(32 * kb + r, 2 * ks + hh));
        s = __builtin_amdgcn_mfma_f32_32x32x16_bf16(a, Qf[ks], s, 0, 0, 0);
    }
    return s;
}
__device__ __forceinline__ void softmax_step(f32x16& x, float& m, float& l, f32x16 (&O)[2]) {
    float mx = x[0];
#pragma unroll
    for (int i = 1; i < 16; ++i) mx = fmaxf(mx, x[i]);
    mx = fmaxf(mx, xhalf(mx));
    const float mn = fmaxf(m, mx);
    if (!__all(mn == m)) {
        const float alpha = __builtin_amdgcn_exp2f(m - mn);
        l *= alpha;
#pragma unroll
        for (int i = 0; i < 16; ++i) { O[0][i] *= alpha; O[1][i] *= alpha; }
        m = mn;
    }
    float ls = 0.f;
#pragma unroll
    for (int i = 0; i < 16; ++i) { x[i] = __builtin_amdgcn_exp2f(x[i] - m); ls += x[i]; }
    l += ls;
}
__device__ __forceinline__ void store_ot(bf16_t* orow, const f32x16 (&O)[2], int hh) {
#pragma unroll
    for (int db = 0; db < 2; ++db)
#pragma unroll
        for (int g = 0; g < 4; ++g) {
            const int d0 = 32 * db + 8 * g + 4 * hh;
            *(uint2*)(orow + d0) = make_uint2(cvtpk(O[db][4 * g], O[db][4 * g + 1]), cvtpk(O[db][4 * g + 2], O[db][4 * g + 3]));
        }
}

struct UnitArgs {
    const bf16_t* qkv;
    bf16_t* out;
    int qcol, kcol, vcol, ocol;
};

template <int TYPE>
__device__ __forceinline__ void causal_unit(const UnitArgs& A, int b, int h, int qb, unsigned char* scratch, int tid,
                                            const float* t5  , float lam, const float* subg, const float* F  ) {
    const LAS unsigned char* lds = (const LAS unsigned char*)scratch;
    LAS unsigned char* ldsw = (LAS unsigned char*)scratch;
    const int lane = tid & 63, w = tid >> 6, r = lane & 31, hh = lane >> 5;
    const int q0 = qb * 256 + 32 * w, tq = q0 + r;
    const size_t rowbase = (size_t)b * SEQ;
    const int ktmax = 4 * qb + 3, kdiag = 4 * qb + (w >> 1);
    const int srow = tid >> 3, sch = tid & 7;
    const bf16_t* kg = A.qkv + (rowbase + srow) * QKV_W + A.kcol + h * 64 + sch * 8;
    const bf16_t* vg = A.qkv + (rowbase + srow) * QKV_W + A.vcol + h * 64 + sch * 8;
    const int soff = tile_off(srow, sch);
    bf16x8 Qf[4];
    {
        const bf16_t* qr = A.qkv + (rowbase + tq) * QKV_W + A.qcol + h * 64 + 8 * hh;
#pragma unroll
        for (int s = 0; s < 4; ++s) Qf[s] = *(const bf16x8*)(qr + 16 * s);
    }
    __syncthreads();
    if (TYPE == 0 && tid < 128) {
        const float far = t5[31 * 8 + h];
        ((LAS float*)(ldsw + TBUF))[tid] = (t5[t5_bucket(tid) * 8 + h] - far) * LOG2E;
    }
    if (TYPE == 1 && tid == 0) *(LAS unsigned*)(ldsw + CNT) = 0u;
    typedef unsigned u32x4 __attribute__((ext_vector_type(4)));
    u32x4 kreg = *(const u32x4*)(kg + (size_t)ktmax * 64 * QKV_W), vreg = *(const u32x4*)(vg + (size_t)ktmax * 64 * QKV_W);
    float freg = 0.f;
    if (TYPE == 3 && tid < 64) freg = F[(size_t)(b * 8 + h) * SEQ + ktmax * 64 + tid] * LOG2E;
    *(LAS u32x4*)(ldsw + KBUF + soff) = kreg; *(LAS u32x4*)(ldsw + VBUF + soff) = vreg;
    if (TYPE == 3 && tid < 64) ((LAS float*)(ldsw + FBUF))[tid] = freg;
    __syncthreads();

    f32x16 O0[2], O1[2];
#pragma unroll
    for (int i = 0; i < 16; ++i) { O0[0][i] = 0.f; O0[1][i] = 0.f; O1[0][i] = 0.f; O1[1][i] = 0.f; }
    float m0 = NEG, l0 = 0.f, m1 = NEG, l1 = 0.f;
    float R = 0.f;
    bool wdone = false;
    float f2t = 0.f;
    if (TYPE == 3) f2t = F[(size_t)(b * 8 + h) * SEQ + tq] * LOG2E;

    for (int kt = ktmax, it = 0; kt >= 0; --kt, ++it) {
        const int cur = it & 1;
        if (kt > 0) {
            kreg = *(const u32x4*)(kg + (size_t)(kt - 1) * 64 * QKV_W); vreg = *(const u32x4*)(vg + (size_t)(kt - 1) * 64 * QKV_W);
            if (TYPE == 3 && tid < 64) freg = F[(size_t)(b * 8 + h) * SEQ + (kt - 1) * 64 + tid] * LOG2E;
        }
        const LAS unsigned char* kbuf = lds + KBUF + cur * 8192;
        const LAS unsigned char* vbuf = lds + VBUF + cur * 8192;
        if (kt <= kdiag && !wdone) {
#pragma unroll
            for (int kbi = 0; kbi < 2; ++kbi) {
                const int kb = 1 - kbi;
                const int key0 = kt * 64 + kb * 32;
                if (TYPE == 1 ? (key0 >= q0 + 31) : (key0 > q0 + 31)) continue;
                const bool need_mask = (TYPE == 1) ? (key0 + 31 >= q0) : (key0 + 31 > q0);
                if (TYPE == 0) {
                    f32x16 x0 = qk_block<0, 2>(kbuf, kb, Qf, lane), x1 = qk_block<2, 2>(kbuf, kb, Qf, lane);
                    if (q0 - (key0 + 31) < 113) {
                        const LAS float* tb = (const LAS float*)(lds + TBUF);
#pragma unroll
                        for (int i = 0; i < 16; ++i) {
                            const int dist = tq - (key0 + key_of(i, hh));
                            const float bv = (dist >= 0 && dist < 128) ? tb[dist < 0 ? 0 : (dist > 127 ? 127 : dist)] : 0.f;
                            x0[i] = dist < 0 ? NEG : x0[i] + bv; x1[i] = dist < 0 ? NEG : x1[i] + bv;
                        }
                    }
                    softmax_step(x0, m0, l0, O0);
                    pv_block(O0, vbuf, kb, x0, lane);
                    softmax_step(x1, m1, l1, O1);
                    pv_block(O1, vbuf, kb, x1, lane);
                } else if (TYPE == 3) {
                    f32x16 x = qk_block<0, 4>(kbuf, kb, Qf, lane);
                    const LAS float* fb = (const LAS float*)(lds + FBUF + cur * 256);
#pragma unroll
                    for (int g = 0; g < 4; ++g) {
                        const f32x4 fv = *(const LAS f32x4*)(fb + 32 * kb + 8 * g + 4 * hh);
#pragma unroll
                        for (int j = 0; j < 4; ++j) x[4 * g + j] += f2t - fv[j];
                    }
                    if (need_mask) {
#pragma unroll
                        for (int i = 0; i < 16; ++i) x[i] = (key0 + key_of(i, hh) > tq) ? NEG : x[i];
                    }
                    softmax_step(x, m0, l0, O0);
                    pv_block(O0, vbuf, kb, x, lane);
                } else {
                    f32x16 z = qk_block<0, 4>(kbuf, kb, Qf, lane);
                    f32x16 lr;
#pragma unroll
                    for (int i = 0; i < 16; ++i) {
                        const float e = __builtin_amdgcn_exp2f(-fabsf(z[i]));
                        float v = -(fmaxf(z[i], 0.f) + __builtin_amdgcn_logf(1.f + e));
                        if (need_mask) v = (key0 + key_of(i, hh) >= tq) ? 0.f : v;
                        lr[i] = v;
                    }
                    float T[4], Tp[4], sfx[16];
#pragma unroll
                    for (int g = 0; g < 4; ++g) {
                        sfx[4 * g + 3] = 0.f; sfx[4 * g + 2] = lr[4 * g + 3]; sfx[4 * g + 1] = sfx[4 * g + 2] + lr[4 * g + 2]; sfx[4 * g] = sfx[4 * g + 1] + lr[4 * g + 1];
                        T[g] = sfx[4 * g] + lr[4 * g];
                        Tp[g] = xhalf(T[g]);
                    }
                    float SP[4];
                    SP[3] = 0.f; SP[2] = T[3] + Tp[3]; SP[1] = SP[2] + T[2] + Tp[2]; SP[0] = SP[1] + T[1] + Tp[1];
                    const float tot = SP[0] + T[0] + Tp[0];
                    const float msel = hh == 0 ? 1.f : 0.f;
#pragma unroll
                    for (int g = 0; g < 4; ++g) {
                        const float goff = R + SP[g] + msel * Tp[g];
#pragma unroll
                        for (int j = 0; j < 4; ++j) {
                            const int i = 4 * g + j;
                            float wv = __builtin_amdgcn_exp2f(lr[i] + z[i] + goff + sfx[i]);
                            if (need_mask) wv = (key0 + key_of(i, hh) >= tq) ? 0.f : wv;
                            z[i] = wv;
                        }
                    }
                    R += tot;
                    pv_block(O0, vbuf, kb, z, lane);
                }
            }
            if (TYPE == 1) {
                if (__all(R < -216.4f)) { wdone = true; if (lane == 0) (void)__hip_atomic_fetch_add((LAS unsigned*)(ldsw + CNT), 1u, __ATOMIC_RELAXED, __HIP_MEMORY_SCOPE_WORKGROUP); }
            }
        }
        if (kt > 0) {
            *(LAS u32x4*)(ldsw + KBUF + (cur ^ 1) * 8192 + soff) = kreg; *(LAS u32x4*)(ldsw + VBUF + (cur ^ 1) * 8192 + soff) = vreg;
            if (TYPE == 3 && tid < 64) ((LAS float*)(ldsw + FBUF + (cur ^ 1) * 256))[tid] = freg;
        }
        __syncthreads();
        if (TYPE == 1) { const unsigned cnt = *(const LAS unsigned*)(lds + CNT); __syncthreads(); if (cnt == 8u) break; }
    }
    bf16_t* orow = A.out + (rowbase + tq) * DM + A.ocol + h * 64;
    if (TYPE == 0) {
        const float i0 = 1.f / (l0 + xhalf(l0)), i1 = lam / (l1 + xhalf(l1));
        float ss = 0.f;
#pragma unroll
        for (int db = 0; db < 2; ++db)
#pragma unroll
            for (int i = 0; i < 16; ++i) { const float o = O0[db][i] * i0 - O1[db][i] * i1; O0[db][i] = o; ss = fmaf(o, o, ss); }
        ss += xhalf(ss);
        const float rn = rsqrtf(ss * (1.f / 64.f) + LN_EPS) * 0.8f;
#pragma unroll
        for (int db = 0; db < 2; ++db)
#pragma unroll
            for (int i = 0; i < 16; ++i) O0[db][i] *= rn * subg[32 * db + key_of(i, hh)];
        store_ot(orow, O0, hh);
    } else if (TYPE == 3) {
        const float i0 = 1.f / (l0 + xhalf(l0));
#pragma unroll
        for (int db = 0; db < 2; ++db)
#pragma unroll
            for (int i = 0; i < 16; ++i) O0[db][i] *= i0;
        store_ot(orow, O0, hh);
    } else {
        store_ot(orow, O0, hh);
    }
}
}

__device__ __forceinline__ int xcd_perm256(int p) { return (p & 7) * 32 + (p >> 3); }

__device__ __forceinline__ void attn_layer0_mfma(const Ctx& c, const bf16_t* qkv, bf16_t* out, const float* t5, const float* lamv, const float* subg) {
    float s01 = 0.f, s23 = 0.f;
    for (int i = 0; i < 32; ++i) { s01 += lamv[i] * lamv[32 + i]; s23 += lamv[64 + i] * lamv[96 + i]; }
    const float lam = expf(s01) - expf(s23) + 0.2f;
    unsigned char* scratch = (unsigned char*)c.lds;
    const att::UnitArgs UA{qkv, out, 0, 512, 1024, 0}, UB{qkv, out, 1536, 2048, 2560, 512};
    for (int p = c.bid; p < 256; p += c.nblk) {
        const int pp = xcd_perm256(p), bh = pp >> 3, qb = pp & 7;
        att::causal_unit<0>(UA, bh >> 3, bh & 7, 15 - qb, scratch, c.tid, t5, lam, subg, nullptr);
        att::causal_unit<0>(UA, bh >> 3, bh & 7, qb, scratch, c.tid, t5, lam, subg, nullptr);
#pragma unroll 1
        for (int k = 0; k < 2; ++k) {
            const int u = pp * 2 + k, bh2 = u >> 4, qb2 = u & 15;
            att::causal_unit<1>(UB, bh2 >> 3, bh2 & 7, qb2, scratch, c.tid, nullptr, 0.f, nullptr, nullptr);
        }
    }
}
__device__ __forceinline__ void attn_fox_mfma(const Ctx& c, const bf16_t* qkv, const float* F, bf16_t* out) {
    unsigned char* scratch = (unsigned char*)c.lds;
    const att::UnitArgs UD{qkv, out, 1536, 2048, 2560, 512};
    for (int p = c.bid; p < 256; p += c.nblk) {
        const int pp = xcd_perm256(p), bh = pp >> 3, qb = pp & 7;
        att::causal_unit<3>(UD, bh >> 3, bh & 7, 15 - qb, scratch, c.tid, nullptr, 0.f, nullptr, F);
        att::causal_unit<3>(UD, bh >> 3, bh & 7, qb, scratch, c.tid, nullptr, 0.f, nullptr, F);
    }
}

__device__ __forceinline__ void ln_residual_naive(const Ctx& c, const float* hin, const float* add, const float* g, const float* bta, float* out, bf16_t* outb) {
    for (int t = c.gwave; t < NT; t += c.nwaves) {
        float v[16];
        float s = 0.f;
#pragma unroll
        for (int r = 0; r < 4; ++r) {
            const int d = r * 256 + c.lane * 4;
            const float4 a = *(const float4*)(hin + (size_t)t * DM + d), m = *(const float4*)(add + (size_t)t * DM + d);
            v[r * 4 + 0] = DN_ALPHA * a.x + m.x; v[r * 4 + 1] = DN_ALPHA * a.y + m.y; v[r * 4 + 2] = DN_ALPHA * a.z + m.z; v[r * 4 + 3] = DN_ALPHA * a.w + m.w;
            s += v[r * 4] + v[r * 4 + 1] + v[r * 4 + 2] + v[r * 4 + 3];
        }
        const float mu = wave_sum(s) * (1.f / DM);
        float q = 0.f;
#pragma unroll
        for (int i = 0; i < 16; ++i) { v[i] -= mu; q = fmaf(v[i], v[i], q); }
        const float rs = rsqrtf(wave_sum(q) * (1.f / DM) + LN_EPS);
#pragma unroll
        for (int r = 0; r < 4; ++r) {
            const int d = r * 256 + c.lane * 4;
            const float4 gg = *(const float4*)(g + d), bb = *(const float4*)(bta + d);
            const float4 o = make_float4(v[r * 4] * rs * gg.x + bb.x, v[r * 4 + 1] * rs * gg.y + bb.y, v[r * 4 + 2] * rs * gg.z + bb.z, v[r * 4 + 3] * rs * gg.w + bb.w);
            *(float4*)(out + (size_t)t * DM + d) = o;
            *(uint2*)(outb + (size_t)t * DM + d) = make_uint2(pk2(o.x, o.y), pk2(o.z, o.w));
        }
    }
}

__device__ __forceinline__ void topk_insert(float (&tv)[16], int (&ti)[16], float v, int id) {
#pragma unroll
    for (int j = 15; j >= 1; --j) {
        const bool g = v > tv[j], gp = v > tv[j - 1];
        tv[j] = g ? (gp ? tv[j - 1] : v) : tv[j];
        ti[j] = g ? (gp ? ti[j - 1] : id) : ti[j];
    }
    const bool g0 = v > tv[0];
    tv[0] = g0 ? v : tv[0]; ti[0] = g0 ? id : ti[0];
}

__device__ __forceinline__ void peer_stage1_naive(const Ctx& c, const bf16_t* pq, const float* subk  , float* lv, int* li) {
    const int ntask = (NT / 64) * 16;
    for (int task = c.gwave; task < ntask; task += c.nwaves) {
        const int hc = task & 15, t = (task >> 4) * 64 + c.lane;
        float q[128];
        const bf16_t* qr = pq + (size_t)t * PEER_QW + hc * 128;
#pragma unroll
        for (int i = 0; i < 128; ++i) q[i] = bf2f(qr[i]);
        float tv[16]; int ti[16];
#pragma unroll
        for (int j = 0; j < 16; ++j) { tv[j] = -INFINITY; ti[j] = 0; }
        for (int k = 0; k < 128; ++k) {
            const float* kr = subk + ((size_t)hc * 128 + k) * 128;
            float d = 0.f;
#pragma unroll
            for (int i = 0; i < 128; ++i) d = fmaf(q[i], kr[i], d);
            topk_insert(tv, ti, d, k);
        }
        float* ov = lv + ((size_t)t * 16 + hc) * 16; int* oi = li + ((size_t)t * 16 + hc) * 16;
#pragma unroll
        for (int j = 0; j < 16; ++j) { ov[j] = tv[j]; oi[j] = ti[j]; }
    }
}

__device__ __forceinline__ void peer_stage2_naive(const Ctx& c, const float* lv, const int* li, int* eidx, float* gate) {
    const int ntask = (NT / 64) * 8;
    for (int task = c.gwave; task < ntask; task += c.nwaves) {
        const int h = task & 7, t = (task >> 3) * 64 + c.lane;
        const float* av = lv + ((size_t)t * 16 + h * 2) * 16; const int* ai = li + ((size_t)t * 16 + h * 2) * 16;
        float tv[16]; int ti[16];
#pragma unroll
        for (int j = 0; j < 16; ++j) { tv[j] = -INFINITY; ti[j] = 0; }
#pragma unroll 1
        for (int ij = 0; ij < 256; ++ij) {
            const int i = ij >> 4, jj = ij & 15;
            topk_insert(tv, ti, av[i] + av[16 + jj], ai[i] * 128 + ai[16 + jj]);
        }
        float sum = 0.f, e[16];
#pragma unroll
        for (int j = 0; j < 16; ++j) { e[j] = expf(tv[j] - tv[0]); sum += e[j]; }
        const float inv = 1.f / sum;
        int* oi = eidx + ((size_t)t * 8 + h) * 16; float* og = gate + ((size_t)t * 8 + h) * 16;
#pragma unroll
        for (int j = 0; j < 16; ++j) { oi[j] = ti[j]; og[j] = e[j] * inv; }
    }
}

__device__ __forceinline__ void peer_gather_naive(const Ctx& c, const float* h1, const int* eidx, const float* gate, const float* U, const float* V, const float* g, const float* bta, float* out, bf16_t* outb) {
    for (int t = c.gwave; t < NT; t += c.nwaves) {
        float x[16], acc[16];
#pragma unroll
        for (int r = 0; r < 4; ++r) {
            const float4 a = *(const float4*)(h1 + (size_t)t * DM + r * 256 + c.lane * 4);
            x[r * 4] = a.x; x[r * 4 + 1] = a.y; x[r * 4 + 2] = a.z; x[r * 4 + 3] = a.w;
            acc[r * 4] = 0.f; acc[r * 4 + 1] = 0.f; acc[r * 4 + 2] = 0.f; acc[r * 4 + 3] = 0.f;
        }
        for (int k = 0; k < 128; ++k) {
            const int e = eidx[(size_t)t * 128 + k];
            const float gk = gate[(size_t)t * 128 + k];
            const float* ur = U + (size_t)e * DM;
            float d = 0.f;
#pragma unroll
            for (int r = 0; r < 4; ++r) {
                const float4 u = *(const float4*)(ur + r * 256 + c.lane * 4);
                d = fmaf(u.x, x[r * 4], d); d = fmaf(u.y, x[r * 4 + 1], d); d = fmaf(u.z, x[r * 4 + 2], d); d = fmaf(u.w, x[r * 4 + 3], d);
            }
            d = wave_sum(d);
            const float act = 0.5f * d * (1.f + erff(d * 0.70710678118654752f));
            const float cf = gk * act;
            const float* vr = V + (size_t)e * DM;
#pragma unroll
            for (int r = 0; r < 4; ++r) {
                const float4 v = *(const float4*)(vr + r * 256 + c.lane * 4);
                acc[r * 4] = fmaf(cf, v.x, acc[r * 4]); acc[r * 4 + 1] = fmaf(cf, v.y, acc[r * 4 + 1]); acc[r * 4 + 2] = fmaf(cf, v.z, acc[r * 4 + 2]); acc[r * 4 + 3] = fmaf(cf, v.w, acc[r * 4 + 3]);
            }
        }
        float s = 0.f;
#pragma unroll
        for (int i = 0; i < 16; ++i) { acc[i] = DN_ALPHA * x[i] + acc[i]; s += acc[i]; }
        const float mu = wave_sum(s) * (1.f / DM);
        float q = 0.f;
#pragma unroll
        for (int i = 0; i < 16; ++i) { acc[i] -= mu; q = fmaf(acc[i], acc[i], q); }
        const float rs = rsqrtf(wave_sum(q) * (1.f / DM) + LN_EPS);
#pragma unroll
        for (int r = 0; r < 4; ++r) {
            const int d = r * 256 + c.lane * 4;
            const float4 gg = *(const float4*)(g + d), bb = *(const float4*)(bta + d);
            const float4 o = make_float4(acc[r * 4] * rs * gg.x + bb.x, acc[r * 4 + 1] * rs * gg.y + bb.y, acc[r * 4 + 2] * rs * gg.z + bb.z, acc[r * 4 + 3] * rs * gg.w + bb.w);
            *(float4*)(out + (size_t)t * DM + d) = o;
            if (outb) *(uint2*)(outb + (size_t)t * DM + d) = make_uint2(pk2(o.x, o.y), pk2(o.z, o.w));
        }
    }
}

constexpr int NPHASE = 1 + 2 * 9;
__global__ void __launch_bounds__(NTHREADS, 2) fwd(Args args) {
    unsigned* ctl = (unsigned*)(args.ws + WS_CTL);
    volatile LAS unsigned* xbw = (volatile LAS unsigned*)(dyn_lds + MISC_OFF);
    if (threadIdx.x == 0) { xbw[0] = 0u; xbw[1] = 0u; xbw[2] = 0u; xbw[3] = 0u; }
    __syncthreads();
    const int lo = args.ph_lo, hi = args.ph_hi;
    XcdBarrier bar = xcd_barrier_post(ctl + 4096, xbw);
#define IN(k) (lo <= (k) && (k) < hi)
#define SEAM(k) do { if (IN(k) && IN((k) + 1)) xcd_barrier(bar); } while (0)
#define LAUNDER(ptr) ptr = launder_ptr(ptr)
#define PIN(k) ((const float*)launder_ptr((unsigned char*)args.in[k]))
#define GEMM_LDS ((PG8_LAS unsigned char*)dyn_lds + RING_OFF)
    if (IN(0)) { unsigned char* ws = args.ws; LAUNDER(ws); const Ctx c = make_ctx(); prologue_phase(c, PIN(0), PIN(2), PIN(5), PIN(6), PIN(8), PIN(9), ws); }
    SEAM(0);
#pragma unroll 1
    for (int layer = 0; layer < 2; ++layer) {
        const int pb = 1 + layer * 9;
        if (IN(pb + 0)) {
            unsigned char* ws = args.ws; LAUNDER(ws); const Ctx c = make_ctx();
            pg8::Gemm g{(const bf16_t*)(ws + WS_ACTIN), (const bf16_t*)(ws + (layer == 0 ? WT_ABIN : WT_CDIN)), NT, QKV_W, DM};
            pg8::StaticOrder S; S.init(NT, QKV_W, c.nblk, c.bid);
            pg8::EpiStoreBf16 E{(bf16_t*)(ws + WS_QKV), QKV_W, layer == 0 ? 0.17677669529663687f * 1.4426950408889634f : 1.f, 0.125f * 1.4426950408889634f};
            pg8::gemm_phase<pg8::EpiStoreBf16, pg8::StaticOrder, true, true>(GEMM_LDS, g, S, E);
            if (layer == 1) fg_phase(c, (const float*)(ws + WS_H2), PIN(6), (float*)(ws + WS_FG));
        }
        SEAM(pb + 0);
        if (IN(pb + 1) && layer == 1) { unsigned char* ws = args.ws; LAUNDER(ws); const Ctx c = make_ctx(); fscan_naive(c, (const float*)(ws + WS_FG), (float*)(ws + WS_F), PIN(7)); }
        SEAM(pb + 1);
        if (IN(pb + 2)) {
            unsigned char* ws = args.ws; LAUNDER(ws); const Ctx c = make_ctx();
            if (layer == 0) attn_layer0_mfma(c, (const bf16_t*)(ws + WS_QKV), (bf16_t*)(ws + WS_ATTB), PIN(1), PIN(3), PIN(4));
            else { attn_fox_mfma(c, (const bf16_t*)(ws + WS_QKV), (const float*)(ws + WS_F), (bf16_t*)(ws + WS_ATTB)); __syncthreads(); attn_dilated_naive(c, (const bf16_t*)(ws + WS_QKV), (bf16_t*)(ws + WS_ATTB), PIN(1)); }
        }
        SEAM(pb + 2);
        if (IN(pb + 3)) {
            unsigned char* ws = args.ws; LAUNDER(ws); const Ctx c = make_ctx();
            pg8::Gemm g{(const bf16_t*)(ws + WS_ATTB), (const bf16_t*)(ws + (layer == 0 ? WT_ABOUT : WT_CDOUT)), NT, DM, DM};
            pg8::StaticOrder S; S.init(NT, DM, c.nblk, c.bid);
            pg8::EpiStoreF32 E{(float*)(ws + WS_MIX), DM};
            pg8::gemm_phase<pg8::EpiStoreF32, pg8::StaticOrder, true, true>(GEMM_LDS, g, S, E);
        }
        SEAM(pb + 3);
        if (IN(pb + 4)) {
            unsigned char* ws = args.ws; LAUNDER(ws); const Ctx c = make_ctx();
            const float* hin = layer == 0 ? PIN(0) : (const float*)(ws + WS_H2);
            ln_residual_naive(c, hin, (const float*)(ws + WS_MIX), PIN(13) + (size_t)layer * 2 * DM, PIN(14) + (size_t)layer * 2 * DM, (float*)(ws + WS_H1), (bf16_t*)(ws + WS_H1B));
        }
        SEAM(pb + 4);
        if (IN(pb + 5)) {
            unsigned char* ws = args.ws; LAUNDER(ws); const Ctx c = make_ctx();
            pg8::Gemm g{(const bf16_t*)(ws + WS_H1B), (const bf16_t*)(ws + WT_WQ + (size_t)layer * 4 * MiB), NT, PEER_QW, DM};
            pg8::StaticOrder S; S.init(NT, PEER_QW, c.nblk, c.bid);
            pg8::EpiStoreBf16 E{(bf16_t*)(ws + WS_QKV), PEER_QW, 1.f, 1.f};
            pg8::gemm_phase<pg8::EpiStoreBf16, pg8::StaticOrder, true, true>(GEMM_LDS, g, S, E);
        }
        SEAM(pb + 5);
        if (IN(pb + 6)) {
            unsigned char* ws = args.ws; LAUNDER(ws); const Ctx c = make_ctx();
            float* LV = (float*)(ws + WS_LISTS);
            peer_stage1_naive(c, (const bf16_t*)(ws + WS_QKV), PIN(10) + (size_t)layer * 16 * 128 * 128, LV, (int*)(LV + (size_t)NT * 256));
        }
        SEAM(pb + 6);
        if (IN(pb + 7)) {
            unsigned char* ws = args.ws; LAUNDER(ws); const Ctx c = make_ctx();
            float* LV = (float*)(ws + WS_LISTS); float* MIXp = (float*)(ws + WS_MIX);
            peer_stage2_naive(c, LV, (const int*)(LV + (size_t)NT * 256), (int*)MIXp, MIXp + (size_t)NT * 128);
        }
        SEAM(pb + 7);
        if (IN(pb + 8)) {
            unsigned char* ws = args.ws; LAUNDER(ws); const Ctx c = make_ctx();
            float* MIXp = (float*)(ws + WS_MIX);
            float* hout = layer == 0 ? (float*)(ws + WS_H2) : (float*)launder_ptr((unsigned char*)args.out);
            bf16_t* houtb = layer == 0 ? (bf16_t*)(ws + WS_ACTIN) : (bf16_t*)nullptr;
            peer_gather_naive(c, (const float*)(ws + WS_H1), (const int*)MIXp, MIXp + (size_t)NT * 128, PIN(11) + (size_t)layer * 16384 * DM, PIN(12) + (size_t)layer * 16384 * DM,
                              PIN(13) + (size_t)(layer * 2 + 1) * DM, PIN(14) + (size_t)(layer * 2 + 1) * DM, hout, houtb);
        }
        SEAM(pb + 8);
    }
}

extern "C" void kernel_launch(void* const* d_in, const int* in_sizes, int n_in, void* d_out, int out_size, void* d_ws, size_t ws_size, hipStream_t stream) {
    (void)in_sizes; (void)n_in; (void)out_size;
    static int grid = 0;
    if (!grid) {
        int dev = 0, cus = 0, per_cu = 0;
        (void)hipGetDevice(&dev);
        (void)hipDeviceGetAttribute(&cus, hipDeviceAttributeMultiprocessorCount, dev);
        (void)hipFuncSetAttribute((const void*)fwd, hipFuncAttributeMaxDynamicSharedMemorySize, LDS_BYTES);
        (void)hipOccupancyMaxActiveBlocksPerMultiprocessor(&per_cu, fwd, NTHREADS, LDS_BYTES);
        if (per_cu < 1) fprintf(stderr, "occupancy query says %d blocks per CU\n", per_cu);
        grid = cus;
        if (ws_size < WS_END) fprintf(stderr, "workspace too small: %zu < %zu\n", ws_size, (size_t)WS_END);
    }
    (void)hipMemsetAsync((unsigned char*)d_ws + WS_CTL, 0, 1 * MiB, stream);
    Args a{};
    for (int i = 0; i < 15; ++i) a.in[i] = (const float*)d_in[i];
    a.out = (float*)d_out; a.ws = (unsigned char*)d_ws;
    a.ph_lo = 0; a.ph_hi = NPHASE;
    hipLaunchKernelGGL(fwd, dim3(grid), dim3(NTHREADS), LDS_BYTES, stream, a);
}
```

```cpp
#include <hip/hip_runtime.h>
#include <cstdio>
#include <cstdint>
#include <cmath>

constexpr int BATCH = 4, SEQ = 4096, DM = 1024, NT = BATCH * SEQ;
constexpr int NH = 8, HD = 64;
constexpr int QKV_W = 3072, CD_IN = 3080;
constexpr int PEER_QW = 2048;
constexpr float DN_ALPHA = 1.4142135623730951f;
constexpr float LN_EPS = 1e-5f;
constexpr int NTHREADS = 512, NWAVES = 8;
typedef unsigned short bf16_t;

constexpr size_t MiB = 1u << 20;
constexpr size_t WS_CTL = 0;
constexpr size_t WS_WT = 1 * MiB;
constexpr size_t WT_ABIN = WS_WT, WT_ABOUT = WS_WT + 6 * MiB, WT_CDIN = WS_WT + 8 * MiB, WT_CDOUT = WS_WT + 14 * MiB, WT_WQ = WS_WT + 16 * MiB;
constexpr size_t WS_ACTIN = 25 * MiB;
constexpr size_t WS_ATTB = 57 * MiB;
constexpr size_t WS_H1B = 89 * MiB;
constexpr size_t WS_QKV = 121 * MiB;
constexpr size_t WS_LISTS = WS_QKV + 64 * MiB;
constexpr size_t WS_MIX = 217 * MiB;
constexpr size_t WS_EIDX = 281 * MiB;
constexpr size_t WS_COEF = 289 * MiB;
constexpr size_t WS_F = 297 * MiB;
constexpr size_t WS_FG = 298 * MiB;
constexpr size_t WS_UB = 299 * MiB;
constexpr size_t WS_VB = 363 * MiB;
constexpr size_t WS_END = 427 * MiB;
constexpr int LDS_BYTES = 147456;
constexpr int RING_OFF = 0, MISC_OFF = 131072;

#define XB_TMO      128
#define XB_XCNT(j)  (256  + 64 * (j))
#define XB_XSUB(j)  (1280 + 64 * (j))
#define XB_XGEN(j)  (2304 + 64 * (j))
#define XB_TOP      3328
#define XB_TOPGEN   3392
#define XCD_BAR_WORDS 3456
#define XB_SPIN_CAP (1u << 18)
#define LAS __attribute__((address_space(3)))

__device__ __forceinline__ unsigned xb_ld(unsigned* p)              { return __hip_atomic_load(p, __ATOMIC_RELAXED, __HIP_MEMORY_SCOPE_AGENT); }
__device__ __forceinline__ unsigned xb_add(unsigned* p, unsigned v) { return __hip_atomic_fetch_add(p, v, __ATOMIC_RELAXED, __HIP_MEMORY_SCOPE_AGENT); }
__device__ __forceinline__ unsigned xb_xcc_id() { return (unsigned)__builtin_amdgcn_s_getreg((3 << 11) | 20) & 0xFu; }
#define XB_SPIN(cond, bar) do { unsigned _sp = 0; while (cond) { __builtin_amdgcn_s_sleep(1); \
    if ((++_sp & 255u) == 0u) { if (xb_ld(&(bar)[XB_TMO])) break; if (_sp > XB_SPIN_CAP) { atomicAdd(&(bar)[XB_TMO], 1u); break; } } } } while (0)

struct XcdBarrier {
    unsigned* bar; unsigned x;
    volatile LAS unsigned* st;
};
__device__ __forceinline__ XcdBarrier xcd_barrier_post(unsigned* bar, volatile LAS unsigned* st) {
    XcdBarrier b; b.bar = bar; b.x = xb_xcc_id(); b.st = st;
    if (threadIdx.x == 0) (void)xb_add(&bar[XB_XCNT(b.x)], 1u);
    return b;
}
__device__ __forceinline__ void xcd_barrier_complete(unsigned* bar, unsigned x, unsigned& nloc, unsigned& nx) {
    const unsigned G = gridDim.x * gridDim.y * gridDim.z;
    unsigned sum, cnt, mine, sp = 0u;
    for (;;) {
        sum = 0u; cnt = 0u; mine = 0u;
#pragma unroll
        for (unsigned j = 0; j < 16; ++j) { const unsigned c = xb_ld(&bar[XB_XCNT(j)]); sum += c; cnt += (c > 0u) ? 1u : 0u; mine = (j == x) ? c : mine; }
        if (sum == G) break;
        __builtin_amdgcn_s_sleep(1);
        if ((++sp & 255u) == 0u) { if (xb_ld(&bar[XB_TMO])) break; if (sp > XB_SPIN_CAP) { atomicAdd(&bar[XB_TMO], 1u); break; } }
    }
    nloc = mine > 0u ? mine : 1u; nx = cnt > 0u ? cnt : 1u;
}
__device__ __forceinline__ void xcd_barrier(const XcdBarrier& b) {
    asm volatile("s_waitcnt vmcnt(0)" ::: "memory");
    __syncthreads();
    if (threadIdx.x == 0) {
        unsigned* bar = b.bar;
        __builtin_amdgcn_s_waitcnt(0);
        unsigned nloc = b.st[0], nx = b.st[1];
        if (nloc == 0u) { xcd_barrier_complete(bar, b.x, nloc, nx); b.st[0] = nloc; b.st[1] = nx; }
        const unsigned old = xb_add(&bar[XB_XSUB(b.x)], 1u);
        const unsigned gen = old / nloc;
        if (old + 1u == (gen + 1u) * nloc) {
            __builtin_amdgcn_fence(__ATOMIC_RELEASE, "agent");
            asm volatile("s_waitcnt vmcnt(0)" ::: "memory");
            const unsigned og = xb_add(&bar[XB_TOP], 1u);
            const unsigned tg = og / nx;
            if (og + 1u == (tg + 1u) * nx) xb_add(&bar[XB_TOPGEN], 1u);
            else XB_SPIN(xb_ld(&bar[XB_TOPGEN]) == tg, bar);
            __builtin_amdgcn_fence(__ATOMIC_ACQUIRE, "agent");
            xb_add(&bar[XB_XGEN(b.x)], 1u);
            asm volatile("s_waitcnt vmcnt(0)" ::: "memory");
        } else {
            XB_SPIN(xb_ld(&bar[XB_XGEN(b.x)]) == gen, bar);
            __builtin_amdgcn_fence(__ATOMIC_ACQUIRE, "agent");
            asm volatile("s_waitcnt vmcnt(0)" ::: "memory");
        }
    }
    __syncthreads();
}

struct Args {
    const float* in[15];
    float* out;
    unsigned char* ws;
    int ph_lo, ph_hi;
};
struct Ctx {
    int tid, lane, wave, gwave, nwaves, bid, nblk;
    float* lds;
};
extern __shared__ __attribute__((aligned(16))) unsigned char dyn_lds[];
__device__ __forceinline__ Ctx make_ctx() {
    int t = threadIdx.x, b = blockIdx.x, g = gridDim.x;
    asm volatile("" : "+v"(t));
    asm volatile("" : "+s"(b), "+s"(g));
    Ctx c; c.tid = t; c.lane = t & 63; c.wave = t >> 6; c.bid = b; c.nblk = g;
    c.gwave = b * NWAVES + c.wave; c.nwaves = g * NWAVES; c.lds = (float*)(dyn_lds + RING_OFF);
    return c;
}
__device__ __forceinline__ unsigned char* launder_ptr(unsigned char* p) {
    unsigned lo = __builtin_amdgcn_readfirstlane((unsigned)(uintptr_t)p), hi = __builtin_amdgcn_readfirstlane((unsigned)((uintptr_t)p >> 32));
    asm volatile("" : "+s"(lo), "+s"(hi));
    return (unsigned char*)(((uintptr_t)hi << 32) | (uintptr_t)lo);
}
__device__ __forceinline__ float wave_sum(float v) {
#pragma unroll
    for (int o = 32; o >= 1; o >>= 1) v += __shfl_xor(v, o);
    return v;
}
__device__ __forceinline__ float log_sigmoid(float z) { return fminf(z, 0.f) - log1pf(expf(-fabsf(z))); }
__device__ __forceinline__ int t5_bucket(int n) {
    if (n < 16) return n;
    int large = 16 + (int)(logf((float)n / 16.f) / 2.0794415416798357f * 16.f);
    return large < 31 ? large : 31;
}
__device__ __forceinline__ float bf2f(bf16_t v) { return __builtin_bit_cast(float, (unsigned)v << 16); }
__device__ __forceinline__ unsigned f2bf(float f) { unsigned u = __builtin_bit_cast(unsigned, f); return (u + 0x7fffu + ((u >> 16) & 1u)) >> 16; }
__device__ __forceinline__ unsigned pk2(float lo, float hi) { return f2bf(lo) | (f2bf(hi) << 16); }

namespace pg8 {
#define PG8_LAS __attribute__((address_space(3)))
typedef unsigned short bf16_t;
typedef short bf16x8 __attribute__((ext_vector_type(8)));
typedef float f32x4 __attribute__((ext_vector_type(4)));
typedef unsigned u32x4 __attribute__((ext_vector_type(4)));
constexpr int BM = 256, BK = 64, HALF = 128, HTB = HALF * BK * 2  , STAGE_BYTES = 8 * HTB, NXCD = 8, WGM = 8;

__host__ __device__ __forceinline__ int lds_byte(int r, int c) { const int st = (r >> 4) * 2 + (c >> 5), rr = r & 15, cc = c & 31, ob = rr * 64 + cc * 2; return st * 1024 + (ob ^ (((ob >> 9) & 1) << 5)); }
__host__ __device__ __forceinline__ void stage_rc(int b, int& R, int& C) { const int st = b / 1024, sb = b % 1024, swz = sb ^ (((sb >> 9) & 1) << 5); R = (st >> 1) * 16 + swz / 64; C = (st & 1) * 32 + (swz % 64) / 2; }
__host__ __device__ __forceinline__ int perm32(int rho) { const int n = rho >> 4, i = rho & 15; return 8 * (i >> 2) + 4 * n + (i & 3); }

struct Unit { int pm, pn; };
struct Gemm { const bf16_t* A; const bf16_t* Bt; int M, N, K; };

struct StaticOrder {
    int nM, nN, nwg, G, c;
    __host__ __device__ void init(int M, int N, int G_, int c_) { nM = M / BM; nN = N / BM; nwg = nM * nN; G = G_; c = c_; }
    __host__ __device__ bool next(int i, Unit& u) const {
        const long L = (long)i * G + c; if (L >= nwg) return false;
        int wgid = (int)L; { const int q = nwg / NXCD, r = nwg % NXCD, xcd = wgid % NXCD, off = wgid / NXCD; wgid = (xcd < r ? xcd * (q + 1) : r * (q + 1) + (xcd - r) * q) + off; }
        const int nig = WGM * nN, gid = wgid / nig, fm = gid * WGM, gsz = (nM - fm) < WGM ? (nM - fm) : WGM;
        u.pm = fm + ((wgid % nig) % gsz); u.pn = (wgid % nig) / gsz; return true;
    }
    __device__ __forceinline__ void a_ready(const Unit&) const {}
    __device__ __forceinline__ void done(const Unit&) const {}
};

__device__ __forceinline__ unsigned cvt_pk_bf16(float lo, float hi) { unsigned r; asm volatile("v_cvt_pk_bf16_f32 %0, %1, %2" : "=v"(r) : "v"(lo), "v"(hi)); return r; }
template <class Epi, class Sched, bool ALIGN_EPI = false, bool SP2 = false>
__device__ __forceinline__ void gemm_phase(PG8_LAS unsigned char* lds, const Gemm g, const Sched& S, const Epi& E) {
    const int tid = threadIdx.x, wid = __builtin_amdgcn_readfirstlane(tid >> 6), lane = tid & 63, wr = wid >> 2, wc = wid & 3, fr = lane & 15, fq = lane >> 4;
    const int K = g.K, nt = K / BK;
    unsigned voffA[2], voffB[2];
#pragma unroll
    for (int i = 0; i < 2; ++i) { int R, C; stage_rc(tid * 16 + i * 8192, R, C); const int Rb = Epi::PERM ? ((R & ~31) + perm32(R & 31)) : R;
        voffA[i] = (unsigned)(R * K + C) * 2u; voffB[i] = (unsigned)(Rb * K + C) * 2u; }
    const size_t kstep = (size_t)(BK * 2);
    const size_t hstep = (size_t)HALF * K * 2;
    const size_t tstep = 2 * hstep;
    const unsigned ldsw = (unsigned)wid * 1024u;
    const int aoff = lds_byte(wr * 64 + fr, fq * 8), boff = lds_byte(wc * 32 + fr, fq * 8);
#define PG8_SA(b, h) (((b) * 2 + (h)) * HTB)
#define PG8_SB(b, h) ((4 + (b) * 2 + (h)) * HTB)
#define PG8_STAGE(bufoff, gbase, voff) do { _Pragma("unroll") for (int _i = 0; _i < 2; ++_i) \
        __builtin_amdgcn_global_load_lds((const unsigned*)((const char*)(gbase) + (voff)[_i]), (PG8_LAS unsigned*)(lds + (bufoff) + ldsw + _i * 8192), 16, 0, 0); } while (0)
#define PG8_LDA(dst, b, h) do { _Pragma("unroll") for (int m = 0; m < 4; ++m) _Pragma("unroll") for (int k = 0; k < 2; ++k) dst[m][k] = *(const PG8_LAS bf16x8*)(lds + PG8_SA(b, h) + aoff + m * 2048 + k * 1024); } while (0)
#define PG8_LDB(dst, b, h) do { _Pragma("unroll") for (int n = 0; n < 2; ++n) _Pragma("unroll") for (int k = 0; k < 2; ++k) dst[n][k] = *(const PG8_LAS bf16x8*)(lds + PG8_SB(b, h) + boff + n * 2048 + k * 1024); } while (0)
#define PG8_MMA(ai, bj, At, Bt) do { __builtin_amdgcn_s_setprio(1); _Pragma("unroll") for (int m = 0; m < 4; ++m) _Pragma("unroll") for (int n = 0; n < 2; ++n) _Pragma("unroll") for (int k = 0; k < 2; ++k) \
        acc[ai][bj][m][n] = __builtin_amdgcn_mfma_f32_16x16x32_bf16(Bt[n][k], At[m][k], acc[ai][bj][m][n], 0, 0, 0); __builtin_amdgcn_s_setprio(0); } while (0)
#define PG8_WAIT_V(n) asm volatile("s_waitcnt vmcnt(" #n ")" ::: "memory")
#define PG8_WAIT_L(n) asm volatile("s_waitcnt lgkmcnt(" #n ")" ::: "memory")
#define PG8_BAR __builtin_amdgcn_s_barrier()
#define PG8_SCHED __builtin_amdgcn_sched_barrier(0)
    Unit cur, nxt; int ui = 0;
    if (!S.next(0, cur)) return;
    f32x4 acc[2][2][4][2];
#pragma unroll
    for (int a = 0; a < 2; ++a)
#pragma unroll
        for (int b = 0; b < 2; ++b)
#pragma unroll
            for (int m = 0; m < 4; ++m)
#pragma unroll
                for (int n = 0; n < 2; ++n) acc[a][b][m][n] = (f32x4){0.f, 0.f, 0.f, 0.f};
    bf16x8 At[4][2], B0[2][2], B1[2][2];
    const char* cA = (const char*)g.A + (size_t)cur.pm * tstep; const char* cB = (const char*)g.Bt + (size_t)cur.pn * tstep;
    S.a_ready(cur);
    if constexpr (SP2) {
        PG8_STAGE(PG8_SB(0, 0), cB, voffB); PG8_STAGE(PG8_SB(0, 1), cB + hstep, voffB); PG8_STAGE(PG8_SA(0, 0), cA, voffA); PG8_STAGE(PG8_SA(0, 1), cA + hstep, voffA);
        if (wr == 1) PG8_BAR;
        PG8_WAIT_V(2); PG8_BAR;
        PG8_STAGE(PG8_SB(1, 0), cB + kstep, voffB); PG8_STAGE(PG8_SA(1, 0), cA + kstep, voffA); PG8_STAGE(PG8_SB(1, 1), cB + hstep + kstep, voffB);
        PG8_WAIT_V(6); PG8_BAR;
    } else {
        PG8_STAGE(PG8_SB(0, 0), cB, voffB); PG8_STAGE(PG8_SA(0, 0), cA, voffA); PG8_STAGE(PG8_SB(0, 1), cB + hstep, voffB); PG8_STAGE(PG8_SA(0, 1), cA + hstep, voffA);
        if (wr == 1) PG8_BAR;
        PG8_WAIT_V(4); PG8_BAR;
        PG8_STAGE(PG8_SB(1, 0), cB + kstep, voffB); PG8_STAGE(PG8_SA(1, 0), cA + kstep, voffA); PG8_STAGE(PG8_SB(1, 1), cB + hstep + kstep, voffB);
        PG8_WAIT_V(6); PG8_BAR;
    }
    for (;;) {
        const bool has_next = S.next(ui + 1, nxt);
        const char* nA = has_next ? (const char*)g.A + (size_t)nxt.pm * tstep : cA; const char* nB = has_next ? (const char*)g.Bt + (size_t)nxt.pn * tstep : cB;
        for (int t = 0; t < nt; t += 2) {
            const bool last = (t == nt - 2);
            const char* a1 = cA + (size_t)(t + 1) * kstep;
            const char* a2 = last ? nA : cA + (size_t)(t + 2) * kstep; const char* b2 = last ? nB : cB + (size_t)(t + 2) * kstep;
            const char* a3 = a2 + kstep; const char* b3 = b2 + kstep;
            if (last && has_next) S.a_ready(nxt);
            if constexpr (SP2) {
            PG8_LDB(B0, 0, 0); PG8_LDB(B1, 0, 1); PG8_SCHED; PG8_LDA(At, 0, 0); PG8_STAGE(PG8_SA(1, 1), a1 + hstep, voffA);
            PG8_WAIT_V(8); PG8_WAIT_L(0); PG8_BAR; PG8_MMA(0, 0, At, B0); PG8_MMA(0, 1, At, B1); PG8_BAR; PG8_SCHED;
            PG8_LDA(At, 0, 1); PG8_STAGE(PG8_SB(0, 0), b2, voffB); PG8_STAGE(PG8_SB(0, 1), b2 + hstep, voffB); PG8_STAGE(PG8_SA(0, 0), a2, voffA);
            PG8_WAIT_V(8); PG8_WAIT_L(0); PG8_BAR; PG8_MMA(1, 0, At, B0); PG8_MMA(1, 1, At, B1); PG8_BAR; PG8_SCHED;
            PG8_LDB(B0, 1, 0); PG8_LDB(B1, 1, 1); PG8_SCHED; PG8_LDA(At, 1, 0); PG8_STAGE(PG8_SA(0, 1), a2 + hstep, voffA);
            PG8_WAIT_V(8); PG8_WAIT_L(0); PG8_BAR; PG8_MMA(0, 0, At, B0); PG8_MMA(0, 1, At, B1); PG8_BAR; PG8_SCHED;
            PG8_LDA(At, 1, 1); PG8_STAGE(PG8_SB(1, 0), b3, voffB); PG8_STAGE(PG8_SB(1, 1), b3 + hstep, voffB); PG8_STAGE(PG8_SA(1, 0), a3, voffA);
            PG8_WAIT_V(8); PG8_WAIT_L(0); PG8_BAR; PG8_MMA(1, 0, At, B0); PG8_MMA(1, 1, At, B1); PG8_BAR; PG8_SCHED;
            } else {
            PG8_LDB(B0, 0, 0); PG8_SCHED; PG8_LDA(At, 0, 0); PG8_STAGE(PG8_SA(1, 1), a1 + hstep, voffA);
            PG8_WAIT_L(8); PG8_BAR; PG8_WAIT_L(0); PG8_MMA(0, 0, At, B0); PG8_BAR; PG8_SCHED;
            PG8_LDB(B1, 0, 1); PG8_STAGE(PG8_SB(0, 0), b2, voffB);
            PG8_BAR; PG8_WAIT_L(0); PG8_MMA(0, 1, At, B1); PG8_BAR;
            PG8_LDA(At, 0, 1); PG8_STAGE(PG8_SA(0, 0), a2, voffA);
            PG8_BAR; PG8_WAIT_L(0); PG8_MMA(1, 0, At, B0); PG8_BAR; PG8_SCHED;
            PG8_STAGE(PG8_SB(0, 1), b2 + hstep, voffB);
            PG8_WAIT_V(6); PG8_BAR; PG8_MMA(1, 1, At, B1); PG8_BAR;
            PG8_LDB(B0, 1, 0); PG8_SCHED; PG8_LDA(At, 1, 0); PG8_STAGE(PG8_SA(0, 1), a2 + hstep, voffA);
            PG8_WAIT_L(8); PG8_BAR; PG8_WAIT_L(0); PG8_MMA(0, 0, At, B0); PG8_BAR; PG8_SCHED;
            PG8_LDB(B1, 1, 1); PG8_STAGE(PG8_SB(1, 0), b3, voffB);
            PG8_BAR; PG8_WAIT_L(0); PG8_MMA(0, 1, At, B1); PG8_BAR;
            PG8_LDA(At, 1, 1); PG8_STAGE(PG8_SA(1, 0), a3, voffA);
            PG8_BAR; PG8_WAIT_L(0); PG8_MMA(1, 0, At, B0); PG8_BAR; PG8_SCHED;
            PG8_STAGE(PG8_SB(1, 1), b3 + hstep, voffB);
            PG8_WAIT_V(6); PG8_BAR; PG8_MMA(1, 1, At, B1); PG8_BAR;
            }
        }
        if constexpr (ALIGN_EPI) { if (wr == 0) PG8_BAR; }
        if constexpr (!Epi::AFTER_DRAIN) { E(acc, cur, wr, wc, fr, fq); S.done(cur); }
        if (!has_next) break;
#pragma unroll
        for (int a = 0; a < 2; ++a)
#pragma unroll
            for (int b = 0; b < 2; ++b)
#pragma unroll
                for (int m = 0; m < 4; ++m)
#pragma unroll
                    for (int n = 0; n < 2; ++n) acc[a][b][m][n] = (f32x4){0.f, 0.f, 0.f, 0.f};
        cur = nxt; cA = nA; cB = nB; ++ui;
        if constexpr (ALIGN_EPI) { if (wr == 1) PG8_BAR; }
    }
    PG8_WAIT_V(0);
    if constexpr (!ALIGN_EPI) { if (wr == 0) PG8_BAR; }
    PG8_BAR;
    if constexpr (Epi::AFTER_DRAIN) { E.fused(acc, cur, wr, wc, fr, fq, lds, wid, lane); S.done(cur); }
#undef PG8_SA
#undef PG8_SB
#undef PG8_STAGE
#undef PG8_LDA
#undef PG8_LDB
#undef PG8_MMA
#undef PG8_WAIT_V
#undef PG8_WAIT_L
#undef PG8_BAR
#undef PG8_SCHED
}
}

namespace pg8 {
struct EpiStoreBf16 {
    static constexpr bool PERM = true, AFTER_DRAIN = false;
    bf16_t* O; int ldc; float s01, s67;
    __device__ __forceinline__ void operator()(const f32x4 (&acc)[2][2][4][2], const Unit& u, int wr, int wc, int fr, int fq) const {
        const int row0 = u.pm * BM + wr * 64 + fr, col0 = u.pn * BM + wc * 32 + 8 * fq;
        const float sc = u.pn < 2 ? s01 : ((u.pn == 6 || u.pn == 7) ? s67 : 1.f);
#pragma unroll
        for (int ai = 0; ai < 2; ++ai)
#pragma unroll
            for (int m = 0; m < 4; ++m) { bf16_t* rowp = O + (size_t)(row0 + ai * HALF + m * 16) * ldc + col0;
#pragma unroll
                for (int bj = 0; bj < 2; ++bj) { const f32x4 v0 = acc[ai][bj][m][0] * sc, v1 = acc[ai][bj][m][1] * sc;
                    u32x4 w; w.x = cvt_pk_bf16(v0[0], v0[1]); w.y = cvt_pk_bf16(v0[2], v0[3]); w.z = cvt_pk_bf16(v1[0], v1[1]); w.w = cvt_pk_bf16(v1[2], v1[3]);
                    *(u32x4*)(rowp + bj * HALF) = w; } }
    }
};
struct EpiStoreF32 {
    static constexpr bool PERM = true, AFTER_DRAIN = false;
    float* C; int ldc;
    __device__ __forceinline__ void operator()(const f32x4 (&acc)[2][2][4][2], const Unit& u, int wr, int wc, int fr, int fq) const {
        const int row0 = u.pm * BM + wr * 64 + fr, col0 = u.pn * BM + wc * 32 + 8 * fq;
#pragma unroll
        for (int ai = 0; ai < 2; ++ai)
#pragma unroll
            for (int m = 0; m < 4; ++m) { float* rowp = C + (size_t)(row0 + ai * HALF + m * 16) * ldc + col0;
#pragma unroll
                for (int bj = 0; bj < 2; ++bj) { *(f32x4*)(rowp + bj * HALF) = acc[ai][bj][m][0]; *(f32x4*)(rowp + bj * HALF + 4) = acc[ai][bj][m][1]; } }
    }
};
}

__device__ __forceinline__ void transpose_item(const float* W, int ldw, int K, int ncols, bf16_t* WT, float* scr, int item, int lane) {
    const int nblk = ncols / 32, kb = item / nblk, nb = item % nblk, k0 = 64 * kb, n0 = 32 * nb;
#pragma unroll 8
    for (int i = 0; i < 32; ++i) { const int kk = 2 * i + (lane >> 5); scr[kk * 33 + (lane & 31)] = W[(size_t)(k0 + kk) * ldw + n0 + (lane & 31)]; }
    asm volatile("s_waitcnt lgkmcnt(0)" ::: "memory");
    const int c = lane & 7;
#pragma unroll
    for (int j = 0; j < 4; ++j) { const int n = (lane >> 3) + 8 * j; const float* s = scr + (8 * c) * 33 + n;
        uint4 o; o.x = pk2(s[0 * 33], s[1 * 33]); o.y = pk2(s[2 * 33], s[3 * 33]); o.z = pk2(s[4 * 33], s[5 * 33]); o.w = pk2(s[6 * 33], s[7 * 33]);
        *(uint4*)(WT + (size_t)(n0 + n) * K + k0 + 8 * c) = o; }
    asm volatile("s_waitcnt lgkmcnt(0)" ::: "memory");
}
__device__ __forceinline__ void cvt_rows_bf16(const Ctx& c, const float* src, bf16_t* dst, size_t n8) {
    for (size_t i = (size_t)c.gwave * 64 + c.lane; i < n8; i += (size_t)c.nwaves * 64) {
        const float4 a = *(const float4*)(src + i * 8), b = *(const float4*)(src + i * 8 + 4);
        uint4 o; o.x = pk2(a.x, a.y); o.y = pk2(a.z, a.w); o.z = pk2(b.x, b.y); o.w = pk2(b.z, b.w);
        *(uint4*)(dst + i * 8) = o;
    }
}
__device__ __forceinline__ void prologue_phase(const Ctx& c, const float* x, const float* ab_in, const float* ab_out, const float* cd_in, const float* cd_out, const float* wq, const float* pu, const float* pv, unsigned char* ws) {
    float* scr = c.lds + c.wave * 4096;
    constexpr int I_IN = 16 * 96, I_OUT = 16 * 32, I_WQ = 16 * 64;
    constexpr int NITEMS = 2 * I_IN + 2 * I_OUT + 2 * I_WQ;
    for (int it = c.gwave; it < NITEMS; it += c.nwaves) {
        int r = it;
        if (r < I_IN) { transpose_item(ab_in, QKV_W, DM, QKV_W, (bf16_t*)(ws + WT_ABIN), scr, r, c.lane); continue; } r -= I_IN;
        if (r < I_IN) { transpose_item(cd_in, CD_IN, DM, QKV_W, (bf16_t*)(ws + WT_CDIN), scr, r, c.lane); continue; } r -= I_IN;
        if (r < I_OUT) { transpose_item(ab_out, DM, DM, DM, (bf16_t*)(ws + WT_ABOUT), scr, r, c.lane); continue; } r -= I_OUT;
        if (r < I_OUT) { transpose_item(cd_out, DM, DM, DM, (bf16_t*)(ws + WT_CDOUT), scr, r, c.lane); continue; } r -= I_OUT;
        if (r < I_WQ) { transpose_item(wq, PEER_QW, DM, PEER_QW, (bf16_t*)(ws + WT_WQ), scr, r, c.lane); continue; } r -= I_WQ;
        transpose_item(wq + (size_t)DM * PEER_QW, PEER_QW, DM, PEER_QW, (bf16_t*)(ws + WT_WQ + 4 * MiB), scr, r, c.lane);
    }
    cvt_rows_bf16(c, x, (bf16_t*)(ws + WS_ACTIN), (size_t)NT * DM / 8);
    cvt_rows_bf16(c, pu, (bf16_t*)(ws + WS_UB), (size_t)2 * 16384 * DM / 8);
    cvt_rows_bf16(c, pv, (bf16_t*)(ws + WS_VB), (size_t)2 * 16384 * DM / 8);
}

template <int DQ, class BiasF>
__device__ __forceinline__ void causal_softmax_row(const float (&q)[DQ], const bf16_t* kbase, const bf16_t* vbase, int ld, int t, int smax, float scale, BiasF biasf, float (&O)[64]) {
    float m = -INFINITY;
    for (int s = 0; s <= smax; ++s) {
        const bf16_t* kr = kbase + (size_t)s * ld;
        float d = 0.f;
#pragma unroll
        for (int i = 0; i < DQ; ++i) d = fmaf(q[i], bf2f(kr[i]), d);
        const float lg = d * scale + biasf(s);
        m = (s <= t) ? fmaxf(m, lg) : m;
    }
    float l = 0.f;
#pragma unroll
    for (int i = 0; i < 64; ++i) O[i] = 0.f;
    for (int s = 0; s <= smax; ++s) {
        const bf16_t* kr = kbase + (size_t)s * ld;
        const bf16_t* vr = vbase + (size_t)s * ld;
        float d = 0.f;
#pragma unroll
        for (int i = 0; i < DQ; ++i) d = fmaf(q[i], bf2f(kr[i]), d);
        const float lg = d * scale + biasf(s);
        const float p = (s <= t) ? expf(lg - m) : 0.f;
        l += p;
#pragma unroll
        for (int i = 0; i < 64; ++i) O[i] = fmaf(p, bf2f(vr[i]), O[i]);
    }
    const float inv = 1.f / l;
#pragma unroll
    for (int i = 0; i < 64; ++i) O[i] *= inv;
}
__device__ __forceinline__ void store_row64_bf16(bf16_t* orow, const float (&v)[64]) {
#pragma unroll
    for (int i = 0; i < 64; i += 8) { uint4 o; o.x = pk2(v[i], v[i + 1]); o.y = pk2(v[i + 2], v[i + 3]); o.z = pk2(v[i + 4], v[i + 5]); o.w = pk2(v[i + 6], v[i + 7]); *(uint4*)(orow + i) = o; }
}

__device__ __forceinline__ void fg_phase(const Ctx& c, const bf16_t* hin, const float* cd_in, float* fg) {
    for (int t = c.gwave; t < NT; t += c.nwaves) {
        float acc[8];
#pragma unroll
        for (int j = 0; j < 8; ++j) acc[j] = 0.f;
        for (int r = 0; r < 16; ++r) {
            const int d = r * 64 + c.lane;
            const float xv = bf2f(hin[(size_t)t * DM + d]);
            const float4 w0 = *(const float4*)(cd_in + (size_t)d * CD_IN + 3072), w1 = *(const float4*)(cd_in + (size_t)d * CD_IN + 3076);
            acc[0] = fmaf(xv, w0.x, acc[0]); acc[1] = fmaf(xv, w0.y, acc[1]); acc[2] = fmaf(xv, w0.z, acc[2]); acc[3] = fmaf(xv, w0.w, acc[3]);
            acc[4] = fmaf(xv, w1.x, acc[4]); acc[5] = fmaf(xv, w1.y, acc[5]); acc[6] = fmaf(xv, w1.z, acc[6]); acc[7] = fmaf(xv, w1.w, acc[7]);
        }
#pragma unroll
        for (int j = 0; j < 8; ++j) acc[j] = wave_sum(acc[j]);
        if (c.lane == 0) { *(float4*)(fg + (size_t)t * 8) = make_float4(acc[0], acc[1], acc[2], acc[3]); *(float4*)(fg + (size_t)t * 8 + 4) = make_float4(acc[4], acc[5], acc[6], acc[7]); }
    }
}
__device__ __forceinline__ void fscan_naive(const Ctx& c, const float* fg, float* F, const float* bf) {
    for (int task = c.gwave; task < 32; task += c.nwaves) {
        const int b = task >> 3, h = task & 7;
        const int lane = c.lane;
        float v[64]; float tot = 0.f;
#pragma unroll
        for (int i = 0; i < 64; ++i) { const int s = lane * 64 + i; v[i] = log_sigmoid(fg[((size_t)b * SEQ + s) * 8 + h] + bf[h]); tot += v[i]; }
        float incl = tot;
#pragma unroll
        for (int o = 1; o < 64; o <<= 1) { const float n = __shfl_up(incl, o); if (lane >= o) incl += n; }
        float run = incl - tot;
#pragma unroll
        for (int i = 0; i < 64; ++i) { run += v[i]; F[(size_t)task * SEQ + lane * 64 + i] = run; }
    }
}

__device__ __forceinline__ void attn_dilated_naive(const Ctx& c, const bf16_t* qkv, bf16_t* out, const float* t5) {
    float* biasTab = c.lds;
    for (int i = c.tid; i < 8 * 129; i += NTHREADS) { const int h = i / 129, d = i % 129; biasTab[i] = t5[t5_bucket(d) * 8 + h]; }
    __syncthreads();
    const int lane = c.lane;
    for (int task = c.gwave; task < 32 * 32; task += c.nwaves) {
        const int p = task & 31, bh = (task >> 5) & 31;
        const int b = bh >> 3, h = bh & 7;
        for (int half = 0; half < 2; ++half) {
            const int tb = half ? 63 - p : p;
            const int t = tb * 64 + lane, smax = tb * 64 + 63;
            const size_t rowbase = (size_t)b * SEQ;
            {
                float q[64], O[64];
                const bf16_t* qr = qkv + (rowbase + t) * QKV_W + h * 64;
#pragma unroll
                for (int i = 0; i < 64; ++i) { q[i] = bf2f(qr[i]); O[i] = 0.f; }
                const bf16_t* kbase = qkv + rowbase * QKV_W + 512 + h * 64;
                const bf16_t* vbase = qkv + rowbase * QKV_W + 1024 + h * 64;
                float m = -INFINITY;
                for (int pat = 0; pat < 3; ++pat) {
                    const int dil = pat == 0 ? 1 : (pat == 1 ? 4 : 16);
                    for (int j = 0; j <= 128; ++j) {
                        const int dist = j * dil, s = t - dist;
                        if (s >= 0) {
                            const bf16_t* kr = kbase + (size_t)s * QKV_W;
                            float d = 0.f;
#pragma unroll
                            for (int i = 0; i < 64; ++i) d = fmaf(q[i], bf2f(kr[i]), d);
                            const float lg = d * 0.125f + biasTab[h * 129 + (dist > 128 ? 128 : dist)];
                            m = fmaxf(m, lg);
                        }
                    }
                }
                float l = 0.f;
                for (int pat = 0; pat < 3; ++pat) {
                    const int dil = pat == 0 ? 1 : (pat == 1 ? 4 : 16);
                    for (int j = 0; j <= 128; ++j) {
                        const int dist = j * dil, s = t - dist;
                        if (s >= 0) {
                            const bf16_t* kr = kbase + (size_t)s * QKV_W;
                            const bf16_t* vr = vbase + (size_t)s * QKV_W;
                            float d = 0.f;
#pragma unroll
                            for (int i = 0; i < 64; ++i) d = fmaf(q[i], bf2f(kr[i]), d);
                            const float lg = d * 0.125f + biasTab[h * 129 + (dist > 128 ? 128 : dist)];
                            const float pw = expf(lg - m);
                            l += pw;
#pragma unroll
                            for (int i = 0; i < 64; ++i) O[i] = fmaf(pw, bf2f(vr[i]), O[i]);
                        }
                    }
                }
                const float inv = 1.f / l;
#pragma unroll
                for (int i = 0; i < 64; ++i) O[i] *= inv;
                store_row64_bf16(out + (rowbase + t) * DM + h * 64, O);
            }
        }
    }
}

namespace att {
typedef short bf16x8 __attribute__((ext_vector_type(8)));
typedef short s16x4 __attribute__((ext_vector_type(4)));
typedef float f32x16 __attribute__((ext_vector_type(16)));
typedef float f32x4 __attribute__((ext_vector_type(4)));
typedef short v4i16_t __attribute__((ext_vector_type(4)));
constexpr float LOG2E = 1.4426950408889634f;
constexpr float NEG = -1e30f;
constexpr int KBUF = 0, VBUF = 16384, FBUF = 32768, TBUF = 33792, CNT = 34816;

__device__ __forceinline__ int tile_off(int row, int ch) { return 1024 * (row >> 3) + 512 * (ch >> 2) + 64 * (row & 7) + 16 * ((ch & 3) ^ ((row >> 2) & 3)); }
__device__ __forceinline__ s16x4 vtr(const LAS unsigned char* p) { return __builtin_bit_cast(s16x4, __builtin_amdgcn_ds_read_tr16_b64_v4i16((LAS v4i16_t*)p)); }
__device__ __forceinline__ unsigned cvtpk(float lo, float hi) { unsigned r; asm("v_cvt_pk_bf16_f32 %0, %1, %2" : "=v"(r) : "v"(lo), "v"(hi)); return r; }
__device__ __forceinline__ float xhalf(float v) { return __shfl_xor(v, 32); }
__device__ __forceinline__ int key_of(int i, int hh) { return 8 * (i >> 2) + 4 * hh + (i & 3); }

__device__ __forceinline__ bf16x8 pfrag(const f32x16& p, int ks2) {
    unsigned w[4];
#pragma unroll
    for (int j = 0; j < 4; ++j) w[j] = cvtpk(p[8 * ks2 + 2 * j], p[8 * ks2 + 2 * j + 1]);
    typedef unsigned u32x4 __attribute__((ext_vector_type(4)));
    u32x4 v = {w[0], w[1], w[2], w[3]};
    return __builtin_bit_cast(bf16x8, v);
}
__device__ __forceinline__ void pv_block(f32x16 (&O)[2], const LAS unsigned char* vbuf, int kb, const f32x16& p, int lane) {
    const int hh = lane >> 5, q_ = (lane & 15) >> 2, p_ = lane & 3, cg = (lane >> 4) & 1;
#pragma unroll
    for (int ks2 = 0; ks2 < 2; ++ks2) {
        const bf16x8 pb = pfrag(p, ks2);
#pragma unroll
        for (int db = 0; db < 2; ++db) {
            const int c0 = 32 * db + 16 * cg, ch = (c0 >> 3) + (p_ >> 1);
            const int r0 = 32 * kb + 16 * ks2 + 4 * hh;
            const s16x4 a0 = vtr(vbuf + tile_off(r0 + q_, ch) + 8 * (p_ & 1));
            const s16x4 a1 = vtr(vbuf + tile_off(r0 + 8 + q_, ch) + 8 * (p_ & 1));
            const bf16x8 a = {a0[0], a0[1], a0[2], a0[3], a1[0], a1[1], a1[2], a1[3]};
            O[db] = __builtin_amdgcn_mfma_f32_32x32x16_bf16(a, pb, O[db], 0, 0, 0);
        }
    }
}
template <int S0, int NS>
__device__ __forceinline__ f32x16 qk_block(const LAS unsigned char* kbuf, int kb, const bf16x8 (&Qf)[4], int lane) {
    const int r = lane & 31, hh = lane >> 5;
    f32x16 s = {0.f, 0.f, 0.f, 0.f, 0.f, 0.f, 0.f, 0.f, 0.f, 0.f, 0.f, 0.f, 0.f, 0.f, 0.f, 0.f};
#pragma unroll
    for (int ks = S0; ks < S0 + NS; ++ks) {
        const bf16x8 a = *(const LAS bf16x8*)(kbuf + tile_off(32 * kb + r, 2 * ks + hh));
        s = __builtin_amdgcn_mfma_f32_32x32x16_bf16(a, Qf[ks], s, 0, 0, 0);
    }
    return s;
}
__device__ __forceinline__ void softmax_step(f32x16& x, float& m, float& l, f32x16 (&O)[2]) {
    float mx = x[0];
#pragma unroll
    for (int i = 1; i < 16; ++i) mx = fmaxf(mx, x[i]);
    mx = fmaxf(mx, xhalf(mx));
    const float mn = fmaxf(m, mx);
    if (!__all(mn == m)) {
        const float alpha = __builtin_amdgcn_exp2f(m - mn);
        l *= alpha;
#pragma unroll
        for (int i = 0; i < 16; ++i) { O[0][i] *= alpha; O[1][i] *= alpha; }
        m = mn;
    }
    float ls = 0.f;
#pragma unroll
    for (int i = 0; i < 16; ++i) { x[i] = __builtin_amdgcn_exp2f(x[i] - m); ls += x[i]; }
    l += ls;
}
__device__ __forceinline__ void store_ot(bf16_t* orow, const f32x16 (&O)[2], int hh) {
#pragma unroll
    for (int db = 0; db < 2; ++db)
#pragma unroll
        for (int g = 0; g < 4; ++g) {
            const int d0 = 32 * db + 8 * g + 4 * hh;
            *(uint2*)(orow + d0) = make_uint2(cvtpk(O[db][4 * g], O[db][4 * g + 1]), cvtpk(O[db][4 * g + 2], O[db][4 * g + 3]));
        }
}

struct UnitArgs {
    const bf16_t* qkv;
    bf16_t* out;
    int qcol, kcol, vcol, ocol;
};

template <int TYPE>
__device__ __forceinline__ void causal_unit(const UnitArgs& A, int b, int h, int qb, unsigned char* scratch, int tid,
                                            const float* t5  , float lam, const float* subg, const float* F  ) {
    const LAS unsigned char* lds = (const LAS unsigned char*)scratch;
    LAS unsigned char* ldsw = (LAS unsigned char*)scratch;
    const int lane = tid & 63, w = tid >> 6, r = lane & 31, hh = lane >> 5;
    const int q0 = qb * 256 + 32 * w, tq = q0 + r;
    const size_t rowbase = (size_t)b * SEQ;
    const int ktmax = 4 * qb + 3, kdiag = 4 * qb + (w >> 1);
    const int srow = tid >> 3, sch = tid & 7;
    const bf16_t* kg = A.qkv + (rowbase + srow) * QKV_W + A.kcol + h * 64 + sch * 8;
    const bf16_t* vg = A.qkv + (rowbase + srow) * QKV_W + A.vcol + h * 64 + sch * 8;
    const int soff = tile_off(srow, sch);
    bf16x8 Qf[4];
    {
        const bf16_t* qr = A.qkv + (rowbase + tq) * QKV_W + A.qcol + h * 64 + 8 * hh;
#pragma unroll
        for (int s = 0; s < 4; ++s) Qf[s] = *(const bf16x8*)(qr + 16 * s);
    }
    __syncthreads();
    if (TYPE == 0 && tid < 128) {
        const float far = t5[31 * 8 + h];
        ((LAS float*)(ldsw + TBUF))[tid] = (t5[t5_bucket(tid) * 8 + h] - far) * LOG2E;
    }
    if (TYPE == 1 && tid == 0) *(LAS unsigned*)(ldsw + CNT) = 0u;
    typedef unsigned u32x4 __attribute__((ext_vector_type(4)));
    u32x4 kreg = *(const u32x4*)(kg + (size_t)ktmax * 64 * QKV_W), vreg = *(const u32x4*)(vg + (size_t)ktmax * 64 * QKV_W);
    float freg = 0.f;
    if (TYPE == 3 && tid < 64) freg = F[(size_t)(b * 8 + h) * SEQ + ktmax * 64 + tid] * LOG2E;
    *(LAS u32x4*)(ldsw + KBUF + soff) = kreg; *(LAS u32x4*)(ldsw + VBUF + soff) = vreg;
    if (TYPE == 3 && tid < 64) ((LAS float*)(ldsw + FBUF))[tid] = freg;
    __syncthreads();

    f32x16 O0[2], O1[2];
#pragma unroll
    for (int i = 0; i < 16; ++i) { O0[0][i] = 0.f; O0[1][i] = 0.f; O1[0][i] = 0.f; O1[1][i] = 0.f; }
    float m0 = NEG, l0 = 0.f, m1 = NEG, l1 = 0.f;
    float R = 0.f;
    bool wdone = false;
    float f2t = 0.f;
    if (TYPE == 3) f2t = F[(size_t)(b * 8 + h) * SEQ + tq] * LOG2E;

    for (int kt = ktmax, it = 0; kt >= 0; --kt, ++it) {
        const int cur = it & 1;
        if (kt > 0) {
            kreg = *(const u32x4*)(kg + (size_t)(kt - 1) * 64 * QKV_W); vreg = *(const u32x4*)(vg + (size_t)(kt - 1) * 64 * QKV_W);
            if (TYPE == 3 && tid < 64) freg = F[(size_t)(b * 8 + h) * SEQ + (kt - 1) * 64 + tid] * LOG2E;
        }
        const LAS unsigned char* kbuf = lds + KBUF + cur * 8192;
        const LAS unsigned char* vbuf = lds + VBUF + cur * 8192;
        if (kt <= kdiag && !wdone) {
#pragma unroll
            for (int kbi = 0; kbi < 2; ++kbi) {
                const int kb = 1 - kbi;
                const int key0 = kt * 64 + kb * 32;
                if (TYPE == 1 ? (key0 >= q0 + 31) : (key0 > q0 + 31)) continue;
                const bool need_mask = (TYPE == 1) ? (key0 + 31 >= q0) : (key0 + 31 > q0);
                if (TYPE == 0) {
                    f32x16 x0 = qk_block<0, 2>(kbuf, kb, Qf, lane), x1 = qk_block<2, 2>(kbuf, kb, Qf, lane);
                    if (q0 - (key0 + 31) < 113) {
                        const LAS float* tb = (const LAS float*)(lds + TBUF);
#pragma unroll
                        for (int i = 0; i < 16; ++i) {
                            const int dist = tq - (key0 + key_of(i, hh));
                            const float bv = (dist >= 0 && dist < 128) ? tb[dist < 0 ? 0 : (dist > 127 ? 127 : dist)] : 0.f;
                            x0[i] = dist < 0 ? NEG : x0[i] + bv; x1[i] = dist < 0 ? NEG : x1[i] + bv;
                        }
                    }
                    softmax_step(x0, m0, l0, O0);
                    pv_block(O0, vbuf, kb, x0, lane);
                    softmax_step(x1, m1, l1, O1);
                    pv_block(O1, vbuf, kb, x1, lane);
                } else if (TYPE == 3) {
                    f32x16 x = qk_block<0, 4>(kbuf, kb, Qf, lane);
                    const LAS float* fb = (const LAS float*)(lds + FBUF + cur * 256);
#pragma unroll
                    for (int g = 0; g < 4; ++g) {
                        const f32x4 fv = *(const LAS f32x4*)(fb + 32 * kb + 8 * g + 4 * hh);
#pragma unroll
                        for (int j = 0; j < 4; ++j) x[4 * g + j] += f2t - fv[j];
                    }
                    if (need_mask) {
#pragma unroll
                        for (int i = 0; i < 16; ++i) x[i] = (key0 + key_of(i, hh) > tq) ? NEG : x[i];
                    }
                    softmax_step(x, m0, l0, O0);
                    pv_block(O0, vbuf, kb, x, lane);
                } else {
                    f32x16 z = qk_block<0, 4>(kbuf, kb, Qf, lane);
                    f32x16 lr;
#pragma unroll
                    for (int i = 0; i < 16; ++i) {
                        const float e = __builtin_amdgcn_exp2f(-fabsf(z[i]));
                        float v = -(fmaxf(z[i], 0.f) + __builtin_amdgcn_logf(1.f + e));
                        if (need_mask) v = (key0 + key_of(i, hh) >= tq) ? 0.f : v;
                        lr[i] = v;
                    }
                    float T[4], Tp[4], sfx[16];
#pragma unroll
                    for (int g = 0; g < 4; ++g) {
                        sfx[4 * g + 3] = 0.f; sfx[4 * g + 2] = lr[4 * g + 3]; sfx[4 * g + 1] = sfx[4 * g + 2] + lr[4 * g + 2]; sfx[4 * g] = sfx[4 * g + 1] + lr[4 * g + 1];
                        T[g] = sfx[4 * g] + lr[4 * g];
                        Tp[g] = xhalf(T[g]);
                    }
                    float SP[4];
                    SP[3] = 0.f; SP[2] = T[3] + Tp[3]; SP[1] = SP[2] + T[2] + Tp[2]; SP[0] = SP[1] + T[1] + Tp[1];
                    const float tot = SP[0] + T[0] + Tp[0];
                    const float msel = hh == 0 ? 1.f : 0.f;
#pragma unroll
                    for (int g = 0; g < 4; ++g) {
                        const float goff = R + SP[g] + msel * Tp[g];
#pragma unroll
                        for (int j = 0; j < 4; ++j) {
                            const int i = 4 * g + j;
                            float wv = __builtin_amdgcn_exp2f(lr[i] + z[i] + goff + sfx[i]);
                            if (need_mask) wv = (key0 + key_of(i, hh) >= tq) ? 0.f : wv;
                            z[i] = wv;
                        }
                    }
                    R += tot;
                    pv_block(O0, vbuf, kb, z, lane);
                }
            }
            if (TYPE == 1) {
                if (__all(R < -216.4f)) { wdone = true; if (lane == 0) (void)__hip_atomic_fetch_add((LAS unsigned*)(ldsw + CNT), 1u, __ATOMIC_RELAXED, __HIP_MEMORY_SCOPE_WORKGROUP); }
            }
        }
        if (kt > 0) {
            *(LAS u32x4*)(ldsw + KBUF + (cur ^ 1) * 8192 + soff) = kreg; *(LAS u32x4*)(ldsw + VBUF + (cur ^ 1) * 8192 + soff) = vreg;
            if (TYPE == 3 && tid < 64) ((LAS float*)(ldsw + FBUF + (cur ^ 1) * 256))[tid] = freg;
        }
        __syncthreads();
        if (TYPE == 1) { const unsigned cnt = *(const LAS unsigned*)(lds + CNT); __syncthreads(); if (cnt == 8u) break; }
    }
    bf16_t* orow = A.out + (rowbase + tq) * DM + A.ocol + h * 64;
    if (TYPE == 0) {
        const float i0 = 1.f / (l0 + xhalf(l0)), i1 = lam / (l1 + xhalf(l1));
        float ss = 0.f;
#pragma unroll
        for (int db = 0; db < 2; ++db)
#pragma unroll
            for (int i = 0; i < 16; ++i) { const float o = O0[db][i] * i0 - O1[db][i] * i1; O0[db][i] = o; ss = fmaf(o, o, ss); }
        ss += xhalf(ss);
        const float rn = rsqrtf(ss * (1.f / 64.f) + LN_EPS) * 0.8f;
#pragma unroll
        for (int db = 0; db < 2; ++db)
#pragma unroll
            for (int i = 0; i < 16; ++i) O0[db][i] *= rn * subg[32 * db + key_of(i, hh)];
        store_ot(orow, O0, hh);
    } else if (TYPE == 3) {
        const float i0 = 1.f / (l0 + xhalf(l0));
#pragma unroll
        for (int db = 0; db < 2; ++db)
#pragma unroll
            for (int i = 0; i < 16; ++i) O0[db][i] *= i0;
        store_ot(orow, O0, hh);
    } else {
        store_ot(orow, O0, hh);
    }
}
}

__device__ __forceinline__ int xcd_perm256(int p) { return (p & 7) * 32 + (p >> 3); }

__device__ __forceinline__ void attn_layer0_mfma(const Ctx& c, const bf16_t* qkv, bf16_t* out, const float* t5, const float* lamv, const float* subg) {
    float s01 = 0.f, s23 = 0.f;
    for (int i = 0; i < 32; ++i) { s01 += lamv[i] * lamv[32 + i]; s23 += lamv[64 + i] * lamv[96 + i]; }
    const float lam = expf(s01) - expf(s23) + 0.2f;
    unsigned char* scratch = (unsigned char*)c.lds;
    const att::UnitArgs UA{qkv, out, 0, 512, 1024, 0}, UB{qkv, out, 1536, 2048, 2560, 512};
    for (int p = c.bid; p < 256; p += c.nblk) {
        const int pp = xcd_perm256(p), bh = pp >> 3, qb = pp & 7;
        att::causal_unit<0>(UA, bh >> 3, bh & 7, 15 - qb, scratch, c.tid, t5, lam, subg, nullptr);
        att::causal_unit<0>(UA, bh >> 3, bh & 7, qb, scratch, c.tid, t5, lam, subg, nullptr);
#pragma unroll 1
        for (int k = 0; k < 2; ++k) {
            const int u = pp * 2 + k, bh2 = u >> 4, qb2 = u & 15;
            att::causal_unit<1>(UB, bh2 >> 3, bh2 & 7, qb2, scratch, c.tid, nullptr, 0.f, nullptr, nullptr);
        }
    }
}
__device__ __forceinline__ void attn_fox_mfma(const Ctx& c, const bf16_t* qkv, const float* F, bf16_t* out) {
    unsigned char* scratch = (unsigned char*)c.lds;
    const att::UnitArgs UD{qkv, out, 1536, 2048, 2560, 512};
    for (int p = c.bid; p < 256; p += c.nblk) {
        const int pp = xcd_perm256(p), bh = pp >> 3, qb = pp & 7;
        att::causal_unit<3>(UD, bh >> 3, bh & 7, 15 - qb, scratch, c.tid, nullptr, 0.f, nullptr, F);
        att::causal_unit<3>(UD, bh >> 3, bh & 7, qb, scratch, c.tid, nullptr, 0.f, nullptr, F);
    }
}

__device__ __forceinline__ void ln_rows(const Ctx& c, const float* hin32, const bf16_t* hin16, const float* add, const float* g, const float* bta, float* out, bf16_t* outb) {
    for (int t = c.gwave; t < NT; t += c.nwaves) {
        float v[16];
        float s = 0.f;
#pragma unroll
        for (int r = 0; r < 4; ++r) {
            const int d = r * 256 + c.lane * 4;
            float4 a;
            if (hin32) a = *(const float4*)(hin32 + (size_t)t * DM + d);
            else { const uint2 w = *(const uint2*)(hin16 + (size_t)t * DM + d); a = make_float4(__builtin_bit_cast(float, w.x << 16), __builtin_bit_cast(float, w.x & 0xffff0000u), __builtin_bit_cast(float, w.y << 16), __builtin_bit_cast(float, w.y & 0xffff0000u)); }
            const float4 m = *(const float4*)(add + (size_t)t * DM + d);
            v[r * 4 + 0] = DN_ALPHA * a.x + m.x; v[r * 4 + 1] = DN_ALPHA * a.y + m.y; v[r * 4 + 2] = DN_ALPHA * a.z + m.z; v[r * 4 + 3] = DN_ALPHA * a.w + m.w;
            s += v[r * 4] + v[r * 4 + 1] + v[r * 4 + 2] + v[r * 4 + 3];
        }
        const float mu = wave_sum(s) * (1.f / DM);
        float q = 0.f;
#pragma unroll
        for (int i = 0; i < 16; ++i) { v[i] -= mu; q = fmaf(v[i], v[i], q); }
        const float rs = rsqrtf(wave_sum(q) * (1.f / DM) + LN_EPS);
#pragma unroll
        for (int r = 0; r < 4; ++r) {
            const int d = r * 256 + c.lane * 4;
            const float4 gg = *(const float4*)(g + d), bb = *(const float4*)(bta + d);
            const float4 o = make_float4(v[r * 4] * rs * gg.x + bb.x, v[r * 4 + 1] * rs * gg.y + bb.y, v[r * 4 + 2] * rs * gg.z + bb.z, v[r * 4 + 3] * rs * gg.w + bb.w);
            if (out) *(float4*)(out + (size_t)t * DM + d) = o;
            if (outb) *(uint2*)(outb + (size_t)t * DM + d) = make_uint2(pk2(o.x, o.y), pk2(o.z, o.w));
        }
    }
}

__device__ __forceinline__ void topk_insert(float (&tv)[16], int (&ti)[16], float v, int id) {
#pragma unroll
    for (int j = 15; j >= 1; --j) {
        const bool g = v > tv[j], gp = v > tv[j - 1];
        tv[j] = g ? (gp ? tv[j - 1] : v) : tv[j];
        ti[j] = g ? (gp ? ti[j - 1] : id) : ti[j];
    }
    const bool g0 = v > tv[0];
    tv[0] = g0 ? v : tv[0]; ti[0] = g0 ? id : ti[0];
}

__device__ __forceinline__ void peer_stage1_naive(const Ctx& c, const bf16_t* pq, const float* subk  , float* lv, int* li) {
    const int ntask = (NT / 64) * 16;
    for (int task = c.gwave; task < ntask; task += c.nwaves) {
        const int hc = task & 15, t = (task >> 4) * 64 + c.lane;
        float q[128];
        const bf16_t* qr = pq + (size_t)t * PEER_QW + hc * 128;
#pragma unroll
        for (int i = 0; i < 128; ++i) q[i] = bf2f(qr[i]);
        float tv[16]; int ti[16];
#pragma unroll
        for (int j = 0; j < 16; ++j) { tv[j] = -INFINITY; ti[j] = 0; }
        for (int k = 0; k < 128; ++k) {
            const float* kr = subk + ((size_t)hc * 128 + k) * 128;
            float d = 0.f;
#pragma unroll
            for (int i = 0; i < 128; ++i) d = fmaf(q[i], kr[i], d);
            topk_insert(tv, ti, d, k);
        }
        float* ov = lv + ((size_t)t * 16 + hc) * 16; int* oi = li + ((size_t)t * 16 + hc) * 16;
#pragma unroll
        for (int j = 0; j < 16; ++j) { ov[j] = tv[j]; oi[j] = ti[j]; }
    }
}

__device__ __forceinline__ void peer_stage2_naive(const Ctx& c, const float* lv, const int* li, int* eidx, float* gate) {
    const int ntask = (NT / 64) * 8;
    for (int task = c.gwave; task < ntask; task += c.nwaves) {
        const int h = task & 7, t = (task >> 3) * 64 + c.lane;
        const float* av = lv + ((size_t)t * 16 + h * 2) * 16; const int* ai = li + ((size_t)t * 16 + h * 2) * 16;
        float tv[16]; int ti[16];
#pragma unroll
        for (int j = 0; j < 16; ++j) { tv[j] = -INFINITY; ti[j] = 0; }
#pragma unroll 1
        for (int ij = 0; ij < 256; ++ij) {
            const int i = ij >> 4, jj = ij & 15;
            topk_insert(tv, ti, av[i] + av[16 + jj], ai[i] * 128 + ai[16 + jj]);
        }
        float sum = 0.f, e[16];
#pragma unroll
        for (int j = 0; j < 16; ++j) { e[j] = expf(tv[j] - tv[0]); sum += e[j]; }
        const float inv = 1.f / sum;
        int* oi = eidx + ((size_t)t * 8 + h) * 16; float* og = gate + ((size_t)t * 8 + h) * 16;
#pragma unroll
        for (int j = 0; j < 16; ++j) { oi[j] = ti[j]; og[j] = e[j] * inv; }
    }
}

typedef unsigned u32x4_t __attribute__((ext_vector_type(4)));
typedef __bf16 bf16x2_t __attribute__((ext_vector_type(2)));
__device__ __forceinline__ float dot2u(unsigned w, unsigned x, float acc) { return __builtin_amdgcn_fdot2_f32_bf16(__builtin_bit_cast(bf16x2_t, w), __builtin_bit_cast(bf16x2_t, x), acc, false); }
__device__ __forceinline__ float dot8_bf16(const u32x4_t a, const u32x4_t b, float acc) {
    const unsigned a0 = a.x, a1 = a.y, a2 = a.z, a3 = a.w, b0 = b.x, b1 = b.y, b2 = b.z, b3 = b.w;
    acc = dot2u(a0, b0, acc); acc = dot2u(a1, b1, acc); acc = dot2u(a2, b2, acc); acc = dot2u(a3, b3, acc);
    return acc;
}
__device__ __forceinline__ float gelu_exact(float d) { return 0.5f * d * (1.f + erff(d * 0.70710678118654752f)); }

__device__ __forceinline__ void peer_u_phase(const Ctx& c, const bf16_t* h1b, const int* eidx, float* coef, const bf16_t* U) {
    const int lane = c.lane;
    for (int vb = c.bid; vb < 256; vb += c.nblk) {
        const int j = vb & 7, rnk = vb >> 3;
#pragma unroll 1
        for (int pass = 0; pass < 2; ++pass) {
            const int s16 = j + 8 * pass;
#pragma unroll 1
            for (int i = 0; i < 64; ++i) {
                const int t = rnk * 512 + c.wave * 64 + i;
                const u32x4_t x0 = *(const u32x4_t*)(h1b + (size_t)t * DM + lane * 8), x1 = *(const u32x4_t*)(h1b + (size_t)t * DM + 512 + lane * 8);
                const int e0 = eidx[(size_t)t * 128 + lane], e1 = eidx[(size_t)t * 128 + 64 + lane];
                unsigned long long m0 = __ballot((e0 & 15) == s16), m1 = __ballot((e1 & 15) == s16);
                while (m0 | m1) {
                    int ks[4], es[4];
#pragma unroll
                    for (int u = 0; u < 4; ++u) {
                        if (m0) { const int k = __builtin_ctzll(m0); m0 &= m0 - 1; ks[u] = k; es[u] = __builtin_amdgcn_readlane(e0, k); }
                        else if (m1) { const int k = __builtin_ctzll(m1); m1 &= m1 - 1; ks[u] = 64 + k; es[u] = __builtin_amdgcn_readlane(e1, k); }
                        else { ks[u] = -1; es[u] = es[0]; }
                    }
                    u32x4_t ua[4], ub[4];
#pragma unroll
                    for (int u = 0; u < 4; ++u) { const bf16_t* ur = U + (size_t)es[u] * DM + lane * 8; ua[u] = *(const u32x4_t*)ur; ub[u] = *(const u32x4_t*)(ur + 512); }
                    float p[4];
#pragma unroll
                    for (int u = 0; u < 4; ++u) p[u] = dot8_bf16(ub[u], x1, dot8_bf16(ua[u], x0, 0.f));
                    const bool hi = lane >= 32, h16 = (lane >> 4) & 1;
                    const float r0 = (hi ? p[2] : p[0]) + __shfl_xor(hi ? p[0] : p[2], 32);
                    const float r1 = (hi ? p[3] : p[1]) + __shfl_xor(hi ? p[1] : p[3], 32);
                    float s = (h16 ? r1 : r0) + __shfl_xor(h16 ? r0 : r1, 16);
                    s += __shfl_xor(s, 8); s += __shfl_xor(s, 4); s += __shfl_xor(s, 2); s += __shfl_xor(s, 1);
                    const int g = lane >> 4;
                    const int kk = g == 0 ? ks[0] : (g == 1 ? ks[1] : (g == 2 ? ks[2] : ks[3]));
                    if ((lane & 15) == 0 && kk >= 0) { float* cp = coef + (size_t)t * 128 + kk; __hip_atomic_store(cp, *cp * gelu_exact(s), __ATOMIC_RELAXED, __HIP_MEMORY_SCOPE_AGENT); }
                }
            }
        }
    }
}

__device__ __forceinline__ void peer_v_phase(const Ctx& c, const int* eidx, const float* coef, const bf16_t* V, float* Y) {
    const int lane = c.lane, sg = lane >> 3, part = lane & 7;
    typedef int i32x4_t __attribute__((ext_vector_type(4)));
    typedef float f32x4_t __attribute__((ext_vector_type(4)));
    for (int vb = c.bid; vb < 256; vb += c.nblk) {
        const int j = vb & 7, rnk = vb >> 3;
#pragma unroll 1
        for (int pass = 0; pass < 2; ++pass) {
            const int dcol = 64 * (j + 8 * pass) + part * 8;
#pragma unroll 1
            for (int i = 0; i < 64; ++i) {
                const int t = rnk * 512 + c.wave * 64 + i;
                i32x4_t e[4]; f32x4_t cf[4];
#pragma unroll
                for (int q = 0; q < 4; ++q) { e[q] = *(const i32x4_t*)(eidx + (size_t)t * 128 + sg * 16 + 4 * q); cf[q] = *(const f32x4_t*)(coef + (size_t)t * 128 + sg * 16 + 4 * q); }
                u32x4_t rows[16];
#pragma unroll
                for (int it = 0; it < 16; ++it) rows[it] = *(const u32x4_t*)(V + (size_t)e[it >> 2][it & 3] * DM + dcol);
                float acc[8];
#pragma unroll
                for (int d = 0; d < 8; ++d) acc[d] = 0.f;
#pragma unroll
                for (int it = 0; it < 16; ++it) {
                    const float cv = cf[it >> 2][it & 3];
#pragma unroll
                    for (int w = 0; w < 4; ++w) {
                        const unsigned pk = rows[it][w];
                        acc[2 * w] = fmaf(cv, __builtin_bit_cast(float, pk << 16), acc[2 * w]);
                        acc[2 * w + 1] = fmaf(cv, __builtin_bit_cast(float, pk & 0xffff0000u), acc[2 * w + 1]);
                    }
                }
#pragma unroll
                for (int d = 0; d < 8; ++d) { acc[d] += __shfl_xor(acc[d], 8); acc[d] += __shfl_xor(acc[d], 16); acc[d] += __shfl_xor(acc[d], 32); }
                if (lane < 8) {
                    float* yp = Y + (size_t)t * DM + dcol;
                    *(f32x4_t*)yp = (f32x4_t){acc[0], acc[1], acc[2], acc[3]}; *(f32x4_t*)(yp + 4) = (f32x4_t){acc[4], acc[5], acc[6], acc[7]};
                }
            }
        }
    }
}

constexpr int NPHASE = 1 + 2 * 11;
__global__ void __launch_bounds__(NTHREADS, 2) fwd(Args args) {
    unsigned* ctl = (unsigned*)(args.ws + WS_CTL);
    volatile LAS unsigned* xbw = (volatile LAS unsigned*)(dyn_lds + MISC_OFF);
    if (threadIdx.x == 0) { xbw[0] = 0u; xbw[1] = 0u; xbw[2] = 0u; xbw[3] = 0u; }
    __syncthreads();
    const int lo = args.ph_lo, hi = args.ph_hi;
    XcdBarrier bar = xcd_barrier_post(ctl + 4096, xbw);
#define IN(k) (lo <= (k) && (k) < hi)
#define SEAM(k) do { if (IN(k) && IN((k) + 1)) xcd_barrier(bar); } while (0)
#define LAUNDER(ptr) ptr = launder_ptr(ptr)
#define PIN(k) ((const float*)launder_ptr((unsigned char*)args.in[k]))
#define GEMM_LDS ((PG8_LAS unsigned char*)dyn_lds + RING_OFF)
    if (IN(0)) { unsigned char* ws = args.ws; LAUNDER(ws); const Ctx c = make_ctx(); prologue_phase(c, PIN(0), PIN(2), PIN(5), PIN(6), PIN(8), PIN(9), PIN(11), PIN(12), ws); }
    SEAM(0);
#pragma unroll 1
    for (int layer = 0; layer < 2; ++layer) {
        const int pb = 1 + layer * 11;
        if (IN(pb + 0)) {
            unsigned char* ws = args.ws; LAUNDER(ws); const Ctx c = make_ctx();
            pg8::Gemm g{(const bf16_t*)(ws + WS_ACTIN), (const bf16_t*)(ws + (layer == 0 ? WT_ABIN : WT_CDIN)), NT, QKV_W, DM};
            pg8::StaticOrder S; S.init(NT, QKV_W, c.nblk, c.bid);
            pg8::EpiStoreBf16 E{(bf16_t*)(ws + WS_QKV), QKV_W, layer == 0 ? 0.17677669529663687f * 1.4426950408889634f : 1.f, 0.125f * 1.4426950408889634f};
            pg8::gemm_phase<pg8::EpiStoreBf16, pg8::StaticOrder, true, true>(GEMM_LDS, g, S, E);
            if (layer == 1) fg_phase(c, (const bf16_t*)(ws + WS_ACTIN), PIN(6), (float*)(ws + WS_FG));
        }
        SEAM(pb + 0);
        if (IN(pb + 1) && layer == 1) { unsigned char* ws = args.ws; LAUNDER(ws); const Ctx c = make_ctx(); fscan_naive(c, (const float*)(ws + WS_FG), (float*)(ws + WS_F), PIN(7)); }
        SEAM(pb + 1);
        if (IN(pb + 2)) {
            unsigned char* ws = args.ws; LAUNDER(ws); const Ctx c = make_ctx();
            if (layer == 0) attn_layer0_mfma(c, (const bf16_t*)(ws + WS_QKV), (bf16_t*)(ws + WS_ATTB), PIN(1), PIN(3), PIN(4));
            else { attn_fox_mfma(c, (const bf16_t*)(ws + WS_QKV), (const float*)(ws + WS_F), (bf16_t*)(ws + WS_ATTB)); __syncthreads(); attn_dilated_naive(c, (const bf16_t*)(ws + WS_QKV), (bf16_t*)(ws + WS_ATTB), PIN(1)); }
        }
        SEAM(pb + 2);
        if (IN(pb + 3)) {
            unsigned char* ws = args.ws; LAUNDER(ws); const Ctx c = make_ctx();
            pg8::Gemm g{(const bf16_t*)(ws + WS_ATTB), (const bf16_t*)(ws + (layer == 0 ? WT_ABOUT : WT_CDOUT)), NT, DM, DM};
            pg8::StaticOrder S; S.init(NT, DM, c.nblk, c.bid);
            pg8::EpiStoreF32 E{(float*)(ws + WS_MIX), DM};
            pg8::gemm_phase<pg8::EpiStoreF32, pg8::StaticOrder, true, true>(GEMM_LDS, g, S, E);
        }
        SEAM(pb + 3);
        if (IN(pb + 4)) {
            unsigned char* ws = args.ws; LAUNDER(ws); const Ctx c = make_ctx();
            ln_rows(c, layer == 0 ? PIN(0) : (const float*)nullptr, (const bf16_t*)(ws + WS_ACTIN), (const float*)(ws + WS_MIX), PIN(13) + (size_t)layer * 2 * DM, PIN(14) + (size_t)layer * 2 * DM, (float*)nullptr, (bf16_t*)(ws + WS_H1B));
        }
        SEAM(pb + 4);
        if (IN(pb + 5)) {
            unsigned char* ws = args.ws; LAUNDER(ws); const Ctx c = make_ctx();
            pg8::Gemm g{(const bf16_t*)(ws + WS_H1B), (const bf16_t*)(ws + WT_WQ + (size_t)layer * 4 * MiB), NT, PEER_QW, DM};
            pg8::StaticOrder S; S.init(NT, PEER_QW, c.nblk, c.bid);
            pg8::EpiStoreBf16 E{(bf16_t*)(ws + WS_QKV), PEER_QW, 1.f, 1.f};
            pg8::gemm_phase<pg8::EpiStoreBf16, pg8::StaticOrder, true, true>(GEMM_LDS, g, S, E);
        }
        SEAM(pb + 5);
        if (IN(pb + 6)) {
            unsigned char* ws = args.ws; LAUNDER(ws); const Ctx c = make_ctx();
            float* LV = (float*)(ws + WS_LISTS);
            peer_stage1_naive(c, (const bf16_t*)(ws + WS_QKV), PIN(10) + (size_t)layer * 16 * 128 * 128, LV, (int*)(LV + (size_t)NT * 256));
        }
        SEAM(pb + 6);
        if (IN(pb + 7)) {
            unsigned char* ws = args.ws; LAUNDER(ws); const Ctx c = make_ctx();
            float* LV = (float*)(ws + WS_LISTS);
            peer_stage2_naive(c, LV, (const int*)(LV + (size_t)NT * 256), (int*)(ws + WS_EIDX), (float*)(ws + WS_COEF));
        }
        SEAM(pb + 7);
        if (IN(pb + 8)) {
            unsigned char* ws = args.ws; LAUNDER(ws); const Ctx c = make_ctx();
            peer_u_phase(c, (const bf16_t*)(ws + WS_H1B), (const int*)(ws + WS_EIDX), (float*)(ws + WS_COEF), (const bf16_t*)(ws + WS_UB) + (size_t)layer * 16384 * DM);
        }
        SEAM(pb + 8);
        if (IN(pb + 9)) {
            unsigned char* ws = args.ws; LAUNDER(ws); const Ctx c = make_ctx();
            peer_v_phase(c, (const int*)(ws + WS_EIDX), (const float*)(ws + WS_COEF), (const bf16_t*)(ws + WS_VB) + (size_t)layer * 16384 * DM, (float*)(ws + WS_MIX));
        }
        SEAM(pb + 9);
        if (IN(pb + 10)) {
            unsigned char* ws = args.ws; LAUNDER(ws); const Ctx c = make_ctx();
            float* hout = layer == 0 ? (float*)nullptr : (float*)launder_ptr((unsigned char*)args.out);
            bf16_t* houtb = layer == 0 ? (bf16_t*)(ws + WS_ACTIN) : (bf16_t*)nullptr;
            ln_rows(c, (const float*)nullptr, (const bf16_t*)(ws + WS_H1B), (const float*)(ws + WS_MIX), PIN(13) + (size_t)(layer * 2 + 1) * DM, PIN(14) + (size_t)(layer * 2 + 1) * DM, hout, houtb);
        }
        SEAM(pb + 10);
    }
}

extern "C" void kernel_launch(void* const* d_in, const int* in_sizes, int n_in, void* d_out, int out_size, void* d_ws, size_t ws_size, hipStream_t stream) {
    (void)in_sizes; (void)n_in; (void)out_size;
    static int grid = 0;
    if (!grid) {
        int dev = 0, cus = 0, per_cu = 0;
        (void)hipGetDevice(&dev);
        (void)hipDeviceGetAttribute(&cus, hipDeviceAttributeMultiprocessorCount, dev);
        (void)hipFuncSetAttribute((const void*)fwd, hipFuncAttributeMaxDynamicSharedMemorySize, LDS_BYTES);
        (void)hipOccupancyMaxActiveBlocksPerMultiprocessor(&per_cu, fwd, NTHREADS, LDS_BYTES);
        if (per_cu < 1) fprintf(stderr, "occupancy query says %d blocks per CU\n", per_cu);
        grid = cus;
        if (ws_size < WS_END) fprintf(stderr, "workspace too small: %zu < %zu\n", ws_size, (size_t)WS_END);
    }
    (void)hipMemsetAsync((unsigned char*)d_ws + WS_CTL, 0, 1 * MiB, stream);
    Args a{};
    for (int i = 0; i < 15; ++i) a.in[i] = (const float*)d_in[i];
    a.out = (float*)d_out; a.ws = (unsigned char*)d_ws;
    a.ph_lo = 0; a.ph_hi = NPHASE;
    hipLaunchKernelGGL(fwd, dim3(grid), dim3(NTHREADS), LDS_BYTES, stream, a);
}
```

```cpp
#include <hip/hip_runtime.h>
#include <cstdio>
#include <cstdint>
#include <cmath>

constexpr int BATCH = 4, SEQ = 4096, DM = 1024, NT = BATCH * SEQ;
constexpr int NH = 8, HD = 64;
constexpr int QKV_W = 3072, CD_IN = 3080;
constexpr int PEER_QW = 2048;
constexpr float DN_ALPHA = 1.4142135623730951f;
constexpr float LN_EPS = 1e-5f;
constexpr int NTHREADS = 512, NWAVES = 8;
typedef unsigned short bf16_t;

constexpr size_t MiB = 1u << 20;
constexpr size_t WS_CTL = 0;
constexpr size_t WS_WT = 1 * MiB;
constexpr size_t WT_ABIN = WS_WT, WT_ABOUT = WS_WT + 6 * MiB, WT_CDIN = WS_WT + 8 * MiB, WT_CDOUT = WS_WT + 14 * MiB, WT_WQ = WS_WT + 16 * MiB;
constexpr size_t WS_ACTIN = 25 * MiB;
constexpr size_t WS_ATTB = 57 * MiB;
constexpr size_t WS_H1B = 89 * MiB;
constexpr size_t WS_QKV = 121 * MiB;
constexpr size_t WS_MIX = 217 * MiB;
constexpr size_t WS_EIDX = 281 * MiB;
constexpr size_t WS_COEF = 289 * MiB;
constexpr size_t WS_F = 297 * MiB;
constexpr size_t WS_FG = 298 * MiB;
constexpr size_t WS_UB = 299 * MiB;
constexpr size_t WS_VB = 363 * MiB;
constexpr size_t WS_SKB = 427 * MiB;
constexpr size_t WS_END = 428 * MiB;
constexpr int LDS_BYTES = 147456;
constexpr int RING_OFF = 0, MISC_OFF = 131072;

#define XB_TMO      128
#define XB_XCNT(j)  (256  + 64 * (j))
#define XB_XSUB(j)  (1280 + 64 * (j))
#define XB_XGEN(j)  (2304 + 64 * (j))
#define XB_TOP      3328
#define XB_TOPGEN   3392
#define XCD_BAR_WORDS 3456
#define XB_SPIN_CAP (1u << 18)
#define LAS __attribute__((address_space(3)))

__device__ __forceinline__ unsigned xb_ld(unsigned* p)              { return __hip_atomic_load(p, __ATOMIC_RELAXED, __HIP_MEMORY_SCOPE_AGENT); }
__device__ __forceinline__ unsigned xb_add(unsigned* p, unsigned v) { return __hip_atomic_fetch_add(p, v, __ATOMIC_RELAXED, __HIP_MEMORY_SCOPE_AGENT); }
__device__ __forceinline__ unsigned xb_xcc_id() { return (unsigned)__builtin_amdgcn_s_getreg((3 << 11) | 20) & 0xFu; }
#define XB_SPIN(cond, bar) do { unsigned _sp = 0; while (cond) { __builtin_amdgcn_s_sleep(1); \
    if ((++_sp & 255u) == 0u) { if (xb_ld(&(bar)[XB_TMO])) break; if (_sp > XB_SPIN_CAP) { atomicAdd(&(bar)[XB_TMO], 1u); break; } } } } while (0)

struct XcdBarrier {
    unsigned* bar; unsigned x;
    volatile LAS unsigned* st;
};
__device__ __forceinline__ XcdBarrier xcd_barrier_post(unsigned* bar, volatile LAS unsigned* st) {
    XcdBarrier b; b.bar = bar; b.x = xb_xcc_id(); b.st = st;
    if (threadIdx.x == 0) (void)xb_add(&bar[XB_XCNT(b.x)], 1u);
    return b;
}
__device__ __forceinline__ void xcd_barrier_complete(unsigned* bar, unsigned x, unsigned& nloc, unsigned& nx) {
    const unsigned G = gridDim.x * gridDim.y * gridDim.z;
    unsigned sum, cnt, mine, sp = 0u;
    for (;;) {
        sum = 0u; cnt = 0u; mine = 0u;
#pragma unroll
        for (unsigned j = 0; j < 16; ++j) { const unsigned c = xb_ld(&bar[XB_XCNT(j)]); sum += c; cnt += (c > 0u) ? 1u : 0u; mine = (j == x) ? c : mine; }
        if (sum == G) break;
        __builtin_amdgcn_s_sleep(1);
        if ((++sp & 255u) == 0u) { if (xb_ld(&bar[XB_TMO])) break; if (sp > XB_SPIN_CAP) { atomicAdd(&bar[XB_TMO], 1u); break; } }
    }
    nloc = mine > 0u ? mine : 1u; nx = cnt > 0u ? cnt : 1u;
}
__device__ __forceinline__ void xcd_barrier(const XcdBarrier& b) {
    asm volatile("s_waitcnt vmcnt(0)" ::: "memory");
    __syncthreads();
    if (threadIdx.x == 0) {
        unsigned* bar = b.bar;
        __builtin_amdgcn_s_waitcnt(0);
        unsigned nloc = b.st[0], nx = b.st[1];
        if (nloc == 0u) { xcd_barrier_complete(bar, b.x, nloc, nx); b.st[0] = nloc; b.st[1] = nx; }
        const unsigned old = xb_add(&bar[XB_XSUB(b.x)], 1u);
        const unsigned gen = old / nloc;
        if (old + 1u == (gen + 1u) * nloc) {
            __builtin_amdgcn_fence(__ATOMIC_RELEASE, "agent");
            asm volatile("s_waitcnt vmcnt(0)" ::: "memory");
            const unsigned og = xb_add(&bar[XB_TOP], 1u);
            const unsigned tg = og / nx;
            if (og + 1u == (tg + 1u) * nx) xb_add(&bar[XB_TOPGEN], 1u);
            else XB_SPIN(xb_ld(&bar[XB_TOPGEN]) == tg, bar);
            __builtin_amdgcn_fence(__ATOMIC_ACQUIRE, "agent");
            xb_add(&bar[XB_XGEN(b.x)], 1u);
            asm volatile("s_waitcnt vmcnt(0)" ::: "memory");
        } else {
            XB_SPIN(xb_ld(&bar[XB_XGEN(b.x)]) == gen, bar);
            __builtin_amdgcn_fence(__ATOMIC_ACQUIRE, "agent");
            asm volatile("s_waitcnt vmcnt(0)" ::: "memory");
        }
    }
    __syncthreads();
}

struct Args {
    const float* in[15];
    float* out;
    unsigned char* ws;
    int ph_lo, ph_hi;
};
struct Ctx {
    int tid, lane, wave, gwave, nwaves, bid, nblk;
    float* lds;
};
extern __shared__ __attribute__((aligned(16))) unsigned char dyn_lds[];
__device__ __forceinline__ Ctx make_ctx() {
    int t = threadIdx.x, b = blockIdx.x, g = gridDim.x;
    asm volatile("" : "+v"(t));
    asm volatile("" : "+s"(b), "+s"(g));
    Ctx c; c.tid = t; c.lane = t & 63; c.wave = t >> 6; c.bid = b; c.nblk = g;
    c.gwave = b * NWAVES + c.wave; c.nwaves = g * NWAVES; c.lds = (float*)(dyn_lds + RING_OFF);
    return c;
}
__device__ __forceinline__ unsigned char* launder_ptr(unsigned char* p) {
    unsigned lo = __builtin_amdgcn_readfirstlane((unsigned)(uintptr_t)p), hi = __builtin_amdgcn_readfirstlane((unsigned)((uintptr_t)p >> 32));
    asm volatile("" : "+s"(lo), "+s"(hi));
    return (unsigned char*)(((uintptr_t)hi << 32) | (uintptr_t)lo);
}
__device__ __forceinline__ float wave_sum(float v) {
#pragma unroll
    for (int o = 32; o >= 1; o >>= 1) v += __shfl_xor(v, o);
    return v;
}
__device__ __forceinline__ float log_sigmoid(float z) { return fminf(z, 0.f) - log1pf(expf(-fabsf(z))); }
__device__ __forceinline__ int t5_bucket(int n) {
    if (n < 16) return n;
    int large = 16 + (int)(logf((float)n / 16.f) / 2.0794415416798357f * 16.f);
    return large < 31 ? large : 31;
}
__device__ __forceinline__ float bf2f(bf16_t v) { return __builtin_bit_cast(float, (unsigned)v << 16); }
__device__ __forceinline__ unsigned f2bf(float f) { unsigned u = __builtin_bit_cast(unsigned, f); return (u + 0x7fffu + ((u >> 16) & 1u)) >> 16; }
__device__ __forceinline__ unsigned pk2(float lo, float hi) { return f2bf(lo) | (f2bf(hi) << 16); }

namespace pg8 {
#define PG8_LAS __attribute__((address_space(3)))
typedef unsigned short bf16_t;
typedef short bf16x8 __attribute__((ext_vector_type(8)));
typedef float f32x4 __attribute__((ext_vector_type(4)));
typedef unsigned u32x4 __attribute__((ext_vector_type(4)));
constexpr int BM = 256, BK = 64, HALF = 128, HTB = HALF * BK * 2  , STAGE_BYTES = 8 * HTB, NXCD = 8, WGM = 8;

__host__ __device__ __forceinline__ int lds_byte(int r, int c) { const int st = (r >> 4) * 2 + (c >> 5), rr = r & 15, cc = c & 31, ob = rr * 64 + cc * 2; return st * 1024 + (ob ^ (((ob >> 9) & 1) << 5)); }
__host__ __device__ __forceinline__ void stage_rc(int b, int& R, int& C) { const int st = b / 1024, sb = b % 1024, swz = sb ^ (((sb >> 9) & 1) << 5); R = (st >> 1) * 16 + swz / 64; C = (st & 1) * 32 + (swz % 64) / 2; }
__host__ __device__ __forceinline__ int perm32(int rho) { const int n = rho >> 4, i = rho & 15; return 8 * (i >> 2) + 4 * n + (i & 3); }

struct Unit { int pm, pn; };
struct Gemm { const bf16_t* A; const bf16_t* Bt; int M, N, K; };

struct StaticOrder {
    int nM, nN, nwg, G, c;
    __host__ __device__ void init(int M, int N, int G_, int c_) { nM = M / BM; nN = N / BM; nwg = nM * nN; G = G_; c = c_; }
    __host__ __device__ bool next(int i, Unit& u) const {
        const long L = (long)i * G + c; if (L >= nwg) return false;
        int wgid = (int)L; { const int q = nwg / NXCD, r = nwg % NXCD, xcd = wgid % NXCD, off = wgid / NXCD; wgid = (xcd < r ? xcd * (q + 1) : r * (q + 1) + (xcd - r) * q) + off; }
        const int nig = WGM * nN, gid = wgid / nig, fm = gid * WGM, gsz = (nM - fm) < WGM ? (nM - fm) : WGM;
        u.pm = fm + ((wgid % nig) % gsz); u.pn = (wgid % nig) / gsz; return true;
    }
    __device__ __forceinline__ void a_ready(const Unit&) const {}
    __device__ __forceinline__ void done(const Unit&) const {}
};

__device__ __forceinline__ unsigned cvt_pk_bf16(float lo, float hi) { unsigned r; asm volatile("v_cvt_pk_bf16_f32 %0, %1, %2" : "=v"(r) : "v"(lo), "v"(hi)); return r; }
template <class Epi, class Sched, bool ALIGN_EPI = false, bool SP2 = false>
__device__ __forceinline__ void gemm_phase(PG8_LAS unsigned char* lds, const Gemm g, const Sched& S, const Epi& E) {
    const int tid = threadIdx.x, wid = __builtin_amdgcn_readfirstlane(tid >> 6), lane = tid & 63, wr = wid >> 2, wc = wid & 3, fr = lane & 15, fq = lane >> 4;
    const int K = g.K, nt = K / BK;
    unsigned voffA[2], voffB[2];
#pragma unroll
    for (int i = 0; i < 2; ++i) { int R, C; stage_rc(tid * 16 + i * 8192, R, C); const int Rb = Epi::PERM ? ((R & ~31) + perm32(R & 31)) : R;
        voffA[i] = (unsigned)(R * K + C) * 2u; voffB[i] = (unsigned)(Rb * K + C) * 2u; }
    const size_t kstep = (size_t)(BK * 2);
    const size_t hstep = (size_t)HALF * K * 2;
    const size_t tstep = 2 * hstep;
    const unsigned ldsw = (unsigned)wid * 1024u;
    const int aoff = lds_byte(wr * 64 + fr, fq * 8), boff = lds_byte(wc * 32 + fr, fq * 8);
#define PG8_SA(b, h) (((b) * 2 + (h)) * HTB)
#define PG8_SB(b, h) ((4 + (b) * 2 + (h)) * HTB)
#define PG8_STAGE(bufoff, gbase, voff) do { _Pragma("unroll") for (int _i = 0; _i < 2; ++_i) \
        __builtin_amdgcn_global_load_lds((const unsigned*)((const char*)(gbase) + (voff)[_i]), (PG8_LAS unsigned*)(lds + (bufoff) + ldsw + _i * 8192), 16, 0, 0); } while (0)
#define PG8_LDA(dst, b, h) do { _Pragma("unroll") for (int m = 0; m < 4; ++m) _Pragma("unroll") for (int k = 0; k < 2; ++k) dst[m][k] = *(const PG8_LAS bf16x8*)(lds + PG8_SA(b, h) + aoff + m * 2048 + k * 1024); } while (0)
#define PG8_LDB(dst, b, h) do { _Pragma("unroll") for (int n = 0; n < 2; ++n) _Pragma("unroll") for (int k = 0; k < 2; ++k) dst[n][k] = *(const PG8_LAS bf16x8*)(lds + PG8_SB(b, h) + boff + n * 2048 + k * 1024); } while (0)
#define PG8_MMA(ai, bj, At, Bt) do { __builtin_amdgcn_s_setprio(1); _Pragma("unroll") for (int m = 0; m < 4; ++m) _Pragma("unroll") for (int n = 0; n < 2; ++n) _Pragma("unroll") for (int k = 0; k < 2; ++k) \
        acc[ai][bj][m][n] = __builtin_amdgcn_mfma_f32_16x16x32_bf16(Bt[n][k], At[m][k], acc[ai][bj][m][n], 0, 0, 0); __builtin_amdgcn_s_setprio(0); } while (0)
#define PG8_WAIT_V(n) asm volatile("s_waitcnt vmcnt(" #n ")" ::: "memory")
#define PG8_WAIT_L(n) asm volatile("s_waitcnt lgkmcnt(" #n ")" ::: "memory")
#define PG8_BAR __builtin_amdgcn_s_barrier()
#define PG8_SCHED __builtin_amdgcn_sched_barrier(0)
    Unit cur, nxt; int ui = 0;
    if (!S.next(0, cur)) return;
    f32x4 acc[2][2][4][2];
#pragma unroll
    for (int a = 0; a < 2; ++a)
#pragma unroll
        for (int b = 0; b < 2; ++b)
#pragma unroll
            for (int m = 0; m < 4; ++m)
#pragma unroll
                for (int n = 0; n < 2; ++n) acc[a][b][m][n] = (f32x4){0.f, 0.f, 0.f, 0.f};
    bf16x8 At[4][2], B0[2][2], B1[2][2];
    const char* cA = (const char*)g.A + (size_t)cur.pm * tstep; const char* cB = (const char*)g.Bt + (size_t)cur.pn * tstep;
    S.a_ready(cur);
    if constexpr (SP2) {
        PG8_STAGE(PG8_SB(0, 0), cB, voffB); PG8_STAGE(PG8_SB(0, 1), cB + hstep, voffB); PG8_STAGE(PG8_SA(0, 0), cA, voffA); PG8_STAGE(PG8_SA(0, 1), cA + hstep, voffA);
        if (wr == 1) PG8_BAR;
        PG8_WAIT_V(2); PG8_BAR;
        PG8_STAGE(PG8_SB(1, 0), cB + kstep, voffB); PG8_STAGE(PG8_SA(1, 0), cA + kstep, voffA); PG8_STAGE(PG8_SB(1, 1), cB + hstep + kstep, voffB);
        PG8_WAIT_V(6); PG8_BAR;
    } else {
        PG8_STAGE(PG8_SB(0, 0), cB, voffB); PG8_STAGE(PG8_SA(0, 0), cA, voffA); PG8_STAGE(PG8_SB(0, 1), cB + hstep, voffB); PG8_STAGE(PG8_SA(0, 1), cA + hstep, voffA);
        if (wr == 1) PG8_BAR;
        PG8_WAIT_V(4); PG8_BAR;
        PG8_STAGE(PG8_SB(1, 0), cB + kstep, voffB); PG8_STAGE(PG8_SA(1, 0), cA + kstep, voffA); PG8_STAGE(PG8_SB(1, 1), cB + hstep + kstep, voffB);
        PG8_WAIT_V(6); PG8_BAR;
    }
    for (;;) {
        const bool has_next = S.next(ui + 1, nxt);
        const char* nA = has_next ? (const char*)g.A + (size_t)nxt.pm * tstep : cA; const char* nB = has_next ? (const char*)g.Bt + (size_t)nxt.pn * tstep : cB;
        for (int t = 0; t < nt; t += 2) {
            const bool last = (t == nt - 2);
            const char* a1 = cA + (size_t)(t + 1) * kstep;
            const char* a2 = last ? nA : cA + (size_t)(t + 2) * kstep; const char* b2 = last ? nB : cB + (size_t)(t + 2) * kstep;
            const char* a3 = a2 + kstep; const char* b3 = b2 + kstep;
            if (last && has_next) S.a_ready(nxt);
            if constexpr (SP2) {
            PG8_LDB(B0, 0, 0); PG8_LDB(B1, 0, 1); PG8_SCHED; PG8_LDA(At, 0, 0); PG8_STAGE(PG8_SA(1, 1), a1 + hstep, voffA);
            PG8_WAIT_V(8); PG8_WAIT_L(0); PG8_BAR; PG8_MMA(0, 0, At, B0); PG8_MMA(0, 1, At, B1); PG8_BAR; PG8_SCHED;
            PG8_LDA(At, 0, 1); PG8_STAGE(PG8_SB(0, 0), b2, voffB); PG8_STAGE(PG8_SB(0, 1), b2 + hstep, voffB); PG8_STAGE(PG8_SA(0, 0), a2, voffA);
            PG8_WAIT_V(8); PG8_WAIT_L(0); PG8_BAR; PG8_MMA(1, 0, At, B0); PG8_MMA(1, 1, At, B1); PG8_BAR; PG8_SCHED;
            PG8_LDB(B0, 1, 0); PG8_LDB(B1, 1, 1); PG8_SCHED; PG8_LDA(At, 1, 0); PG8_STAGE(PG8_SA(0, 1), a2 + hstep, voffA);
            PG8_WAIT_V(8); PG8_WAIT_L(0); PG8_BAR; PG8_MMA(0, 0, At, B0); PG8_MMA(0, 1, At, B1); PG8_BAR; PG8_SCHED;
            PG8_LDA(At, 1, 1); PG8_STAGE(PG8_SB(1, 0), b3, voffB); PG8_STAGE(PG8_SB(1, 1), b3 + hstep, voffB); PG8_STAGE(PG8_SA(1, 0), a3, voffA);
            PG8_WAIT_V(8); PG8_WAIT_L(0); PG8_BAR; PG8_MMA(1, 0, At, B0); PG8_MMA(1, 1, At, B1); PG8_BAR; PG8_SCHED;
            } else {
            PG8_LDB(B0, 0, 0); PG8_SCHED; PG8_LDA(At, 0, 0); PG8_STAGE(PG8_SA(1, 1), a1 + hstep, voffA);
            PG8_WAIT_L(8); PG8_BAR; PG8_WAIT_L(0); PG8_MMA(0, 0, At, B0); PG8_BAR; PG8_SCHED;
            PG8_LDB(B1, 0, 1); PG8_STAGE(PG8_SB(0, 0), b2, voffB);
            PG8_BAR; PG8_WAIT_L(0); PG8_MMA(0, 1, At, B1); PG8_BAR;
            PG8_LDA(At, 0, 1); PG8_STAGE(PG8_SA(0, 0), a2, voffA);
            PG8_BAR; PG8_WAIT_L(0); PG8_MMA(1, 0, At, B0); PG8_BAR; PG8_SCHED;
            PG8_STAGE(PG8_SB(0, 1), b2 + hstep, voffB);
            PG8_WAIT_V(6); PG8_BAR; PG8_MMA(1, 1, At, B1); PG8_BAR;
            PG8_LDB(B0, 1, 0); PG8_SCHED; PG8_LDA(At, 1, 0); PG8_STAGE(PG8_SA(0, 1), a2 + hstep, voffA);
            PG8_WAIT_L(8); PG8_BAR; PG8_WAIT_L(0); PG8_MMA(0, 0, At, B0); PG8_BAR; PG8_SCHED;
            PG8_LDB(B1, 1, 1); PG8_STAGE(PG8_SB(1, 0), b3, voffB);
            PG8_BAR; PG8_WAIT_L(0); PG8_MMA(0, 1, At, B1); PG8_BAR;
            PG8_LDA(At, 1, 1); PG8_STAGE(PG8_SA(1, 0), a3, voffA);
            PG8_BAR; PG8_WAIT_L(0); PG8_MMA(1, 0, At, B0); PG8_BAR; PG8_SCHED;
            PG8_STAGE(PG8_SB(1, 1), b3 + hstep, voffB);
            PG8_WAIT_V(6); PG8_BAR; PG8_MMA(1, 1, At, B1); PG8_BAR;
            }
        }
        if constexpr (ALIGN_EPI) { if (wr == 0) PG8_BAR; }
        if constexpr (!Epi::AFTER_DRAIN) { E(acc, cur, wr, wc, fr, fq); S.done(cur); }
        if (!has_next) break;
#pragma unroll
        for (int a = 0; a < 2; ++a)
#pragma unroll
            for (int b = 0; b < 2; ++b)
#pragma unroll
                for (int m = 0; m < 4; ++m)
#pragma unroll
                    for (int n = 0; n < 2; ++n) acc[a][b][m][n] = (f32x4){0.f, 0.f, 0.f, 0.f};
        cur = nxt; cA = nA; cB = nB; ++ui;
        if constexpr (ALIGN_EPI) { if (wr == 1) PG8_BAR; }
    }
    PG8_WAIT_V(0);
    if constexpr (!ALIGN_EPI) { if (wr == 0) PG8_BAR; }
    PG8_BAR;
    if constexpr (Epi::AFTER_DRAIN) { E.fused(acc, cur, wr, wc, fr, fq, lds, wid, lane); S.done(cur); }
#undef PG8_SA
#undef PG8_SB
#undef PG8_STAGE
#undef PG8_LDA
#undef PG8_LDB
#undef PG8_MMA
#undef PG8_WAIT_V
#undef PG8_WAIT_L
#undef PG8_BAR
#undef PG8_SCHED
}
}

namespace pg8 {
struct EpiStoreBf16 {
    static constexpr bool PERM = true, AFTER_DRAIN = false;
    bf16_t* O; int ldc; float s01, s67;
    __device__ __forceinline__ void operator()(const f32x4 (&acc)[2][2][4][2], const Unit& u, int wr, int wc, int fr, int fq) const {
        const int row0 = u.pm * BM + wr * 64 + fr, col0 = u.pn * BM + wc * 32 + 8 * fq;
        const float sc = u.pn < 2 ? s01 : ((u.pn == 6 || u.pn == 7) ? s67 : 1.f);
#pragma unroll
        for (int ai = 0; ai < 2; ++ai)
#pragma unroll
            for (int m = 0; m < 4; ++m) { bf16_t* rowp = O + (size_t)(row0 + ai * HALF + m * 16) * ldc + col0;
#pragma unroll
                for (int bj = 0; bj < 2; ++bj) { const f32x4 v0 = acc[ai][bj][m][0] * sc, v1 = acc[ai][bj][m][1] * sc;
                    u32x4 w; w.x = cvt_pk_bf16(v0[0], v0[1]); w.y = cvt_pk_bf16(v0[2], v0[3]); w.z = cvt_pk_bf16(v1[0], v1[1]); w.w = cvt_pk_bf16(v1[2], v1[3]);
                    *(u32x4*)(rowp + bj * HALF) = w; } }
    }
};
struct EpiStoreF32 {
    static constexpr bool PERM = true, AFTER_DRAIN = false;
    float* C; int ldc;
    __device__ __forceinline__ void operator()(const f32x4 (&acc)[2][2][4][2], const Unit& u, int wr, int wc, int fr, int fq) const {
        const int row0 = u.pm * BM + wr * 64 + fr, col0 = u.pn * BM + wc * 32 + 8 * fq;
#pragma unroll
        for (int ai = 0; ai < 2; ++ai)
#pragma unroll
            for (int m = 0; m < 4; ++m) { float* rowp = C + (size_t)(row0 + ai * HALF + m * 16) * ldc + col0;
#pragma unroll
                for (int bj = 0; bj < 2; ++bj) { *(f32x4*)(rowp + bj * HALF) = acc[ai][bj][m][0]; *(f32x4*)(rowp + bj * HALF + 4) = acc[ai][bj][m][1]; } }
    }
};
}

__device__ __forceinline__ void transpose_item(const float* W, int ldw, int K, int ncols, bf16_t* WT, float* scr, int item, int lane) {
    const int nblk = ncols / 32, kb = item / nblk, nb = item % nblk, k0 = 64 * kb, n0 = 32 * nb;
#pragma unroll 8
    for (int i = 0; i < 32; ++i) { const int kk = 2 * i + (lane >> 5); scr[kk * 33 + (lane & 31)] = W[(size_t)(k0 + kk) * ldw + n0 + (lane & 31)]; }
    asm volatile("s_waitcnt lgkmcnt(0)" ::: "memory");
    const int c = lane & 7;
#pragma unroll
    for (int j = 0; j < 4; ++j) { const int n = (lane >> 3) + 8 * j; const float* s = scr + (8 * c) * 33 + n;
        uint4 o; o.x = pk2(s[0 * 33], s[1 * 33]); o.y = pk2(s[2 * 33], s[3 * 33]); o.z = pk2(s[4 * 33], s[5 * 33]); o.w = pk2(s[6 * 33], s[7 * 33]);
        *(uint4*)(WT + (size_t)(n0 + n) * K + k0 + 8 * c) = o; }
    asm volatile("s_waitcnt lgkmcnt(0)" ::: "memory");
}
__device__ __forceinline__ void cvt_rows_bf16(const Ctx& c, const float* src, bf16_t* dst, size_t n8) {
    for (size_t i = (size_t)c.gwave * 64 + c.lane; i < n8; i += (size_t)c.nwaves * 64) {
        const float4 a = *(const float4*)(src + i * 8), b = *(const float4*)(src + i * 8 + 4);
        uint4 o; o.x = pk2(a.x, a.y); o.y = pk2(a.z, a.w); o.z = pk2(b.x, b.y); o.w = pk2(b.z, b.w);
        *(uint4*)(dst + i * 8) = o;
    }
}
__device__ __forceinline__ void prologue_phase(const Ctx& c, const float* x, const float* ab_in, const float* ab_out, const float* cd_in, const float* cd_out, const float* wq, const float* pu, const float* pv, const float* sk, unsigned char* ws) {
    float* scr = c.lds + c.wave * 4096;
    constexpr int I_IN = 16 * 96, I_OUT = 16 * 32, I_WQ = 16 * 64;
    constexpr int NITEMS = 2 * I_IN + 2 * I_OUT + 2 * I_WQ;
    for (int it = c.gwave; it < NITEMS; it += c.nwaves) {
        int r = it;
        if (r < I_IN) { transpose_item(ab_in, QKV_W, DM, QKV_W, (bf16_t*)(ws + WT_ABIN), scr, r, c.lane); continue; } r -= I_IN;
        if (r < I_IN) { transpose_item(cd_in, CD_IN, DM, QKV_W, (bf16_t*)(ws + WT_CDIN), scr, r, c.lane); continue; } r -= I_IN;
        if (r < I_OUT) { transpose_item(ab_out, DM, DM, DM, (bf16_t*)(ws + WT_ABOUT), scr, r, c.lane); continue; } r -= I_OUT;
        if (r < I_OUT) { transpose_item(cd_out, DM, DM, DM, (bf16_t*)(ws + WT_CDOUT), scr, r, c.lane); continue; } r -= I_OUT;
        if (r < I_WQ) { transpose_item(wq, PEER_QW, DM, PEER_QW, (bf16_t*)(ws + WT_WQ), scr, r, c.lane); continue; } r -= I_WQ;
        transpose_item(wq + (size_t)DM * PEER_QW, PEER_QW, DM, PEER_QW, (bf16_t*)(ws + WT_WQ + 4 * MiB), scr, r, c.lane);
    }
    cvt_rows_bf16(c, x, (bf16_t*)(ws + WS_ACTIN), (size_t)NT * DM / 8);
    cvt_rows_bf16(c, pu, (bf16_t*)(ws + WS_UB), (size_t)2 * 16384 * DM / 8);
    cvt_rows_bf16(c, pv, (bf16_t*)(ws + WS_VB), (size_t)2 * 16384 * DM / 8);
    cvt_rows_bf16(c, sk, (bf16_t*)(ws + WS_SKB), (size_t)2 * 16 * 128 * 128 / 8);
}

template <int DQ, class BiasF>
__device__ __forceinline__ void causal_softmax_row(const float (&q)[DQ], const bf16_t* kbase, const bf16_t* vbase, int ld, int t, int smax, float scale, BiasF biasf, float (&O)[64]) {
    float m = -INFINITY;
    for (int s = 0; s <= smax; ++s) {
        const bf16_t* kr = kbase + (size_t)s * ld;
        float d = 0.f;
#pragma unroll
        for (int i = 0; i < DQ; ++i) d = fmaf(q[i], bf2f(kr[i]), d);
        const float lg = d * scale + biasf(s);
        m = (s <= t) ? fmaxf(m, lg) : m;
    }
    float l = 0.f;
#pragma unroll
    for (int i = 0; i < 64; ++i) O[i] = 0.f;
    for (int s = 0; s <= smax; ++s) {
        const bf16_t* kr = kbase + (size_t)s * ld;
        const bf16_t* vr = vbase + (size_t)s * ld;
        float d = 0.f;
#pragma unroll
        for (int i = 0; i < DQ; ++i) d = fmaf(q[i], bf2f(kr[i]), d);
        const float lg = d * scale + biasf(s);
        const float p = (s <= t) ? expf(lg - m) : 0.f;
        l += p;
#pragma unroll
        for (int i = 0; i < 64; ++i) O[i] = fmaf(p, bf2f(vr[i]), O[i]);
    }
    const float inv = 1.f / l;
#pragma unroll
    for (int i = 0; i < 64; ++i) O[i] *= inv;
}
__device__ __forceinline__ void store_row64_bf16(bf16_t* orow, const float (&v)[64]) {
#pragma unroll
    for (int i = 0; i < 64; i += 8) { uint4 o; o.x = pk2(v[i], v[i + 1]); o.y = pk2(v[i + 2], v[i + 3]); o.z = pk2(v[i + 4], v[i + 5]); o.w = pk2(v[i + 6], v[i + 7]); *(uint4*)(orow + i) = o; }
}

__device__ __forceinline__ void fg_phase(const Ctx& c, const bf16_t* hin, const float* cd_in, float* fg) {
    for (int t = c.gwave; t < NT; t += c.nwaves) {
        float acc[8];
#pragma unroll
        for (int j = 0; j < 8; ++j) acc[j] = 0.f;
        for (int r = 0; r < 16; ++r) {
            const int d = r * 64 + c.lane;
            const float xv = bf2f(hin[(size_t)t * DM + d]);
            const float4 w0 = *(const float4*)(cd_in + (size_t)d * CD_IN + 3072), w1 = *(const float4*)(cd_in + (size_t)d * CD_IN + 3076);
            acc[0] = fmaf(xv, w0.x, acc[0]); acc[1] = fmaf(xv, w0.y, acc[1]); acc[2] = fmaf(xv, w0.z, acc[2]); acc[3] = fmaf(xv, w0.w, acc[3]);
            acc[4] = fmaf(xv, w1.x, acc[4]); acc[5] = fmaf(xv, w1.y, acc[5]); acc[6] = fmaf(xv, w1.z, acc[6]); acc[7] = fmaf(xv, w1.w, acc[7]);
        }
#pragma unroll
        for (int j = 0; j < 8; ++j) acc[j] = wave_sum(acc[j]);
        if (c.lane == 0) { *(float4*)(fg + (size_t)t * 8) = make_float4(acc[0], acc[1], acc[2], acc[3]); *(float4*)(fg + (size_t)t * 8 + 4) = make_float4(acc[4], acc[5], acc[6], acc[7]); }
    }
}
__device__ __forceinline__ void fscan_naive(const Ctx& c, const float* fg, float* F, const float* bf) {
    for (int task = c.gwave; task < 32; task += c.nwaves) {
        const int b = task >> 3, h = task & 7;
        const int lane = c.lane;
        float v[64]; float tot = 0.f;
#pragma unroll
        for (int i = 0; i < 64; ++i) { const int s = lane * 64 + i; v[i] = log_sigmoid(fg[((size_t)b * SEQ + s) * 8 + h] + bf[h]); tot += v[i]; }
        float incl = tot;
#pragma unroll
        for (int o = 1; o < 64; o <<= 1) { const float n = __shfl_up(incl, o); if (lane >= o) incl += n; }
        float run = incl - tot;
#pragma unroll
        for (int i = 0; i < 64; ++i) { run += v[i]; F[(size_t)task * SEQ + lane * 64 + i] = run; }
    }
}

namespace att {
typedef short bf16x8 __attribute__((ext_vector_type(8)));
typedef short s16x4 __attribute__((ext_vector_type(4)));
typedef float f32x16 __attribute__((ext_vector_type(16)));
typedef float f32x4 __attribute__((ext_vector_type(4)));
typedef short v4i16_t __attribute__((ext_vector_type(4)));
constexpr float LOG2E = 1.4426950408889634f;
constexpr float NEG = -1e30f;
constexpr int KBUF = 0, VBUF = 16384, FBUF = 32768, TBUF = 33792, CNT = 34816;

__device__ __forceinline__ int tile_off(int row, int ch) { return 1024 * (row >> 3) + 512 * (ch >> 2) + 64 * (row & 7) + 16 * ((ch & 3) ^ ((row >> 2) & 3)); }
__device__ __forceinline__ s16x4 vtr(const LAS unsigned char* p) { return __builtin_bit_cast(s16x4, __builtin_amdgcn_ds_read_tr16_b64_v4i16((LAS v4i16_t*)p)); }
__device__ __forceinline__ unsigned cvtpk(float lo, float hi) { unsigned r; asm("v_cvt_pk_bf16_f32 %0, %1, %2" : "=v"(r) : "v"(lo), "v"(hi)); return r; }
__device__ __forceinline__ float xhalf(float v) { return __shfl_xor(v, 32); }
__device__ __forceinline__ int key_of(int i, int hh) { return 8 * (i >> 2) + 4 * hh + (i & 3); }

__device__ __forceinline__ bf16x8 pfrag(const f32x16& p, int ks2) {
    unsigned w[4];
#pragma unroll
    for (int j = 0; j < 4; ++j) w[j] = cvtpk(p[8 * ks2 + 2 * j], p[8 * ks2 + 2 * j + 1]);
    typedef unsigned u32x4 __attribute__((ext_vector_type(4)));
    u32x4 v = {w[0], w[1], w[2], w[3]};
    return __builtin_bit_cast(bf16x8, v);
}
__device__ __forceinline__ void pv_block(f32x16 (&O)[2], const LAS unsigned char* vbuf, int kb, const f32x16& p, int lane) {
    const int hh = lane >> 5, q_ = (lane & 15) >> 2, p_ = lane & 3, cg = (lane >> 4) & 1;
#pragma unroll
    for (int ks2 = 0; ks2 < 2; ++ks2) {
        const bf16x8 pb = pfrag(p, ks2);
#pragma unroll
        for (int db = 0; db < 2; ++db) {
            const int c0 = 32 * db + 16 * cg, ch = (c0 >> 3) + (p_ >> 1);
            const int r0 = 32 * kb + 16 * ks2 + 4 * hh;
            const s16x4 a0 = vtr(vbuf + tile_off(r0 + q_, ch) + 8 * (p_ & 1));
            const s16x4 a1 = vtr(vbuf + tile_off(r0 + 8 + q_, ch) + 8 * (p_ & 1));
            const bf16x8 a = {a0[0], a0[1], a0[2], a0[3], a1[0], a1[1], a1[2], a1[3]};
            O[db] = __builtin_amdgcn_mfma_f32_32x32x16_bf16(a, pb, O[db], 0, 0, 0);
        }
    }
}
template <int S0, int NS>
__device__ __forceinline__ f32x16 qk_block(const LAS unsigned char* kbuf, int kb, const bf16x8 (&Qf)[4], int lane) {
    const int r = lane & 31, hh = lane >> 5;
    f32x16 s = {0.f, 0.f, 0.f, 0.f, 0.f, 0.f, 0.f, 0.f, 0.f, 0.f, 0.f, 0.f, 0.f, 0.f, 0.f, 0.f};
#pragma unroll
    for (int ks = S0; ks < S0 + NS; ++ks) {
        const bf16x8 a = *(const LAS bf16x8*)(kbuf + tile_off(32 * kb + r, 2 * ks + hh));
        s = __builtin_amdgcn_mfma_f32_32x32x16_bf16(a, Qf[ks], s, 0, 0, 0);
    }
    return s;
}
__device__ __forceinline__ void softmax_step(f32x16& x, float& m, float& l, f32x16 (&O)[2]) {
    float mx = x[0];
#pragma unroll
    for (int i = 1; i < 16; ++i) mx = fmaxf(mx, x[i]);
    mx = fmaxf(mx, xhalf(mx));
    const float mn = fmaxf(m, mx);
    if (!__all(mn == m)) {
        const float alpha = __builtin_amdgcn_exp2f(m - mn);
        l *= alpha;
#pragma unroll
        for (int i = 0; i < 16; ++i) { O[0][i] *= alpha; O[1][i] *= alpha; }
        m = mn;
    }
    float ls = 0.f;
#pragma unroll
    for (int i = 0; i < 16; ++i) { x[i] = __builtin_amdgcn_exp2f(x[i] - m); ls += x[i]; }
    l += ls;
}
__device__ __forceinline__ void store_ot(bf16_t* orow, const f32x16 (&O)[2], int hh) {
#pragma unroll
    for (int db = 0; db < 2; ++db)
#pragma unroll
        for (int g = 0; g < 4; ++g) {
            const int d0 = 32 * db + 8 * g + 4 * hh;
            *(uint2*)(orow + d0) = make_uint2(cvtpk(O[db][4 * g], O[db][4 * g + 1]), cvtpk(O[db][4 * g + 2], O[db][4 * g + 3]));
        }
}

struct UnitArgs {
    const bf16_t* qkv;
    bf16_t* out;
    int qcol, kcol, vcol, ocol;
};

struct DilArgs { int dil, rho, pat; bf16_t* po; float* pml; };
template <int TYPE>
__device__ __forceinline__ void causal_unit(const UnitArgs& A, int b, int h, int qb, unsigned char* scratch, int tid,
                                            const float* t5  , float lam, const float* subg, const float* F  , const DilArgs DA = DilArgs{1, 0, 0, nullptr, nullptr}) {
    const LAS unsigned char* lds = (const LAS unsigned char*)scratch;
    LAS unsigned char* ldsw = (LAS unsigned char*)scratch;
    const int lane = tid & 63, w = tid >> 6, r = lane & 31, hh = lane >> 5;
    const int q0 = qb * 256 + 32 * w, tq = q0 + r;
    const size_t rowbase = (size_t)b * SEQ;
    const int ktmax = 4 * qb + 3, kdiag = 4 * qb + (w >> 1);
    const int ktmin = (TYPE == 2) ? (4 * qb - 2 > 0 ? 4 * qb - 2 : 0) : 0;
    const int rs = (TYPE == 2) ? DA.dil : 1, r0off = (TYPE == 2) ? DA.rho : 0;
    const int srow = tid >> 3, sch = tid & 7;
    const bf16_t* kg = A.qkv + (rowbase + r0off + (size_t)rs * srow) * QKV_W + A.kcol + h * 64 + sch * 8;
    const bf16_t* vg = A.qkv + (rowbase + r0off + (size_t)rs * srow) * QKV_W + A.vcol + h * 64 + sch * 8;
    const size_t tstep = (size_t)64 * rs * QKV_W;
    const int soff = tile_off(srow, sch);
    bf16x8 Qf[4];
    {
        const bf16_t* qr = A.qkv + (rowbase + r0off + (size_t)rs * tq) * QKV_W + A.qcol + h * 64 + 8 * hh;
#pragma unroll
        for (int s = 0; s < 4; ++s) Qf[s] = *(const bf16x8*)(qr + 16 * s);
    }
    __syncthreads();
    if ((TYPE == 0 || TYPE == 2) && tid < 128) {
        const float far = t5[31 * 8 + h];
        ((LAS float*)(ldsw + TBUF))[tid] = (t5[t5_bucket(tid) * 8 + h] - far) * LOG2E;
    }
    if (TYPE == 1 && tid == 0) *(LAS unsigned*)(ldsw + CNT) = 0u;
    typedef unsigned u32x4 __attribute__((ext_vector_type(4)));
    u32x4 kreg = *(const u32x4*)(kg + (size_t)ktmax * tstep), vreg = *(const u32x4*)(vg + (size_t)ktmax * tstep);
    float freg = 0.f;
    if (TYPE == 3 && tid < 64) freg = F[(size_t)(b * 8 + h) * SEQ + ktmax * 64 + tid] * LOG2E;
    *(LAS u32x4*)(ldsw + KBUF + soff) = kreg; *(LAS u32x4*)(ldsw + VBUF + soff) = vreg;
    if (TYPE == 3 && tid < 64) ((LAS float*)(ldsw + FBUF))[tid] = freg;
    __syncthreads();

    f32x16 O0[2], O1[2];
#pragma unroll
    for (int i = 0; i < 16; ++i) { O0[0][i] = 0.f; O0[1][i] = 0.f; O1[0][i] = 0.f; O1[1][i] = 0.f; }
    float m0 = NEG, l0 = 0.f, m1 = NEG, l1 = 0.f;
    float R = 0.f;
    bool wdone = false;
    float f2t = 0.f;
    if (TYPE == 3) f2t = F[(size_t)(b * 8 + h) * SEQ + tq] * LOG2E;

    for (int kt = ktmax, it = 0; kt >= ktmin; --kt, ++it) {
        const int cur = it & 1;
        if (kt > ktmin) {
            kreg = *(const u32x4*)(kg + (size_t)(kt - 1) * tstep); vreg = *(const u32x4*)(vg + (size_t)(kt - 1) * tstep);
            if (TYPE == 3 && tid < 64) freg = F[(size_t)(b * 8 + h) * SEQ + (kt - 1) * 64 + tid] * LOG2E;
        }
        const LAS unsigned char* kbuf = lds + KBUF + cur * 8192;
        const LAS unsigned char* vbuf = lds + VBUF + cur * 8192;
        if (kt <= kdiag && !wdone) {
#pragma unroll
            for (int kbi = 0; kbi < 2; ++kbi) {
                const int kb = 1 - kbi;
                const int key0 = kt * 64 + kb * 32;
                if (TYPE == 1 ? (key0 >= q0 + 31) : (key0 > q0 + 31)) continue;
                if (TYPE == 2 && key0 + 31 < q0 - 128) continue;
                const bool need_mask = (TYPE == 1) ? (key0 + 31 >= q0) : (key0 + 31 > q0);
                if (TYPE == 0) {
                    f32x16 x0 = qk_block<0, 2>(kbuf, kb, Qf, lane), x1 = qk_block<2, 2>(kbuf, kb, Qf, lane);
                    if (q0 - (key0 + 31) < 113) {
                        const LAS float* tb = (const LAS float*)(lds + TBUF);
#pragma unroll
                        for (int i = 0; i < 16; ++i) {
                            const int dist = tq - (key0 + key_of(i, hh));
                            const float bv = (dist >= 0 && dist < 128) ? tb[dist < 0 ? 0 : (dist > 127 ? 127 : dist)] : 0.f;
                            x0[i] = dist < 0 ? NEG : x0[i] + bv; x1[i] = dist < 0 ? NEG : x1[i] + bv;
                        }
                    }
                    softmax_step(x0, m0, l0, O0);
                    pv_block(O0, vbuf, kb, x0, lane);
                    softmax_step(x1, m1, l1, O1);
                    pv_block(O1, vbuf, kb, x1, lane);
                } else if (TYPE == 2) {
                    f32x16 x = qk_block<0, 4>(kbuf, kb, Qf, lane);
                    const LAS float* tb = (const LAS float*)(lds + TBUF);
#pragma unroll
                    for (int i = 0; i < 16; ++i) {
                        const int dist = tq - (key0 + key_of(i, hh));
                        int bi = dist * rs; bi = bi < 0 ? 0 : (bi > 127 ? 127 : bi);
                        x[i] = (dist >= 0 && dist <= 128) ? x[i] + tb[bi] : NEG;
                    }
                    softmax_step(x, m0, l0, O0);
                    pv_block(O0, vbuf, kb, x, lane);
                } else if (TYPE == 3) {
                    f32x16 x = qk_block<0, 4>(kbuf, kb, Qf, lane);
                    const LAS float* fb = (const LAS float*)(lds + FBUF + cur * 256);
#pragma unroll
                    for (int g = 0; g < 4; ++g) {
                        const f32x4 fv = *(const LAS f32x4*)(fb + 32 * kb + 8 * g + 4 * hh);
#pragma unroll
                        for (int j = 0; j < 4; ++j) x[4 * g + j] += f2t - fv[j];
                    }
                    if (need_mask) {
#pragma unroll
                        for (int i = 0; i < 16; ++i) x[i] = (key0 + key_of(i, hh) > tq) ? NEG : x[i];
                    }
                    softmax_step(x, m0, l0, O0);
                    pv_block(O0, vbuf, kb, x, lane);
                } else {
                    f32x16 z = qk_block<0, 4>(kbuf, kb, Qf, lane);
                    f32x16 lr;
#pragma unroll
                    for (int i = 0; i < 16; ++i) {
                        const float e = __builtin_amdgcn_exp2f(-fabsf(z[i]));
                        float v = -(fmaxf(z[i], 0.f) + __builtin_amdgcn_logf(1.f + e));
                        if (need_mask) v = (key0 + key_of(i, hh) >= tq) ? 0.f : v;
                        lr[i] = v;
                    }
                    float T[4], Tp[4], sfx[16];
#pragma unroll
                    for (int g = 0; g < 4; ++g) {
                        sfx[4 * g + 3] = 0.f; sfx[4 * g + 2] = lr[4 * g + 3]; sfx[4 * g + 1] = sfx[4 * g + 2] + lr[4 * g + 2]; sfx[4 * g] = sfx[4 * g + 1] + lr[4 * g + 1];
                        T[g] = sfx[4 * g] + lr[4 * g];
                        Tp[g] = xhalf(T[g]);
                    }
                    float SP[4];
                    SP[3] = 0.f; SP[2] = T[3] + Tp[3]; SP[1] = SP[2] + T[2] + Tp[2]; SP[0] = SP[1] + T[1] + Tp[1];
                    const float tot = SP[0] + T[0] + Tp[0];
                    const float msel = hh == 0 ? 1.f : 0.f;
#pragma unroll
                    for (int g = 0; g < 4; ++g) {
                        const float goff = R + SP[g] + msel * Tp[g];
#pragma unroll
                        for (int j = 0; j < 4; ++j) {
                            const int i = 4 * g + j;
                            float wv = __builtin_amdgcn_exp2f(lr[i] + z[i] + goff + sfx[i]);
                            if (need_mask) wv = (key0 + key_of(i, hh) >= tq) ? 0.f : wv;
                            z[i] = wv;
                        }
                    }
                    R += tot;
                    pv_block(O0, vbuf, kb, z, lane);
                }
            }
            if (TYPE == 1) {
                if (__all(R < -216.4f)) { wdone = true; if (lane == 0) (void)__hip_atomic_fetch_add((LAS unsigned*)(ldsw + CNT), 1u, __ATOMIC_RELAXED, __HIP_MEMORY_SCOPE_WORKGROUP); }
            }
        }
        if (kt > ktmin) {
            *(LAS u32x4*)(ldsw + KBUF + (cur ^ 1) * 8192 + soff) = kreg; *(LAS u32x4*)(ldsw + VBUF + (cur ^ 1) * 8192 + soff) = vreg;
            if (TYPE == 3 && tid < 64) ((LAS float*)(ldsw + FBUF + (cur ^ 1) * 256))[tid] = freg;
        }
        __syncthreads();
        if (TYPE == 1) { const unsigned cnt = *(const LAS unsigned*)(lds + CNT); __syncthreads(); if (cnt == 8u) break; }
    }
    if (TYPE == 2) {
        const size_t prow = ((size_t)DA.pat * NT + rowbase + r0off + (size_t)rs * tq) * 8 + h;
        store_ot(DA.po + prow * 64, O0, hh);
        const float lt = l0 + xhalf(l0);
        if (hh == 0) *(float2*)(DA.pml + prow * 2) = make_float2(m0, lt);
        return;
    }
    bf16_t* orow = A.out + (rowbase + tq) * DM + A.ocol + h * 64;
    if (TYPE == 0) {
        const float i0 = 1.f / (l0 + xhalf(l0)), i1 = lam / (l1 + xhalf(l1));
        float ss = 0.f;
#pragma unroll
        for (int db = 0; db < 2; ++db)
#pragma unroll
            for (int i = 0; i < 16; ++i) { const float o = O0[db][i] * i0 - O1[db][i] * i1; O0[db][i] = o; ss = fmaf(o, o, ss); }
        ss += xhalf(ss);
        const float rn = rsqrtf(ss * (1.f / 64.f) + LN_EPS) * 0.8f;
#pragma unroll
        for (int db = 0; db < 2; ++db)
#pragma unroll
            for (int i = 0; i < 16; ++i) O0[db][i] *= rn * subg[32 * db + key_of(i, hh)];
        store_ot(orow, O0, hh);
    } else if (TYPE == 3) {
        const float i0 = 1.f / (l0 + xhalf(l0));
#pragma unroll
        for (int db = 0; db < 2; ++db)
#pragma unroll
            for (int i = 0; i < 16; ++i) O0[db][i] *= i0;
        store_ot(orow, O0, hh);
    } else {
        store_ot(orow, O0, hh);
    }
}
}

__device__ __forceinline__ int xcd_perm256(int p) { return (p & 7) * 32 + (p >> 3); }

__device__ __forceinline__ void attn_layer0_mfma(const Ctx& c, const bf16_t* qkv, bf16_t* out, const float* t5, const float* lamv, const float* subg) {
    float s01 = 0.f, s23 = 0.f;
    for (int i = 0; i < 32; ++i) { s01 += lamv[i] * lamv[32 + i]; s23 += lamv[64 + i] * lamv[96 + i]; }
    const float lam = expf(s01) - expf(s23) + 0.2f;
    unsigned char* scratch = (unsigned char*)c.lds;
    const att::UnitArgs UA{qkv, out, 0, 512, 1024, 0}, UB{qkv, out, 1536, 2048, 2560, 512};
    for (int p = c.bid; p < 256; p += c.nblk) {
        const int pp = xcd_perm256(p), bh = pp >> 3, qb = pp & 7;
        att::causal_unit<0>(UA, bh >> 3, bh & 7, 15 - qb, scratch, c.tid, t5, lam, subg, nullptr);
        att::causal_unit<0>(UA, bh >> 3, bh & 7, qb, scratch, c.tid, t5, lam, subg, nullptr);
#pragma unroll 1
        for (int k = 0; k < 2; ++k) {
            const int u = pp * 2 + k, bh2 = u >> 4, qb2 = u & 15;
            att::causal_unit<1>(UB, bh2 >> 3, bh2 & 7, qb2, scratch, c.tid, nullptr, 0.f, nullptr, nullptr);
        }
    }
}
__device__ __forceinline__ void attn_dilated_mfma(const Ctx& c, const bf16_t* qkv, const float* t5, bf16_t* po, float* pml) {
    unsigned char* scratch = (unsigned char*)c.lds;
    const att::UnitArgs UC{qkv, nullptr, 0, 512, 1024, 0};
    for (int p = c.bid; p < 256; p += c.nblk) {
        const int pp = xcd_perm256(p);
#pragma unroll 1
        for (int k = 0; k < 6; ++k) {
            const int u = pp * 6 + k, bh = u / 48, v = u % 48;
            int pat, rho, qb, dil;
            if (v < 16) { pat = 0; dil = 1; rho = 0; qb = v; }
            else if (v < 32) { pat = 1; dil = 4; rho = (v - 16) >> 2; qb = (v - 16) & 3; }
            else { pat = 2; dil = 16; rho = v - 32; qb = 0; }
            att::causal_unit<2>(UC, bh >> 3, bh & 7, qb, scratch, c.tid, t5, 0.f, nullptr, nullptr, att::DilArgs{dil, rho, pat, po, pml});
        }
    }
}
__device__ __forceinline__ void dilated_combine(const Ctx& c, const bf16_t* po, const float* pml, bf16_t* out) {
    const size_t n = (size_t)NT * 8 * 8;
    for (size_t i = (size_t)c.gwave * 64 + c.lane; i < n; i += (size_t)c.nwaves * 64) {
        const size_t th = i >> 3; const int ch = (int)(i & 7);
        float m[3], l[3];
#pragma unroll
        for (int p = 0; p < 3; ++p) { const float2 ml = *(const float2*)(pml + ((size_t)p * NT * 8 + th) * 2); m[p] = ml.x; l[p] = ml.y; }
        const float mm = fmaxf(m[0], fmaxf(m[1], m[2]));
        float wgt[3], den = 0.f;
#pragma unroll
        for (int p = 0; p < 3; ++p) { wgt[p] = __builtin_amdgcn_exp2f(m[p] - mm); den += wgt[p] * l[p]; }
        const float inv = 1.f / den;
        float o[8];
#pragma unroll
        for (int d = 0; d < 8; ++d) o[d] = 0.f;
#pragma unroll
        for (int p = 0; p < 3; ++p) {
            const uint4 v = *(const uint4*)(po + ((size_t)p * NT * 8 + th) * 64 + ch * 8);
            const unsigned w4[4] = {v.x, v.y, v.z, v.w};
#pragma unroll
            for (int q = 0; q < 4; ++q) { o[2 * q] = fmaf(wgt[p], __builtin_bit_cast(float, w4[q] << 16), o[2 * q]); o[2 * q + 1] = fmaf(wgt[p], __builtin_bit_cast(float, w4[q] & 0xffff0000u), o[2 * q + 1]); }
        }
        uint4 ov; ov.x = pk2(o[0] * inv, o[1] * inv); ov.y = pk2(o[2] * inv, o[3] * inv); ov.z = pk2(o[4] * inv, o[5] * inv); ov.w = pk2(o[6] * inv, o[7] * inv);
        const size_t tok = th >> 3; const int hd = (int)(th & 7);
        *(uint4*)(out + tok * DM + hd * 64 + ch * 8) = ov;
    }
}
__device__ __forceinline__ void attn_fox_mfma(const Ctx& c, const bf16_t* qkv, const float* F, bf16_t* out) {
    unsigned char* scratch = (unsigned char*)c.lds;
    const att::UnitArgs UD{qkv, out, 1536, 2048, 2560, 512};
    for (int p = c.bid; p < 256; p += c.nblk) {
        const int pp = xcd_perm256(p), bh = pp >> 3, qb = pp & 7;
        att::causal_unit<3>(UD, bh >> 3, bh & 7, 15 - qb, scratch, c.tid, nullptr, 0.f, nullptr, F);
        att::causal_unit<3>(UD, bh >> 3, bh & 7, qb, scratch, c.tid, nullptr, 0.f, nullptr, F);
    }
}

__device__ __forceinline__ void ln_rows(const Ctx& c, const float* hin32, const bf16_t* hin16, const float* add, const float* g, const float* bta, float* out, bf16_t* outb) {
    for (int t = c.gwave; t < NT; t += c.nwaves) {
        float v[16];
        float s = 0.f;
#pragma unroll
        for (int r = 0; r < 4; ++r) {
            const int d = r * 256 + c.lane * 4;
            float4 a;
            if (hin32) a = *(const float4*)(hin32 + (size_t)t * DM + d);
            else { const uint2 w = *(const uint2*)(hin16 + (size_t)t * DM + d); a = make_float4(__builtin_bit_cast(float, w.x << 16), __builtin_bit_cast(float, w.x & 0xffff0000u), __builtin_bit_cast(float, w.y << 16), __builtin_bit_cast(float, w.y & 0xffff0000u)); }
            const float4 m = *(const float4*)(add + (size_t)t * DM + d);
            v[r * 4 + 0] = DN_ALPHA * a.x + m.x; v[r * 4 + 1] = DN_ALPHA * a.y + m.y; v[r * 4 + 2] = DN_ALPHA * a.z + m.z; v[r * 4 + 3] = DN_ALPHA * a.w + m.w;
            s += v[r * 4] + v[r * 4 + 1] + v[r * 4 + 2] + v[r * 4 + 3];
        }
        const float mu = wave_sum(s) * (1.f / DM);
        float q = 0.f;
#pragma unroll
        for (int i = 0; i < 16; ++i) { v[i] -= mu; q = fmaf(v[i], v[i], q); }
        const float rs = rsqrtf(wave_sum(q) * (1.f / DM) + LN_EPS);
#pragma unroll
        for (int r = 0; r < 4; ++r) {
            const int d = r * 256 + c.lane * 4;
            const float4 gg = *(const float4*)(g + d), bb = *(const float4*)(bta + d);
            const float4 o = make_float4(v[r * 4] * rs * gg.x + bb.x, v[r * 4 + 1] * rs * gg.y + bb.y, v[r * 4 + 2] * rs * gg.z + bb.z, v[r * 4 + 3] * rs * gg.w + bb.w);
            if (out) *(float4*)(out + (size_t)t * DM + d) = o;
            if (outb) *(uint2*)(outb + (size_t)t * DM + d) = make_uint2(pk2(o.x, o.y), pk2(o.z, o.w));
        }
    }
}

__device__ __forceinline__ void topk_insert(float (&tv)[16], int (&ti)[16], float v, int id) {
#pragma unroll
    for (int j = 15; j >= 1; --j) {
        const bool g = v > tv[j], gp = v > tv[j - 1];
        tv[j] = g ? (gp ? tv[j - 1] : v) : tv[j];
        ti[j] = g ? (gp ? ti[j - 1] : id) : ti[j];
    }
    const bool g0 = v > tv[0];
    tv[0] = g0 ? v : tv[0]; ti[0] = g0 ? id : ti[0];
}

namespace rt {
typedef short bf16x8 __attribute__((ext_vector_type(8)));
typedef float f32x16 __attribute__((ext_vector_type(16)));
__device__ __forceinline__ void ins_packed(float (&tv)[16], float v) {
#pragma unroll
    for (int j = 15; j >= 1; --j) { const bool g = v > tv[j], gp = v > tv[j - 1]; tv[j] = g ? (gp ? tv[j - 1] : v) : tv[j]; }
    tv[0] = v > tv[0] ? v : tv[0];
}
__device__ __forceinline__ float pk_idx(float v, int idx) { return __builtin_bit_cast(float, (__builtin_bit_cast(unsigned, v) & ~127u) | (unsigned)idx); }
__device__ __forceinline__ float pk_val(float p) { return __builtin_bit_cast(float, __builtin_bit_cast(unsigned, p) & ~127u); }
__device__ __forceinline__ int pk_id(float p) { return (int)(__builtin_bit_cast(unsigned, p) & 127u); }

__device__ __forceinline__ void top16_of_set(float (&tv)[16], const bf16_t* pq_row  , const bf16_t* keys  , int r, int hh) {
    bf16x8 B[8];
#pragma unroll
    for (int s = 0; s < 8; ++s) B[s] = *(const bf16x8*)(pq_row + 16 * s);
#pragma unroll
    for (int j = 0; j < 16; ++j) tv[j] = -INFINITY;
#pragma unroll 1
    for (int blk = 0; blk < 4; ++blk) {
        const bf16_t* kr = keys + (size_t)(32 * blk + r) * 128 + 8 * hh;
        f32x16 acc = {0.f, 0.f, 0.f, 0.f, 0.f, 0.f, 0.f, 0.f, 0.f, 0.f, 0.f, 0.f, 0.f, 0.f, 0.f, 0.f};
#pragma unroll
        for (int s = 0; s < 8; ++s) acc = __builtin_amdgcn_mfma_f32_32x32x16_bf16(*(const bf16x8*)(kr + 16 * s), B[s], acc, 0, 0, 0);
#pragma unroll
        for (int i = 0; i < 16; ++i) ins_packed(tv, pk_idx(acc[i], 32 * blk + 8 * (i >> 2) + 4 * hh + (i & 3)));
    }
    float pt[16];
#pragma unroll
    for (int j = 0; j < 16; ++j) pt[j] = __shfl_xor(tv[j], 32);
#pragma unroll
    for (int j = 0; j < 16; ++j) ins_packed(tv, pt[j]);
}
}

__device__ __forceinline__ void peer_route_phase(const Ctx& c, const bf16_t* pq, const bf16_t* subk  , int* eidx, float* gate) {
    const int lane = c.lane, r = lane & 31, hh = lane >> 5;
    for (int task = c.gwave; task < (NT / 32) * 8; task += c.nwaves) {
        const int h = task & 7, t = (task >> 3) * 32 + r;
        float la[16], lb[16];
        rt::top16_of_set(la, pq + (size_t)t * PEER_QW + (2 * h) * 128 + 8 * hh, subk + (size_t)(2 * h) * 128 * 128, r, hh);
        rt::top16_of_set(lb, pq + (size_t)t * PEER_QW + (2 * h + 1) * 128 + 8 * hh, subk + (size_t)(2 * h + 1) * 128 * 128, r, hh);
        float tv[16]; int ti[16];
#pragma unroll
        for (int j = 0; j < 16; ++j) { tv[j] = -INFINITY; ti[j] = 0; }
#pragma unroll
        for (int i = 0; i < 16; ++i) {
            const float av = rt::pk_val(la[i]); const int ai = rt::pk_id(la[i]) * 128;
#pragma unroll
            for (int j = 0; j < 16 / (i + 1); ++j) topk_insert(tv, ti, av + rt::pk_val(lb[j]), ai + rt::pk_id(lb[j]));
        }
        float sum = 0.f, e[16];
#pragma unroll
        for (int j = 0; j < 16; ++j) { e[j] = expf(tv[j] - tv[0]); sum += e[j]; }
        const float inv = 1.f / sum;
        if (hh == 0) {
            int* oi = eidx + ((size_t)t * 8 + h) * 16; float* og = gate + ((size_t)t * 8 + h) * 16;
#pragma unroll
            for (int j = 0; j < 16; j += 4) {
                *(int4*)(oi + j) = make_int4(ti[j], ti[j + 1], ti[j + 2], ti[j + 3]);
                *(float4*)(og + j) = make_float4(e[j] * inv, e[j + 1] * inv, e[j + 2] * inv, e[j + 3] * inv);
            }
        }
    }
}

typedef unsigned u32x4_t __attribute__((ext_vector_type(4)));
typedef __bf16 bf16x2_t __attribute__((ext_vector_type(2)));
__device__ __forceinline__ float dot2u(unsigned w, unsigned x, float acc) { return __builtin_amdgcn_fdot2_f32_bf16(__builtin_bit_cast(bf16x2_t, w), __builtin_bit_cast(bf16x2_t, x), acc, false); }
__device__ __forceinline__ float dot8_bf16(const u32x4_t a, const u32x4_t b, float acc) {
    const unsigned a0 = a.x, a1 = a.y, a2 = a.z, a3 = a.w, b0 = b.x, b1 = b.y, b2 = b.z, b3 = b.w;
    acc = dot2u(a0, b0, acc); acc = dot2u(a1, b1, acc); acc = dot2u(a2, b2, acc); acc = dot2u(a3, b3, acc);
    return acc;
}
__device__ __forceinline__ float gelu_exact(float d) { return 0.5f * d * (1.f + erff(d * 0.70710678118654752f)); }

__device__ __forceinline__ void peer_u_phase(const Ctx& c, const bf16_t* h1b, const int* eidx, float* coef, const bf16_t* U) {
    const int lane = c.lane;
    for (int vb = c.bid; vb < 256; vb += c.nblk) {
        const int j = vb & 7, rnk = vb >> 3;
#pragma unroll 1
        for (int pass = 0; pass < 2; ++pass) {
            const int s16 = j + 8 * pass;
#pragma unroll 1
            for (int i = 0; i < 64; ++i) {
                const int t = rnk * 512 + c.wave * 64 + i;
                const u32x4_t x0 = *(const u32x4_t*)(h1b + (size_t)t * DM + lane * 8), x1 = *(const u32x4_t*)(h1b + (size_t)t * DM + 512 + lane * 8);
                const int e0 = eidx[(size_t)t * 128 + lane], e1 = eidx[(size_t)t * 128 + 64 + lane];
                unsigned long long m0 = __ballot((e0 & 15) == s16), m1 = __ballot((e1 & 15) == s16);
                while (m0 | m1) {
                    int ks[4], es[4];
#pragma unroll
                    for (int u = 0; u < 4; ++u) {
                        if (m0) { const int k = __builtin_ctzll(m0); m0 &= m0 - 1; ks[u] = k; es[u] = __builtin_amdgcn_readlane(e0, k); }
                        else if (m1) { const int k = __builtin_ctzll(m1); m1 &= m1 - 1; ks[u] = 64 + k; es[u] = __builtin_amdgcn_readlane(e1, k); }
                        else { ks[u] = -1; es[u] = es[0]; }
                    }
                    u32x4_t ua[4], ub[4];
#pragma unroll
                    for (int u = 0; u < 4; ++u) { const bf16_t* ur = U + (size_t)es[u] * DM + lane * 8; ua[u] = *(const u32x4_t*)ur; ub[u] = *(const u32x4_t*)(ur + 512); }
                    float p[4];
#pragma unroll
                    for (int u = 0; u < 4; ++u) p[u] = dot8_bf16(ub[u], x1, dot8_bf16(ua[u], x0, 0.f));
                    const bool hi = lane >= 32, h16 = (lane >> 4) & 1;
                    const float r0 = (hi ? p[2] : p[0]) + __shfl_xor(hi ? p[0] : p[2], 32);
                    const float r1 = (hi ? p[3] : p[1]) + __shfl_xor(hi ? p[1] : p[3], 32);
                    float s = (h16 ? r1 : r0) + __shfl_xor(h16 ? r0 : r1, 16);
                    s += __shfl_xor(s, 8); s += __shfl_xor(s, 4); s += __shfl_xor(s, 2); s += __shfl_xor(s, 1);
                    const int g = lane >> 4;
                    const int kk = g == 0 ? ks[0] : (g == 1 ? ks[1] : (g == 2 ? ks[2] : ks[3]));
                    if ((lane & 15) == 0 && kk >= 0) { float* cp = coef + (size_t)t * 128 + kk; __hip_atomic_store(cp, *cp * gelu_exact(s), __ATOMIC_RELAXED, __HIP_MEMORY_SCOPE_AGENT); }
                }
            }
        }
    }
}

__device__ __forceinline__ void peer_v_phase(const Ctx& c, const int* eidx, const float* coef, const bf16_t* V, float* Y) {
    const int lane = c.lane, sg = lane >> 3, part = lane & 7;
    typedef int i32x4_t __attribute__((ext_vector_type(4)));
    typedef float f32x4_t __attribute__((ext_vector_type(4)));
    for (int vb = c.bid; vb < 256; vb += c.nblk) {
        const int j = vb & 7, rnk = vb >> 3;
#pragma unroll 1
        for (int pass = 0; pass < 2; ++pass) {
            const int dcol = 64 * (j + 8 * pass) + part * 8;
#pragma unroll 1
            for (int i = 0; i < 64; ++i) {
                const int t = rnk * 512 + c.wave * 64 + i;
                i32x4_t e[4]; f32x4_t cf[4];
#pragma unroll
                for (int q = 0; q < 4; ++q) { e[q] = *(const i32x4_t*)(eidx + (size_t)t * 128 + sg * 16 + 4 * q); cf[q] = *(const f32x4_t*)(coef + (size_t)t * 128 + sg * 16 + 4 * q); }
                u32x4_t rows[16];
#pragma unroll
                for (int it = 0; it < 16; ++it) rows[it] = *(const u32x4_t*)(V + (size_t)e[it >> 2][it & 3] * DM + dcol);
                float acc[8];
#pragma unroll
                for (int d = 0; d < 8; ++d) acc[d] = 0.f;
#pragma unroll
                for (int it = 0; it < 16; ++it) {
                    const float cv = cf[it >> 2][it & 3];
#pragma unroll
                    for (int w = 0; w < 4; ++w) {
                        const unsigned pk = rows[it][w];
                        acc[2 * w] = fmaf(cv, __builtin_bit_cast(float, pk << 16), acc[2 * w]);
                        acc[2 * w + 1] = fmaf(cv, __builtin_bit_cast(float, pk & 0xffff0000u), acc[2 * w + 1]);
                    }
                }
#pragma unroll
                for (int d = 0; d < 8; ++d) { acc[d] += __shfl_xor(acc[d], 8); acc[d] += __shfl_xor(acc[d], 16); acc[d] += __shfl_xor(acc[d], 32); }
                if (lane < 8) {
                    float* yp = Y + (size_t)t * DM + dcol;
                    *(f32x4_t*)yp = (f32x4_t){acc[0], acc[1], acc[2], acc[3]}; *(f32x4_t*)(yp + 4) = (f32x4_t){acc[4], acc[5], acc[6], acc[7]};
                }
            }
        }
    }
}

constexpr int NPHASE = 1 + 2 * 11;
__global__ void __launch_bounds__(NTHREADS, 2) fwd(Args args) {
    unsigned* ctl = (unsigned*)(args.ws + WS_CTL);
    volatile LAS unsigned* xbw = (volatile LAS unsigned*)(dyn_lds + MISC_OFF);
    if (threadIdx.x == 0) { xbw[0] = 0u; xbw[1] = 0u; xbw[2] = 0u; xbw[3] = 0u; }
    __syncthreads();
    const int lo = args.ph_lo, hi = args.ph_hi;
    XcdBarrier bar = xcd_barrier_post(ctl + 4096, xbw);
#define IN(k) (lo <= (k) && (k) < hi)
#define SEAM(k) do { if (IN(k) && IN((k) + 1)) xcd_barrier(bar); } while (0)
#define LAUNDER(ptr) ptr = launder_ptr(ptr)
#define PIN(k) ((const float*)launder_ptr((unsigned char*)args.in[k]))
#define GEMM_LDS ((PG8_LAS unsigned char*)dyn_lds + RING_OFF)
    if (IN(0)) { unsigned char* ws = args.ws; LAUNDER(ws); const Ctx c = make_ctx(); prologue_phase(c, PIN(0), PIN(2), PIN(5), PIN(6), PIN(8), PIN(9), PIN(11), PIN(12), PIN(10), ws); }
    SEAM(0);
#pragma unroll 1
    for (int layer = 0; layer < 2; ++layer) {
        const int pb = 1 + layer * 11;
        if (IN(pb + 0)) {
            unsigned char* ws = args.ws; LAUNDER(ws); const Ctx c = make_ctx();
            pg8::Gemm g{(const bf16_t*)(ws + WS_ACTIN), (const bf16_t*)(ws + (layer == 0 ? WT_ABIN : WT_CDIN)), NT, QKV_W, DM};
            pg8::StaticOrder S; S.init(NT, QKV_W, c.nblk, c.bid);
            pg8::EpiStoreBf16 E{(bf16_t*)(ws + WS_QKV), QKV_W, (layer == 0 ? 0.17677669529663687f : 0.125f) * 1.4426950408889634f, 0.125f * 1.4426950408889634f};
            pg8::gemm_phase<pg8::EpiStoreBf16, pg8::StaticOrder, true, true>(GEMM_LDS, g, S, E);
            if (layer == 1) fg_phase(c, (const bf16_t*)(ws + WS_ACTIN), PIN(6), (float*)(ws + WS_FG));
        }
        SEAM(pb + 0);
        if (IN(pb + 1) && layer == 1) { unsigned char* ws = args.ws; LAUNDER(ws); const Ctx c = make_ctx(); fscan_naive(c, (const float*)(ws + WS_FG), (float*)(ws + WS_F), PIN(7)); }
        SEAM(pb + 1);
        if (IN(pb + 2)) {
            unsigned char* ws = args.ws; LAUNDER(ws); const Ctx c = make_ctx();
            if (layer == 0) attn_layer0_mfma(c, (const bf16_t*)(ws + WS_QKV), (bf16_t*)(ws + WS_ATTB), PIN(1), PIN(3), PIN(4));
            else { attn_fox_mfma(c, (const bf16_t*)(ws + WS_QKV), (const float*)(ws + WS_F), (bf16_t*)(ws + WS_ATTB)); attn_dilated_mfma(c, (const bf16_t*)(ws + WS_QKV), PIN(1), (bf16_t*)(ws + WS_MIX), (float*)(ws + WS_H1B)); }
        }
        SEAM(pb + 2);
        if (IN(pb + 3) && layer == 1) { unsigned char* ws = args.ws; LAUNDER(ws); const Ctx c = make_ctx(); dilated_combine(c, (const bf16_t*)(ws + WS_MIX), (const float*)(ws + WS_H1B), (bf16_t*)(ws + WS_ATTB)); }
        SEAM(pb + 3);
        if (IN(pb + 4)) {
            unsigned char* ws = args.ws; LAUNDER(ws); const Ctx c = make_ctx();
            pg8::Gemm g{(const bf16_t*)(ws + WS_ATTB), (const bf16_t*)(ws + (layer == 0 ? WT_ABOUT : WT_CDOUT)), NT, DM, DM};
            pg8::StaticOrder S; S.init(NT, DM, c.nblk, c.bid);
            pg8::EpiStoreF32 E{(float*)(ws + WS_MIX), DM};
            pg8::gemm_phase<pg8::EpiStoreF32, pg8::StaticOrder, true, true>(GEMM_LDS, g, S, E);
        }
        SEAM(pb + 4);
        if (IN(pb + 5)) {
            unsigned char* ws = args.ws; LAUNDER(ws); const Ctx c = make_ctx();
            ln_rows(c, layer == 0 ? PIN(0) : (const float*)nullptr, (const bf16_t*)(ws + WS_ACTIN), (const float*)(ws + WS_MIX), PIN(13) + (size_t)layer * 2 * DM, PIN(14) + (size_t)layer * 2 * DM, (float*)nullptr, (bf16_t*)(ws + WS_H1B));
        }
        SEAM(pb + 5);
        if (IN(pb + 6)) {
            unsigned char* ws = args.ws; LAUNDER(ws); const Ctx c = make_ctx();
            pg8::Gemm g{(const bf16_t*)(ws + WS_H1B), (const bf16_t*)(ws + WT_WQ + (size_t)layer * 4 * MiB), NT, PEER_QW, DM};
            pg8::StaticOrder S; S.init(NT, PEER_QW, c.nblk, c.bid);
            pg8::EpiStoreBf16 E{(bf16_t*)(ws + WS_QKV), PEER_QW, 1.f, 1.f};
            pg8::gemm_phase<pg8::EpiStoreBf16, pg8::StaticOrder, true, true>(GEMM_LDS, g, S, E);
        }
        SEAM(pb + 6);
        if (IN(pb + 7)) {
            unsigned char* ws = args.ws; LAUNDER(ws); const Ctx c = make_ctx();
            peer_route_phase(c, (const bf16_t*)(ws + WS_QKV), (const bf16_t*)(ws + WS_SKB) + (size_t)layer * 16 * 128 * 128, (int*)(ws + WS_EIDX), (float*)(ws + WS_COEF));
        }
        SEAM(pb + 7);
        if (IN(pb + 8)) {
            unsigned char* ws = args.ws; LAUNDER(ws); const Ctx c = make_ctx();
            peer_u_phase(c, (const bf16_t*)(ws + WS_H1B), (const int*)(ws + WS_EIDX), (float*)(ws + WS_COEF), (const bf16_t*)(ws + WS_UB) + (size_t)layer * 16384 * DM);
        }
        SEAM(pb + 8);
        if (IN(pb + 9)) {
            unsigned char* ws = args.ws; LAUNDER(ws); const Ctx c = make_ctx();
            peer_v_phase(c, (const int*)(ws + WS_EIDX), (const float*)(ws + WS_COEF), (const bf16_t*)(ws + WS_VB) + (size_t)layer * 16384 * DM, (float*)(ws + WS_MIX));
        }
        SEAM(pb + 9);
        if (IN(pb + 10)) {
            unsigned char* ws = args.ws; LAUNDER(ws); const Ctx c = make_ctx();
            float* hout = layer == 0 ? (float*)nullptr : (float*)launder_ptr((unsigned char*)args.out);
            bf16_t* houtb = layer == 0 ? (bf16_t*)(ws + WS_ACTIN) : (bf16_t*)nullptr;
            ln_rows(c, (const float*)nullptr, (const bf16_t*)(ws + WS_H1B), (const float*)(ws + WS_MIX), PIN(13) + (size_t)(layer * 2 + 1) * DM, PIN(14) + (size_t)(layer * 2 + 1) * DM, hout, houtb);
        }
        SEAM(pb + 10);
    }
}

extern "C" void kernel_launch(void* const* d_in, const int* in_sizes, int n_in, void* d_out, int out_size, void* d_ws, size_t ws_size, hipStream_t stream) {
    (void)in_sizes; (void)n_in; (void)out_size;
    static int grid = 0;
    if (!grid) {
        int dev = 0, cus = 0, per_cu = 0;
        (void)hipGetDevice(&dev);
        (void)hipDeviceGetAttribute(&cus, hipDeviceAttributeMultiprocessorCount, dev);
        (void)hipFuncSetAttribute((const void*)fwd, hipFuncAttributeMaxDynamicSharedMemorySize, LDS_BYTES);
        (void)hipOccupancyMaxActiveBlocksPerMultiprocessor(&per_cu, fwd, NTHREADS, LDS_BYTES);
        if (per_cu < 1) fprintf(stderr, "occupancy query says %d blocks per CU\n", per_cu);
        grid = cus;
        if (ws_size < WS_END) fprintf(stderr, "workspace too small: %zu < %zu\n", ws_size, (size_t)WS_END);
    }
    (void)hipMemsetAsync((unsigned char*)d_ws + WS_CTL, 0, 1 * MiB, stream);
    Args a{};
    for (int i = 0; i < 15; ++i) a.in[i] = (const float*)d_in[i];
    a.out = (float*)d_out; a.ws = (unsigned char*)d_ws;
    a.ph_lo = 0; a.ph_hi = NPHASE;
    hipLaunchKernelGGL(fwd, dim3(grid), dim3(NTHREADS), LDS_BYTES, stream, a);
}
```

```cpp
#include <hip/hip_runtime.h>
#include <cstdio>
#include <cstdint>
#include <cmath>

constexpr int BATCH = 4, SEQ = 4096, DM = 1024, NT = BATCH * SEQ;
constexpr int NH = 8, HD = 64;
constexpr int QKV_W = 3072, CD_IN = 3080;
constexpr int PEER_QW = 2048;
constexpr float DN_ALPHA = 1.4142135623730951f;
constexpr float LN_EPS = 1e-5f;
constexpr int NTHREADS = 512, NWAVES = 8;
typedef unsigned short bf16_t;

constexpr size_t MiB = 1u << 20;
constexpr size_t WS_CTL = 0;
constexpr size_t WS_WT = 1 * MiB;
constexpr size_t WT_ABIN = WS_WT, WT_ABOUT = WS_WT + 6 * MiB, WT_CDIN = WS_WT + 8 * MiB, WT_CDOUT = WS_WT + 14 * MiB, WT_WQ = WS_WT + 16 * MiB;
constexpr size_t WS_ACTIN = 25 * MiB;
constexpr size_t WS_ATTB = 57 * MiB;
constexpr size_t WS_H1B = 89 * MiB;
constexpr size_t WS_QKV = 121 * MiB;
constexpr size_t WS_MIX = 217 * MiB;
constexpr size_t WS_EIDX = 281 * MiB;
constexpr size_t WS_COEF = 289 * MiB;
constexpr size_t WS_F = 297 * MiB;
constexpr size_t WS_FG = 298 * MiB;
constexpr size_t WS_U8 = 299 * MiB;
constexpr size_t WS_V8 = 331 * MiB;
constexpr size_t WS_RS = 363 * MiB;
constexpr size_t WS_SKB = 364 * MiB;
constexpr size_t WS_GATE = 365 * MiB;
constexpr size_t WS_END = 373 * MiB;
constexpr int LDS_BYTES = 147456;
constexpr int RING_OFF = 0, MISC_OFF = 131072;

#define XB_TMO      128
#define XB_XCNT(j)  (256  + 64 * (j))
#define XB_XSUB(j)  (1280 + 64 * (j))
#define XB_XGEN(j)  (2304 + 64 * (j))
#define XB_TOP      3328
#define XB_TOPGEN   3392
#define XCD_BAR_WORDS 3456
#define XB_SPIN_CAP (1u << 18)
#define LAS __attribute__((address_space(3)))

__device__ __forceinline__ unsigned xb_ld(unsigned* p)              { return __hip_atomic_load(p, __ATOMIC_RELAXED, __HIP_MEMORY_SCOPE_AGENT); }
__device__ __forceinline__ unsigned xb_add(unsigned* p, unsigned v) { return __hip_atomic_fetch_add(p, v, __ATOMIC_RELAXED, __HIP_MEMORY_SCOPE_AGENT); }
__device__ __forceinline__ unsigned xb_xcc_id() { return (unsigned)__builtin_amdgcn_s_getreg((3 << 11) | 20) & 0xFu; }
#define XB_SPIN(cond, bar) do { unsigned _sp = 0; while (cond) { __builtin_amdgcn_s_sleep(1); \
    if ((++_sp & 255u) == 0u) { if (xb_ld(&(bar)[XB_TMO])) break; if (_sp > XB_SPIN_CAP) { atomicAdd(&(bar)[XB_TMO], 1u); break; } } } } while (0)

struct XcdBarrier {
    unsigned* bar; unsigned x;
    volatile LAS unsigned* st;
};
__device__ __forceinline__ XcdBarrier xcd_barrier_post(unsigned* bar, volatile LAS unsigned* st) {
    XcdBarrier b; b.bar = bar; b.x = xb_xcc_id(); b.st = st;
    if (threadIdx.x == 0) (void)xb_add(&bar[XB_XCNT(b.x)], 1u);
    return b;
}
__device__ __forceinline__ void xcd_barrier_complete(unsigned* bar, unsigned x, unsigned& nloc, unsigned& nx) {
    const unsigned G = gridDim.x * gridDim.y * gridDim.z;
    unsigned sum, cnt, mine, sp = 0u;
    for (;;) {
        sum = 0u; cnt = 0u; mine = 0u;
#pragma unroll
        for (unsigned j = 0; j < 16; ++j) { const unsigned c = xb_ld(&bar[XB_XCNT(j)]); sum += c; cnt += (c > 0u) ? 1u : 0u; mine = (j == x) ? c : mine; }
        if (sum == G) break;
        __builtin_amdgcn_s_sleep(1);
        if ((++sp & 255u) == 0u) { if (xb_ld(&bar[XB_TMO])) break; if (sp > XB_SPIN_CAP) { atomicAdd(&bar[XB_TMO], 1u); break; } }
    }
    nloc = mine > 0u ? mine : 1u; nx = cnt > 0u ? cnt : 1u;
}
__device__ __forceinline__ void xcd_barrier(const XcdBarrier& b) {
    asm volatile("s_waitcnt vmcnt(0)" ::: "memory");
    __syncthreads();
    if (threadIdx.x == 0) {
        unsigned* bar = b.bar;
        __builtin_amdgcn_s_waitcnt(0);
        unsigned nloc = b.st[0], nx = b.st[1];
        if (nloc == 0u) { xcd_barrier_complete(bar, b.x, nloc, nx); b.st[0] = nloc; b.st[1] = nx; }
        const unsigned old = xb_add(&bar[XB_XSUB(b.x)], 1u);
        const unsigned gen = old / nloc;
        if (old + 1u == (gen + 1u) * nloc) {
            __builtin_amdgcn_fence(__ATOMIC_RELEASE, "agent");
            asm volatile("s_waitcnt vmcnt(0)" ::: "memory");
            const unsigned og = xb_add(&bar[XB_TOP], 1u);
            const unsigned tg = og / nx;
            if (og + 1u == (tg + 1u) * nx) xb_add(&bar[XB_TOPGEN], 1u);
            else XB_SPIN(xb_ld(&bar[XB_TOPGEN]) == tg, bar);
            __builtin_amdgcn_fence(__ATOMIC_ACQUIRE, "agent");
            xb_add(&bar[XB_XGEN(b.x)], 1u);
            asm volatile("s_waitcnt vmcnt(0)" ::: "memory");
        } else {
            XB_SPIN(xb_ld(&bar[XB_XGEN(b.x)]) == gen, bar);
            __builtin_amdgcn_fence(__ATOMIC_ACQUIRE, "agent");
            asm volatile("s_waitcnt vmcnt(0)" ::: "memory");
        }
    }
    __syncthreads();
}

struct Args {
    const float* in[15];
    float* out;
    unsigned char* ws;
    int ph_lo, ph_hi;
};
struct Ctx {
    int tid, lane, wave, gwave, nwaves, bid, nblk;
    float* lds;
};
extern __shared__ __attribute__((aligned(16))) unsigned char dyn_lds[];
__device__ __forceinline__ Ctx make_ctx() {
    int t = threadIdx.x, b = blockIdx.x, g = gridDim.x;
    asm volatile("" : "+v"(t));
    asm volatile("" : "+s"(b), "+s"(g));
    Ctx c; c.tid = t; c.lane = t & 63; c.wave = t >> 6; c.bid = b; c.nblk = g;
    c.gwave = b * NWAVES + c.wave; c.nwaves = g * NWAVES; c.lds = (float*)(dyn_lds + RING_OFF);
    return c;
}
__device__ __forceinline__ unsigned char* launder_ptr(unsigned char* p) {
    unsigned lo = __builtin_amdgcn_readfirstlane((unsigned)(uintptr_t)p), hi = __builtin_amdgcn_readfirstlane((unsigned)((uintptr_t)p >> 32));
    asm volatile("" : "+s"(lo), "+s"(hi));
    return (unsigned char*)(((uintptr_t)hi << 32) | (uintptr_t)lo);
}
__device__ __forceinline__ float wave_sum(float v) {
#pragma unroll
    for (int o = 32; o >= 1; o >>= 1) v += __shfl_xor(v, o);
    return v;
}
__device__ __forceinline__ float log_sigmoid(float z) { return fminf(z, 0.f) - log1pf(expf(-fabsf(z))); }
__device__ __forceinline__ int t5_bucket(int n) {
    if (n < 16) return n;
    int large = 16 + (int)(logf((float)n / 16.f) / 2.0794415416798357f * 16.f);
    return large < 31 ? large : 31;
}
__device__ __forceinline__ float bf2f(bf16_t v) { return __builtin_bit_cast(float, (unsigned)v << 16); }
__device__ __forceinline__ unsigned f2bf(float f) { unsigned u = __builtin_bit_cast(unsigned, f); return (u + 0x7fffu + ((u >> 16) & 1u)) >> 16; }
__device__ __forceinline__ unsigned pk2(float lo, float hi) { return f2bf(lo) | (f2bf(hi) << 16); }

namespace pg8 {
#define PG8_LAS __attribute__((address_space(3)))
typedef unsigned short bf16_t;
typedef short bf16x8 __attribute__((ext_vector_type(8)));
typedef float f32x4 __attribute__((ext_vector_type(4)));
typedef unsigned u32x4 __attribute__((ext_vector_type(4)));
constexpr int BM = 256, BK = 64, HALF = 128, HTB = HALF * BK * 2  , STAGE_BYTES = 8 * HTB, NXCD = 8, WGM = 8;

__host__ __device__ __forceinline__ int lds_byte(int r, int c) { const int st = (r >> 4) * 2 + (c >> 5), rr = r & 15, cc = c & 31, ob = rr * 64 + cc * 2; return st * 1024 + (ob ^ (((ob >> 9) & 1) << 5)); }
__host__ __device__ __forceinline__ void stage_rc(int b, int& R, int& C) { const int st = b / 1024, sb = b % 1024, swz = sb ^ (((sb >> 9) & 1) << 5); R = (st >> 1) * 16 + swz / 64; C = (st & 1) * 32 + (swz % 64) / 2; }
__host__ __device__ __forceinline__ int perm32(int rho) { const int n = rho >> 4, i = rho & 15; return 8 * (i >> 2) + 4 * n + (i & 3); }

struct Unit { int pm, pn; };
struct Gemm { const bf16_t* A; const bf16_t* Bt; int M, N, K; };

struct StaticOrder {
    int nM, nN, nwg, G, c;
    __host__ __device__ void init(int M, int N, int G_, int c_) { nM = M / BM; nN = N / BM; nwg = nM * nN; G = G_; c = c_; }
    __host__ __device__ bool next(int i, Unit& u) const {
        const long L = (long)i * G + c; if (L >= nwg) return false;
        int wgid = (int)L; { const int q = nwg / NXCD, r = nwg % NXCD, xcd = wgid % NXCD, off = wgid / NXCD; wgid = (xcd < r ? xcd * (q + 1) : r * (q + 1) + (xcd - r) * q) + off; }
        const int nig = WGM * nN, gid = wgid / nig, fm = gid * WGM, gsz = (nM - fm) < WGM ? (nM - fm) : WGM;
        u.pm = fm + ((wgid % nig) % gsz); u.pn = (wgid % nig) / gsz; return true;
    }
    __device__ __forceinline__ void a_ready(const Unit&) const {}
    __device__ __forceinline__ void done(const Unit&) const {}
};

__device__ __forceinline__ unsigned cvt_pk_bf16(float lo, float hi) { unsigned r; asm volatile("v_cvt_pk_bf16_f32 %0, %1, %2" : "=v"(r) : "v"(lo), "v"(hi)); return r; }
template <class Epi, class Sched, bool ALIGN_EPI = false, bool SP2 = false>
__device__ __forceinline__ void gemm_phase(PG8_LAS unsigned char* lds, const Gemm g, const Sched& S, const Epi& E) {
    const int tid = threadIdx.x, wid = __builtin_amdgcn_readfirstlane(tid >> 6), lane = tid & 63, wr = wid >> 2, wc = wid & 3, fr = lane & 15, fq = lane >> 4;
    const int K = g.K, nt = K / BK;
    unsigned voffA[2], voffB[2];
#pragma unroll
    for (int i = 0; i < 2; ++i) { int R, C; stage_rc(tid * 16 + i * 8192, R, C); const int Rb = Epi::PERM ? ((R & ~31) + perm32(R & 31)) : R;
        voffA[i] = (unsigned)(R * K + C) * 2u; voffB[i] = (unsigned)(Rb * K + C) * 2u; }
    const size_t kstep = (size_t)(BK * 2);
    const size_t hstep = (size_t)HALF * K * 2;
    const size_t tstep = 2 * hstep;
    const unsigned ldsw = (unsigned)wid * 1024u;
    const int aoff = lds_byte(wr * 64 + fr, fq * 8), boff = lds_byte(wc * 32 + fr, fq * 8);
#define PG8_SA(b, h) (((b) * 2 + (h)) * HTB)
#define PG8_SB(b, h) ((4 + (b) * 2 + (h)) * HTB)
#define PG8_STAGE(bufoff, gbase, voff) do { _Pragma("unroll") for (int _i = 0; _i < 2; ++_i) \
        __builtin_amdgcn_global_load_lds((const unsigned*)((const char*)(gbase) + (voff)[_i]), (PG8_LAS unsigned*)(lds + (bufoff) + ldsw + _i * 8192), 16, 0, 0); } while (0)
#define PG8_LDA(dst, b, h) do { _Pragma("unroll") for (int m = 0; m < 4; ++m) _Pragma("unroll") for (int k = 0; k < 2; ++k) dst[m][k] = *(const PG8_LAS bf16x8*)(lds + PG8_SA(b, h) + aoff + m * 2048 + k * 1024); } while (0)
#define PG8_LDB(dst, b, h) do { _Pragma("unroll") for (int n = 0; n < 2; ++n) _Pragma("unroll") for (int k = 0; k < 2; ++k) dst[n][k] = *(const PG8_LAS bf16x8*)(lds + PG8_SB(b, h) + boff + n * 2048 + k * 1024); } while (0)
#define PG8_MMA(ai, bj, At, Bt) do { __builtin_amdgcn_s_setprio(1); _Pragma("unroll") for (int m = 0; m < 4; ++m) _Pragma("unroll") for (int n = 0; n < 2; ++n) _Pragma("unroll") for (int k = 0; k < 2; ++k) \
        acc[ai][bj][m][n] = __builtin_amdgcn_mfma_f32_16x16x32_bf16(Bt[n][k], At[m][k], acc[ai][bj][m][n], 0, 0, 0); __builtin_amdgcn_s_setprio(0); } while (0)
#define PG8_WAIT_V(n) asm volatile("s_waitcnt vmcnt(" #n ")" ::: "memory")
#define PG8_WAIT_L(n) asm volatile("s_waitcnt lgkmcnt(" #n ")" ::: "memory")
#define PG8_BAR __builtin_amdgcn_s_barrier()
#define PG8_SCHED __builtin_amdgcn_sched_barrier(0)
    Unit cur, nxt; int ui = 0;
    if (!S.next(0, cur)) return;
    f32x4 acc[2][2][4][2];
#pragma unroll
    for (int a = 0; a < 2; ++a)
#pragma unroll
        for (int b = 0; b < 2; ++b)
#pragma unroll
            for (int m = 0; m < 4; ++m)
#pragma unroll
                for (int n = 0; n < 2; ++n) acc[a][b][m][n] = (f32x4){0.f, 0.f, 0.f, 0.f};
    bf16x8 At[4][2], B0[2][2], B1[2][2];
    const char* cA = (const char*)g.A + (size_t)cur.pm * tstep; const char* cB = (const char*)g.Bt + (size_t)cur.pn * tstep;
    S.a_ready(cur);
    if constexpr (SP2) {
        PG8_STAGE(PG8_SB(0, 0), cB, voffB); PG8_STAGE(PG8_SB(0, 1), cB + hstep, voffB); PG8_STAGE(PG8_SA(0, 0), cA, voffA); PG8_STAGE(PG8_SA(0, 1), cA + hstep, voffA);
        if (wr == 1) PG8_BAR;
        PG8_WAIT_V(2); PG8_BAR;
        PG8_STAGE(PG8_SB(1, 0), cB + kstep, voffB); PG8_STAGE(PG8_SA(1, 0), cA + kstep, voffA); PG8_STAGE(PG8_SB(1, 1), cB + hstep + kstep, voffB);
        PG8_WAIT_V(6); PG8_BAR;
    } else {
        PG8_STAGE(PG8_SB(0, 0), cB, voffB); PG8_STAGE(PG8_SA(0, 0), cA, voffA); PG8_STAGE(PG8_SB(0, 1), cB + hstep, voffB); PG8_STAGE(PG8_SA(0, 1), cA + hstep, voffA);
        if (wr == 1) PG8_BAR;
        PG8_WAIT_V(4); PG8_BAR;
        PG8_STAGE(PG8_SB(1, 0), cB + kstep, voffB); PG8_STAGE(PG8_SA(1, 0), cA + kstep, voffA); PG8_STAGE(PG8_SB(1, 1), cB + hstep + kstep, voffB);
        PG8_WAIT_V(6); PG8_BAR;
    }
    for (;;) {
        const bool has_next = S.next(ui + 1, nxt);
        const char* nA = has_next ? (const char*)g.A + (size_t)nxt.pm * tstep : cA; const char* nB = has_next ? (const char*)g.Bt + (size_t)nxt.pn * tstep : cB;
        for (int t = 0; t < nt; t += 2) {
            const bool last = (t == nt - 2);
            const char* a1 = cA + (size_t)(t + 1) * kstep;
            const char* a2 = last ? nA : cA + (size_t)(t + 2) * kstep; const char* b2 = last ? nB : cB + (size_t)(t + 2) * kstep;
            const char* a3 = a2 + kstep; const char* b3 = b2 + kstep;
            if (last && has_next) S.a_ready(nxt);
            if constexpr (SP2) {
            PG8_LDB(B0, 0, 0); PG8_LDB(B1, 0, 1); PG8_SCHED; PG8_LDA(At, 0, 0); PG8_STAGE(PG8_SA(1, 1), a1 + hstep, voffA);
            PG8_WAIT_V(8); PG8_WAIT_L(0); PG8_BAR; PG8_MMA(0, 0, At, B0); PG8_MMA(0, 1, At, B1); PG8_BAR; PG8_SCHED;
            PG8_LDA(At, 0, 1); PG8_STAGE(PG8_SB(0, 0), b2, voffB); PG8_STAGE(PG8_SB(0, 1), b2 + hstep, voffB); PG8_STAGE(PG8_SA(0, 0), a2, voffA);
            PG8_WAIT_V(8); PG8_WAIT_L(0); PG8_BAR; PG8_MMA(1, 0, At, B0); PG8_MMA(1, 1, At, B1); PG8_BAR; PG8_SCHED;
            PG8_LDB(B0, 1, 0); PG8_LDB(B1, 1, 1); PG8_SCHED; PG8_LDA(At, 1, 0); PG8_STAGE(PG8_SA(0, 1), a2 + hstep, voffA);
            PG8_WAIT_V(8); PG8_WAIT_L(0); PG8_BAR; PG8_MMA(0, 0, At, B0); PG8_MMA(0, 1, At, B1); PG8_BAR; PG8_SCHED;
            PG8_LDA(At, 1, 1); PG8_STAGE(PG8_SB(1, 0), b3, voffB); PG8_STAGE(PG8_SB(1, 1), b3 + hstep, voffB); PG8_STAGE(PG8_SA(1, 0), a3, voffA);
            PG8_WAIT_V(8); PG8_WAIT_L(0); PG8_BAR; PG8_MMA(1, 0, At, B0); PG8_MMA(1, 1, At, B1); PG8_BAR; PG8_SCHED;
            } else {
            PG8_LDB(B0, 0, 0); PG8_SCHED; PG8_LDA(At, 0, 0); PG8_STAGE(PG8_SA(1, 1), a1 + hstep, voffA);
            PG8_WAIT_L(8); PG8_BAR; PG8_WAIT_L(0); PG8_MMA(0, 0, At, B0); PG8_BAR; PG8_SCHED;
            PG8_LDB(B1, 0, 1); PG8_STAGE(PG8_SB(0, 0), b2, voffB);
            PG8_BAR; PG8_WAIT_L(0); PG8_MMA(0, 1, At, B1); PG8_BAR;
            PG8_LDA(At, 0, 1); PG8_STAGE(PG8_SA(0, 0), a2, voffA);
            PG8_BAR; PG8_WAIT_L(0); PG8_MMA(1, 0, At, B0); PG8_BAR; PG8_SCHED;
            PG8_STAGE(PG8_SB(0, 1), b2 + hstep, voffB);
            PG8_WAIT_V(6); PG8_BAR; PG8_MMA(1, 1, At, B1); PG8_BAR;
            PG8_LDB(B0, 1, 0); PG8_SCHED; PG8_LDA(At, 1, 0); PG8_STAGE(PG8_SA(0, 1), a2 + hstep, voffA);
            PG8_WAIT_L(8); PG8_BAR; PG8_WAIT_L(0); PG8_MMA(0, 0, At, B0); PG8_BAR; PG8_SCHED;
            PG8_LDB(B1, 1, 1); PG8_STAGE(PG8_SB(1, 0), b3, voffB);
            PG8_BAR; PG8_WAIT_L(0); PG8_MMA(0, 1, At, B1); PG8_BAR;
            PG8_LDA(At, 1, 1); PG8_STAGE(PG8_SA(1, 0), a3, voffA);
            PG8_BAR; PG8_WAIT_L(0); PG8_MMA(1, 0, At, B0); PG8_BAR; PG8_SCHED;
            PG8_STAGE(PG8_SB(1, 1), b3 + hstep, voffB);
            PG8_WAIT_V(6); PG8_BAR; PG8_MMA(1, 1, At, B1); PG8_BAR;
            }
        }
        if constexpr (ALIGN_EPI) { if (wr == 0) PG8_BAR; }
        if constexpr (!Epi::AFTER_DRAIN) { E(acc, cur, wr, wc, fr, fq); S.done(cur); }
        if (!has_next) break;
#pragma unroll
        for (int a = 0; a < 2; ++a)
#pragma unroll
            for (int b = 0; b < 2; ++b)
#pragma unroll
                for (int m = 0; m < 4; ++m)
#pragma unroll
                    for (int n = 0; n < 2; ++n) acc[a][b][m][n] = (f32x4){0.f, 0.f, 0.f, 0.f};
        cur = nxt; cA = nA; cB = nB; ++ui;
        if constexpr (ALIGN_EPI) { if (wr == 1) PG8_BAR; }
    }
    PG8_WAIT_V(0);
    if constexpr (!ALIGN_EPI) { if (wr == 0) PG8_BAR; }
    PG8_BAR;
    if constexpr (Epi::AFTER_DRAIN) { E.fused(acc, cur, wr, wc, fr, fq, lds, wid, lane); S.done(cur); }
#undef PG8_SA
#undef PG8_SB
#undef PG8_STAGE
#undef PG8_LDA
#undef PG8_LDB
#undef PG8_MMA
#undef PG8_WAIT_V
#undef PG8_WAIT_L
#undef PG8_BAR
#undef PG8_SCHED
}
}

namespace pg8 {
struct EpiStoreBf16 {
    static constexpr bool PERM = true, AFTER_DRAIN = false;
    bf16_t* O; int ldc; float s01, s67;
    __device__ __forceinline__ void operator()(const f32x4 (&acc)[2][2][4][2], const Unit& u, int wr, int wc, int fr, int fq) const {
        const int row0 = u.pm * BM + wr * 64 + fr, col0 = u.pn * BM + wc * 32 + 8 * fq;
        const float sc = u.pn < 2 ? s01 : ((u.pn == 6 || u.pn == 7) ? s67 : 1.f);
#pragma unroll
        for (int ai = 0; ai < 2; ++ai)
#pragma unroll
            for (int m = 0; m < 4; ++m) { bf16_t* rowp = O + (size_t)(row0 + ai * HALF + m * 16) * ldc + col0;
#pragma unroll
                for (int bj = 0; bj < 2; ++bj) { const f32x4 v0 = acc[ai][bj][m][0] * sc, v1 = acc[ai][bj][m][1] * sc;
                    u32x4 w; w.x = cvt_pk_bf16(v0[0], v0[1]); w.y = cvt_pk_bf16(v0[2], v0[3]); w.z = cvt_pk_bf16(v1[0], v1[1]); w.w = cvt_pk_bf16(v1[2], v1[3]);
                    *(u32x4*)(rowp + bj * HALF) = w; } }
    }
};
struct EpiStoreF32 {
    static constexpr bool PERM = true, AFTER_DRAIN = false;
    float* C; int ldc;
    __device__ __forceinline__ void operator()(const f32x4 (&acc)[2][2][4][2], const Unit& u, int wr, int wc, int fr, int fq) const {
        const int row0 = u.pm * BM + wr * 64 + fr, col0 = u.pn * BM + wc * 32 + 8 * fq;
#pragma unroll
        for (int ai = 0; ai < 2; ++ai)
#pragma unroll
            for (int m = 0; m < 4; ++m) { float* rowp = C + (size_t)(row0 + ai * HALF + m * 16) * ldc + col0;
#pragma unroll
                for (int bj = 0; bj < 2; ++bj) { *(f32x4*)(rowp + bj * HALF) = acc[ai][bj][m][0]; *(f32x4*)(rowp + bj * HALF + 4) = acc[ai][bj][m][1]; } }
    }
};
}

__device__ __forceinline__ void transpose_item(const float* W, int ldw, int K, int ncols, bf16_t* WT, float* scr, int item, int lane) {
    const int nblk = ncols / 32, kb = item / nblk, nb = item % nblk, k0 = 64 * kb, n0 = 32 * nb;
#pragma unroll 8
    for (int i = 0; i < 32; ++i) { const int kk = 2 * i + (lane >> 5); scr[kk * 33 + (lane & 31)] = W[(size_t)(k0 + kk) * ldw + n0 + (lane & 31)]; }
    asm volatile("s_waitcnt lgkmcnt(0)" ::: "memory");
    const int c = lane & 7;
#pragma unroll
    for (int j = 0; j < 4; ++j) { const int n = (lane >> 3) + 8 * j; const float* s = scr + (8 * c) * 33 + n;
        uint4 o; o.x = pk2(s[0 * 33], s[1 * 33]); o.y = pk2(s[2 * 33], s[3 * 33]); o.z = pk2(s[4 * 33], s[5 * 33]); o.w = pk2(s[6 * 33], s[7 * 33]);
        *(uint4*)(WT + (size_t)(n0 + n) * K + k0 + 8 * c) = o; }
    asm volatile("s_waitcnt lgkmcnt(0)" ::: "memory");
}
__device__ __forceinline__ void cvt_rows_bf16(const Ctx& c, const float* src, bf16_t* dst, size_t n8) {
    for (size_t i = (size_t)c.gwave * 64 + c.lane; i < n8; i += (size_t)c.nwaves * 64) {
        const float4 a = *(const float4*)(src + i * 8), b = *(const float4*)(src + i * 8 + 4);
        uint4 o; o.x = pk2(a.x, a.y); o.y = pk2(a.z, a.w); o.z = pk2(b.x, b.y); o.w = pk2(b.z, b.w);
        *(uint4*)(dst + i * 8) = o;
    }
}

template <int DQ, class BiasF>
__device__ __forceinline__ void causal_softmax_row(const float (&q)[DQ], const bf16_t* kbase, const bf16_t* vbase, int ld, int t, int smax, float scale, BiasF biasf, float (&O)[64]) {
    float m = -INFINITY;
    for (int s = 0; s <= smax; ++s) {
        const bf16_t* kr = kbase + (size_t)s * ld;
        float d = 0.f;
#pragma unroll
        for (int i = 0; i < DQ; ++i) d = fmaf(q[i], bf2f(kr[i]), d);
        const float lg = d * scale + biasf(s);
        m = (s <= t) ? fmaxf(m, lg) : m;
    }
    float l = 0.f;
#pragma unroll
    for (int i = 0; i < 64; ++i) O[i] = 0.f;
    for (int s = 0; s <= smax; ++s) {
        const bf16_t* kr = kbase + (size_t)s * ld;
        const bf16_t* vr = vbase + (size_t)s * ld;
        float d = 0.f;
#pragma unroll
        for (int i = 0; i < DQ; ++i) d = fmaf(q[i], bf2f(kr[i]), d);
        const float lg = d * scale + biasf(s);
        const float p = (s <= t) ? expf(lg - m) : 0.f;
        l += p;
#pragma unroll
        for (int i = 0; i < 64; ++i) O[i] = fmaf(p, bf2f(vr[i]), O[i]);
    }
    const float inv = 1.f / l;
#pragma unroll
    for (int i = 0; i < 64; ++i) O[i] *= inv;
}
__device__ __forceinline__ void store_row64_bf16(bf16_t* orow, const float (&v)[64]) {
#pragma unroll
    for (int i = 0; i < 64; i += 8) { uint4 o; o.x = pk2(v[i], v[i + 1]); o.y = pk2(v[i + 2], v[i + 3]); o.z = pk2(v[i + 4], v[i + 5]); o.w = pk2(v[i + 6], v[i + 7]); *(uint4*)(orow + i) = o; }
}

__device__ __forceinline__ void fg_phase(const Ctx& c, const bf16_t* hin, const float* cd_in, float* fg) {
    for (int t = c.gwave; t < NT; t += c.nwaves) {
        float acc[8];
#pragma unroll
        for (int j = 0; j < 8; ++j) acc[j] = 0.f;
        for (int r = 0; r < 16; ++r) {
            const int d = r * 64 + c.lane;
            const float xv = bf2f(hin[(size_t)t * DM + d]);
            const float4 w0 = *(const float4*)(cd_in + (size_t)d * CD_IN + 3072), w1 = *(const float4*)(cd_in + (size_t)d * CD_IN + 3076);
            acc[0] = fmaf(xv, w0.x, acc[0]); acc[1] = fmaf(xv, w0.y, acc[1]); acc[2] = fmaf(xv, w0.z, acc[2]); acc[3] = fmaf(xv, w0.w, acc[3]);
            acc[4] = fmaf(xv, w1.x, acc[4]); acc[5] = fmaf(xv, w1.y, acc[5]); acc[6] = fmaf(xv, w1.z, acc[6]); acc[7] = fmaf(xv, w1.w, acc[7]);
        }
#pragma unroll
        for (int j = 0; j < 8; ++j) acc[j] = wave_sum(acc[j]);
        if (c.lane == 0) { *(float4*)(fg + (size_t)t * 8) = make_float4(acc[0], acc[1], acc[2], acc[3]); *(float4*)(fg + (size_t)t * 8 + 4) = make_float4(acc[4], acc[5], acc[6], acc[7]); }
    }
}
__device__ __forceinline__ void fscan_naive(const Ctx& c, const float* fg, float* F, const float* bf) {
    for (int task = c.gwave; task < 32; task += c.nwaves) {
        const int b = task >> 3, h = task & 7;
        const int lane = c.lane;
        float v[64]; float tot = 0.f;
#pragma unroll
        for (int i = 0; i < 64; ++i) { const int s = lane * 64 + i; v[i] = log_sigmoid(fg[((size_t)b * SEQ + s) * 8 + h] + bf[h]); tot += v[i]; }
        float incl = tot;
#pragma unroll
        for (int o = 1; o < 64; o <<= 1) { const float n = __shfl_up(incl, o); if (lane >= o) incl += n; }
        float run = incl - tot;
#pragma unroll
        for (int i = 0; i < 64; ++i) { run += v[i]; F[(size_t)task * SEQ + lane * 64 + i] = run; }
    }
}

namespace att {
typedef short bf16x8 __attribute__((ext_vector_type(8)));
typedef short s16x4 __attribute__((ext_vector_type(4)));
typedef float f32x16 __attribute__((ext_vector_type(16)));
typedef float f32x4 __attribute__((ext_vector_type(4)));
typedef short v4i16_t __attribute__((ext_vector_type(4)));
constexpr float LOG2E = 1.4426950408889634f;
constexpr float NEG = -1e30f;
constexpr int KBUF = 0, VBUF = 16384, FBUF = 32768, TBUF = 33792, CNT = 34816;

__device__ __forceinline__ int tile_off(int row, int ch) { return 1024 * (row >> 3) + 512 * (ch >> 2) + 64 * (row & 7) + 16 * ((ch & 3) ^ ((row >> 2) & 3)); }
__device__ __forceinline__ s16x4 vtr(const LAS unsigned char* p) { return __builtin_bit_cast(s16x4, __builtin_amdgcn_ds_read_tr16_b64_v4i16((LAS v4i16_t*)p)); }
typedef float f32x2_t __attribute__((ext_vector_type(2))); typedef __bf16 bf16x2_t __attribute__((ext_vector_type(2)));
__device__ __forceinline__ unsigned cvtpk(float lo, float hi) { f32x2_t v = {lo, hi}; bf16x2_t b = __builtin_convertvector(v, bf16x2_t); return __builtin_bit_cast(unsigned, b); }
__device__ __forceinline__ float xhalf(float v) { return __shfl_xor(v, 32); }
__device__ __forceinline__ int key_of(int i, int hh) { return 8 * (i >> 2) + 4 * hh + (i & 3); }

__device__ __forceinline__ bf16x8 pfrag(const f32x16& p, int ks2) {
    unsigned w[4];
#pragma unroll
    for (int j = 0; j < 4; ++j) w[j] = cvtpk(p[8 * ks2 + 2 * j], p[8 * ks2 + 2 * j + 1]);
    typedef unsigned u32x4 __attribute__((ext_vector_type(4)));
    u32x4 v = {w[0], w[1], w[2], w[3]};
    return __builtin_bit_cast(bf16x8, v);
}
__device__ __forceinline__ void pv_block(f32x16 (&O)[2], const LAS unsigned char* vbuf, int kb, const f32x16& p, int lane) {
    const int hh = lane >> 5, q_ = (lane & 15) >> 2, p_ = lane & 3, cg = (lane >> 4) & 1;
#pragma unroll
    for (int ks2 = 0; ks2 < 2; ++ks2) {
        const bf16x8 pb = pfrag(p, ks2);
#pragma unroll
        for (int db = 0; db < 2; ++db) {
            const int c0 = 32 * db + 16 * cg, ch = (c0 >> 3) + (p_ >> 1);
            const int r0 = 32 * kb + 16 * ks2 + 4 * hh;
            const s16x4 a0 = vtr(vbuf + tile_off(r0 + q_, ch) + 8 * (p_ & 1));
            const s16x4 a1 = vtr(vbuf + tile_off(r0 + 8 + q_, ch) + 8 * (p_ & 1));
            const bf16x8 a = {a0[0], a0[1], a0[2], a0[3], a1[0], a1[1], a1[2], a1[3]};
            O[db] = __builtin_amdgcn_mfma_f32_32x32x16_bf16(a, pb, O[db], 0, 0, 0);
        }
    }
}
template <int S0, int NS>
__device__ __forceinline__ f32x16 qk_block(const LAS unsigned char* kbuf, int kb, const bf16x8 (&Qf)[4], int lane) {
    const int r = lane & 31, hh = lane >> 5;
    f32x16 s = {0.f, 0.f, 0.f, 0.f, 0.f, 0.f, 0.f, 0.f, 0.f, 0.f, 0.f, 0.f, 0.f, 0.f, 0.f, 0.f};
#pragma unroll
    for (int ks = S0; ks < S0 + NS; ++ks) {
        const bf16x8 a = *(const LAS bf16x8*)(kbuf + tile_off(32 * kb + r, 2 * ks + hh));
        s = __builtin_amdgcn_mfma_f32_32x32x16_bf16(a, Qf[ks], s, 0, 0, 0);
    }
    return s;
}
__device__ __forceinline__ void softmax_step(f32x16& x, float& m, float& l, f32x16 (&O)[2]) {
    float mx = x[0];
#pragma unroll
    for (int i = 1; i < 16; ++i) mx = fmaxf(mx, x[i]);
    mx = fmaxf(mx, xhalf(mx));
    const float mn = fmaxf(m, mx);
    if (!__all(mn == m)) {
        const float alpha = __builtin_amdgcn_exp2f(m - mn);
        l *= alpha;
#pragma unroll
        for (int i = 0; i < 16; ++i) { O[0][i] *= alpha; O[1][i] *= alpha; }
        m = mn;
    }
    float ls = 0.f;
#pragma unroll
    for (int i = 0; i < 16; ++i) { x[i] = __builtin_amdgcn_exp2f(x[i] - m); ls += x[i]; }
    l += ls;
}
__device__ __forceinline__ void store_ot(bf16_t* orow, const f32x16 (&O)[2], int hh) {
#pragma unroll
    for (int db = 0; db < 2; ++db)
#pragma unroll
        for (int g = 0; g < 4; ++g) {
            const int d0 = 32 * db + 8 * g + 4 * hh;
            *(uint2*)(orow + d0) = make_uint2(cvtpk(O[db][4 * g], O[db][4 * g + 1]), cvtpk(O[db][4 * g + 2], O[db][4 * g + 3]));
        }
}

struct UnitArgs {
    const bf16_t* qkv;
    bf16_t* out;
    int qcol, kcol, vcol, ocol;
};

struct DilArgs { int dil, rho, pat; bf16_t* po; float* pml; };
template <int TYPE>
__device__ __forceinline__ void causal_unit(const UnitArgs& A, int b, int h, int qb, unsigned char* scratch, int tid,
                                            const float* t5  , float lam, const float* subg, const float* F  , const DilArgs DA = DilArgs{1, 0, 0, nullptr, nullptr}) {
    const LAS unsigned char* lds = (const LAS unsigned char*)scratch;
    LAS unsigned char* ldsw = (LAS unsigned char*)scratch;
    const int lane = tid & 63, w = tid >> 6, r = lane & 31, hh = lane >> 5;
    const int q0 = qb * 256 + 32 * w, tq = q0 + r;
    const size_t rowbase = (size_t)b * SEQ;
    const int ktmax = 4 * qb + 3, kdiag = 4 * qb + (w >> 1);
    const int ktmin = (TYPE == 2) ? (4 * qb - 2 > 0 ? 4 * qb - 2 : 0) : 0;
    const int rs = (TYPE == 2) ? DA.dil : 1, r0off = (TYPE == 2) ? DA.rho : 0;
    const int srow = tid >> 3, sch = tid & 7;
    const bf16_t* kg = A.qkv + (rowbase + r0off + (size_t)rs * srow) * QKV_W + A.kcol + h * 64 + sch * 8;
    const bf16_t* vg = A.qkv + (rowbase + r0off + (size_t)rs * srow) * QKV_W + A.vcol + h * 64 + sch * 8;
    const size_t tstep = (size_t)64 * rs * QKV_W;
    const int soff = tile_off(srow, sch);
    bf16x8 Qf[4];
    {
        const bf16_t* qr = A.qkv + (rowbase + r0off + (size_t)rs * tq) * QKV_W + A.qcol + h * 64 + 8 * hh;
#pragma unroll
        for (int s = 0; s < 4; ++s) Qf[s] = *(const bf16x8*)(qr + 16 * s);
    }
    __syncthreads();
    if ((TYPE == 0 || TYPE == 2) && tid < 128) {
        const float far = t5[31 * 8 + h];
        ((LAS float*)(ldsw + TBUF))[tid] = (t5[t5_bucket(tid) * 8 + h] - far) * LOG2E;
    }
    if (TYPE == 1 && tid == 0) *(LAS unsigned*)(ldsw + CNT) = 0u;
    typedef unsigned u32x4 __attribute__((ext_vector_type(4)));
    u32x4 kreg = *(const u32x4*)(kg + (size_t)ktmax * tstep), vreg = *(const u32x4*)(vg + (size_t)ktmax * tstep);
    float freg = 0.f;
    if (TYPE == 3 && tid < 64) freg = F[(size_t)(b * 8 + h) * SEQ + ktmax * 64 + tid] * LOG2E;
    *(LAS u32x4*)(ldsw + KBUF + soff) = kreg; *(LAS u32x4*)(ldsw + VBUF + soff) = vreg;
    if (TYPE == 3 && tid < 64) ((LAS float*)(ldsw + FBUF))[tid] = freg;
    __syncthreads();

    f32x16 O0[2], O1[2];
#pragma unroll
    for (int i = 0; i < 16; ++i) { O0[0][i] = 0.f; O0[1][i] = 0.f; O1[0][i] = 0.f; O1[1][i] = 0.f; }
    float m0 = NEG, l0 = 0.f, m1 = NEG, l1 = 0.f;
    float R = 0.f;
    bool wdone = false;
    float f2t = 0.f;
    if (TYPE == 3) f2t = F[(size_t)(b * 8 + h) * SEQ + tq] * LOG2E;

    for (int kt = ktmax, it = 0; kt >= ktmin; --kt, ++it) {
        const int cur = it & 1;
        if (kt > ktmin) {
            kreg = *(const u32x4*)(kg + (size_t)(kt - 1) * tstep); vreg = *(const u32x4*)(vg + (size_t)(kt - 1) * tstep);
            if (TYPE == 3 && tid < 64) freg = F[(size_t)(b * 8 + h) * SEQ + (kt - 1) * 64 + tid] * LOG2E;
        }
        const LAS unsigned char* kbuf = lds + KBUF + cur * 8192;
        const LAS unsigned char* vbuf = lds + VBUF + cur * 8192;
        if (kt <= kdiag && !wdone) {
#pragma unroll
            for (int kbi = 0; kbi < 2; ++kbi) {
                const int kb = 1 - kbi;
                const int key0 = kt * 64 + kb * 32;
                if (TYPE == 1 ? (key0 >= q0 + 31) : (key0 > q0 + 31)) continue;
                if (TYPE == 2 && key0 + 31 < q0 - 128) continue;
                const bool need_mask = (TYPE == 1) ? (key0 + 31 >= q0) : (key0 + 31 > q0);
                if (TYPE == 0) {
                    f32x16 x0 = qk_block<0, 2>(kbuf, kb, Qf, lane), x1 = qk_block<2, 2>(kbuf, kb, Qf, lane);
                    if (q0 - (key0 + 31) < 113) {
                        const LAS float* tb = (const LAS float*)(lds + TBUF);
#pragma unroll
                        for (int i = 0; i < 16; ++i) {
                            const int dist = tq - (key0 + key_of(i, hh));
                            const float bv = (dist >= 0 && dist < 128) ? tb[dist < 0 ? 0 : (dist > 127 ? 127 : dist)] : 0.f;
                            x0[i] = dist < 0 ? NEG : x0[i] + bv; x1[i] = dist < 0 ? NEG : x1[i] + bv;
                        }
                    }
                    softmax_step(x0, m0, l0, O0);
                    pv_block(O0, vbuf, kb, x0, lane);
                    softmax_step(x1, m1, l1, O1);
                    pv_block(O1, vbuf, kb, x1, lane);
                } else if (TYPE == 2) {
                    f32x16 x = qk_block<0, 4>(kbuf, kb, Qf, lane);
                    const LAS float* tb = (const LAS float*)(lds + TBUF);
#pragma unroll
                    for (int i = 0; i < 16; ++i) {
                        const int dist = tq - (key0 + key_of(i, hh));
                        int bi = dist * rs; bi = bi < 0 ? 0 : (bi > 127 ? 127 : bi);
                        x[i] = (dist >= 0 && dist <= 128) ? x[i] + tb[bi] : NEG;
                    }
                    softmax_step(x, m0, l0, O0);
                    pv_block(O0, vbuf, kb, x, lane);
                } else if (TYPE == 3) {
                    f32x16 x = qk_block<0, 4>(kbuf, kb, Qf, lane);
                    const LAS float* fb = (const LAS float*)(lds + FBUF + cur * 256);
#pragma unroll
                    for (int g = 0; g < 4; ++g) {
                        const f32x4 fv = *(const LAS f32x4*)(fb + 32 * kb + 8 * g + 4 * hh);
#pragma unroll
                        for (int j = 0; j < 4; ++j) x[4 * g + j] += f2t - fv[j];
                    }
                    if (need_mask) {
#pragma unroll
                        for (int i = 0; i < 16; ++i) x[i] = (key0 + key_of(i, hh) > tq) ? NEG : x[i];
                    }
                    softmax_step(x, m0, l0, O0);
                    pv_block(O0, vbuf, kb, x, lane);
                } else {
                    f32x16 z = qk_block<0, 4>(kbuf, kb, Qf, lane);
                    f32x16 lr;
#pragma unroll
                    for (int i = 0; i < 16; ++i) {
                        const float e = __builtin_amdgcn_exp2f(-fabsf(z[i]));
                        float v = -(fmaxf(z[i], 0.f) + __builtin_amdgcn_logf(1.f + e));
                        if (need_mask) v = (key0 + key_of(i, hh) >= tq) ? 0.f : v;
                        lr[i] = v;
                    }
                    float T[4], Tp[4], sfx[16];
#pragma unroll
                    for (int g = 0; g < 4; ++g) {
                        sfx[4 * g + 3] = 0.f; sfx[4 * g + 2] = lr[4 * g + 3]; sfx[4 * g + 1] = sfx[4 * g + 2] + lr[4 * g + 2]; sfx[4 * g] = sfx[4 * g + 1] + lr[4 * g + 1];
                        T[g] = sfx[4 * g] + lr[4 * g];
                        Tp[g] = xhalf(T[g]);
                    }
                    float SP[4];
                    SP[3] = 0.f; SP[2] = T[3] + Tp[3]; SP[1] = SP[2] + T[2] + Tp[2]; SP[0] = SP[1] + T[1] + Tp[1];
                    const float tot = SP[0] + T[0] + Tp[0];
                    const float msel = hh == 0 ? 1.f : 0.f;
#pragma unroll
                    for (int g = 0; g < 4; ++g) {
                        const float goff = R + SP[g] + msel * Tp[g];
#pragma unroll
                        for (int j = 0; j < 4; ++j) {
                            const int i = 4 * g + j;
                            float wv = __builtin_amdgcn_exp2f(lr[i] + z[i] + goff + sfx[i]);
                            if (need_mask) wv = (key0 + key_of(i, hh) >= tq) ? 0.f : wv;
                            z[i] = wv;
                        }
                    }
                    R += tot;
                    pv_block(O0, vbuf, kb, z, lane);
                }
            }
            if (TYPE == 1) {
                if (__all(R < -216.4f)) { wdone = true; if (lane == 0) (void)__hip_atomic_fetch_add((LAS unsigned*)(ldsw + CNT), 1u, __ATOMIC_RELAXED, __HIP_MEMORY_SCOPE_WORKGROUP); }
            }
        }
        if (kt > ktmin) {
            *(LAS u32x4*)(ldsw + KBUF + (cur ^ 1) * 8192 + soff) = kreg; *(LAS u32x4*)(ldsw + VBUF + (cur ^ 1) * 8192 + soff) = vreg;
            if (TYPE == 3 && tid < 64) ((LAS float*)(ldsw + FBUF + (cur ^ 1) * 256))[tid] = freg;
        }
        __syncthreads();
        if (TYPE == 1) { const unsigned cnt = *(const LAS unsigned*)(lds + CNT); __syncthreads(); if (cnt == 8u) break; }
    }
    if (TYPE == 2) {
        const size_t prow = ((size_t)DA.pat * NT + rowbase + r0off + (size_t)rs * tq) * 8 + h;
        store_ot(DA.po + prow * 64, O0, hh);
        const float lt = l0 + xhalf(l0);
        if (hh == 0) *(float2*)(DA.pml + prow * 2) = make_float2(m0, lt);
        return;
    }
    bf16_t* orow = A.out + (rowbase + tq) * DM + A.ocol + h * 64;
    if (TYPE == 0) {
        const float i0 = 1.f / (l0 + xhalf(l0)), i1 = lam / (l1 + xhalf(l1));
        float ss = 0.f;
#pragma unroll
        for (int db = 0; db < 2; ++db)
#pragma unroll
            for (int i = 0; i < 16; ++i) { const float o = O0[db][i] * i0 - O1[db][i] * i1; O0[db][i] = o; ss = fmaf(o, o, ss); }
        ss += xhalf(ss);
        const float rn = rsqrtf(ss * (1.f / 64.f) + LN_EPS) * 0.8f;
#pragma unroll
        for (int db = 0; db < 2; ++db)
#pragma unroll
            for (int i = 0; i < 16; ++i) O0[db][i] *= rn * subg[32 * db + key_of(i, hh)];
        store_ot(orow, O0, hh);
    } else if (TYPE == 3) {
        const float i0 = 1.f / (l0 + xhalf(l0));
#pragma unroll
        for (int db = 0; db < 2; ++db)
#pragma unroll
            for (int i = 0; i < 16; ++i) O0[db][i] *= i0;
        store_ot(orow, O0, hh);
    } else {
        store_ot(orow, O0, hh);
    }
}
}

__device__ __forceinline__ int xcd_perm256(int p) { return (p & 7) * 32 + (p >> 3); }

__device__ __forceinline__ void attn_layer0_mfma(const Ctx& c, const bf16_t* qkv, bf16_t* out, const float* t5, const float* lamv, const float* subg) {
    float s01 = 0.f, s23 = 0.f;
    for (int i = 0; i < 32; ++i) { s01 += lamv[i] * lamv[32 + i]; s23 += lamv[64 + i] * lamv[96 + i]; }
    const float lam = expf(s01) - expf(s23) + 0.2f;
    unsigned char* scratch = (unsigned char*)c.lds;
    const att::UnitArgs UA{qkv, out, 0, 512, 1024, 0}, UB{qkv, out, 1536, 2048, 2560, 512};
    for (int p = c.bid; p < 256; p += c.nblk) {
        const int pp = xcd_perm256(p), bh = pp >> 3, qb = pp & 7;
        att::causal_unit<0>(UA, bh >> 3, bh & 7, 15 - qb, scratch, c.tid, t5, lam, subg, nullptr);
        att::causal_unit<0>(UA, bh >> 3, bh & 7, qb, scratch, c.tid, t5, lam, subg, nullptr);
#pragma unroll 1
        for (int k = 0; k < 2; ++k) {
            const int u = pp * 2 + k, bh2 = u >> 4, qb2 = u & 15;
            att::causal_unit<1>(UB, bh2 >> 3, bh2 & 7, qb2, scratch, c.tid, nullptr, 0.f, nullptr, nullptr);
        }
    }
}
__device__ __forceinline__ void attn_dilated_mfma(const Ctx& c, const bf16_t* qkv, const float* t5, bf16_t* po, float* pml) {
    unsigned char* scratch = (unsigned char*)c.lds;
    const att::UnitArgs UC{qkv, nullptr, 0, 512, 1024, 0};
    for (int p = c.bid; p < 256; p += c.nblk) {
        const int pp = xcd_perm256(p);
#pragma unroll 1
        for (int k = 0; k < 6; ++k) {
            const int u = pp * 6 + k, bh = u / 48, v = u % 48;
            int pat, rho, qb, dil;
            if (v < 16) { pat = 0; dil = 1; rho = 0; qb = v; }
            else if (v < 32) { pat = 1; dil = 4; rho = (v - 16) >> 2; qb = (v - 16) & 3; }
            else { pat = 2; dil = 16; rho = v - 32; qb = 0; }
            att::causal_unit<2>(UC, bh >> 3, bh & 7, qb, scratch, c.tid, t5, 0.f, nullptr, nullptr, att::DilArgs{dil, rho, pat, po, pml});
        }
    }
}
__device__ __forceinline__ void dilated_combine(const Ctx& c, const bf16_t* po, const float* pml, bf16_t* out) {
    const size_t n = (size_t)NT * 8 * 8;
    for (size_t i = (size_t)c.gwave * 64 + c.lane; i < n; i += (size_t)c.nwaves * 64) {
        const size_t th = i >> 3; const int ch = (int)(i & 7);
        float m[3], l[3];
#pragma unroll
        for (int p = 0; p < 3; ++p) { const float2 ml = *(const float2*)(pml + ((size_t)p * NT * 8 + th) * 2); m[p] = ml.x; l[p] = ml.y; }
        const float mm = fmaxf(m[0], fmaxf(m[1], m[2]));
        float wgt[3], den = 0.f;
#pragma unroll
        for (int p = 0; p < 3; ++p) { wgt[p] = __builtin_amdgcn_exp2f(m[p] - mm); den += wgt[p] * l[p]; }
        const float inv = 1.f / den;
        float o[8];
#pragma unroll
        for (int d = 0; d < 8; ++d) o[d] = 0.f;
#pragma unroll
        for (int p = 0; p < 3; ++p) {
            const uint4 v = *(const uint4*)(po + ((size_t)p * NT * 8 + th) * 64 + ch * 8);
            const unsigned w4[4] = {v.x, v.y, v.z, v.w};
#pragma unroll
            for (int q = 0; q < 4; ++q) { o[2 * q] = fmaf(wgt[p], __builtin_bit_cast(float, w4[q] << 16), o[2 * q]); o[2 * q + 1] = fmaf(wgt[p], __builtin_bit_cast(float, w4[q] & 0xffff0000u), o[2 * q + 1]); }
        }
        uint4 ov; ov.x = pk2(o[0] * inv, o[1] * inv); ov.y = pk2(o[2] * inv, o[3] * inv); ov.z = pk2(o[4] * inv, o[5] * inv); ov.w = pk2(o[6] * inv, o[7] * inv);
        const size_t tok = th >> 3; const int hd = (int)(th & 7);
        *(uint4*)(out + tok * DM + hd * 64 + ch * 8) = ov;
    }
}
__device__ __forceinline__ void attn_fox_mfma(const Ctx& c, const bf16_t* qkv, const float* F, bf16_t* out) {
    unsigned char* scratch = (unsigned char*)c.lds;
    const att::UnitArgs UD{qkv, out, 1536, 2048, 2560, 512};
    for (int p = c.bid; p < 256; p += c.nblk) {
        const int pp = xcd_perm256(p), bh = pp >> 3, qb = pp & 7;
        att::causal_unit<3>(UD, bh >> 3, bh & 7, 15 - qb, scratch, c.tid, nullptr, 0.f, nullptr, F);
        att::causal_unit<3>(UD, bh >> 3, bh & 7, qb, scratch, c.tid, nullptr, 0.f, nullptr, F);
    }
}

__device__ __forceinline__ void ln_rows(const Ctx& c, const float* hin32, const bf16_t* hin16, const float* add, const float* g, const float* bta, float* out, bf16_t* outb) {
    for (int t = c.gwave; t < NT; t += c.nwaves) {
        float v[16];
        float s = 0.f;
#pragma unroll
        for (int r = 0; r < 4; ++r) {
            const int d = r * 256 + c.lane * 4;
            float4 a;
            if (hin32) a = *(const float4*)(hin32 + (size_t)t * DM + d);
            else { const uint2 w = *(const uint2*)(hin16 + (size_t)t * DM + d); a = make_float4(__builtin_bit_cast(float, w.x << 16), __builtin_bit_cast(float, w.x & 0xffff0000u), __builtin_bit_cast(float, w.y << 16), __builtin_bit_cast(float, w.y & 0xffff0000u)); }
            const float4 m = *(const float4*)(add + (size_t)t * DM + d);
            v[r * 4 + 0] = DN_ALPHA * a.x + m.x; v[r * 4 + 1] = DN_ALPHA * a.y + m.y; v[r * 4 + 2] = DN_ALPHA * a.z + m.z; v[r * 4 + 3] = DN_ALPHA * a.w + m.w;
            s += v[r * 4] + v[r * 4 + 1] + v[r * 4 + 2] + v[r * 4 + 3];
        }
        const float mu = wave_sum(s) * (1.f / DM);
        float q = 0.f;
#pragma unroll
        for (int i = 0; i < 16; ++i) { v[i] -= mu; q = fmaf(v[i], v[i], q); }
        const float rs = rsqrtf(wave_sum(q) * (1.f / DM) + LN_EPS);
#pragma unroll
        for (int r = 0; r < 4; ++r) {
            const int d = r * 256 + c.lane * 4;
            const float4 gg = *(const float4*)(g + d), bb = *(const float4*)(bta + d);
            const float4 o = make_float4(v[r * 4] * rs * gg.x + bb.x, v[r * 4 + 1] * rs * gg.y + bb.y, v[r * 4 + 2] * rs * gg.z + bb.z, v[r * 4 + 3] * rs * gg.w + bb.w);
            if (out) *(float4*)(out + (size_t)t * DM + d) = o;
            if (outb) *(uint2*)(outb + (size_t)t * DM + d) = make_uint2(pk2(o.x, o.y), pk2(o.z, o.w));
        }
    }
}

__device__ __forceinline__ void topk_insert(float (&tv)[16], int (&ti)[16], float v, int id) {
#pragma unroll
    for (int j = 15; j >= 1; --j) {
        const bool g = v > tv[j], gp = v > tv[j - 1];
        tv[j] = g ? (gp ? tv[j - 1] : v) : tv[j];
        ti[j] = g ? (gp ? ti[j - 1] : id) : ti[j];
    }
    const bool g0 = v > tv[0];
    tv[0] = g0 ? v : tv[0]; ti[0] = g0 ? id : ti[0];
}

namespace rt {
typedef short bf16x8 __attribute__((ext_vector_type(8)));
typedef float f32x16 __attribute__((ext_vector_type(16)));
__device__ __forceinline__ void ins_packed(float (&tv)[16], float v) {
#pragma unroll
    for (int j = 15; j >= 1; --j) { const bool g = v > tv[j], gp = v > tv[j - 1]; tv[j] = g ? (gp ? tv[j - 1] : v) : tv[j]; }
    tv[0] = v > tv[0] ? v : tv[0];
}
__device__ __forceinline__ float pk_idx(float v, int idx) { return __builtin_bit_cast(float, (__builtin_bit_cast(unsigned, v) & ~127u) | (unsigned)idx); }
__device__ __forceinline__ float pk_val(float p) { return __builtin_bit_cast(float, __builtin_bit_cast(unsigned, p) & ~127u); }
__device__ __forceinline__ int pk_id(float p) { return (int)(__builtin_bit_cast(unsigned, p) & 127u); }

__device__ __forceinline__ void top16_of_set(float (&tv)[16], const bf16_t* pq_row  , const bf16_t* keys  , int r, int hh) {
    bf16x8 B[8];
#pragma unroll
    for (int s = 0; s < 8; ++s) B[s] = *(const bf16x8*)(pq_row + 16 * s);
#pragma unroll
    for (int j = 0; j < 16; ++j) tv[j] = -INFINITY;
#pragma unroll 1
    for (int blk = 0; blk < 4; ++blk) {
        const bf16_t* kr = keys + (size_t)(32 * blk + r) * 128 + 8 * hh;
        f32x16 acc = {0.f, 0.f, 0.f, 0.f, 0.f, 0.f, 0.f, 0.f, 0.f, 0.f, 0.f, 0.f, 0.f, 0.f, 0.f, 0.f};
#pragma unroll
        for (int s = 0; s < 8; ++s) acc = __builtin_amdgcn_mfma_f32_32x32x16_bf16(*(const bf16x8*)(kr + 16 * s), B[s], acc, 0, 0, 0);
#pragma unroll
        for (int i = 0; i < 16; ++i) ins_packed(tv, pk_idx(acc[i], 32 * blk + 8 * (i >> 2) + 4 * hh + (i & 3)));
    }
    float pt[16];
#pragma unroll
    for (int j = 0; j < 16; ++j) pt[j] = __shfl_xor(tv[j], 32);
#pragma unroll
    for (int j = 0; j < 16; ++j) ins_packed(tv, pt[j]);
}
}

__device__ __forceinline__ void peer_route_phase(const Ctx& c, const bf16_t* pq, const bf16_t* subk  , int* eidx, float* gate) {
    const int lane = c.lane, r = lane & 31, hh = lane >> 5;
    for (int task = c.gwave; task < (NT / 32) * 8; task += c.nwaves) {
        const int h = task & 7, t = (task >> 3) * 32 + r;
        float la[16], lb[16];
        rt::top16_of_set(la, pq + (size_t)t * PEER_QW + (2 * h) * 128 + 8 * hh, subk + (size_t)(2 * h) * 128 * 128, r, hh);
        rt::top16_of_set(lb, pq + (size_t)t * PEER_QW + (2 * h + 1) * 128 + 8 * hh, subk + (size_t)(2 * h + 1) * 128 * 128, r, hh);
        float tv[16]; int ti[16];
#pragma unroll
        for (int j = 0; j < 16; ++j) { tv[j] = -INFINITY; ti[j] = 0; }
#pragma unroll
        for (int i = 0; i < 16; ++i) {
            const float av = rt::pk_val(la[i]); const int ai = rt::pk_id(la[i]) * 128;
#pragma unroll
            for (int j = 0; j < 16 / (i + 1); ++j) topk_insert(tv, ti, av + rt::pk_val(lb[j]), ai + rt::pk_id(lb[j]));
        }
        float sum = 0.f, e[16];
#pragma unroll
        for (int j = 0; j < 16; ++j) { e[j] = expf(tv[j] - tv[0]); sum += e[j]; }
        const float inv = 1.f / sum;
        if (hh == 0) {
            int* oi = eidx + ((size_t)t * 8 + h) * 16; float* og = gate + ((size_t)t * 8 + h) * 16;
#pragma unroll
            for (int j = 0; j < 16; j += 4) {
                *(int4*)(oi + j) = make_int4(ti[j], ti[j + 1], ti[j + 2], ti[j + 3]);
                *(float4*)(og + j) = make_float4(e[j] * inv, e[j + 1] * inv, e[j + 2] * inv, e[j + 3] * inv);
            }
        }
    }
}

typedef unsigned u32x4_t __attribute__((ext_vector_type(4)));
typedef float f32x2_t __attribute__((ext_vector_type(2)));
#define GAS __attribute__((address_space(1)))
__device__ __forceinline__ float gelu_exact(float d) { return 0.5f * d * (1.f + erff(d * 0.70710678118654752f)); }

__device__ __forceinline__ void cvt_rows_fp8(const Ctx& c, const float* src, unsigned char* dst, float* rowscale, int nrows) {
    for (int row = c.gwave; row < nrows; row += c.nwaves) {
        const float* s = src + (size_t)row * DM + c.lane * 16;
        const float4 a0 = *(const float4*)s, a1 = *(const float4*)(s + 4), a2 = *(const float4*)(s + 8), a3 = *(const float4*)(s + 12);
        float am = fmaxf(fmaxf(fmaxf(fabsf(a0.x), fabsf(a0.y)), fmaxf(fabsf(a0.z), fabsf(a0.w))), fmaxf(fmaxf(fabsf(a1.x), fabsf(a1.y)), fmaxf(fabsf(a1.z), fabsf(a1.w))));
        am = fmaxf(am, fmaxf(fmaxf(fmaxf(fabsf(a2.x), fabsf(a2.y)), fmaxf(fabsf(a2.z), fabsf(a2.w))), fmaxf(fmaxf(fabsf(a3.x), fabsf(a3.y)), fmaxf(fabsf(a3.z), fabsf(a3.w)))));
#pragma unroll
        for (int o = 32; o >= 1; o >>= 1) am = fmaxf(am, __shfl_xor(am, o));
        int e = (int)((__builtin_bit_cast(unsigned, am) >> 23) & 0xffu) - 127;
        e = e < -100 ? -100 : (e > 100 ? 100 : e);
        const float sc = __builtin_bit_cast(float, (unsigned)(127 + 7 - e) << 23), inv = __builtin_bit_cast(float, (unsigned)(127 - 7 + e) << 23);
        int w0 = 0, w1 = 0, w2 = 0, w3 = 0;
        w0 = __builtin_amdgcn_cvt_pk_fp8_f32(a0.x * sc, a0.y * sc, w0, false); w0 = __builtin_amdgcn_cvt_pk_fp8_f32(a0.z * sc, a0.w * sc, w0, true);
        w1 = __builtin_amdgcn_cvt_pk_fp8_f32(a1.x * sc, a1.y * sc, w1, false); w1 = __builtin_amdgcn_cvt_pk_fp8_f32(a1.z * sc, a1.w * sc, w1, true);
        w2 = __builtin_amdgcn_cvt_pk_fp8_f32(a2.x * sc, a2.y * sc, w2, false); w2 = __builtin_amdgcn_cvt_pk_fp8_f32(a2.z * sc, a2.w * sc, w2, true);
        w3 = __builtin_amdgcn_cvt_pk_fp8_f32(a3.x * sc, a3.y * sc, w3, false); w3 = __builtin_amdgcn_cvt_pk_fp8_f32(a3.z * sc, a3.w * sc, w3, true);
        *(uint4*)(dst + (size_t)row * DM + c.lane * 16) = make_uint4((unsigned)w0, (unsigned)w1, (unsigned)w2, (unsigned)w3);
        if (c.lane == 0) rowscale[row] = inv;
    }
}
__device__ __forceinline__ float dot16_fp8(const u32x4_t w, const float (&x)[16], float acc) {
    const int w0 = (int)w.x, w1 = (int)w.y, w2 = (int)w.z, w3 = (int)w.w;
    f32x2_t p;
    p = __builtin_amdgcn_cvt_pk_f32_fp8(w0, false); acc = fmaf(p.x, x[0], acc); acc = fmaf(p.y, x[1], acc);
    p = __builtin_amdgcn_cvt_pk_f32_fp8(w0, true);  acc = fmaf(p.x, x[2], acc); acc = fmaf(p.y, x[3], acc);
    p = __builtin_amdgcn_cvt_pk_f32_fp8(w1, false); acc = fmaf(p.x, x[4], acc); acc = fmaf(p.y, x[5], acc);
    p = __builtin_amdgcn_cvt_pk_f32_fp8(w1, true);  acc = fmaf(p.x, x[6], acc); acc = fmaf(p.y, x[7], acc);
    p = __builtin_amdgcn_cvt_pk_f32_fp8(w2, false); acc = fmaf(p.x, x[8], acc); acc = fmaf(p.y, x[9], acc);
    p = __builtin_amdgcn_cvt_pk_f32_fp8(w2, true);  acc = fmaf(p.x, x[10], acc); acc = fmaf(p.y, x[11], acc);
    p = __builtin_amdgcn_cvt_pk_f32_fp8(w3, false); acc = fmaf(p.x, x[12], acc); acc = fmaf(p.y, x[13], acc);
    p = __builtin_amdgcn_cvt_pk_f32_fp8(w3, true);  acc = fmaf(p.x, x[14], acc); acc = fmaf(p.y, x[15], acc);
    return acc;
}
__device__ __forceinline__ void axpy16_fp8(const u32x4_t w, float cv, float (&acc)[16]) {
    const int w0 = (int)w.x, w1 = (int)w.y, w2 = (int)w.z, w3 = (int)w.w;
    f32x2_t p;
    p = __builtin_amdgcn_cvt_pk_f32_fp8(w0, false); acc[0] = fmaf(cv, p.x, acc[0]); acc[1] = fmaf(cv, p.y, acc[1]);
    p = __builtin_amdgcn_cvt_pk_f32_fp8(w0, true);  acc[2] = fmaf(cv, p.x, acc[2]); acc[3] = fmaf(cv, p.y, acc[3]);
    p = __builtin_amdgcn_cvt_pk_f32_fp8(w1, false); acc[4] = fmaf(cv, p.x, acc[4]); acc[5] = fmaf(cv, p.y, acc[5]);
    p = __builtin_amdgcn_cvt_pk_f32_fp8(w1, true);  acc[6] = fmaf(cv, p.x, acc[6]); acc[7] = fmaf(cv, p.y, acc[7]);
    p = __builtin_amdgcn_cvt_pk_f32_fp8(w2, false); acc[8] = fmaf(cv, p.x, acc[8]); acc[9] = fmaf(cv, p.y, acc[9]);
    p = __builtin_amdgcn_cvt_pk_f32_fp8(w2, true);  acc[10] = fmaf(cv, p.x, acc[10]); acc[11] = fmaf(cv, p.y, acc[11]);
    p = __builtin_amdgcn_cvt_pk_f32_fp8(w3, false); acc[12] = fmaf(cv, p.x, acc[12]); acc[13] = fmaf(cv, p.y, acc[13]);
    p = __builtin_amdgcn_cvt_pk_f32_fp8(w3, true);  acc[14] = fmaf(cv, p.x, acc[14]); acc[15] = fmaf(cv, p.y, acc[15]);
}

__device__ __forceinline__ void peer_u_phase(const Ctx& c, const bf16_t* h1b_, const int* eidx_, const float* gate_, float* coef, const unsigned char* U8_, const float* rsu_, const float* rsv_) {
    const GAS bf16_t* h1b = (const GAS bf16_t*)h1b_; const GAS int* eidx = (const GAS int*)eidx_; const GAS float* gate = (const GAS float*)gate_;
    const GAS unsigned char* U8 = (const GAS unsigned char*)U8_; const GAS float* rsu = (const GAS float*)rsu_; const GAS float* rsv = (const GAS float*)rsv_;
    const int lane = c.lane;
    for (int vb = c.bid; vb < 256; vb += c.nblk) {
        const int j = vb & 7, rnk = vb >> 3;
#pragma unroll 1
        for (int i = 0; i < 64; ++i) {
            const int t = rnk * 512 + c.wave * 64 + i;
            const u32x4_t xa = *(const GAS u32x4_t*)(h1b + (size_t)t * DM + lane * 16), xb = *(const GAS u32x4_t*)(h1b + (size_t)t * DM + lane * 16 + 8);
            const int e0 = eidx[(size_t)t * 128 + lane], e1 = eidx[(size_t)t * 128 + 64 + lane];
            float x[16];
            {
                const unsigned w[8] = {xa.x, xa.y, xa.z, xa.w, xb.x, xb.y, xb.z, xb.w};
#pragma unroll
                for (int q = 0; q < 8; ++q) { x[2 * q] = __builtin_bit_cast(float, w[q] << 16); x[2 * q + 1] = __builtin_bit_cast(float, w[q] & 0xffff0000u); }
            }
            unsigned long long m0 = __ballot((e0 & 7) == j), m1 = __ballot((e1 & 7) == j);
            while (m0 | m1) {
                int ks[4], es[4];
#pragma unroll
                for (int u = 0; u < 4; ++u) {
                    if (m0) { const int k = __builtin_ctzll(m0); m0 &= m0 - 1; ks[u] = k; es[u] = __builtin_amdgcn_readlane(e0, k); }
                    else if (m1) { const int k = __builtin_ctzll(m1); m1 &= m1 - 1; ks[u] = 64 + k; es[u] = __builtin_amdgcn_readlane(e1, k); }
                    else { ks[u] = -1; es[u] = es[0]; }
                }
                u32x4_t ua[4];
#pragma unroll
                for (int u = 0; u < 4; ++u) ua[u] = *(const GAS u32x4_t*)(U8 + (size_t)es[u] * DM + lane * 16);
                float p[4];
#pragma unroll
                for (int u = 0; u < 4; ++u) p[u] = dot16_fp8(ua[u], x, 0.f);
                const bool hi = lane >= 32, h16 = (lane >> 4) & 1;
                const float r0 = (hi ? p[2] : p[0]) + __shfl_xor(hi ? p[0] : p[2], 32);
                const float r1 = (hi ? p[3] : p[1]) + __shfl_xor(hi ? p[1] : p[3], 32);
                float s = (h16 ? r1 : r0) + __shfl_xor(h16 ? r0 : r1, 16);
                s += __shfl_xor(s, 8); s += __shfl_xor(s, 4); s += __shfl_xor(s, 2); s += __shfl_xor(s, 1);
                const int g = lane >> 4;
                const int kk = g == 0 ? ks[0] : (g == 1 ? ks[1] : (g == 2 ? ks[2] : ks[3]));
                const int ee = g == 0 ? es[0] : (g == 1 ? es[1] : (g == 2 ? es[2] : es[3]));
                if ((lane & 15) == 0 && kk >= 0)
                    __hip_atomic_store(coef + (size_t)t * 128 + kk, gate[(size_t)t * 128 + kk] * gelu_exact(s * rsu[ee]) * rsv[ee], __ATOMIC_RELAXED, __HIP_MEMORY_SCOPE_AGENT);
            }
        }
    }
}

__device__ __forceinline__ void peer_v_phase(const Ctx& c, const int* eidx_, const float* coef_, const unsigned char* V8_, float* Y) {
    const GAS int* eidx = (const GAS int*)eidx_; const GAS float* coef = (const GAS float*)coef_; const GAS unsigned char* V8 = (const GAS unsigned char*)V8_;
    const int lane = c.lane, sg = lane >> 3, part = lane & 7;
    typedef int i32x4_t __attribute__((ext_vector_type(4)));
    typedef float f32x4_t __attribute__((ext_vector_type(4)));
    for (int vb = c.bid; vb < 256; vb += c.nblk) {
        const int j = vb & 7, rnk = vb >> 3;
        const int dcol = 128 * j + part * 16;
        const int t0 = rnk * 512 + c.wave * 64;
        i32x4_t e[4]; f32x4_t cf[4];
#pragma unroll
        for (int q = 0; q < 4; ++q) { e[q] = *(const GAS i32x4_t*)(eidx + (size_t)t0 * 128 + sg * 16 + 4 * q); cf[q] = *(const GAS f32x4_t*)(coef + (size_t)t0 * 128 + sg * 16 + 4 * q); }
#pragma unroll 1
        for (int i = 0; i < 64; ++i) {
            const int t = t0 + i, tn = t0 + (i < 63 ? i + 1 : 63);
            u32x4_t rows[16];
#pragma unroll
            for (int it = 0; it < 16; ++it) rows[it] = *(const GAS u32x4_t*)(V8 + (size_t)e[it >> 2][it & 3] * DM + dcol);
            i32x4_t en[4]; f32x4_t cn[4];
#pragma unroll
            for (int q = 0; q < 4; ++q) { en[q] = *(const GAS i32x4_t*)(eidx + (size_t)tn * 128 + sg * 16 + 4 * q); cn[q] = *(const GAS f32x4_t*)(coef + (size_t)tn * 128 + sg * 16 + 4 * q); }
            float acc[16];
#pragma unroll
            for (int d = 0; d < 16; ++d) acc[d] = 0.f;
#pragma unroll
            for (int it = 0; it < 16; ++it) axpy16_fp8(rows[it], cf[it >> 2][it & 3], acc);
#pragma unroll
            for (int d = 0; d < 16; ++d) { acc[d] += __shfl_xor(acc[d], 8); acc[d] += __shfl_xor(acc[d], 16); acc[d] += __shfl_xor(acc[d], 32); }
            if (lane < 8) {
                float* yp = Y + (size_t)t * DM + dcol;
#pragma unroll
                for (int q = 0; q < 4; ++q) *(f32x4_t*)(yp + 4 * q) = (f32x4_t){acc[4 * q], acc[4 * q + 1], acc[4 * q + 2], acc[4 * q + 3]};
            }
#pragma unroll
            for (int q = 0; q < 4; ++q) { e[q] = en[q]; cf[q] = cn[q]; }
        }
    }
}

__device__ __forceinline__ void prologue_phase(const Ctx& c, const float* x, const float* ab_in, const float* ab_out, const float* cd_in, const float* cd_out, const float* wq, const float* pu, const float* pv, const float* sk, unsigned char* ws) {
    float* scr = c.lds + c.wave * 4096;
    constexpr int I_IN = 16 * 96, I_OUT = 16 * 32, I_WQ = 16 * 64;
    constexpr int NITEMS = 2 * I_IN + 2 * I_OUT + 2 * I_WQ;
    for (int it = c.gwave; it < NITEMS; it += c.nwaves) {
        int r = it;
        if (r < I_IN) { transpose_item(ab_in, QKV_W, DM, QKV_W, (bf16_t*)(ws + WT_ABIN), scr, r, c.lane); continue; } r -= I_IN;
        if (r < I_IN) { transpose_item(cd_in, CD_IN, DM, QKV_W, (bf16_t*)(ws + WT_CDIN), scr, r, c.lane); continue; } r -= I_IN;
        if (r < I_OUT) { transpose_item(ab_out, DM, DM, DM, (bf16_t*)(ws + WT_ABOUT), scr, r, c.lane); continue; } r -= I_OUT;
        if (r < I_OUT) { transpose_item(cd_out, DM, DM, DM, (bf16_t*)(ws + WT_CDOUT), scr, r, c.lane); continue; } r -= I_OUT;
        if (r < I_WQ) { transpose_item(wq, PEER_QW, DM, PEER_QW, (bf16_t*)(ws + WT_WQ), scr, r, c.lane); continue; } r -= I_WQ;
        transpose_item(wq + (size_t)DM * PEER_QW, PEER_QW, DM, PEER_QW, (bf16_t*)(ws + WT_WQ + 4 * MiB), scr, r, c.lane);
    }
    cvt_rows_bf16(c, x, (bf16_t*)(ws + WS_ACTIN), (size_t)NT * DM / 8);
    cvt_rows_fp8(c, pu, ws + WS_U8, (float*)(ws + WS_RS), 2 * 16384);
    cvt_rows_fp8(c, pv, ws + WS_V8, (float*)(ws + WS_RS) + 2 * 16384, 2 * 16384);
    cvt_rows_bf16(c, sk, (bf16_t*)(ws + WS_SKB), (size_t)2 * 16 * 128 * 128 / 8);
}

constexpr int NPHASE = 1 + 2 * 11;
__global__ void __launch_bounds__(NTHREADS, 2) fwd(Args args) {
    unsigned* ctl = (unsigned*)(args.ws + WS_CTL);
    volatile LAS unsigned* xbw = (volatile LAS unsigned*)(dyn_lds + MISC_OFF);
    if (threadIdx.x == 0) { xbw[0] = 0u; xbw[1] = 0u; xbw[2] = 0u; xbw[3] = 0u; }
    __syncthreads();
    const int lo = args.ph_lo, hi = args.ph_hi;
    XcdBarrier bar = xcd_barrier_post(ctl + 4096, xbw);
#define IN(k) (lo <= (k) && (k) < hi)
#define SEAM(k) do { if (IN(k) && IN((k) + 1)) xcd_barrier(bar); } while (0)
#define LAUNDER(ptr) ptr = launder_ptr(ptr)
#define PIN(k) ((const float*)launder_ptr((unsigned char*)args.in[k]))
#define GEMM_LDS ((PG8_LAS unsigned char*)dyn_lds + RING_OFF)
    if (IN(0)) { unsigned char* ws = args.ws; LAUNDER(ws); const Ctx c = make_ctx(); prologue_phase(c, PIN(0), PIN(2), PIN(5), PIN(6), PIN(8), PIN(9), PIN(11), PIN(12), PIN(10), ws); }
    SEAM(0);
#pragma unroll 1
    for (int layer = 0; layer < 2; ++layer) {
        const int pb = 1 + layer * 11;
        if (IN(pb + 0)) {
            unsigned char* ws = args.ws; LAUNDER(ws); const Ctx c = make_ctx();
            pg8::Gemm g{(const bf16_t*)(ws + WS_ACTIN), (const bf16_t*)(ws + (layer == 0 ? WT_ABIN : WT_CDIN)), NT, QKV_W, DM};
            pg8::StaticOrder S; S.init(NT, QKV_W, c.nblk, c.bid);
            pg8::EpiStoreBf16 E{(bf16_t*)(ws + WS_QKV), QKV_W, (layer == 0 ? 0.17677669529663687f : 0.125f) * 1.4426950408889634f, 0.125f * 1.4426950408889634f};
            pg8::gemm_phase<pg8::EpiStoreBf16, pg8::StaticOrder, true, true>(GEMM_LDS, g, S, E);
            if (layer == 1) fg_phase(c, (const bf16_t*)(ws + WS_ACTIN), PIN(6), (float*)(ws + WS_FG));
        }
        SEAM(pb + 0);
        if (IN(pb + 1) && layer == 1) { unsigned char* ws = args.ws; LAUNDER(ws); const Ctx c = make_ctx(); fscan_naive(c, (const float*)(ws + WS_FG), (float*)(ws + WS_F), PIN(7)); }
        SEAM(pb + 1);
        if (IN(pb + 2)) {
            unsigned char* ws = args.ws; LAUNDER(ws); const Ctx c = make_ctx();
            if (layer == 0) attn_layer0_mfma(c, (const bf16_t*)(ws + WS_QKV), (bf16_t*)(ws + WS_ATTB), PIN(1), PIN(3), PIN(4));
            else { attn_fox_mfma(c, (const bf16_t*)(ws + WS_QKV), (const float*)(ws + WS_F), (bf16_t*)(ws + WS_ATTB)); attn_dilated_mfma(c, (const bf16_t*)(ws + WS_QKV), PIN(1), (bf16_t*)(ws + WS_MIX), (float*)(ws + WS_H1B)); }
        }
        SEAM(pb + 2);
        if (IN(pb + 3) && layer == 1) { unsigned char* ws = args.ws; LAUNDER(ws); const Ctx c = make_ctx(); dilated_combine(c, (const bf16_t*)(ws + WS_MIX), (const float*)(ws + WS_H1B), (bf16_t*)(ws + WS_ATTB)); }
        SEAM(pb + 3);
        if (IN(pb + 4)) {
            unsigned char* ws = args.ws; LAUNDER(ws); const Ctx c = make_ctx();
            pg8::Gemm g{(const bf16_t*)(ws + WS_ATTB), (const bf16_t*)(ws + (layer == 0 ? WT_ABOUT : WT_CDOUT)), NT, DM, DM};
            pg8::StaticOrder S; S.init(NT, DM, c.nblk, c.bid);
            pg8::EpiStoreF32 E{(float*)(ws + WS_MIX), DM};
            pg8::gemm_phase<pg8::EpiStoreF32, pg8::StaticOrder, true, true>(GEMM_LDS, g, S, E);
        }
        SEAM(pb + 4);
        if (IN(pb + 5)) {
            unsigned char* ws = args.ws; LAUNDER(ws); const Ctx c = make_ctx();
            ln_rows(c, layer == 0 ? PIN(0) : (const float*)nullptr, (const bf16_t*)(ws + WS_ACTIN), (const float*)(ws + WS_MIX), PIN(13) + (size_t)layer * 2 * DM, PIN(14) + (size_t)layer * 2 * DM, (float*)nullptr, (bf16_t*)(ws + WS_H1B));
        }
        SEAM(pb + 5);
        if (IN(pb + 6)) {
            unsigned char* ws = args.ws; LAUNDER(ws); const Ctx c = make_ctx();
            pg8::Gemm g{(const bf16_t*)(ws + WS_H1B), (const bf16_t*)(ws + WT_WQ + (size_t)layer * 4 * MiB), NT, PEER_QW, DM};
            pg8::StaticOrder S; S.init(NT, PEER_QW, c.nblk, c.bid);
            pg8::EpiStoreBf16 E{(bf16_t*)(ws + WS_QKV), PEER_QW, 1.f, 1.f};
            pg8::gemm_phase<pg8::EpiStoreBf16, pg8::StaticOrder, true, true>(GEMM_LDS, g, S, E);
        }
        SEAM(pb + 6);
        if (IN(pb + 7)) {
            unsigned char* ws = args.ws; LAUNDER(ws); const Ctx c = make_ctx();
            peer_route_phase(c, (const bf16_t*)(ws + WS_QKV), (const bf16_t*)(ws + WS_SKB) + (size_t)layer * 16 * 128 * 128, (int*)(ws + WS_EIDX), (float*)(ws + WS_GATE));
        }
        SEAM(pb + 7);
        if (IN(pb + 8)) {
            unsigned char* ws = args.ws; LAUNDER(ws); const Ctx c = make_ctx();
            peer_u_phase(c, (const bf16_t*)(ws + WS_H1B), (const int*)(ws + WS_EIDX), (const float*)(ws + WS_GATE), (float*)(ws + WS_COEF), ws + WS_U8 + (size_t)layer * 16384 * DM, (const float*)(ws + WS_RS) + (size_t)layer * 16384, (const float*)(ws + WS_RS) + (size_t)(2 + layer) * 16384);
        }
        SEAM(pb + 8);
        if (IN(pb + 9)) {
            unsigned char* ws = args.ws; LAUNDER(ws); const Ctx c = make_ctx();
            peer_v_phase(c, (const int*)(ws + WS_EIDX), (const float*)(ws + WS_COEF), ws + WS_V8 + (size_t)layer * 16384 * DM, (float*)(ws + WS_MIX));
        }
        SEAM(pb + 9);
        if (IN(pb + 10)) {
            unsigned char* ws = args.ws; LAUNDER(ws); const Ctx c = make_ctx();
            float* hout = layer == 0 ? (float*)nullptr : (float*)launder_ptr((unsigned char*)args.out);
            bf16_t* houtb = layer == 0 ? (bf16_t*)(ws + WS_ACTIN) : (bf16_t*)nullptr;
            ln_rows(c, (const float*)nullptr, (const bf16_t*)(ws + WS_H1B), (const float*)(ws + WS_MIX), PIN(13) + (size_t)(layer * 2 + 1) * DM, PIN(14) + (size_t)(layer * 2 + 1) * DM, hout, houtb);
        }
        SEAM(pb + 10);
    }
}

extern "C" void kernel_launch(void* const* d_in, const int* in_sizes, int n_in, void* d_out, int out_size, void* d_ws, size_t ws_size, hipStream_t stream) {
    (void)in_sizes; (void)n_in; (void)out_size;
    static int grid = 0;
    if (!grid) {
        int dev = 0, cus = 0, per_cu = 0;
        (void)hipGetDevice(&dev);
        (void)hipDeviceGetAttribute(&cus, hipDeviceAttributeMultiprocessorCount, dev);
        (void)hipFuncSetAttribute((const void*)fwd, hipFuncAttributeMaxDynamicSharedMemorySize, LDS_BYTES);
        (void)hipOccupancyMaxActiveBlocksPerMultiprocessor(&per_cu, fwd, NTHREADS, LDS_BYTES);
        if (per_cu < 1) fprintf(stderr, "occupancy query says %d blocks per CU\n", per_cu);
        grid = cus;
        if (ws_size < WS_END) fprintf(stderr, "workspace too small: %zu < %zu\n", ws_size, (size_t)WS_END);
    }
    (void)hipMemsetAsync((unsigned char*)d_ws + WS_CTL, 0, 1 * MiB, stream);
    Args a{};
    for (int i = 0; i < 15; ++i) a.in[i] = (const float*)d_in[i];
    a.out = (float*)d_out; a.ws = (unsigned char*)d_ws;
    a.ph_lo = 0; a.ph_hi = NPHASE;
    hipLaunchKernelGGL(fwd, dim3(grid), dim3(NTHREADS), LDS_BYTES, stream, a);
}
```

```cpp
#include <hip/hip_runtime.h>
#include <cstdio>
#include <cstdint>
#include <cmath>

constexpr int BATCH = 4, SEQ = 4096, DM = 1024, NT = BATCH * SEQ;
constexpr int NH = 8, HD = 64;
constexpr int QKV_W = 3072, CD_IN = 3080;
constexpr int PEER_QW = 2048;
constexpr float DN_ALPHA = 1.4142135623730951f;
constexpr float LN_EPS = 1e-5f;
constexpr int NTHREADS = 512, NWAVES = 8;
typedef unsigned short bf16_t;

constexpr size_t MiB = 1u << 20;
constexpr size_t WS_CTL = 0;
constexpr size_t WS_WT = 1 * MiB;
constexpr size_t WT_ABIN = WS_WT, WT_ABOUT = WS_WT + 6 * MiB, WT_CDIN = WS_WT + 8 * MiB, WT_CDOUT = WS_WT + 14 * MiB, WT_WQ = WS_WT + 16 * MiB;
constexpr size_t WS_ACTIN = 25 * MiB;
constexpr size_t WS_ATTB = 57 * MiB;
constexpr size_t WS_H1B = 89 * MiB;
constexpr size_t WS_QKV = 121 * MiB;
constexpr size_t WS_MIX = 217 * MiB;
constexpr size_t WS_EIDX = 281 * MiB;
constexpr size_t WS_COEF = 289 * MiB;
constexpr size_t WS_F = 297 * MiB;
constexpr size_t WS_FG = 298 * MiB;
constexpr size_t WS_U8 = 299 * MiB;
constexpr size_t WS_V8 = 331 * MiB;
constexpr size_t WS_RS = 363 * MiB;
constexpr size_t WS_SKB = 364 * MiB;
constexpr size_t WS_GATE = 365 * MiB;
constexpr size_t WS_X8 = 373 * MiB;
constexpr size_t WS_XS = 389 * MiB;
constexpr size_t WS_END = 390 * MiB;
constexpr int LDS_BYTES = 147456;
constexpr int RING_OFF = 0, MISC_OFF = 143360;

#define XB_TMO      128
#define XB_XCNT(j)  (256  + 64 * (j))
#define XB_XSUB(j)  (1280 + 64 * (j))
#define XB_XGEN(j)  (2304 + 64 * (j))
#define XB_TOP      3328
#define XB_TOPGEN   3392
#define XCD_BAR_WORDS 3456
#define XB_SPIN_CAP (1u << 18)
#define LAS __attribute__((address_space(3)))

__device__ __forceinline__ unsigned xb_ld(unsigned* p)              { return __hip_atomic_load(p, __ATOMIC_RELAXED, __HIP_MEMORY_SCOPE_AGENT); }
__device__ __forceinline__ unsigned xb_add(unsigned* p, unsigned v) { return __hip_atomic_fetch_add(p, v, __ATOMIC_RELAXED, __HIP_MEMORY_SCOPE_AGENT); }
__device__ __forceinline__ unsigned xb_xcc_id() { return (unsigned)__builtin_amdgcn_s_getreg((3 << 11) | 20) & 0xFu; }
#define XB_SPIN(cond, bar) do { unsigned _sp = 0; while (cond) { __builtin_amdgcn_s_sleep(1); \
    if ((++_sp & 255u) == 0u) { if (xb_ld(&(bar)[XB_TMO])) break; if (_sp > XB_SPIN_CAP) { atomicAdd(&(bar)[XB_TMO], 1u); break; } } } } while (0)

struct XcdBarrier {
    unsigned* bar; unsigned x;
    volatile LAS unsigned* st;
};
__device__ __forceinline__ XcdBarrier xcd_barrier_post(unsigned* bar, volatile LAS unsigned* st) {
    XcdBarrier b; b.bar = bar; b.x = xb_xcc_id(); b.st = st;
    if (threadIdx.x == 0) (void)xb_add(&bar[XB_XCNT(b.x)], 1u);
    return b;
}
__device__ __forceinline__ void xcd_barrier_complete(unsigned* bar, unsigned x, unsigned& nloc, unsigned& nx) {
    const unsigned G = gridDim.x * gridDim.y * gridDim.z;
    unsigned sum, cnt, mine, sp = 0u;
    for (;;) {
        sum = 0u; cnt = 0u; mine = 0u;
#pragma unroll
        for (unsigned j = 0; j < 16; ++j) { const unsigned c = xb_ld(&bar[XB_XCNT(j)]); sum += c; cnt += (c > 0u) ? 1u : 0u; mine = (j == x) ? c : mine; }
        if (sum == G) break;
        __builtin_amdgcn_s_sleep(1);
        if ((++sp & 255u) == 0u) { if (xb_ld(&bar[XB_TMO])) break; if (sp > XB_SPIN_CAP) { atomicAdd(&bar[XB_TMO], 1u); break; } }
    }
    nloc = mine > 0u ? mine : 1u; nx = cnt > 0u ? cnt : 1u;
}
__device__ __forceinline__ void xcd_barrier(const XcdBarrier& b) {
    asm volatile("s_waitcnt vmcnt(0)" ::: "memory");
    __syncthreads();
    if (threadIdx.x == 0) {
        unsigned* bar = b.bar;
        __builtin_amdgcn_s_waitcnt(0);
        unsigned nloc = b.st[0], nx = b.st[1];
        if (nloc == 0u) { xcd_barrier_complete(bar, b.x, nloc, nx); b.st[0] = nloc; b.st[1] = nx; }
        const unsigned old = xb_add(&bar[XB_XSUB(b.x)], 1u);
        const unsigned gen = old / nloc;
        if (old + 1u == (gen + 1u) * nloc) {
            __builtin_amdgcn_fence(__ATOMIC_RELEASE, "agent");
            asm volatile("s_waitcnt vmcnt(0)" ::: "memory");
            const unsigned og = xb_add(&bar[XB_TOP], 1u);
            const unsigned tg = og / nx;
            if (og + 1u == (tg + 1u) * nx) xb_add(&bar[XB_TOPGEN], 1u);
            else XB_SPIN(xb_ld(&bar[XB_TOPGEN]) == tg, bar);
            __builtin_amdgcn_fence(__ATOMIC_ACQUIRE, "agent");
            xb_add(&bar[XB_XGEN(b.x)], 1u);
            asm volatile("s_waitcnt vmcnt(0)" ::: "memory");
        } else {
            XB_SPIN(xb_ld(&bar[XB_XGEN(b.x)]) == gen, bar);
            __builtin_amdgcn_fence(__ATOMIC_ACQUIRE, "agent");
            asm volatile("s_waitcnt vmcnt(0)" ::: "memory");
        }
    }
    __syncthreads();
}

struct Args {
    const float* in[15];
    float* out;
    unsigned char* ws;
    int ph_lo, ph_hi;
};
struct Ctx {
    int tid, lane, wave, gwave, nwaves, bid, nblk;
    float* lds;
};
extern __shared__ __attribute__((aligned(16))) unsigned char dyn_lds[];
__device__ __forceinline__ Ctx make_ctx() {
    int t = threadIdx.x, b = blockIdx.x, g = gridDim.x;
    asm volatile("" : "+v"(t));
    asm volatile("" : "+s"(b), "+s"(g));
    Ctx c; c.tid = t; c.lane = t & 63; c.wave = t >> 6; c.bid = b; c.nblk = g;
    c.gwave = b * NWAVES + c.wave; c.nwaves = g * NWAVES; c.lds = (float*)(dyn_lds + RING_OFF);
    return c;
}
__device__ __forceinline__ unsigned char* launder_ptr(unsigned char* p) {
    unsigned lo = __builtin_amdgcn_readfirstlane((unsigned)(uintptr_t)p), hi = __builtin_amdgcn_readfirstlane((unsigned)((uintptr_t)p >> 32));
    asm volatile("" : "+s"(lo), "+s"(hi));
    return (unsigned char*)(((uintptr_t)hi << 32) | (uintptr_t)lo);
}
__device__ __forceinline__ float wave_sum(float v) {
#pragma unroll
    for (int o = 32; o >= 1; o >>= 1) v += __shfl_xor(v, o);
    return v;
}
__device__ __forceinline__ float log_sigmoid(float z) { return fminf(z, 0.f) - log1pf(expf(-fabsf(z))); }
__device__ __forceinline__ int t5_bucket(int n) {
    if (n < 16) return n;
    int large = 16 + (int)(logf((float)n / 16.f) / 2.0794415416798357f * 16.f);
    return large < 31 ? large : 31;
}
__device__ __forceinline__ float bf2f(bf16_t v) { return __builtin_bit_cast(float, (unsigned)v << 16); }
__device__ __forceinline__ unsigned f2bf(float f) { unsigned u = __builtin_bit_cast(unsigned, f); return (u + 0x7fffu + ((u >> 16) & 1u)) >> 16; }
__device__ __forceinline__ unsigned pk2(float lo, float hi) { return f2bf(lo) | (f2bf(hi) << 16); }

namespace pg8 {
#define PG8_LAS __attribute__((address_space(3)))
typedef unsigned short bf16_t;
typedef short bf16x8 __attribute__((ext_vector_type(8)));
typedef float f32x4 __attribute__((ext_vector_type(4)));
typedef unsigned u32x4 __attribute__((ext_vector_type(4)));
constexpr int BM = 256, BK = 64, HALF = 128, HTB = HALF * BK * 2  , STAGE_BYTES = 8 * HTB, NXCD = 8, WGM = 8;

__host__ __device__ __forceinline__ int lds_byte(int r, int c) { const int st = (r >> 4) * 2 + (c >> 5), rr = r & 15, cc = c & 31, ob = rr * 64 + cc * 2; return st * 1024 + (ob ^ (((ob >> 9) & 1) << 5)); }
__host__ __device__ __forceinline__ void stage_rc(int b, int& R, int& C) { const int st = b / 1024, sb = b % 1024, swz = sb ^ (((sb >> 9) & 1) << 5); R = (st >> 1) * 16 + swz / 64; C = (st & 1) * 32 + (swz % 64) / 2; }
__host__ __device__ __forceinline__ int perm32(int rho) { const int n = rho >> 4, i = rho & 15; return 8 * (i >> 2) + 4 * n + (i & 3); }

struct Unit { int pm, pn; };
struct Gemm { const bf16_t* A; const bf16_t* Bt; int M, N, K; };

struct StaticOrder {
    int nM, nN, nwg, G, c;
    __host__ __device__ void init(int M, int N, int G_, int c_) { nM = M / BM; nN = N / BM; nwg = nM * nN; G = G_; c = c_; }
    __host__ __device__ bool next(int i, Unit& u) const {
        const long L = (long)i * G + c; if (L >= nwg) return false;
        int wgid = (int)L; { const int q = nwg / NXCD, r = nwg % NXCD, xcd = wgid % NXCD, off = wgid / NXCD; wgid = (xcd < r ? xcd * (q + 1) : r * (q + 1) + (xcd - r) * q) + off; }
        const int nig = WGM * nN, gid = wgid / nig, fm = gid * WGM, gsz = (nM - fm) < WGM ? (nM - fm) : WGM;
        u.pm = fm + ((wgid % nig) % gsz); u.pn = (wgid % nig) / gsz; return true;
    }
    __device__ __forceinline__ void a_ready(const Unit&) const {}
    __device__ __forceinline__ void done(const Unit&) const {}
};

__device__ __forceinline__ unsigned cvt_pk_bf16(float lo, float hi) { unsigned r; asm volatile("v_cvt_pk_bf16_f32 %0, %1, %2" : "=v"(r) : "v"(lo), "v"(hi)); return r; }
template <class Epi, class Sched, bool ALIGN_EPI = false, bool SP2 = false>
__device__ __forceinline__ void gemm_phase(PG8_LAS unsigned char* lds, const Gemm g, const Sched& S, const Epi& E) {
    int tid_ = threadIdx.x; asm volatile("" : "+v"(tid_));
    const int tid = tid_, wid = __builtin_amdgcn_readfirstlane(tid >> 6), lane = tid & 63, wr = wid >> 2, wc = wid & 3, fr = lane & 15, fq = lane >> 4;
    const int K = g.K, nt = K / BK;
    unsigned voffA[2], voffB[2];
#pragma unroll
    for (int i = 0; i < 2; ++i) { int R, C; stage_rc(tid * 16 + i * 8192, R, C); const int Rb = Epi::PERM ? ((R & ~31) + perm32(R & 31)) : R;
        voffA[i] = (unsigned)(R * K + C) * 2u; voffB[i] = (unsigned)(Rb * K + C) * 2u; }
    const size_t kstep = (size_t)(BK * 2);
    const size_t hstep = (size_t)HALF * K * 2;
    const size_t tstep = 2 * hstep;
    const unsigned ldsw = (unsigned)wid * 1024u;
    const int aoff = lds_byte(wr * 64 + fr, fq * 8), boff = lds_byte(wc * 32 + fr, fq * 8);
#define PG8_SA(b, h) (((b) * 2 + (h)) * HTB)
#define PG8_SB(b, h) ((4 + (b) * 2 + (h)) * HTB)
#define PG8_STAGE(bufoff, gbase, voff) do { _Pragma("unroll") for (int _i = 0; _i < 2; ++_i) \
        __builtin_amdgcn_global_load_lds((const unsigned*)((const char*)(gbase) + (voff)[_i]), (PG8_LAS unsigned*)(lds + (bufoff) + ldsw + _i * 8192), 16, 0, 0); } while (0)
#define PG8_LDA(dst, b, h) do { _Pragma("unroll") for (int m = 0; m < 4; ++m) _Pragma("unroll") for (int k = 0; k < 2; ++k) dst[m][k] = *(const PG8_LAS bf16x8*)(lds + PG8_SA(b, h) + aoff + m * 2048 + k * 1024); } while (0)
#define PG8_LDB(dst, b, h) do { _Pragma("unroll") for (int n = 0; n < 2; ++n) _Pragma("unroll") for (int k = 0; k < 2; ++k) dst[n][k] = *(const PG8_LAS bf16x8*)(lds + PG8_SB(b, h) + boff + n * 2048 + k * 1024); } while (0)
#define PG8_MMA(ai, bj, At, Bt) do { __builtin_amdgcn_s_setprio(1); _Pragma("unroll") for (int m = 0; m < 4; ++m) _Pragma("unroll") for (int n = 0; n < 2; ++n) _Pragma("unroll") for (int k = 0; k < 2; ++k) \
        acc[ai][bj][m][n] = __builtin_amdgcn_mfma_f32_16x16x32_bf16(Bt[n][k], At[m][k], acc[ai][bj][m][n], 0, 0, 0); __builtin_amdgcn_s_setprio(0); } while (0)
#define PG8_WAIT_V(n) asm volatile("s_waitcnt vmcnt(" #n ")" ::: "memory")
#define PG8_WAIT_L(n) asm volatile("s_waitcnt lgkmcnt(" #n ")" ::: "memory")
#define PG8_BAR __builtin_amdgcn_s_barrier()
#define PG8_SCHED __builtin_amdgcn_sched_barrier(0)
    Unit cur, nxt; int ui = 0;
    if (!S.next(0, cur)) return;
    f32x4 acc[2][2][4][2];
#pragma unroll
    for (int a = 0; a < 2; ++a)
#pragma unroll
        for (int b = 0; b < 2; ++b)
#pragma unroll
            for (int m = 0; m < 4; ++m)
#pragma unroll
                for (int n = 0; n < 2; ++n) acc[a][b][m][n] = (f32x4){0.f, 0.f, 0.f, 0.f};
    bf16x8 At[4][2], B0[2][2], B1[2][2];
    const char* cA = (const char*)g.A + (size_t)cur.pm * tstep; const char* cB = (const char*)g.Bt + (size_t)cur.pn * tstep;
    S.a_ready(cur);
    if constexpr (SP2) {
        PG8_STAGE(PG8_SB(0, 0), cB, voffB); PG8_STAGE(PG8_SB(0, 1), cB + hstep, voffB); PG8_STAGE(PG8_SA(0, 0), cA, voffA); PG8_STAGE(PG8_SA(0, 1), cA + hstep, voffA);
        if (wr == 1) PG8_BAR;
        PG8_WAIT_V(2); PG8_BAR;
        PG8_STAGE(PG8_SB(1, 0), cB + kstep, voffB); PG8_STAGE(PG8_SA(1, 0), cA + kstep, voffA); PG8_STAGE(PG8_SB(1, 1), cB + hstep + kstep, voffB);
        PG8_WAIT_V(6); PG8_BAR;
    } else {
        PG8_STAGE(PG8_SB(0, 0), cB, voffB); PG8_STAGE(PG8_SA(0, 0), cA, voffA); PG8_STAGE(PG8_SB(0, 1), cB + hstep, voffB); PG8_STAGE(PG8_SA(0, 1), cA + hstep, voffA);
        if (wr == 1) PG8_BAR;
        PG8_WAIT_V(4); PG8_BAR;
        PG8_STAGE(PG8_SB(1, 0), cB + kstep, voffB); PG8_STAGE(PG8_SA(1, 0), cA + kstep, voffA); PG8_STAGE(PG8_SB(1, 1), cB + hstep + kstep, voffB);
        PG8_WAIT_V(6); PG8_BAR;
    }
    for (;;) {
        const bool has_next = S.next(ui + 1, nxt);
        const char* nA = has_next ? (const char*)g.A + (size_t)nxt.pm * tstep : cA; const char* nB = has_next ? (const char*)g.Bt + (size_t)nxt.pn * tstep : cB;
        for (int t = 0; t < nt; t += 2) {
            const bool last = (t == nt - 2);
            const char* a1 = cA + (size_t)(t + 1) * kstep;
            const char* a2 = last ? nA : cA + (size_t)(t + 2) * kstep; const char* b2 = last ? nB : cB + (size_t)(t + 2) * kstep;
            const char* a3 = a2 + kstep; const char* b3 = b2 + kstep;
            if (last && has_next) S.a_ready(nxt);
            if constexpr (SP2) {
            PG8_LDB(B0, 0, 0); PG8_LDB(B1, 0, 1); PG8_SCHED; PG8_LDA(At, 0, 0); PG8_STAGE(PG8_SA(1, 1), a1 + hstep, voffA);
            PG8_WAIT_V(8); PG8_WAIT_L(0); PG8_BAR; PG8_MMA(0, 0, At, B0); PG8_MMA(0, 1, At, B1); PG8_BAR; PG8_SCHED;
            PG8_LDA(At, 0, 1); PG8_STAGE(PG8_SB(0, 0), b2, voffB); PG8_STAGE(PG8_SB(0, 1), b2 + hstep, voffB); PG8_STAGE(PG8_SA(0, 0), a2, voffA);
            PG8_WAIT_V(8); PG8_WAIT_L(0); PG8_BAR; PG8_MMA(1, 0, At, B0); PG8_MMA(1, 1, At, B1); PG8_BAR; PG8_SCHED;
            PG8_LDB(B0, 1, 0); PG8_LDB(B1, 1, 1); PG8_SCHED; PG8_LDA(At, 1, 0); PG8_STAGE(PG8_SA(0, 1), a2 + hstep, voffA);
            PG8_WAIT_V(8); PG8_WAIT_L(0); PG8_BAR; PG8_MMA(0, 0, At, B0); PG8_MMA(0, 1, At, B1); PG8_BAR; PG8_SCHED;
            PG8_LDA(At, 1, 1); PG8_STAGE(PG8_SB(1, 0), b3, voffB); PG8_STAGE(PG8_SB(1, 1), b3 + hstep, voffB); PG8_STAGE(PG8_SA(1, 0), a3, voffA);
            PG8_WAIT_V(8); PG8_WAIT_L(0); PG8_BAR; PG8_MMA(1, 0, At, B0); PG8_MMA(1, 1, At, B1); PG8_BAR; PG8_SCHED;
            } else {
            PG8_LDB(B0, 0, 0); PG8_SCHED; PG8_LDA(At, 0, 0); PG8_STAGE(PG8_SA(1, 1), a1 + hstep, voffA);
            PG8_WAIT_L(8); PG8_BAR; PG8_WAIT_L(0); PG8_MMA(0, 0, At, B0); PG8_BAR; PG8_SCHED;
            PG8_LDB(B1, 0, 1); PG8_STAGE(PG8_SB(0, 0), b2, voffB);
            PG8_BAR; PG8_WAIT_L(0); PG8_MMA(0, 1, At, B1); PG8_BAR;
            PG8_LDA(At, 0, 1); PG8_STAGE(PG8_SA(0, 0), a2, voffA);
            PG8_BAR; PG8_WAIT_L(0); PG8_MMA(1, 0, At, B0); PG8_BAR; PG8_SCHED;
            PG8_STAGE(PG8_SB(0, 1), b2 + hstep, voffB);
            PG8_WAIT_V(6); PG8_BAR; PG8_MMA(1, 1, At, B1); PG8_BAR;
            PG8_LDB(B0, 1, 0); PG8_SCHED; PG8_LDA(At, 1, 0); PG8_STAGE(PG8_SA(0, 1), a2 + hstep, voffA);
            PG8_WAIT_L(8); PG8_BAR; PG8_WAIT_L(0); PG8_MMA(0, 0, At, B0); PG8_BAR; PG8_SCHED;
            PG8_LDB(B1, 1, 1); PG8_STAGE(PG8_SB(1, 0), b3, voffB);
            PG8_BAR; PG8_WAIT_L(0); PG8_MMA(0, 1, At, B1); PG8_BAR;
            PG8_LDA(At, 1, 1); PG8_STAGE(PG8_SA(1, 0), a3, voffA);
            PG8_BAR; PG8_WAIT_L(0); PG8_MMA(1, 0, At, B0); PG8_BAR; PG8_SCHED;
            PG8_STAGE(PG8_SB(1, 1), b3 + hstep, voffB);
            PG8_WAIT_V(6); PG8_BAR; PG8_MMA(1, 1, At, B1); PG8_BAR;
            }
        }
        if constexpr (ALIGN_EPI) { if (wr == 0) PG8_BAR; }
        if constexpr (!Epi::AFTER_DRAIN) { E(acc, cur, wr, wc, fr, fq); S.done(cur); }
        if (!has_next) break;
#pragma unroll
        for (int a = 0; a < 2; ++a)
#pragma unroll
            for (int b = 0; b < 2; ++b)
#pragma unroll
                for (int m = 0; m < 4; ++m)
#pragma unroll
                    for (int n = 0; n < 2; ++n) acc[a][b][m][n] = (f32x4){0.f, 0.f, 0.f, 0.f};
        cur = nxt; cA = nA; cB = nB; ++ui;
        if constexpr (ALIGN_EPI) { if (wr == 1) PG8_BAR; }
    }
    PG8_WAIT_V(0);
    if constexpr (!ALIGN_EPI) { if (wr == 0) PG8_BAR; }
    PG8_BAR;
    if constexpr (Epi::AFTER_DRAIN) { E.fused(acc, cur, wr, wc, fr, fq, lds, wid, lane); S.done(cur); }
#undef PG8_SA
#undef PG8_SB
#undef PG8_STAGE
#undef PG8_LDA
#undef PG8_LDB
#undef PG8_MMA
#undef PG8_WAIT_V
#undef PG8_WAIT_L
#undef PG8_BAR
#undef PG8_SCHED
}
}

namespace pg8 {
struct EpiStoreBf16 {
    static constexpr bool PERM = true, AFTER_DRAIN = false;
    bf16_t* O; int ldc; float s01, s67;
    __device__ __forceinline__ void operator()(const f32x4 (&acc)[2][2][4][2], const Unit& u, int wr, int wc, int fr, int fq) const {
        const int row0 = u.pm * BM + wr * 64 + fr, col0 = u.pn * BM + wc * 32 + 8 * fq;
        const float sc = u.pn < 2 ? s01 : ((u.pn == 6 || u.pn == 7) ? s67 : 1.f);
#pragma unroll
        for (int ai = 0; ai < 2; ++ai)
#pragma unroll
            for (int m = 0; m < 4; ++m) { bf16_t* rowp = O + (size_t)(row0 + ai * HALF + m * 16) * ldc + col0;
#pragma unroll
                for (int bj = 0; bj < 2; ++bj) { const f32x4 v0 = acc[ai][bj][m][0] * sc, v1 = acc[ai][bj][m][1] * sc;
                    u32x4 w; w.x = cvt_pk_bf16(v0[0], v0[1]); w.y = cvt_pk_bf16(v0[2], v0[3]); w.z = cvt_pk_bf16(v1[0], v1[1]); w.w = cvt_pk_bf16(v1[2], v1[3]);
                    *(u32x4*)(rowp + bj * HALF) = w; } }
    }
};
struct EpiStoreF32 {
    static constexpr bool PERM = true, AFTER_DRAIN = false;
    float* C; int ldc;
    __device__ __forceinline__ void operator()(const f32x4 (&acc)[2][2][4][2], const Unit& u, int wr, int wc, int fr, int fq) const {
        const int row0 = u.pm * BM + wr * 64 + fr, col0 = u.pn * BM + wc * 32 + 8 * fq;
#pragma unroll
        for (int ai = 0; ai < 2; ++ai)
#pragma unroll
            for (int m = 0; m < 4; ++m) { float* rowp = C + (size_t)(row0 + ai * HALF + m * 16) * ldc + col0;
#pragma unroll
                for (int bj = 0; bj < 2; ++bj) { *(f32x4*)(rowp + bj * HALF) = acc[ai][bj][m][0]; *(f32x4*)(rowp + bj * HALF + 4) = acc[ai][bj][m][1]; } }
    }
};
}

__device__ __forceinline__ void transpose_item(const float* W, int ldw, int K, int ncols, bf16_t* WT, float* scr, int item, int lane) {
    const int nblk = ncols / 32, kb = item / nblk, nb = item % nblk, k0 = 64 * kb, n0 = 32 * nb;
#pragma unroll 8
    for (int i = 0; i < 32; ++i) { const int kk = 2 * i + (lane >> 5); scr[kk * 33 + (lane & 31)] = W[(size_t)(k0 + kk) * ldw + n0 + (lane & 31)]; }
    asm volatile("s_waitcnt lgkmcnt(0)" ::: "memory");
    const int c = lane & 7;
#pragma unroll
    for (int j = 0; j < 4; ++j) { const int n = (lane >> 3) + 8 * j; const float* s = scr + (8 * c) * 33 + n;
        uint4 o; o.x = pk2(s[0 * 33], s[1 * 33]); o.y = pk2(s[2 * 33], s[3 * 33]); o.z = pk2(s[4 * 33], s[5 * 33]); o.w = pk2(s[6 * 33], s[7 * 33]);
        *(uint4*)(WT + (size_t)(n0 + n) * K + k0 + 8 * c) = o; }
    asm volatile("s_waitcnt lgkmcnt(0)" ::: "memory");
}
__device__ __forceinline__ void cvt_rows_bf16(const Ctx& c, const float* src, bf16_t* dst, size_t n8) {
    for (size_t i = (size_t)c.gwave * 64 + c.lane; i < n8; i += (size_t)c.nwaves * 64) {
        const float4 a = *(const float4*)(src + i * 8), b = *(const float4*)(src + i * 8 + 4);
        uint4 o; o.x = pk2(a.x, a.y); o.y = pk2(a.z, a.w); o.z = pk2(b.x, b.y); o.w = pk2(b.z, b.w);
        *(uint4*)(dst + i * 8) = o;
    }
}

template <int DQ, class BiasF>
__device__ __forceinline__ void causal_softmax_row(const float (&q)[DQ], const bf16_t* kbase, const bf16_t* vbase, int ld, int t, int smax, float scale, BiasF biasf, float (&O)[64]) {
    float m = -INFINITY;
    for (int s = 0; s <= smax; ++s) {
        const bf16_t* kr = kbase + (size_t)s * ld;
        float d = 0.f;
#pragma unroll
        for (int i = 0; i < DQ; ++i) d = fmaf(q[i], bf2f(kr[i]), d);
        const float lg = d * scale + biasf(s);
        m = (s <= t) ? fmaxf(m, lg) : m;
    }
    float l = 0.f;
#pragma unroll
    for (int i = 0; i < 64; ++i) O[i] = 0.f;
    for (int s = 0; s <= smax; ++s) {
        const bf16_t* kr = kbase + (size_t)s * ld;
        const bf16_t* vr = vbase + (size_t)s * ld;
        float d = 0.f;
#pragma unroll
        for (int i = 0; i < DQ; ++i) d = fmaf(q[i], bf2f(kr[i]), d);
        const float lg = d * scale + biasf(s);
        const float p = (s <= t) ? expf(lg - m) : 0.f;
        l += p;
#pragma unroll
        for (int i = 0; i < 64; ++i) O[i] = fmaf(p, bf2f(vr[i]), O[i]);
    }
    const float inv = 1.f / l;
#pragma unroll
    for (int i = 0; i < 64; ++i) O[i] *= inv;
}
__device__ __forceinline__ void store_row64_bf16(bf16_t* orow, const float (&v)[64]) {
#pragma unroll
    for (int i = 0; i < 64; i += 8) { uint4 o; o.x = pk2(v[i], v[i + 1]); o.y = pk2(v[i + 2], v[i + 3]); o.z = pk2(v[i + 4], v[i + 5]); o.w = pk2(v[i + 6], v[i + 7]); *(uint4*)(orow + i) = o; }
}

__device__ __forceinline__ void fg_phase(const Ctx& c, const bf16_t* hin, const float* cd_in, float* fg) {
    for (int t = c.gwave; t < NT; t += c.nwaves) {
        float acc[8];
#pragma unroll
        for (int j = 0; j < 8; ++j) acc[j] = 0.f;
        for (int r = 0; r < 16; ++r) {
            const int d = r * 64 + c.lane;
            const float xv = bf2f(hin[(size_t)t * DM + d]);
            const float4 w0 = *(const float4*)(cd_in + (size_t)d * CD_IN + 3072), w1 = *(const float4*)(cd_in + (size_t)d * CD_IN + 3076);
            acc[0] = fmaf(xv, w0.x, acc[0]); acc[1] = fmaf(xv, w0.y, acc[1]); acc[2] = fmaf(xv, w0.z, acc[2]); acc[3] = fmaf(xv, w0.w, acc[3]);
            acc[4] = fmaf(xv, w1.x, acc[4]); acc[5] = fmaf(xv, w1.y, acc[5]); acc[6] = fmaf(xv, w1.z, acc[6]); acc[7] = fmaf(xv, w1.w, acc[7]);
        }
#pragma unroll
        for (int j = 0; j < 8; ++j) acc[j] = wave_sum(acc[j]);
        if (c.lane == 0) { *(float4*)(fg + (size_t)t * 8) = make_float4(acc[0], acc[1], acc[2], acc[3]); *(float4*)(fg + (size_t)t * 8 + 4) = make_float4(acc[4], acc[5], acc[6], acc[7]); }
    }
}
__device__ __forceinline__ void fscan_naive(const Ctx& c, const float* fg, float* F, const float* bf) {
    for (int task = c.gwave; task < 32; task += c.nwaves) {
        const int b = task >> 3, h = task & 7;
        const int lane = c.lane;
        float v[64]; float tot = 0.f;
#pragma unroll
        for (int i = 0; i < 64; ++i) { const int s = lane * 64 + i; v[i] = log_sigmoid(fg[((size_t)b * SEQ + s) * 8 + h] + bf[h]); tot += v[i]; }
        float incl = tot;
#pragma unroll
        for (int o = 1; o < 64; o <<= 1) { const float n = __shfl_up(incl, o); if (lane >= o) incl += n; }
        float run = incl - tot;
#pragma unroll
        for (int i = 0; i < 64; ++i) { run += v[i]; F[(size_t)task * SEQ + lane * 64 + i] = run; }
    }
}

namespace att {
typedef short bf16x8 __attribute__((ext_vector_type(8)));
typedef short s16x4 __attribute__((ext_vector_type(4)));
typedef float f32x16 __attribute__((ext_vector_type(16)));
typedef float f32x4 __attribute__((ext_vector_type(4)));
typedef short v4i16_t __attribute__((ext_vector_type(4)));
constexpr float LOG2E = 1.4426950408889634f;
constexpr float NEG = -1e30f;
constexpr int KBUF = 0, VBUF = 16384, FBUF = 32768, TBUF = 33792, CNT = 34816;

__device__ __forceinline__ int tile_off(int row, int ch) { return 1024 * (row >> 3) + 512 * (ch >> 2) + 64 * (row & 7) + 16 * ((ch & 3) ^ ((row >> 2) & 3)); }
__device__ __forceinline__ s16x4 vtr(const LAS unsigned char* p) { return __builtin_bit_cast(s16x4, __builtin_amdgcn_ds_read_tr16_b64_v4i16((LAS v4i16_t*)p)); }
typedef float f32x2_t __attribute__((ext_vector_type(2))); typedef __bf16 bf16x2_t __attribute__((ext_vector_type(2)));
__device__ __forceinline__ unsigned cvtpk(float lo, float hi) { f32x2_t v = {lo, hi}; bf16x2_t b = __builtin_convertvector(v, bf16x2_t); return __builtin_bit_cast(unsigned, b); }
__device__ __forceinline__ float xhalf(float v) { return __shfl_xor(v, 32); }
__device__ __forceinline__ int key_of(int i, int hh) { return 8 * (i >> 2) + 4 * hh + (i & 3); }

__device__ __forceinline__ bf16x8 pfrag(const f32x16& p, int ks2) {
    unsigned w[4];
#pragma unroll
    for (int j = 0; j < 4; ++j) w[j] = cvtpk(p[8 * ks2 + 2 * j], p[8 * ks2 + 2 * j + 1]);
    typedef unsigned u32x4 __attribute__((ext_vector_type(4)));
    u32x4 v = {w[0], w[1], w[2], w[3]};
    return __builtin_bit_cast(bf16x8, v);
}
__device__ __forceinline__ void pv_block(f32x16 (&O)[2], const LAS unsigned char* vbuf, int kb, const f32x16& p, int lane) {
    const int hh = lane >> 5, q_ = (lane & 15) >> 2, p_ = lane & 3, cg = (lane >> 4) & 1;
#pragma unroll
    for (int ks2 = 0; ks2 < 2; ++ks2) {
        const bf16x8 pb = pfrag(p, ks2);
#pragma unroll
        for (int db = 0; db < 2; ++db) {
            const int c0 = 32 * db + 16 * cg, ch = (c0 >> 3) + (p_ >> 1);
            const int r0 = 32 * kb + 16 * ks2 + 4 * hh;
            const s16x4 a0 = vtr(vbuf + tile_off(r0 + q_, ch) + 8 * (p_ & 1));
            const s16x4 a1 = vtr(vbuf + tile_off(r0 + 8 + q_, ch) + 8 * (p_ & 1));
            const bf16x8 a = {a0[0], a0[1], a0[2], a0[3], a1[0], a1[1], a1[2], a1[3]};
            O[db] = __builtin_amdgcn_mfma_f32_32x32x16_bf16(a, pb, O[db], 0, 0, 0);
        }
    }
}
template <int S0, int NS>
__device__ __forceinline__ f32x16 qk_block(const LAS unsigned char* kbuf, int kb, const bf16x8 (&Qf)[4], int lane) {
    const int r = lane & 31, hh = lane >> 5;
    f32x16 s = {0.f, 0.f, 0.f, 0.f, 0.f, 0.f, 0.f, 0.f, 0.f, 0.f, 0.f, 0.f, 0.f, 0.f, 0.f, 0.f};
#pragma unroll
    for (int ks = S0; ks < S0 + NS; ++ks) {
        const bf16x8 a = *(const LAS bf16x8*)(kbuf + tile_off(32 * kb + r, 2 * ks + hh));
        s = __builtin_amdgcn_mfma_f32_32x32x16_bf16(a, Qf[ks], s, 0, 0, 0);
    }
    return s;
}
__device__ __forceinline__ void softmax_step(f32x16& x, float& m, float& l, f32x16 (&O)[2]) {
    float mx = x[0];
#pragma unroll
    for (int i = 1; i < 16; ++i) mx = fmaxf(mx, x[i]);
    mx = fmaxf(mx, xhalf(mx));
    const float mn = fmaxf(m, mx);
    if (!__all(mn == m)) {
        const float alpha = __builtin_amdgcn_exp2f(m - mn);
        l *= alpha;
#pragma unroll
        for (int i = 0; i < 16; ++i) { O[0][i] *= alpha; O[1][i] *= alpha; }
        m = mn;
    }
    float ls = 0.f;
#pragma unroll
    for (int i = 0; i < 16; ++i) { x[i] = __builtin_amdgcn_exp2f(x[i] - m); ls += x[i]; }
    l += ls;
}
__device__ __forceinline__ void store_ot(bf16_t* orow, const f32x16 (&O)[2], int hh) {
#pragma unroll
    for (int db = 0; db < 2; ++db)
#pragma unroll
        for (int g = 0; g < 4; ++g) {
            const int d0 = 32 * db + 8 * g + 4 * hh;
            *(uint2*)(orow + d0) = make_uint2(cvtpk(O[db][4 * g], O[db][4 * g + 1]), cvtpk(O[db][4 * g + 2], O[db][4 * g + 3]));
        }
}

struct UnitArgs {
    const bf16_t* qkv;
    bf16_t* out;
    int qcol, kcol, vcol, ocol;
};

struct DilArgs { int dil, rho, pat; bf16_t* po; float* pml; };
template <int TYPE>
__device__ __forceinline__ void causal_unit(const UnitArgs& A, int b, int h, int qb, unsigned char* scratch, int tid,
                                            const float* t5  , float lam, const float* subg, const float* F  , const DilArgs DA = DilArgs{1, 0, 0, nullptr, nullptr}) {
    const LAS unsigned char* lds = (const LAS unsigned char*)scratch;
    LAS unsigned char* ldsw = (LAS unsigned char*)scratch;
    const int lane = tid & 63, w = tid >> 6, r = lane & 31, hh = lane >> 5;
    const int q0 = qb * 256 + 32 * w, tq = q0 + r;
    const size_t rowbase = (size_t)b * SEQ;
    const int ktmax = 4 * qb + 3, kdiag = 4 * qb + (w >> 1);
    const int ktmin = (TYPE == 2) ? (4 * qb - 2 > 0 ? 4 * qb - 2 : 0) : 0;
    const int rs = (TYPE == 2) ? DA.dil : 1, r0off = (TYPE == 2) ? DA.rho : 0;
    const int srow = tid >> 3, sch = tid & 7;
    const bf16_t* kg = A.qkv + (rowbase + r0off + (size_t)rs * srow) * QKV_W + A.kcol + h * 64 + sch * 8;
    const bf16_t* vg = A.qkv + (rowbase + r0off + (size_t)rs * srow) * QKV_W + A.vcol + h * 64 + sch * 8;
    const size_t tstep = (size_t)64 * rs * QKV_W;
    const int soff = tile_off(srow, sch);
    bf16x8 Qf[4];
    {
        const bf16_t* qr = A.qkv + (rowbase + r0off + (size_t)rs * tq) * QKV_W + A.qcol + h * 64 + 8 * hh;
#pragma unroll
        for (int s = 0; s < 4; ++s) Qf[s] = *(const bf16x8*)(qr + 16 * s);
    }
    __syncthreads();
    if ((TYPE == 0 || TYPE == 2) && tid < 128) {
        const float far = t5[31 * 8 + h];
        ((LAS float*)(ldsw + TBUF))[tid] = (t5[t5_bucket(tid) * 8 + h] - far) * LOG2E;
    }
    if (TYPE == 1 && tid == 0) *(LAS unsigned*)(ldsw + CNT) = 0u;
    typedef unsigned u32x4 __attribute__((ext_vector_type(4)));
    u32x4 kreg = *(const u32x4*)(kg + (size_t)ktmax * tstep), vreg = *(const u32x4*)(vg + (size_t)ktmax * tstep);
    float freg = 0.f;
    if (TYPE == 3 && tid < 64) freg = F[(size_t)(b * 8 + h) * SEQ + ktmax * 64 + tid] * LOG2E;
    *(LAS u32x4*)(ldsw + KBUF + soff) = kreg; *(LAS u32x4*)(ldsw + VBUF + soff) = vreg;
    if (TYPE == 3 && tid < 64) ((LAS float*)(ldsw + FBUF))[tid] = freg;
    __syncthreads();

    f32x16 O0[2], O1[2];
#pragma unroll
    for (int i = 0; i < 16; ++i) { O0[0][i] = 0.f; O0[1][i] = 0.f; O1[0][i] = 0.f; O1[1][i] = 0.f; }
    float m0 = NEG, l0 = 0.f, m1 = NEG, l1 = 0.f;
    float R = 0.f;
    bool wdone = false;
    float f2t = 0.f;
    if (TYPE == 3) f2t = F[(size_t)(b * 8 + h) * SEQ + tq] * LOG2E;

    for (int kt = ktmax, it = 0; kt >= ktmin; --kt, ++it) {
        const int cur = it & 1;
        if (kt > ktmin) {
            kreg = *(const u32x4*)(kg + (size_t)(kt - 1) * tstep); vreg = *(const u32x4*)(vg + (size_t)(kt - 1) * tstep);
            if (TYPE == 3 && tid < 64) freg = F[(size_t)(b * 8 + h) * SEQ + (kt - 1) * 64 + tid] * LOG2E;
        }
        const LAS unsigned char* kbuf = lds + KBUF + cur * 8192;
        const LAS unsigned char* vbuf = lds + VBUF + cur * 8192;
        if (kt <= kdiag && !wdone) {
#pragma unroll
            for (int kbi = 0; kbi < 2; ++kbi) {
                const int kb = 1 - kbi;
                const int key0 = kt * 64 + kb * 32;
                if (TYPE == 1 ? (key0 >= q0 + 31) : (key0 > q0 + 31)) continue;
                if (TYPE == 2 && key0 + 31 < q0 - 128) continue;
                const bool need_mask = (TYPE == 1) ? (key0 + 31 >= q0) : (key0 + 31 > q0);
                if (TYPE == 0) {
                    f32x16 x0 = qk_block<0, 2>(kbuf, kb, Qf, lane), x1 = qk_block<2, 2>(kbuf, kb, Qf, lane);
                    if (q0 - (key0 + 31) < 113) {
                        const LAS float* tb = (const LAS float*)(lds + TBUF);
#pragma unroll
                        for (int i = 0; i < 16; ++i) {
                            const int dist = tq - (key0 + key_of(i, hh));
                            const float bv = (dist >= 0 && dist < 128) ? tb[dist < 0 ? 0 : (dist > 127 ? 127 : dist)] : 0.f;
                            x0[i] = dist < 0 ? NEG : x0[i] + bv; x1[i] = dist < 0 ? NEG : x1[i] + bv;
                        }
                    }
                    softmax_step(x0, m0, l0, O0);
                    pv_block(O0, vbuf, kb, x0, lane);
                    softmax_step(x1, m1, l1, O1);
                    pv_block(O1, vbuf, kb, x1, lane);
                } else if (TYPE == 2) {
                    f32x16 x = qk_block<0, 4>(kbuf, kb, Qf, lane);
                    const LAS float* tb = (const LAS float*)(lds + TBUF);
#pragma unroll
                    for (int i = 0; i < 16; ++i) {
                        const int dist = tq - (key0 + key_of(i, hh));
                        int bi = dist * rs; bi = bi < 0 ? 0 : (bi > 127 ? 127 : bi);
                        x[i] = (dist >= 0 && dist <= 128) ? x[i] + tb[bi] : NEG;
                    }
                    softmax_step(x, m0, l0, O0);
                    pv_block(O0, vbuf, kb, x, lane);
                } else if (TYPE == 3) {
                    f32x16 x = qk_block<0, 4>(kbuf, kb, Qf, lane);
                    const LAS float* fb = (const LAS float*)(lds + FBUF + cur * 256);
#pragma unroll
                    for (int g = 0; g < 4; ++g) {
                        const f32x4 fv = *(const LAS f32x4*)(fb + 32 * kb + 8 * g + 4 * hh);
#pragma unroll
                        for (int j = 0; j < 4; ++j) x[4 * g + j] += f2t - fv[j];
                    }
                    if (need_mask) {
#pragma unroll
                        for (int i = 0; i < 16; ++i) x[i] = (key0 + key_of(i, hh) > tq) ? NEG : x[i];
                    }
                    softmax_step(x, m0, l0, O0);
                    pv_block(O0, vbuf, kb, x, lane);
                } else {
                    f32x16 z = qk_block<0, 4>(kbuf, kb, Qf, lane);
                    f32x16 lr;
#pragma unroll
                    for (int i = 0; i < 16; ++i) {
                        const float e = __builtin_amdgcn_exp2f(-fabsf(z[i]));
                        float v = -(fmaxf(z[i], 0.f) + __builtin_amdgcn_logf(1.f + e));
                        if (need_mask) v = (key0 + key_of(i, hh) >= tq) ? 0.f : v;
                        lr[i] = v;
                    }
                    float T[4], Tp[4], sfx[16];
#pragma unroll
                    for (int g = 0; g < 4; ++g) {
                        sfx[4 * g + 3] = 0.f; sfx[4 * g + 2] = lr[4 * g + 3]; sfx[4 * g + 1] = sfx[4 * g + 2] + lr[4 * g + 2]; sfx[4 * g] = sfx[4 * g + 1] + lr[4 * g + 1];
                        T[g] = sfx[4 * g] + lr[4 * g];
                        Tp[g] = xhalf(T[g]);
                    }
                    float SP[4];
                    SP[3] = 0.f; SP[2] = T[3] + Tp[3]; SP[1] = SP[2] + T[2] + Tp[2]; SP[0] = SP[1] + T[1] + Tp[1];
                    const float tot = SP[0] + T[0] + Tp[0];
                    const float msel = hh == 0 ? 1.f : 0.f;
#pragma unroll
                    for (int g = 0; g < 4; ++g) {
                        const float goff = R + SP[g] + msel * Tp[g];
#pragma unroll
                        for (int j = 0; j < 4; ++j) {
                            const int i = 4 * g + j;
                            float wv = __builtin_amdgcn_exp2f(lr[i] + z[i] + goff + sfx[i]);
                            if (need_mask) wv = (key0 + key_of(i, hh) >= tq) ? 0.f : wv;
                            z[i] = wv;
                        }
                    }
                    R += tot;
                    pv_block(O0, vbuf, kb, z, lane);
                }
            }
            if (TYPE == 1) {
                if (__all(R < -216.4f)) { wdone = true; if (lane == 0) (void)__hip_atomic_fetch_add((LAS unsigned*)(ldsw + CNT), 1u, __ATOMIC_RELAXED, __HIP_MEMORY_SCOPE_WORKGROUP); }
            }
        }
        if (kt > ktmin) {
            *(LAS u32x4*)(ldsw + KBUF + (cur ^ 1) * 8192 + soff) = kreg; *(LAS u32x4*)(ldsw + VBUF + (cur ^ 1) * 8192 + soff) = vreg;
            if (TYPE == 3 && tid < 64) ((LAS float*)(ldsw + FBUF + (cur ^ 1) * 256))[tid] = freg;
        }
        __syncthreads();
        if (TYPE == 1) { const unsigned cnt = *(const LAS unsigned*)(lds + CNT); __syncthreads(); if (cnt == 8u) break; }
    }
    if (TYPE == 2) {
        const size_t prow = ((size_t)DA.pat * NT + rowbase + r0off + (size_t)rs * tq) * 8 + h;
        store_ot(DA.po + prow * 64, O0, hh);
        const float lt = l0 + xhalf(l0);
        if (hh == 0) *(float2*)(DA.pml + prow * 2) = make_float2(m0, lt);
        return;
    }
    bf16_t* orow = A.out + (rowbase + tq) * DM + A.ocol + h * 64;
    if (TYPE == 0) {
        const float i0 = 1.f / (l0 + xhalf(l0)), i1 = lam / (l1 + xhalf(l1));
        float ss = 0.f;
#pragma unroll
        for (int db = 0; db < 2; ++db)
#pragma unroll
            for (int i = 0; i < 16; ++i) { const float o = O0[db][i] * i0 - O1[db][i] * i1; O0[db][i] = o; ss = fmaf(o, o, ss); }
        ss += xhalf(ss);
        const float rn = rsqrtf(ss * (1.f / 64.f) + LN_EPS) * 0.8f;
#pragma unroll
        for (int db = 0; db < 2; ++db)
#pragma unroll
            for (int i = 0; i < 16; ++i) O0[db][i] *= rn * subg[32 * db + key_of(i, hh)];
        store_ot(orow, O0, hh);
    } else if (TYPE == 3) {
        const float i0 = 1.f / (l0 + xhalf(l0));
#pragma unroll
        for (int db = 0; db < 2; ++db)
#pragma unroll
            for (int i = 0; i < 16; ++i) O0[db][i] *= i0;
        store_ot(orow, O0, hh);
    } else {
        store_ot(orow, O0, hh);
    }
}
}

__device__ __forceinline__ int xcd_perm256(int p) { return (p & 7) * 32 + (p >> 3); }

__device__ __forceinline__ void attn_layer0_mfma(const Ctx& c, const bf16_t* qkv, bf16_t* out, const float* t5, const float* lamv, const float* subg) {
    float s01 = 0.f, s23 = 0.f;
    for (int i = 0; i < 32; ++i) { s01 += lamv[i] * lamv[32 + i]; s23 += lamv[64 + i] * lamv[96 + i]; }
    const float lam = expf(s01) - expf(s23) + 0.2f;
    unsigned char* scratch = (unsigned char*)c.lds;
    const att::UnitArgs UA{qkv, out, 0, 512, 1024, 0}, UB{qkv, out, 1536, 2048, 2560, 512};
    for (int p = c.bid; p < 256; p += c.nblk) {
        const int pp = xcd_perm256(p), bh = pp >> 3, qb = pp & 7;
        att::causal_unit<0>(UA, bh >> 3, bh & 7, 15 - qb, scratch, c.tid, t5, lam, subg, nullptr);
        att::causal_unit<0>(UA, bh >> 3, bh & 7, qb, scratch, c.tid, t5, lam, subg, nullptr);
#pragma unroll 1
        for (int k = 0; k < 2; ++k) {
            const int u = pp * 2 + k, bh2 = u >> 4, qb2 = u & 15;
            att::causal_unit<1>(UB, bh2 >> 3, bh2 & 7, qb2, scratch, c.tid, nullptr, 0.f, nullptr, nullptr);
        }
    }
}
__device__ __forceinline__ void attn_dilated_mfma(const Ctx& c, const bf16_t* qkv, const float* t5, bf16_t* po, float* pml) {
    unsigned char* scratch = (unsigned char*)c.lds;
    const att::UnitArgs UC{qkv, nullptr, 0, 512, 1024, 0};
    for (int p = c.bid; p < 256; p += c.nblk) {
        const int pp = xcd_perm256(p);
#pragma unroll 1
        for (int k = 0; k < 6; ++k) {
            const int u = pp * 6 + k, bh = u / 48, v = u % 48;
            int pat, rho, qb, dil;
            if (v < 16) { pat = 0; dil = 1; rho = 0; qb = v; }
            else if (v < 32) { pat = 1; dil = 4; rho = (v - 16) >> 2; qb = (v - 16) & 3; }
            else { pat = 2; dil = 16; rho = v - 32; qb = 0; }
            att::causal_unit<2>(UC, bh >> 3, bh & 7, qb, scratch, c.tid, t5, 0.f, nullptr, nullptr, att::DilArgs{dil, rho, pat, po, pml});
        }
    }
}
__device__ __forceinline__ void dilated_combine(const Ctx& c, const bf16_t* po, const float* pml, bf16_t* out) {
    const size_t n = (size_t)NT * 8 * 8;
    for (size_t i = (size_t)c.gwave * 64 + c.lane; i < n; i += (size_t)c.nwaves * 64) {
        const size_t th = i >> 3; const int ch = (int)(i & 7);
        float m[3], l[3];
#pragma unroll
        for (int p = 0; p < 3; ++p) { const float2 ml = *(const float2*)(pml + ((size_t)p * NT * 8 + th) * 2); m[p] = ml.x; l[p] = ml.y; }
        const float mm = fmaxf(m[0], fmaxf(m[1], m[2]));
        float wgt[3], den = 0.f;
#pragma unroll
        for (int p = 0; p < 3; ++p) { wgt[p] = __builtin_amdgcn_exp2f(m[p] - mm); den += wgt[p] * l[p]; }
        const float inv = 1.f / den;
        float o[8];
#pragma unroll
        for (int d = 0; d < 8; ++d) o[d] = 0.f;
#pragma unroll
        for (int p = 0; p < 3; ++p) {
            const uint4 v = *(const uint4*)(po + ((size_t)p * NT * 8 + th) * 64 + ch * 8);
            const unsigned w4[4] = {v.x, v.y, v.z, v.w};
#pragma unroll
            for (int q = 0; q < 4; ++q) { o[2 * q] = fmaf(wgt[p], __builtin_bit_cast(float, w4[q] << 16), o[2 * q]); o[2 * q + 1] = fmaf(wgt[p], __builtin_bit_cast(float, w4[q] & 0xffff0000u), o[2 * q + 1]); }
        }
        uint4 ov; ov.x = pk2(o[0] * inv, o[1] * inv); ov.y = pk2(o[2] * inv, o[3] * inv); ov.z = pk2(o[4] * inv, o[5] * inv); ov.w = pk2(o[6] * inv, o[7] * inv);
        const size_t tok = th >> 3; const int hd = (int)(th & 7);
        *(uint4*)(out + tok * DM + hd * 64 + ch * 8) = ov;
    }
}
__device__ __forceinline__ void attn_fox_mfma(const Ctx& c, const bf16_t* qkv, const float* F, bf16_t* out) {
    unsigned char* scratch = (unsigned char*)c.lds;
    const att::UnitArgs UD{qkv, out, 1536, 2048, 2560, 512};
    for (int p = c.bid; p < 256; p += c.nblk) {
        const int pp = xcd_perm256(p), bh = pp >> 3, qb = pp & 7;
        att::causal_unit<3>(UD, bh >> 3, bh & 7, 15 - qb, scratch, c.tid, nullptr, 0.f, nullptr, F);
        att::causal_unit<3>(UD, bh >> 3, bh & 7, qb, scratch, c.tid, nullptr, 0.f, nullptr, F);
    }
}

__device__ __forceinline__ void ln_rows(const Ctx& c, const float* hin32, const bf16_t* hin16, const float* add, const float* g, const float* bta, float* out, bf16_t* outb, unsigned char* out8 = nullptr, float* oscale = nullptr) {
    for (int t = c.gwave; t < NT; t += c.nwaves) {
        float v[16];
        float s = 0.f;
#pragma unroll
        for (int r = 0; r < 4; ++r) {
            const int d = r * 256 + c.lane * 4;
            float4 a;
            if (hin32) a = *(const float4*)(hin32 + (size_t)t * DM + d);
            else { const uint2 w = *(const uint2*)(hin16 + (size_t)t * DM + d); a = make_float4(__builtin_bit_cast(float, w.x << 16), __builtin_bit_cast(float, w.x & 0xffff0000u), __builtin_bit_cast(float, w.y << 16), __builtin_bit_cast(float, w.y & 0xffff0000u)); }
            const float4 m = *(const float4*)(add + (size_t)t * DM + d);
            v[r * 4 + 0] = DN_ALPHA * a.x + m.x; v[r * 4 + 1] = DN_ALPHA * a.y + m.y; v[r * 4 + 2] = DN_ALPHA * a.z + m.z; v[r * 4 + 3] = DN_ALPHA * a.w + m.w;
            s += v[r * 4] + v[r * 4 + 1] + v[r * 4 + 2] + v[r * 4 + 3];
        }
        const float mu = wave_sum(s) * (1.f / DM);
        float q = 0.f;
#pragma unroll
        for (int i = 0; i < 16; ++i) { v[i] -= mu; q = fmaf(v[i], v[i], q); }
        const float rs = rsqrtf(wave_sum(q) * (1.f / DM) + LN_EPS);
        float amax = 0.f;
#pragma unroll
        for (int r = 0; r < 4; ++r) {
            const int d = r * 256 + c.lane * 4;
            const float4 gg = *(const float4*)(g + d), bb = *(const float4*)(bta + d);
            const float4 o = make_float4(v[r * 4] * rs * gg.x + bb.x, v[r * 4 + 1] * rs * gg.y + bb.y, v[r * 4 + 2] * rs * gg.z + bb.z, v[r * 4 + 3] * rs * gg.w + bb.w);
            if (out) *(float4*)(out + (size_t)t * DM + d) = o;
            if (outb) *(uint2*)(outb + (size_t)t * DM + d) = make_uint2(pk2(o.x, o.y), pk2(o.z, o.w));
            v[r * 4] = o.x; v[r * 4 + 1] = o.y; v[r * 4 + 2] = o.z; v[r * 4 + 3] = o.w;
            amax = fmaxf(amax, fmaxf(fmaxf(fabsf(o.x), fabsf(o.y)), fmaxf(fabsf(o.z), fabsf(o.w))));
        }
        if (out8) {
#pragma unroll
            for (int o = 32; o >= 1; o >>= 1) amax = fmaxf(amax, __shfl_xor(amax, o));
            int e = (int)((__builtin_bit_cast(unsigned, amax) >> 23) & 0xffu) - 127;
            e = e < -100 ? -100 : (e > 100 ? 100 : e);
            const float sc = __builtin_bit_cast(float, (unsigned)(127 + 7 - e) << 23);
#pragma unroll
            for (int r = 0; r < 4; ++r) {
                int w = 0;
                w = __builtin_amdgcn_cvt_pk_fp8_f32(v[r * 4] * sc, v[r * 4 + 1] * sc, w, false); w = __builtin_amdgcn_cvt_pk_fp8_f32(v[r * 4 + 2] * sc, v[r * 4 + 3] * sc, w, true);
                *(int*)(out8 + (size_t)t * DM + r * 256 + c.lane * 4) = w;
            }
            if (c.lane == 0) oscale[t] = __builtin_bit_cast(float, (unsigned)(127 - 7 + e) << 23);
        }
    }
}

__device__ __forceinline__ void topk_insert(float (&tv)[16], int (&ti)[16], float v, int id) {
#pragma unroll
    for (int j = 15; j >= 1; --j) {
        const bool g = v > tv[j], gp = v > tv[j - 1];
        tv[j] = g ? (gp ? tv[j - 1] : v) : tv[j];
        ti[j] = g ? (gp ? ti[j - 1] : id) : ti[j];
    }
    const bool g0 = v > tv[0];
    tv[0] = g0 ? v : tv[0]; ti[0] = g0 ? id : ti[0];
}

namespace rt {
typedef short bf16x8 __attribute__((ext_vector_type(8)));
typedef float f32x16 __attribute__((ext_vector_type(16)));
__device__ __forceinline__ void ins_packed(float (&tv)[16], float v) {
#pragma unroll
    for (int j = 15; j >= 1; --j) { const bool g = v > tv[j], gp = v > tv[j - 1]; tv[j] = g ? (gp ? tv[j - 1] : v) : tv[j]; }
    tv[0] = v > tv[0] ? v : tv[0];
}
__device__ __forceinline__ float pk_idx(float v, int idx) { return __builtin_bit_cast(float, (__builtin_bit_cast(unsigned, v) & ~127u) | (unsigned)idx); }
__device__ __forceinline__ float pk_val(float p) { return __builtin_bit_cast(float, __builtin_bit_cast(unsigned, p) & ~127u); }
__device__ __forceinline__ int pk_id(float p) { return (int)(__builtin_bit_cast(unsigned, p) & 127u); }

__device__ __forceinline__ void top16_of_set(float (&tv)[16], const bf16_t* pq_row  , const bf16_t* keys  , int r, int hh) {
    bf16x8 B[8];
#pragma unroll
    for (int s = 0; s < 8; ++s) B[s] = *(const bf16x8*)(pq_row + 16 * s);
#pragma unroll
    for (int j = 0; j < 16; ++j) tv[j] = -INFINITY;
#pragma unroll 1
    for (int blk = 0; blk < 4; ++blk) {
        const bf16_t* kr = keys + (size_t)(32 * blk + r) * 128 + 8 * hh;
        f32x16 acc = {0.f, 0.f, 0.f, 0.f, 0.f, 0.f, 0.f, 0.f, 0.f, 0.f, 0.f, 0.f, 0.f, 0.f, 0.f, 0.f};
#pragma unroll
        for (int s = 0; s < 8; ++s) acc = __builtin_amdgcn_mfma_f32_32x32x16_bf16(*(const bf16x8*)(kr + 16 * s), B[s], acc, 0, 0, 0);
#pragma unroll
        for (int i = 0; i < 16; ++i) ins_packed(tv, pk_idx(acc[i], 32 * blk + 8 * (i >> 2) + 4 * hh + (i & 3)));
    }
    float pt[16];
#pragma unroll
    for (int j = 0; j < 16; ++j) pt[j] = __shfl_xor(tv[j], 32);
#pragma unroll
    for (int j = 0; j < 16; ++j) ins_packed(tv, pt[j]);
}
}

__device__ __forceinline__ void peer_route_phase(const Ctx& c, const bf16_t* pq, const bf16_t* subk  , int* eidx, float* gate) {
    const int lane = c.lane, r = lane & 31, hh = lane >> 5;
    for (int task = c.gwave; task < (NT / 32) * 8; task += c.nwaves) {
        const int h = task & 7, t = (task >> 3) * 32 + r;
        float la[16], lb[16];
        rt::top16_of_set(la, pq + (size_t)t * PEER_QW + (2 * h) * 128 + 8 * hh, subk + (size_t)(2 * h) * 128 * 128, r, hh);
        rt::top16_of_set(lb, pq + (size_t)t * PEER_QW + (2 * h + 1) * 128 + 8 * hh, subk + (size_t)(2 * h + 1) * 128 * 128, r, hh);
        float tv[16]; int ti[16];
#pragma unroll
        for (int j = 0; j < 16; ++j) { tv[j] = -INFINITY; ti[j] = 0; }
#pragma unroll
        for (int i = 0; i < 16; ++i) {
            const float av = rt::pk_val(la[i]); const int ai = rt::pk_id(la[i]) * 128;
#pragma unroll
            for (int j = 0; j < 16 / (i + 1); ++j) topk_insert(tv, ti, av + rt::pk_val(lb[j]), ai + rt::pk_id(lb[j]));
        }
        float sum = 0.f, e[16];
#pragma unroll
        for (int j = 0; j < 16; ++j) { e[j] = expf(tv[j] - tv[0]); sum += e[j]; }
        const float inv = 1.f / sum;
        if (hh == 0) {
            int* oi = eidx + ((size_t)t * 8 + h) * 16; float* og = gate + ((size_t)t * 8 + h) * 16;
#pragma unroll
            for (int j = 0; j < 16; j += 4) {
                *(int4*)(oi + j) = make_int4(ti[j], ti[j + 1], ti[j + 2], ti[j + 3]);
                *(float4*)(og + j) = make_float4(e[j] * inv, e[j + 1] * inv, e[j + 2] * inv, e[j + 3] * inv);
            }
        }
    }
}

typedef unsigned u32x4_t __attribute__((ext_vector_type(4)));
typedef float f32x2_t __attribute__((ext_vector_type(2)));
#define GAS __attribute__((address_space(1)))
__device__ __forceinline__ float gelu_exact(float d) { return 0.5f * d * (1.f + erff(d * 0.70710678118654752f)); }

template <int MODE>
__device__ __forceinline__ void cvt_rows_fp8(const Ctx& c, const float* src, unsigned char* dst, float* rowscale, int nrows) {
    for (int row = c.gwave; row < nrows; row += c.nwaves) {
        const float* s = src + (size_t)row * DM + c.lane * 16;
        const float4 a0 = *(const float4*)s, a1 = *(const float4*)(s + 4), a2 = *(const float4*)(s + 8), a3 = *(const float4*)(s + 12);
        float am = fmaxf(fmaxf(fmaxf(fabsf(a0.x), fabsf(a0.y)), fmaxf(fabsf(a0.z), fabsf(a0.w))), fmaxf(fmaxf(fabsf(a1.x), fabsf(a1.y)), fmaxf(fabsf(a1.z), fabsf(a1.w))));
        am = fmaxf(am, fmaxf(fmaxf(fmaxf(fabsf(a2.x), fabsf(a2.y)), fmaxf(fabsf(a2.z), fabsf(a2.w))), fmaxf(fmaxf(fabsf(a3.x), fabsf(a3.y)), fmaxf(fabsf(a3.z), fabsf(a3.w)))));
#pragma unroll
        for (int o = 32; o >= 1; o >>= 1) am = fmaxf(am, __shfl_xor(am, o));
        int e = (int)((__builtin_bit_cast(unsigned, am) >> 23) & 0xffu) - 127;
        e = e < -100 ? -100 : (e > 100 ? 100 : e);
        const float sc = __builtin_bit_cast(float, (unsigned)(127 + 7 - e) << 23), inv = __builtin_bit_cast(float, (unsigned)(127 - 7 + e) << 23);
        int w0 = 0, w1 = 0, w2 = 0, w3 = 0;
        w0 = __builtin_amdgcn_cvt_pk_fp8_f32(a0.x * sc, a0.y * sc, w0, false); w0 = __builtin_amdgcn_cvt_pk_fp8_f32(a0.z * sc, a0.w * sc, w0, true);
        w1 = __builtin_amdgcn_cvt_pk_fp8_f32(a1.x * sc, a1.y * sc, w1, false); w1 = __builtin_amdgcn_cvt_pk_fp8_f32(a1.z * sc, a1.w * sc, w1, true);
        w2 = __builtin_amdgcn_cvt_pk_fp8_f32(a2.x * sc, a2.y * sc, w2, false); w2 = __builtin_amdgcn_cvt_pk_fp8_f32(a2.z * sc, a2.w * sc, w2, true);
        w3 = __builtin_amdgcn_cvt_pk_fp8_f32(a3.x * sc, a3.y * sc, w3, false); w3 = __builtin_amdgcn_cvt_pk_fp8_f32(a3.z * sc, a3.w * sc, w3, true);
        const int lyr = row >> 14, er = row & 16383;
        unsigned char* dp = MODE == 0 ? dst + ((size_t)lyr * 16384 + (size_t)(er & 7) * 2048 + (er >> 3)) * DM + c.lane * 16
                                      : dst + (size_t)lyr * 16384 * DM + (size_t)(c.lane >> 3) * (16384 * 128) + (size_t)er * 128 + (c.lane & 7) * 16;
        *(uint4*)dp = make_uint4((unsigned)w0, (unsigned)w1, (unsigned)w2, (unsigned)w3);
        if (c.lane == 0) rowscale[row] = inv;
    }
}
__device__ __forceinline__ float dot16_fp8(const u32x4_t w, const float (&x)[16], float acc) {
    const int w0 = (int)w.x, w1 = (int)w.y, w2 = (int)w.z, w3 = (int)w.w;
    f32x2_t p;
    p = __builtin_amdgcn_cvt_pk_f32_fp8(w0, false); acc = fmaf(p.x, x[0], acc); acc = fmaf(p.y, x[1], acc);
    p = __builtin_amdgcn_cvt_pk_f32_fp8(w0, true);  acc = fmaf(p.x, x[2], acc); acc = fmaf(p.y, x[3], acc);
    p = __builtin_amdgcn_cvt_pk_f32_fp8(w1, false); acc = fmaf(p.x, x[4], acc); acc = fmaf(p.y, x[5], acc);
    p = __builtin_amdgcn_cvt_pk_f32_fp8(w1, true);  acc = fmaf(p.x, x[6], acc); acc = fmaf(p.y, x[7], acc);
    p = __builtin_amdgcn_cvt_pk_f32_fp8(w2, false); acc = fmaf(p.x, x[8], acc); acc = fmaf(p.y, x[9], acc);
    p = __builtin_amdgcn_cvt_pk_f32_fp8(w2, true);  acc = fmaf(p.x, x[10], acc); acc = fmaf(p.y, x[11], acc);
    p = __builtin_amdgcn_cvt_pk_f32_fp8(w3, false); acc = fmaf(p.x, x[12], acc); acc = fmaf(p.y, x[13], acc);
    p = __builtin_amdgcn_cvt_pk_f32_fp8(w3, true);  acc = fmaf(p.x, x[14], acc); acc = fmaf(p.y, x[15], acc);
    return acc;
}
__device__ __forceinline__ void axpy16_fp8(const u32x4_t w, float cv, float (&acc)[16]) {
    const int w0 = (int)w.x, w1 = (int)w.y, w2 = (int)w.z, w3 = (int)w.w;
    f32x2_t p;
    p = __builtin_amdgcn_cvt_pk_f32_fp8(w0, false); acc[0] = fmaf(cv, p.x, acc[0]); acc[1] = fmaf(cv, p.y, acc[1]);
    p = __builtin_amdgcn_cvt_pk_f32_fp8(w0, true);  acc[2] = fmaf(cv, p.x, acc[2]); acc[3] = fmaf(cv, p.y, acc[3]);
    p = __builtin_amdgcn_cvt_pk_f32_fp8(w1, false); acc[4] = fmaf(cv, p.x, acc[4]); acc[5] = fmaf(cv, p.y, acc[5]);
    p = __builtin_amdgcn_cvt_pk_f32_fp8(w1, true);  acc[6] = fmaf(cv, p.x, acc[6]); acc[7] = fmaf(cv, p.y, acc[7]);
    p = __builtin_amdgcn_cvt_pk_f32_fp8(w2, false); acc[8] = fmaf(cv, p.x, acc[8]); acc[9] = fmaf(cv, p.y, acc[9]);
    p = __builtin_amdgcn_cvt_pk_f32_fp8(w2, true);  acc[10] = fmaf(cv, p.x, acc[10]); acc[11] = fmaf(cv, p.y, acc[11]);
    p = __builtin_amdgcn_cvt_pk_f32_fp8(w3, false); acc[12] = fmaf(cv, p.x, acc[12]); acc[13] = fmaf(cv, p.y, acc[13]);
    p = __builtin_amdgcn_cvt_pk_f32_fp8(w3, true);  acc[14] = fmaf(cv, p.x, acc[14]); acc[15] = fmaf(cv, p.y, acc[15]);
}

__device__ __forceinline__ void peer_u_phase(const Ctx& c, const unsigned char* x8_, const float* xs_, const int* eidx_, const float* gate_, float* coef, const unsigned char* U8_, const float* rsu_, const float* rsv_) {
    const GAS unsigned char* x8 = (const GAS unsigned char*)x8_; const GAS float* xs = (const GAS float*)xs_; const GAS int* eidx = (const GAS int*)eidx_; const GAS float* gate = (const GAS float*)gate_;
    const GAS unsigned char* U8 = (const GAS unsigned char*)U8_; const GAS float* rsu = (const GAS float*)rsu_; const GAS float* rsv = (const GAS float*)rsv_;
    const int lane = c.lane, r = lane & 15, kb = lane >> 4;
    LAS int* list = (LAS int*)c.lds + c.wave * 256;
    LAS unsigned char* rowbuf = (LAS unsigned char*)c.lds + 8192 + c.wave * (16 * 1040);
    typedef float f32x4_t __attribute__((ext_vector_type(4)));
    typedef long i64x2_t __attribute__((ext_vector_type(2)));
    const unsigned long long lt = (1ull << lane) - 1ull;
    for (int vb = c.bid; vb < 256; vb += c.nblk) {
        const int j = vb & 7, rnk = vb >> 3;
        const int t0 = rnk * 512 + c.wave * 64;
        int e0 = eidx[(size_t)t0 * 128 + lane], e1 = eidx[(size_t)t0 * 128 + 64 + lane];
        float g0 = gate[(size_t)t0 * 128 + lane], g1 = gate[(size_t)t0 * 128 + 64 + lane];
        float xsc = xs[t0];
        i64x2_t bx[16];
#pragma unroll
        for (int s = 0; s < 16; ++s) bx[s] = *(const GAS i64x2_t*)(x8 + (size_t)t0 * DM + 64 * s + 16 * kb);
#pragma unroll 1
        for (int i = 0; i < 64; ++i) {
            const int t = t0 + i, tn = t0 + (i < 63 ? i + 1 : 63);
            const int e0n = eidx[(size_t)tn * 128 + lane], e1n = eidx[(size_t)tn * 128 + 64 + lane];
            const float g0n = gate[(size_t)tn * 128 + lane], g1n = gate[(size_t)tn * 128 + 64 + lane];
            const float xscn = xs[tn];
            i64x2_t bxn[16];
#pragma unroll
            for (int s = 0; s < 16; ++s) bxn[s] = *(const GAS i64x2_t*)(x8 + (size_t)tn * DM + 64 * s + 16 * kb);
            const bool mt0 = (e0 & 7) == j, mt1 = (e1 & 7) == j;
            const unsigned long long m0 = __ballot(mt0), m1 = __ballot(mt1);
            const int cnt0 = __builtin_popcountll(m0), cnt = cnt0 + __builtin_popcountll(m1);
            if (mt0) { const int pos = __builtin_popcountll(m0 & lt); list[pos] = (lane << 16) | e0; list[128 + pos] = __builtin_bit_cast(int, g0); }
            if (mt1) { const int pos = cnt0 + __builtin_popcountll(m1 & lt); list[pos] = ((64 + lane) << 16) | e1; list[128 + pos] = __builtin_bit_cast(int, g1); }
            asm volatile("s_waitcnt lgkmcnt(0)" ::: "memory");
#pragma unroll 1
            for (int ch = 0; ch * 16 < cnt; ++ch) {
#pragma unroll
                for (int q = 0; q < 16; ++q) {
                    const int qi = ch * 16 + q;
                    const int eq = __builtin_amdgcn_readfirstlane(list[qi < cnt ? qi : 0]) & 0xffff;
                    __builtin_amdgcn_global_load_lds((const GAS unsigned*)(U8 + ((size_t)j * 2048 + (eq >> 3)) * DM + lane * 16), (LAS unsigned*)(rowbuf + q * 1040), 16, 0, 0);
                }
                const int fi = ch * 16 + 4 * kb + (lane & 3);
                const bool fv = r < 4 && fi < cnt;
                const int li = list[fv ? fi : 0]; const float gt = __builtin_bit_cast(float, list[128 + (fv ? fi : 0)]);
                const float su = rsu[li & 0xffff], sv = rsv[li & 0xffff];
                asm volatile("s_waitcnt vmcnt(0)" ::: "memory");
                f32x4_t acc = {0.f, 0.f, 0.f, 0.f};
#pragma unroll
                for (int s = 0; s < 16; ++s) {
                    const i64x2_t a = *(const LAS i64x2_t*)(rowbuf + r * 1040 + 64 * s + 16 * kb);
                    acc = __builtin_amdgcn_mfma_f32_16x16x32_fp8_fp8(a.x, bx[s].x, acc, 0, 0, 0);
                    acc = __builtin_amdgcn_mfma_f32_16x16x32_fp8_fp8(a.y, bx[s].y, acc, 0, 0, 0);
                }
                const int c4 = lane & 3;
                const float dsel = c4 == 0 ? acc[0] : (c4 == 1 ? acc[1] : (c4 == 2 ? acc[2] : acc[3]));
                if (fv) coef[(size_t)t * 128 + (li >> 16)] = gt * gelu_exact(dsel * su * xsc) * sv;
            }
            e0 = e0n; e1 = e1n; g0 = g0n; g1 = g1n; xsc = xscn;
#pragma unroll
            for (int s = 0; s < 16; ++s) bx[s] = bxn[s];
        }
    }
}

__device__ __forceinline__ void peer_v_phase(const Ctx& c, const int* eidx_, const float* coef_, const unsigned char* V8_, float* Y) {
    const GAS int* eidx = (const GAS int*)eidx_; const GAS float* coef = (const GAS float*)coef_; const GAS unsigned char* V8 = (const GAS unsigned char*)V8_;
    const int lane = c.lane, sg = lane >> 3, part = lane & 7;
    typedef int i32x4_t __attribute__((ext_vector_type(4)));
    typedef float f32x4_t __attribute__((ext_vector_type(4)));
    for (int vb = c.bid; vb < 256; vb += c.nblk) {
        const int j = vb & 7, rnk = vb >> 3;
        const int dcol = 128 * j + part * 16;
        const int t0 = rnk * 512 + c.wave * 64;
        i32x4_t e[4]; f32x4_t cf[4];
#pragma unroll
        for (int q = 0; q < 4; ++q) { e[q] = *(const GAS i32x4_t*)(eidx + (size_t)t0 * 128 + sg * 16 + 4 * q); cf[q] = *(const GAS f32x4_t*)(coef + (size_t)t0 * 128 + sg * 16 + 4 * q); }
#pragma unroll 1
        for (int i = 0; i < 64; ++i) {
            const int t = t0 + i, tn = t0 + (i < 63 ? i + 1 : 63);
            u32x4_t rows[16];
#pragma unroll
            for (int it = 0; it < 16; ++it) rows[it] = *(const GAS u32x4_t*)(V8 + (size_t)j * (16384 * 128) + (size_t)e[it >> 2][it & 3] * 128 + part * 16);
            i32x4_t en[4]; f32x4_t cn[4];
#pragma unroll
            for (int q = 0; q < 4; ++q) { en[q] = *(const GAS i32x4_t*)(eidx + (size_t)tn * 128 + sg * 16 + 4 * q); cn[q] = *(const GAS f32x4_t*)(coef + (size_t)tn * 128 + sg * 16 + 4 * q); }
            float acc[16];
#pragma unroll
            for (int d = 0; d < 16; ++d) acc[d] = 0.f;
#pragma unroll
            for (int it = 0; it < 16; ++it) axpy16_fp8(rows[it], cf[it >> 2][it & 3], acc);
#pragma unroll
            for (int d = 0; d < 16; ++d) { acc[d] += __shfl_xor(acc[d], 8); acc[d] += __shfl_xor(acc[d], 16); acc[d] += __shfl_xor(acc[d], 32); }
            if (lane < 8) {
                float* yp = Y + (size_t)t * DM + dcol;
#pragma unroll
                for (int q = 0; q < 4; ++q) *(f32x4_t*)(yp + 4 * q) = (f32x4_t){acc[4 * q], acc[4 * q + 1], acc[4 * q + 2], acc[4 * q + 3]};
            }
#pragma unroll
            for (int q = 0; q < 4; ++q) { e[q] = en[q]; cf[q] = cn[q]; }
        }
    }
}

__device__ __forceinline__ void prologue_phase(const Ctx& c, const float* x, const float* ab_in, const float* ab_out, const float* cd_in, const float* cd_out, const float* wq, const float* pu, const float* pv, const float* sk, unsigned char* ws) {
    float* scr = c.lds + c.wave * 4096;
    constexpr int I_IN = 16 * 96, I_OUT = 16 * 32, I_WQ = 16 * 64;
    constexpr int NITEMS = 2 * I_IN + 2 * I_OUT + 2 * I_WQ;
    for (int it = c.gwave; it < NITEMS; it += c.nwaves) {
        int r = it;
        if (r < I_IN) { transpose_item(ab_in, QKV_W, DM, QKV_W, (bf16_t*)(ws + WT_ABIN), scr, r, c.lane); continue; } r -= I_IN;
        if (r < I_IN) { transpose_item(cd_in, CD_IN, DM, QKV_W, (bf16_t*)(ws + WT_CDIN), scr, r, c.lane); continue; } r -= I_IN;
        if (r < I_OUT) { transpose_item(ab_out, DM, DM, DM, (bf16_t*)(ws + WT_ABOUT), scr, r, c.lane); continue; } r -= I_OUT;
        if (r < I_OUT) { transpose_item(cd_out, DM, DM, DM, (bf16_t*)(ws + WT_CDOUT), scr, r, c.lane); continue; } r -= I_OUT;
        if (r < I_WQ) { transpose_item(wq, PEER_QW, DM, PEER_QW, (bf16_t*)(ws + WT_WQ), scr, r, c.lane); continue; } r -= I_WQ;
        transpose_item(wq + (size_t)DM * PEER_QW, PEER_QW, DM, PEER_QW, (bf16_t*)(ws + WT_WQ + 4 * MiB), scr, r, c.lane);
    }
    cvt_rows_bf16(c, x, (bf16_t*)(ws + WS_ACTIN), (size_t)NT * DM / 8);
    cvt_rows_fp8<0>(c, pu, ws + WS_U8, (float*)(ws + WS_RS), 2 * 16384);
    cvt_rows_fp8<1>(c, pv, ws + WS_V8, (float*)(ws + WS_RS) + 2 * 16384, 2 * 16384);
    cvt_rows_bf16(c, sk, (bf16_t*)(ws + WS_SKB), (size_t)2 * 16 * 128 * 128 / 8);
}

constexpr int NPHASE = 1 + 2 * 11;
__global__ void __launch_bounds__(NTHREADS, 2) fwd(Args args) {
    unsigned* ctl = (unsigned*)(args.ws + WS_CTL);
    volatile LAS unsigned* xbw = (volatile LAS unsigned*)(dyn_lds + MISC_OFF);
    if (threadIdx.x == 0) { xbw[0] = 0u; xbw[1] = 0u; xbw[2] = 0u; xbw[3] = 0u; }
    __syncthreads();
    const int lo = args.ph_lo, hi = args.ph_hi;
    XcdBarrier bar = xcd_barrier_post(ctl + 4096, xbw);
#define IN(k) (lo <= (k) && (k) < hi)
#define SEAM(k) do { if (IN(k) && IN((k) + 1)) xcd_barrier(bar); } while (0)
#define LAUNDER(ptr) ptr = launder_ptr(ptr)
#define PIN(k) ((const float*)launder_ptr((unsigned char*)args.in[k]))
#define GEMM_LDS ((PG8_LAS unsigned char*)dyn_lds + RING_OFF)
    if (IN(0)) { unsigned char* ws = args.ws; LAUNDER(ws); const Ctx c = make_ctx(); prologue_phase(c, PIN(0), PIN(2), PIN(5), PIN(6), PIN(8), PIN(9), PIN(11), PIN(12), PIN(10), ws); }
    SEAM(0);
#pragma unroll 1
    for (int layer = 0; layer < 2; ++layer) {
        const int pb = 1 + layer * 11;
        if (IN(pb + 0)) {
            unsigned char* ws = args.ws; LAUNDER(ws); const Ctx c = make_ctx();
            pg8::Gemm g{(const bf16_t*)(ws + WS_ACTIN), (const bf16_t*)(ws + (layer == 0 ? WT_ABIN : WT_CDIN)), NT, QKV_W, DM};
            pg8::StaticOrder S; S.init(NT, QKV_W, c.nblk, c.bid);
            pg8::EpiStoreBf16 E{(bf16_t*)(ws + WS_QKV), QKV_W, (layer == 0 ? 0.17677669529663687f : 0.125f) * 1.4426950408889634f, 0.125f * 1.4426950408889634f};
            pg8::gemm_phase<pg8::EpiStoreBf16, pg8::StaticOrder, true, true>(GEMM_LDS, g, S, E);
            if (layer == 1) fg_phase(c, (const bf16_t*)(ws + WS_ACTIN), PIN(6), (float*)(ws + WS_FG));
        }
        SEAM(pb + 0);
        if (IN(pb + 1) && layer == 1) { unsigned char* ws = args.ws; LAUNDER(ws); const Ctx c = make_ctx(); fscan_naive(c, (const float*)(ws + WS_FG), (float*)(ws + WS_F), PIN(7)); }
        SEAM(pb + 1);
        if (IN(pb + 2)) {
            unsigned char* ws = args.ws; LAUNDER(ws); const Ctx c = make_ctx();
            if (layer == 0) attn_layer0_mfma(c, (const bf16_t*)(ws + WS_QKV), (bf16_t*)(ws + WS_ATTB), PIN(1), PIN(3), PIN(4));
            else { attn_fox_mfma(c, (const bf16_t*)(ws + WS_QKV), (const float*)(ws + WS_F), (bf16_t*)(ws + WS_ATTB)); attn_dilated_mfma(c, (const bf16_t*)(ws + WS_QKV), PIN(1), (bf16_t*)(ws + WS_MIX), (float*)(ws + WS_H1B)); }
        }
        SEAM(pb + 2);
        if (IN(pb + 3) && layer == 1) { unsigned char* ws = args.ws; LAUNDER(ws); const Ctx c = make_ctx(); dilated_combine(c, (const bf16_t*)(ws + WS_MIX), (const float*)(ws + WS_H1B), (bf16_t*)(ws + WS_ATTB)); }
        SEAM(pb + 3);
        if (IN(pb + 4)) {
            unsigned char* ws = args.ws; LAUNDER(ws); const Ctx c = make_ctx();
            pg8::Gemm g{(const bf16_t*)(ws + WS_ATTB), (const bf16_t*)(ws + (layer == 0 ? WT_ABOUT : WT_CDOUT)), NT, DM, DM};
            pg8::StaticOrder S; S.init(NT, DM, c.nblk, c.bid);
            pg8::EpiStoreF32 E{(float*)(ws + WS_MIX), DM};
            pg8::gemm_phase<pg8::EpiStoreF32, pg8::StaticOrder, true, true>(GEMM_LDS, g, S, E);
        }
        SEAM(pb + 4);
        if (IN(pb + 5)) {
            unsigned char* ws = args.ws; LAUNDER(ws); const Ctx c = make_ctx();
            ln_rows(c, layer == 0 ? PIN(0) : (const float*)nullptr, (const bf16_t*)(ws + WS_ACTIN), (const float*)(ws + WS_MIX), PIN(13) + (size_t)layer * 2 * DM, PIN(14) + (size_t)layer * 2 * DM, (float*)nullptr, (bf16_t*)(ws + WS_H1B), ws + WS_X8, (float*)(ws + WS_XS));
        }
        SEAM(pb + 5);
        if (IN(pb + 6)) {
            unsigned char* ws = args.ws; LAUNDER(ws); const Ctx c = make_ctx();
            pg8::Gemm g{(const bf16_t*)(ws + WS_H1B), (const bf16_t*)(ws + WT_WQ + (size_t)layer * 4 * MiB), NT, PEER_QW, DM};
            pg8::StaticOrder S; S.init(NT, PEER_QW, c.nblk, c.bid);
            pg8::EpiStoreBf16 E{(bf16_t*)(ws + WS_QKV), PEER_QW, 1.f, 1.f};
            pg8::gemm_phase<pg8::EpiStoreBf16, pg8::StaticOrder, true, true>(GEMM_LDS, g, S, E);
        }
        SEAM(pb + 6);
        if (IN(pb + 7)) {
            unsigned char* ws = args.ws; LAUNDER(ws); const Ctx c = make_ctx();
            peer_route_phase(c, (const bf16_t*)(ws + WS_QKV), (const bf16_t*)(ws + WS_SKB) + (size_t)layer * 16 * 128 * 128, (int*)(ws + WS_EIDX), (float*)(ws + WS_GATE));
        }
        SEAM(pb + 7);
        if (IN(pb + 8)) {
            unsigned char* ws = args.ws; LAUNDER(ws); const Ctx c = make_ctx();
            peer_u_phase(c, ws + WS_X8, (const float*)(ws + WS_XS), (const int*)(ws + WS_EIDX), (const float*)(ws + WS_GATE), (float*)(ws + WS_COEF), ws + WS_U8 + (size_t)layer * 16384 * DM, (const float*)(ws + WS_RS) + (size_t)layer * 16384, (const float*)(ws + WS_RS) + (size_t)(2 + layer) * 16384);
        }
        SEAM(pb + 8);
        if (IN(pb + 9)) {
            unsigned char* ws = args.ws; LAUNDER(ws); const Ctx c = make_ctx();
            peer_v_phase(c, (const int*)(ws + WS_EIDX), (const float*)(ws + WS_COEF), ws + WS_V8 + (size_t)layer * 16384 * DM, (float*)(ws + WS_MIX));
        }
        SEAM(pb + 9);
        if (IN(pb + 10)) {
            unsigned char* ws = args.ws; LAUNDER(ws); const Ctx c = make_ctx();
            float* hout = layer == 0 ? (float*)nullptr : (float*)launder_ptr((unsigned char*)args.out);
            bf16_t* houtb = layer == 0 ? (bf16_t*)(ws + WS_ACTIN) : (bf16_t*)nullptr;
            ln_rows(c, (const float*)nullptr, (const bf16_t*)(ws + WS_H1B), (const float*)(ws + WS_MIX), PIN(13) + (size_t)(layer * 2 + 1) * DM, PIN(14) + (size_t)(layer * 2 + 1) * DM, hout, houtb);
        }
        SEAM(pb + 10);
    }
}

extern "C" void kernel_launch(void* const* d_in, const int* in_sizes, int n_in, void* d_out, int out_size, void* d_ws, size_t ws_size, hipStream_t stream) {
    (void)in_sizes; (void)n_in; (void)out_size;
    static int grid = 0;
    if (!grid) {
        int dev = 0, cus = 0, per_cu = 0;
        (void)hipGetDevice(&dev);
        (void)hipDeviceGetAttribute(&cus, hipDeviceAttributeMultiprocessorCount, dev);
        (void)hipFuncSetAttribute((const void*)fwd, hipFuncAttributeMaxDynamicSharedMemorySize, LDS_BYTES);
        (void)hipOccupancyMaxActiveBlocksPerMultiprocessor(&per_cu, fwd, NTHREADS, LDS_BYTES);
        if (per_cu < 1) fprintf(stderr, "occupancy query says %d blocks per CU\n", per_cu);
        grid = cus;
        if (ws_size < WS_END) fprintf(stderr, "workspace too small: %zu < %zu\n", ws_size, (size_t)WS_END);
    }
    (void)hipMemsetAsync((unsigned char*)d_ws + WS_CTL, 0, 1 * MiB, stream);
    Args a{};
    for (int i = 0; i < 15; ++i) a.in[i] = (const float*)d_in[i];
    a.out = (float*)d_out; a.ws = (unsigned char*)d_ws;
    a.ph_lo = 0; a.ph_hi = NPHASE;
    hipLaunchKernelGGL(fwd, dim3(grid), dim3(NTHREADS), LDS_BYTES, stream, a);
}
```

```cpp
#include <hip/hip_runtime.h>
#include <cstdio>
#include <cstdint>
#include <cmath>

constexpr int BATCH = 4, SEQ = 4096, DM = 1024, NT = BATCH * SEQ;
constexpr int NH = 8, HD = 64;
constexpr int QKV_W = 3072, CD_IN = 3080;
constexpr int PEER_QW = 2048;
constexpr float DN_ALPHA = 1.4142135623730951f;
constexpr float LN_EPS = 1e-5f;
constexpr int NTHREADS = 512, NWAVES = 8;
typedef unsigned short bf16_t;

constexpr size_t MiB = 1u << 20;
constexpr size_t WS_CTL = 0;
constexpr size_t WS_WT = 1 * MiB;
constexpr size_t WT_ABIN = WS_WT, WT_ABOUT = WS_WT + 6 * MiB, WT_CDIN = WS_WT + 8 * MiB, WT_CDOUT = WS_WT + 14 * MiB, WT_WQ = WS_WT + 16 * MiB;
constexpr size_t WS_ACTIN = 25 * MiB;
constexpr size_t WS_ATTB = 57 * MiB;
constexpr size_t WS_H1B = 89 * MiB;
constexpr size_t WS_QKV = 121 * MiB;
constexpr size_t WS_MIX = 217 * MiB;
constexpr size_t WS_EIDX = 281 * MiB;
constexpr size_t WS_COEF = 289 * MiB;
constexpr size_t WS_F = 297 * MiB;
constexpr size_t WS_FG = 298 * MiB;
constexpr size_t WS_U8 = 299 * MiB;
constexpr size_t WS_V8 = 331 * MiB;
constexpr size_t WS_RS = 363 * MiB;
constexpr size_t WS_SKB = 364 * MiB;
constexpr size_t WS_GATE = 365 * MiB;
constexpr size_t WS_X8 = 373 * MiB;
constexpr size_t WS_XS = 389 * MiB;
constexpr size_t WS_END = 390 * MiB;
constexpr int LDS_BYTES = 147456;
constexpr int RING_OFF = 0, MISC_OFF = 143360;

#define XB_TMO      128
#define XB_XCNT(j)  (256  + 64 * (j))
#define XB_XSUB(j)  (1280 + 64 * (j))
#define XB_XGEN(j)  (2304 + 64 * (j))
#define XB_TOP      3328
#define XB_TOPGEN   3392
#define XCD_BAR_WORDS 3456
#define XB_SPIN_CAP (1u << 18)
#define LAS __attribute__((address_space(3)))

__device__ __forceinline__ unsigned xb_ld(unsigned* p)              { return __hip_atomic_load(p, __ATOMIC_RELAXED, __HIP_MEMORY_SCOPE_AGENT); }
__device__ __forceinline__ unsigned xb_add(unsigned* p, unsigned v) { return __hip_atomic_fetch_add(p, v, __ATOMIC_RELAXED, __HIP_MEMORY_SCOPE_AGENT); }
__device__ __forceinline__ unsigned xb_xcc_id() { return (unsigned)__builtin_amdgcn_s_getreg((3 << 11) | 20) & 0xFu; }
#define XB_SPIN(cond, bar) do { unsigned _sp = 0; while (cond) { __builtin_amdgcn_s_sleep(1); \
    if ((++_sp & 255u) == 0u) { if (xb_ld(&(bar)[XB_TMO])) break; if (_sp > XB_SPIN_CAP) { atomicAdd(&(bar)[XB_TMO], 1u); break; } } } } while (0)

struct XcdBarrier {
    unsigned* bar; unsigned x;
    volatile LAS unsigned* st;
};
__device__ __forceinline__ XcdBarrier xcd_barrier_post(unsigned* bar, volatile LAS unsigned* st) {
    XcdBarrier b; b.bar = bar; b.x = xb_xcc_id(); b.st = st;
    if (threadIdx.x == 0) (void)xb_add(&bar[XB_XCNT(b.x)], 1u);
    return b;
}
__device__ __forceinline__ void xcd_barrier_complete(unsigned* bar, unsigned x, unsigned& nloc, unsigned& nx) {
    const unsigned G = gridDim.x * gridDim.y * gridDim.z;
    unsigned sum, cnt, mine, sp = 0u;
    for (;;) {
        sum = 0u; cnt = 0u; mine = 0u;
#pragma unroll
        for (unsigned j = 0; j < 16; ++j) { const unsigned c = xb_ld(&bar[XB_XCNT(j)]); sum += c; cnt += (c > 0u) ? 1u : 0u; mine = (j == x) ? c : mine; }
        if (sum == G) break;
        __builtin_amdgcn_s_sleep(1);
        if ((++sp & 255u) == 0u) { if (xb_ld(&bar[XB_TMO])) break; if (sp > XB_SPIN_CAP) { atomicAdd(&bar[XB_TMO], 1u); break; } }
    }
    nloc = mine > 0u ? mine : 1u; nx = cnt > 0u ? cnt : 1u;
}
__device__ __forceinline__ void xcd_barrier(const XcdBarrier& b) {
    asm volatile("s_waitcnt vmcnt(0)" ::: "memory");
    __syncthreads();
    if (threadIdx.x == 0) {
        unsigned* bar = b.bar;
        __builtin_amdgcn_s_waitcnt(0);
        unsigned nloc = b.st[0], nx = b.st[1];
        if (nloc == 0u) { xcd_barrier_complete(bar, b.x, nloc, nx); b.st[0] = nloc; b.st[1] = nx; }
        const unsigned old = xb_add(&bar[XB_XSUB(b.x)], 1u);
        const unsigned gen = old / nloc;
        if (old + 1u == (gen + 1u) * nloc) {
            __builtin_amdgcn_fence(__ATOMIC_RELEASE, "agent");
            asm volatile("s_waitcnt vmcnt(0)" ::: "memory");
            const unsigned og = xb_add(&bar[XB_TOP], 1u);
            const unsigned tg = og / nx;
            if (og + 1u == (tg + 1u) * nx) xb_add(&bar[XB_TOPGEN], 1u);
            else XB_SPIN(xb_ld(&bar[XB_TOPGEN]) == tg, bar);
            __builtin_amdgcn_fence(__ATOMIC_ACQUIRE, "agent");
            xb_add(&bar[XB_XGEN(b.x)], 1u);
            asm volatile("s_waitcnt vmcnt(0)" ::: "memory");
        } else {
            XB_SPIN(xb_ld(&bar[XB_XGEN(b.x)]) == gen, bar);
            __builtin_amdgcn_fence(__ATOMIC_ACQUIRE, "agent");
            asm volatile("s_waitcnt vmcnt(0)" ::: "memory");
        }
    }
    __syncthreads();
}

struct Args {
    const float* in[15];
    float* out;
    unsigned char* ws;
    int ph_lo, ph_hi;
};
struct Ctx {
    int tid, lane, wave, gwave, nwaves, bid, nblk;
    float* lds;
};
extern __shared__ __attribute__((aligned(16))) unsigned char dyn_lds[];
__device__ __forceinline__ Ctx make_ctx() {
    int t = threadIdx.x, b = blockIdx.x, g = gridDim.x;
    asm volatile("" : "+v"(t));
    asm volatile("" : "+s"(b), "+s"(g));
    Ctx c; c.tid = t; c.lane = t & 63; c.wave = t >> 6; c.bid = b; c.nblk = g;
    c.gwave = b * NWAVES + c.wave; c.nwaves = g * NWAVES; c.lds = (float*)(dyn_lds + RING_OFF);
    return c;
}
__device__ __forceinline__ unsigned char* launder_ptr(unsigned char* p) {
    unsigned lo = __builtin_amdgcn_readfirstlane((unsigned)(uintptr_t)p), hi = __builtin_amdgcn_readfirstlane((unsigned)((uintptr_t)p >> 32));
    asm volatile("" : "+s"(lo), "+s"(hi));
    return (unsigned char*)(((uintptr_t)hi << 32) | (uintptr_t)lo);
}
__device__ __forceinline__ float wave_sum(float v) {
#pragma unroll
    for (int o = 32; o >= 1; o >>= 1) v += __shfl_xor(v, o);
    return v;
}
__device__ __forceinline__ float log_sigmoid(float z) { return fminf(z, 0.f) - log1pf(expf(-fabsf(z))); }
__device__ __forceinline__ int t5_bucket(int n) {
    if (n < 16) return n;
    int large = 16 + (int)(logf((float)n / 16.f) / 2.0794415416798357f * 16.f);
    return large < 31 ? large : 31;
}
__device__ __forceinline__ float bf2f(bf16_t v) { return __builtin_bit_cast(float, (unsigned)v << 16); }
__device__ __forceinline__ unsigned f2bf(float f) { unsigned u = __builtin_bit_cast(unsigned, f); return (u + 0x7fffu + ((u >> 16) & 1u)) >> 16; }
__device__ __forceinline__ unsigned pk2(float lo, float hi) { return f2bf(lo) | (f2bf(hi) << 16); }

namespace pg8 {
#define PG8_LAS __attribute__((address_space(3)))
typedef unsigned short bf16_t;
typedef short bf16x8 __attribute__((ext_vector_type(8)));
typedef float f32x4 __attribute__((ext_vector_type(4)));
typedef unsigned u32x4 __attribute__((ext_vector_type(4)));
constexpr int BM = 256, BK = 64, HALF = 128, HTB = HALF * BK * 2  , STAGE_BYTES = 8 * HTB, NXCD = 8, WGM = 8;

__host__ __device__ __forceinline__ int lds_byte(int r, int c) { const int st = (r >> 4) * 2 + (c >> 5), rr = r & 15, cc = c & 31, ob = rr * 64 + cc * 2; return st * 1024 + (ob ^ (((ob >> 9) & 1) << 5)); }
__host__ __device__ __forceinline__ void stage_rc(int b, int& R, int& C) { const int st = b / 1024, sb = b % 1024, swz = sb ^ (((sb >> 9) & 1) << 5); R = (st >> 1) * 16 + swz / 64; C = (st & 1) * 32 + (swz % 64) / 2; }
__host__ __device__ __forceinline__ int perm32(int rho) { const int n = rho >> 4, i = rho & 15; return 8 * (i >> 2) + 4 * n + (i & 3); }

struct Unit { int pm, pn; };
struct Gemm { const bf16_t* A; const bf16_t* Bt; int M, N, K; };

struct StaticOrder {
    int nM, nN, nwg, G, c;
    __host__ __device__ void init(int M, int N, int G_, int c_) { nM = M / BM; nN = N / BM; nwg = nM * nN; G = G_; c = c_; }
    __host__ __device__ bool next(int i, Unit& u) const {
        const long L = (long)i * G + c; if (L >= nwg) return false;
        int wgid = (int)L; { const int q = nwg / NXCD, r = nwg % NXCD, xcd = wgid % NXCD, off = wgid / NXCD; wgid = (xcd < r ? xcd * (q + 1) : r * (q + 1) + (xcd - r) * q) + off; }
        const int nig = WGM * nN, gid = wgid / nig, fm = gid * WGM, gsz = (nM - fm) < WGM ? (nM - fm) : WGM;
        u.pm = fm + ((wgid % nig) % gsz); u.pn = (wgid % nig) / gsz; return true;
    }
    __device__ __forceinline__ void a_ready(const Unit&) const {}
    __device__ __forceinline__ void done(const Unit&) const {}
};

__device__ __forceinline__ unsigned cvt_pk_bf16(float lo, float hi) { unsigned r; asm volatile("v_cvt_pk_bf16_f32 %0, %1, %2" : "=v"(r) : "v"(lo), "v"(hi)); return r; }
template <class Epi, class Sched, bool ALIGN_EPI = false, bool SP2 = false>
__device__ __forceinline__ void gemm_phase(PG8_LAS unsigned char* lds, const Gemm g, const Sched& S, const Epi& E) {
    int tid_ = threadIdx.x; asm volatile("" : "+v"(tid_));
    const int tid = tid_, wid = __builtin_amdgcn_readfirstlane(tid >> 6), lane = tid & 63, wr = wid >> 2, wc = wid & 3, fr = lane & 15, fq = lane >> 4;
    const int K = g.K, nt = K / BK;
    unsigned voffA[2], voffB[2];
#pragma unroll
    for (int i = 0; i < 2; ++i) { int R, C; stage_rc(tid * 16 + i * 8192, R, C); const int Rb = Epi::PERM ? ((R & ~31) + perm32(R & 31)) : R;
        voffA[i] = (unsigned)(R * K + C) * 2u; voffB[i] = (unsigned)(Rb * K + C) * 2u; }
    const size_t kstep = (size_t)(BK * 2);
    const size_t hstep = (size_t)HALF * K * 2;
    const size_t tstep = 2 * hstep;
    const unsigned ldsw = (unsigned)wid * 1024u;
    const int aoff = lds_byte(wr * 64 + fr, fq * 8), boff = lds_byte(wc * 32 + fr, fq * 8);
#define PG8_SA(b, h) (((b) * 2 + (h)) * HTB)
#define PG8_SB(b, h) ((4 + (b) * 2 + (h)) * HTB)
#define PG8_STAGE(bufoff, gbase, voff) do { _Pragma("unroll") for (int _i = 0; _i < 2; ++_i) \
        __builtin_amdgcn_global_load_lds((const unsigned*)((const char*)(gbase) + (voff)[_i]), (PG8_LAS unsigned*)(lds + (bufoff) + ldsw + _i * 8192), 16, 0, 0); } while (0)
#define PG8_LDA(dst, b, h) do { _Pragma("unroll") for (int m = 0; m < 4; ++m) _Pragma("unroll") for (int k = 0; k < 2; ++k) dst[m][k] = *(const PG8_LAS bf16x8*)(lds + PG8_SA(b, h) + aoff + m * 2048 + k * 1024); } while (0)
#define PG8_LDB(dst, b, h) do { _Pragma("unroll") for (int n = 0; n < 2; ++n) _Pragma("unroll") for (int k = 0; k < 2; ++k) dst[n][k] = *(const PG8_LAS bf16x8*)(lds + PG8_SB(b, h) + boff + n * 2048 + k * 1024); } while (0)
#define PG8_MMA(ai, bj, At, Bt) do { __builtin_amdgcn_s_setprio(1); _Pragma("unroll") for (int m = 0; m < 4; ++m) _Pragma("unroll") for (int n = 0; n < 2; ++n) _Pragma("unroll") for (int k = 0; k < 2; ++k) \
        acc[ai][bj][m][n] = __builtin_amdgcn_mfma_f32_16x16x32_bf16(Bt[n][k], At[m][k], acc[ai][bj][m][n], 0, 0, 0); __builtin_amdgcn_s_setprio(0); } while (0)
#define PG8_WAIT_V(n) asm volatile("s_waitcnt vmcnt(" #n ")" ::: "memory")
#define PG8_WAIT_L(n) asm volatile("s_waitcnt lgkmcnt(" #n ")" ::: "memory")
#define PG8_BAR __builtin_amdgcn_s_barrier()
#define PG8_SCHED __builtin_amdgcn_sched_barrier(0)
    Unit cur, nxt; int ui = 0;
    if (!S.next(0, cur)) return;
    f32x4 acc[2][2][4][2];
#pragma unroll
    for (int a = 0; a < 2; ++a)
#pragma unroll
        for (int b = 0; b < 2; ++b)
#pragma unroll
            for (int m = 0; m < 4; ++m)
#pragma unroll
                for (int n = 0; n < 2; ++n) acc[a][b][m][n] = (f32x4){0.f, 0.f, 0.f, 0.f};
    bf16x8 At[4][2], B0[2][2], B1[2][2];
    const char* cA = (const char*)g.A + (size_t)cur.pm * tstep; const char* cB = (const char*)g.Bt + (size_t)cur.pn * tstep;
    S.a_ready(cur);
    if constexpr (SP2) {
        PG8_STAGE(PG8_SB(0, 0), cB, voffB); PG8_STAGE(PG8_SB(0, 1), cB + hstep, voffB); PG8_STAGE(PG8_SA(0, 0), cA, voffA); PG8_STAGE(PG8_SA(0, 1), cA + hstep, voffA);
        if (wr == 1) PG8_BAR;
        PG8_WAIT_V(2); PG8_BAR;
        PG8_STAGE(PG8_SB(1, 0), cB + kstep, voffB); PG8_STAGE(PG8_SA(1, 0), cA + kstep, voffA); PG8_STAGE(PG8_SB(1, 1), cB + hstep + kstep, voffB);
        PG8_WAIT_V(6); PG8_BAR;
    } else {
        PG8_STAGE(PG8_SB(0, 0), cB, voffB); PG8_STAGE(PG8_SA(0, 0), cA, voffA); PG8_STAGE(PG8_SB(0, 1), cB + hstep, voffB); PG8_STAGE(PG8_SA(0, 1), cA + hstep, voffA);
        if (wr == 1) PG8_BAR;
        PG8_WAIT_V(4); PG8_BAR;
        PG8_STAGE(PG8_SB(1, 0), cB + kstep, voffB); PG8_STAGE(PG8_SA(1, 0), cA + kstep, voffA); PG8_STAGE(PG8_SB(1, 1), cB + hstep + kstep, voffB);
        PG8_WAIT_V(6); PG8_BAR;
    }
    for (;;) {
        const bool has_next = S.next(ui + 1, nxt);
        const char* nA = has_next ? (const char*)g.A + (size_t)nxt.pm * tstep : cA; const char* nB = has_next ? (const char*)g.Bt + (size_t)nxt.pn * tstep : cB;
        for (int t = 0; t < nt; t += 2) {
            const bool last = (t == nt - 2);
            const char* a1 = cA + (size_t)(t + 1) * kstep;
            const char* a2 = last ? nA : cA + (size_t)(t + 2) * kstep; const char* b2 = last ? nB : cB + (size_t)(t + 2) * kstep;
            const char* a3 = a2 + kstep; const char* b3 = b2 + kstep;
            if (last && has_next) S.a_ready(nxt);
            if constexpr (SP2) {
            PG8_LDB(B0, 0, 0); PG8_LDB(B1, 0, 1); PG8_SCHED; PG8_LDA(At, 0, 0); PG8_STAGE(PG8_SA(1, 1), a1 + hstep, voffA);
            PG8_WAIT_V(8); PG8_WAIT_L(0); PG8_BAR; PG8_MMA(0, 0, At, B0); PG8_MMA(0, 1, At, B1); PG8_BAR; PG8_SCHED;
            PG8_LDA(At, 0, 1); PG8_STAGE(PG8_SB(0, 0), b2, voffB); PG8_STAGE(PG8_SB(0, 1), b2 + hstep, voffB); PG8_STAGE(PG8_SA(0, 0), a2, voffA);
            PG8_WAIT_V(8); PG8_WAIT_L(0); PG8_BAR; PG8_MMA(1, 0, At, B0); PG8_MMA(1, 1, At, B1); PG8_BAR; PG8_SCHED;
            PG8_LDB(B0, 1, 0); PG8_LDB(B1, 1, 1); PG8_SCHED; PG8_LDA(At, 1, 0); PG8_STAGE(PG8_SA(0, 1), a2 + hstep, voffA);
            PG8_WAIT_V(8); PG8_WAIT_L(0); PG8_BAR; PG8_MMA(0, 0, At, B0); PG8_MMA(0, 1, At, B1); PG8_BAR; PG8_SCHED;
            PG8_LDA(At, 1, 1); PG8_STAGE(PG8_SB(1, 0), b3, voffB); PG8_STAGE(PG8_SB(1, 1), b3 + hstep, voffB); PG8_STAGE(PG8_SA(1, 0), a3, voffA);
            PG8_WAIT_V(8); PG8_WAIT_L(0); PG8_BAR; PG8_MMA(1, 0, At, B0); PG8_MMA(1, 1, At, B1); PG8_BAR; PG8_SCHED;
            } else {
            PG8_LDB(B0, 0, 0); PG8_SCHED; PG8_LDA(At, 0, 0); PG8_STAGE(PG8_SA(1, 1), a1 + hstep, voffA);
            PG8_WAIT_L(8); PG8_BAR; PG8_WAIT_L(0); PG8_MMA(0, 0, At, B0); PG8_BAR; PG8_SCHED;
            PG8_LDB(B1, 0, 1); PG8_STAGE(PG8_SB(0, 0), b2, voffB);
            PG8_BAR; PG8_WAIT_L(0); PG8_MMA(0, 1, At, B1); PG8_BAR;
            PG8_LDA(At, 0, 1); PG8_STAGE(PG8_SA(0, 0), a2, voffA);
            PG8_BAR; PG8_WAIT_L(0); PG8_MMA(1, 0, At, B0); PG8_BAR; PG8_SCHED;
            PG8_STAGE(PG8_SB(0, 1), b2 + hstep, voffB);
            PG8_WAIT_V(6); PG8_BAR; PG8_MMA(1, 1, At, B1); PG8_BAR;
            PG8_LDB(B0, 1, 0); PG8_SCHED; PG8_LDA(At, 1, 0); PG8_STAGE(PG8_SA(0, 1), a2 + hstep, voffA);
            PG8_WAIT_L(8); PG8_BAR; PG8_WAIT_L(0); PG8_MMA(0, 0, At, B0); PG8_BAR; PG8_SCHED;
            PG8_LDB(B1, 1, 1); PG8_STAGE(PG8_SB(1, 0), b3, voffB);
            PG8_BAR; PG8_WAIT_L(0); PG8_MMA(0, 1, At, B1); PG8_BAR;
            PG8_LDA(At, 1, 1); PG8_STAGE(PG8_SA(1, 0), a3, voffA);
            PG8_BAR; PG8_WAIT_L(0); PG8_MMA(1, 0, At, B0); PG8_BAR; PG8_SCHED;
            PG8_STAGE(PG8_SB(1, 1), b3 + hstep, voffB);
            PG8_WAIT_V(6); PG8_BAR; PG8_MMA(1, 1, At, B1); PG8_BAR;
            }
        }
        if constexpr (ALIGN_EPI) { if (wr == 0) PG8_BAR; }
        if constexpr (!Epi::AFTER_DRAIN) { E(acc, cur, wr, wc, fr, fq); S.done(cur); }
        if (!has_next) break;
#pragma unroll
        for (int a = 0; a < 2; ++a)
#pragma unroll
            for (int b = 0; b < 2; ++b)
#pragma unroll
                for (int m = 0; m < 4; ++m)
#pragma unroll
                    for (int n = 0; n < 2; ++n) acc[a][b][m][n] = (f32x4){0.f, 0.f, 0.f, 0.f};
        cur = nxt; cA = nA; cB = nB; ++ui;
        if constexpr (ALIGN_EPI) { if (wr == 1) PG8_BAR; }
    }
    PG8_WAIT_V(0);
    if constexpr (!ALIGN_EPI) { if (wr == 0) PG8_BAR; }
    PG8_BAR;
    if constexpr (Epi::AFTER_DRAIN) { E.fused(acc, cur, wr, wc, fr, fq, lds, wid, lane); S.done(cur); }
#undef PG8_SA
#undef PG8_SB
#undef PG8_STAGE
#undef PG8_LDA
#undef PG8_LDB
#undef PG8_MMA
#undef PG8_WAIT_V
#undef PG8_WAIT_L
#undef PG8_BAR
#undef PG8_SCHED
}
}

namespace pg8 {
struct EpiStoreBf16 {
    static constexpr bool PERM = true, AFTER_DRAIN = false;
    bf16_t* O; int ldc; float s01, s67;
    __device__ __forceinline__ void operator()(const f32x4 (&acc)[2][2][4][2], const Unit& u, int wr, int wc, int fr, int fq) const {
        const int row0 = u.pm * BM + wr * 64 + fr, col0 = u.pn * BM + wc * 32 + 8 * fq;
        const float sc = u.pn < 2 ? s01 : ((u.pn == 6 || u.pn == 7) ? s67 : 1.f);
#pragma unroll
        for (int ai = 0; ai < 2; ++ai)
#pragma unroll
            for (int m = 0; m < 4; ++m) { bf16_t* rowp = O + (size_t)(row0 + ai * HALF + m * 16) * ldc + col0;
#pragma unroll
                for (int bj = 0; bj < 2; ++bj) { const f32x4 v0 = acc[ai][bj][m][0] * sc, v1 = acc[ai][bj][m][1] * sc;
                    u32x4 w; w.x = cvt_pk_bf16(v0[0], v0[1]); w.y = cvt_pk_bf16(v0[2], v0[3]); w.z = cvt_pk_bf16(v1[0], v1[1]); w.w = cvt_pk_bf16(v1[2], v1[3]);
                    *(u32x4*)(rowp + bj * HALF) = w; } }
    }
};
struct EpiStoreF32 {
    static constexpr bool PERM = true, AFTER_DRAIN = false;
    float* C; int ldc;
    __device__ __forceinline__ void operator()(const f32x4 (&acc)[2][2][4][2], const Unit& u, int wr, int wc, int fr, int fq) const {
        const int row0 = u.pm * BM + wr * 64 + fr, col0 = u.pn * BM + wc * 32 + 8 * fq;
#pragma unroll
        for (int ai = 0; ai < 2; ++ai)
#pragma unroll
            for (int m = 0; m < 4; ++m) { float* rowp = C + (size_t)(row0 + ai * HALF + m * 16) * ldc + col0;
#pragma unroll
                for (int bj = 0; bj < 2; ++bj) { *(f32x4*)(rowp + bj * HALF) = acc[ai][bj][m][0]; *(f32x4*)(rowp + bj * HALF + 4) = acc[ai][bj][m][1]; } }
    }
};
}

__device__ __forceinline__ void transpose_item(const float* W, int ldw, int K, int ncols, bf16_t* WT, float* scr, int item, int lane) {
    const int nblk = ncols / 32, kb = item / nblk, nb = item % nblk, k0 = 64 * kb, n0 = 32 * nb;
#pragma unroll 8
    for (int i = 0; i < 32; ++i) { const int kk = 2 * i + (lane >> 5); scr[kk * 33 + (lane & 31)] = W[(size_t)(k0 + kk) * ldw + n0 + (lane & 31)]; }
    asm volatile("s_waitcnt lgkmcnt(0)" ::: "memory");
    const int c = lane & 7;
#pragma unroll
    for (int j = 0; j < 4; ++j) { const int n = (lane >> 3) + 8 * j; const float* s = scr + (8 * c) * 33 + n;
        uint4 o; o.x = pk2(s[0 * 33], s[1 * 33]); o.y = pk2(s[2 * 33], s[3 * 33]); o.z = pk2(s[4 * 33], s[5 * 33]); o.w = pk2(s[6 * 33], s[7 * 33]);
        *(uint4*)(WT + (size_t)(n0 + n) * K + k0 + 8 * c) = o; }
    asm volatile("s_waitcnt lgkmcnt(0)" ::: "memory");
}
__device__ __forceinline__ void cvt_rows_bf16(const Ctx& c, const float* src, bf16_t* dst, size_t n8) {
    for (size_t i = (size_t)c.gwave * 64 + c.lane; i < n8; i += (size_t)c.nwaves * 64) {
        const float4 a = *(const float4*)(src + i * 8), b = *(const float4*)(src + i * 8 + 4);
        uint4 o; o.x = pk2(a.x, a.y); o.y = pk2(a.z, a.w); o.z = pk2(b.x, b.y); o.w = pk2(b.z, b.w);
        *(uint4*)(dst + i * 8) = o;
    }
}

template <int DQ, class BiasF>
__device__ __forceinline__ void causal_softmax_row(const float (&q)[DQ], const bf16_t* kbase, const bf16_t* vbase, int ld, int t, int smax, float scale, BiasF biasf, float (&O)[64]) {
    float m = -INFINITY;
    for (int s = 0; s <= smax; ++s) {
        const bf16_t* kr = kbase + (size_t)s * ld;
        float d = 0.f;
#pragma unroll
        for (int i = 0; i < DQ; ++i) d = fmaf(q[i], bf2f(kr[i]), d);
        const float lg = d * scale + biasf(s);
        m = (s <= t) ? fmaxf(m, lg) : m;
    }
    float l = 0.f;
#pragma unroll
    for (int i = 0; i < 64; ++i) O[i] = 0.f;
    for (int s = 0; s <= smax; ++s) {
        const bf16_t* kr = kbase + (size_t)s * ld;
        const bf16_t* vr = vbase + (size_t)s * ld;
        float d = 0.f;
#pragma unroll
        for (int i = 0; i < DQ; ++i) d = fmaf(q[i], bf2f(kr[i]), d);
        const float lg = d * scale + biasf(s);
        const float p = (s <= t) ? expf(lg - m) : 0.f;
        l += p;
#pragma unroll
        for (int i = 0; i < 64; ++i) O[i] = fmaf(p, bf2f(vr[i]), O[i]);
    }
    const float inv = 1.f / l;
#pragma unroll
    for (int i = 0; i < 64; ++i) O[i] *= inv;
}
__device__ __forceinline__ void store_row64_bf16(bf16_t* orow, const float (&v)[64]) {
#pragma unroll
    for (int i = 0; i < 64; i += 8) { uint4 o; o.x = pk2(v[i], v[i + 1]); o.y = pk2(v[i + 2], v[i + 3]); o.z = pk2(v[i + 4], v[i + 5]); o.w = pk2(v[i + 6], v[i + 7]); *(uint4*)(orow + i) = o; }
}

__device__ __forceinline__ void fg_phase(const Ctx& c, const bf16_t* hin, const float* cd_in, float* fg) {
    for (int t = c.gwave; t < NT; t += c.nwaves) {
        float acc[8];
#pragma unroll
        for (int j = 0; j < 8; ++j) acc[j] = 0.f;
        for (int r = 0; r < 16; ++r) {
            const int d = r * 64 + c.lane;
            const float xv = bf2f(hin[(size_t)t * DM + d]);
            const float4 w0 = *(const float4*)(cd_in + (size_t)d * CD_IN + 3072), w1 = *(const float4*)(cd_in + (size_t)d * CD_IN + 3076);
            acc[0] = fmaf(xv, w0.x, acc[0]); acc[1] = fmaf(xv, w0.y, acc[1]); acc[2] = fmaf(xv, w0.z, acc[2]); acc[3] = fmaf(xv, w0.w, acc[3]);
            acc[4] = fmaf(xv, w1.x, acc[4]); acc[5] = fmaf(xv, w1.y, acc[5]); acc[6] = fmaf(xv, w1.z, acc[6]); acc[7] = fmaf(xv, w1.w, acc[7]);
        }
#pragma unroll
        for (int j = 0; j < 8; ++j) acc[j] = wave_sum(acc[j]);
        if (c.lane == 0) { *(float4*)(fg + (size_t)t * 8) = make_float4(acc[0], acc[1], acc[2], acc[3]); *(float4*)(fg + (size_t)t * 8 + 4) = make_float4(acc[4], acc[5], acc[6], acc[7]); }
    }
}
__device__ __forceinline__ void fscan_naive(const Ctx& c, const float* fg, float* F, const float* bf) {
    for (int task = c.gwave; task < 32; task += c.nwaves) {
        const int b = task >> 3, h = task & 7;
        const int lane = c.lane;
        float v[64]; float tot = 0.f;
#pragma unroll
        for (int i = 0; i < 64; ++i) { const int s = lane * 64 + i; v[i] = log_sigmoid(fg[((size_t)b * SEQ + s) * 8 + h] + bf[h]); tot += v[i]; }
        float incl = tot;
#pragma unroll
        for (int o = 1; o < 64; o <<= 1) { const float n = __shfl_up(incl, o); if (lane >= o) incl += n; }
        float run = incl - tot;
#pragma unroll
        for (int i = 0; i < 64; ++i) { run += v[i]; F[(size_t)task * SEQ + lane * 64 + i] = run; }
    }
}

namespace att {
typedef short bf16x8 __attribute__((ext_vector_type(8)));
typedef short s16x4 __attribute__((ext_vector_type(4)));
typedef float f32x16 __attribute__((ext_vector_type(16)));
typedef float f32x4 __attribute__((ext_vector_type(4)));
typedef short v4i16_t __attribute__((ext_vector_type(4)));
constexpr float LOG2E = 1.4426950408889634f;
constexpr float NEG = -1e30f;
constexpr int KBUF = 0, VBUF = 16384, FBUF = 32768, TBUF = 33792, CNT = 34816;

__device__ __forceinline__ int tile_off(int row, int ch) { return 1024 * (row >> 3) + 512 * (ch >> 2) + 64 * (row & 7) + 16 * ((ch & 3) ^ ((row >> 2) & 3)); }
__device__ __forceinline__ s16x4 vtr(const LAS unsigned char* p) { return __builtin_bit_cast(s16x4, __builtin_amdgcn_ds_read_tr16_b64_v4i16((LAS v4i16_t*)p)); }
typedef float f32x2_t __attribute__((ext_vector_type(2))); typedef __bf16 bf16x2_t __attribute__((ext_vector_type(2)));
__device__ __forceinline__ unsigned cvtpk(float lo, float hi) { f32x2_t v = {lo, hi}; bf16x2_t b = __builtin_convertvector(v, bf16x2_t); return __builtin_bit_cast(unsigned, b); }
__device__ __forceinline__ float xhalf(float v) { return __shfl_xor(v, 32); }
__device__ __forceinline__ int key_of(int i, int hh) { return 8 * (i >> 2) + 4 * hh + (i & 3); }

__device__ __forceinline__ bf16x8 pfrag(const f32x16& p, int ks2) {
    unsigned w[4];
#pragma unroll
    for (int j = 0; j < 4; ++j) w[j] = cvtpk(p[8 * ks2 + 2 * j], p[8 * ks2 + 2 * j + 1]);
    typedef unsigned u32x4 __attribute__((ext_vector_type(4)));
    u32x4 v = {w[0], w[1], w[2], w[3]};
    return __builtin_bit_cast(bf16x8, v);
}
__device__ __forceinline__ void pv_block(f32x16 (&O)[2], const LAS unsigned char* vbuf, int kb, const f32x16& p, int lane) {
    const int hh = lane >> 5, q_ = (lane & 15) >> 2, p_ = lane & 3, cg = (lane >> 4) & 1;
#pragma unroll
    for (int ks2 = 0; ks2 < 2; ++ks2) {
        const bf16x8 pb = pfrag(p, ks2);
#pragma unroll
        for (int db = 0; db < 2; ++db) {
            const int c0 = 32 * db + 16 * cg, ch = (c0 >> 3) + (p_ >> 1);
            const int r0 = 32 * kb + 16 * ks2 + 4 * hh;
            const s16x4 a0 = vtr(vbuf + tile_off(r0 + q_, ch) + 8 * (p_ & 1));
            const s16x4 a1 = vtr(vbuf + tile_off(r0 + 8 + q_, ch) + 8 * (p_ & 1));
            const bf16x8 a = {a0[0], a0[1], a0[2], a0[3], a1[0], a1[1], a1[2], a1[3]};
            O[db] = __builtin_amdgcn_mfma_f32_32x32x16_bf16(a, pb, O[db], 0, 0, 0);
        }
    }
}
template <int S0, int NS>
__device__ __forceinline__ f32x16 qk_block(const LAS unsigned char* kbuf, int kb, const bf16x8 (&Qf)[4], int lane) {
    const int r = lane & 31, hh = lane >> 5;
    f32x16 s = {0.f, 0.f, 0.f, 0.f, 0.f, 0.f, 0.f, 0.f, 0.f, 0.f, 0.f, 0.f, 0.f, 0.f, 0.f, 0.f};
#pragma unroll
    for (int ks = S0; ks < S0 + NS; ++ks) {
        const bf16x8 a = *(const LAS bf16x8*)(kbuf + tile_off(32 * kb + r, 2 * ks + hh));
        s = __builtin_amdgcn_mfma_f32_32x32x16_bf16(a, Qf[ks], s, 0, 0, 0);
    }
    return s;
}
__device__ __forceinline__ void softmax_step(f32x16& x, float& m, float& l, f32x16 (&O)[2]) {
    float mx = x[0];
#pragma unroll
    for (int i = 1; i < 16; ++i) mx = fmaxf(mx, x[i]);
    mx = fmaxf(mx, xhalf(mx));
    const float mn = fmaxf(m, mx);
    if (!__all(mn == m)) {
        const float alpha = __builtin_amdgcn_exp2f(m - mn);
        l *= alpha;
#pragma unroll
        for (int i = 0; i < 16; ++i) { O[0][i] *= alpha; O[1][i] *= alpha; }
        m = mn;
    }
    float ls = 0.f;
#pragma unroll
    for (int i = 0; i < 16; ++i) { x[i] = __builtin_amdgcn_exp2f(x[i] - m); ls += x[i]; }
    l += ls;
}
__device__ __forceinline__ void store_ot(bf16_t* orow, const f32x16 (&O)[2], int hh) {
#pragma unroll
    for (int db = 0; db < 2; ++db)
#pragma unroll
        for (int g = 0; g < 4; ++g) {
            const int d0 = 32 * db + 8 * g + 4 * hh;
            *(uint2*)(orow + d0) = make_uint2(cvtpk(O[db][4 * g], O[db][4 * g + 1]), cvtpk(O[db][4 * g + 2], O[db][4 * g + 3]));
        }
}

struct UnitArgs {
    const bf16_t* qkv;
    bf16_t* out;
    int qcol, kcol, vcol, ocol;
};

struct DilArgs { int dil, rho, pat; bf16_t* po; float* pml; };
template <int TYPE>
__device__ __forceinline__ void causal_unit(const UnitArgs& A, int b, int h, int qb, unsigned char* scratch, int tid,
                                            const float* t5  , float lam, const float* subg, const float* F  , const DilArgs DA = DilArgs{1, 0, 0, nullptr, nullptr}) {
    const LAS unsigned char* lds = (const LAS unsigned char*)scratch;
    LAS unsigned char* ldsw = (LAS unsigned char*)scratch;
    const int lane = tid & 63, w = tid >> 6, r = lane & 31, hh = lane >> 5;
    const int q0 = qb * 256 + 32 * w, tq = q0 + r;
    const size_t rowbase = (size_t)b * SEQ;
    const int ktmax = 4 * qb + 3, kdiag = 4 * qb + (w >> 1);
    const int ktmin = (TYPE == 2) ? (4 * qb - 2 > 0 ? 4 * qb - 2 : 0) : 0;
    const int rs = (TYPE == 2) ? DA.dil : 1, r0off = (TYPE == 2) ? DA.rho : 0;
    const int srow = tid >> 3, sch = tid & 7;
    const bf16_t* kg = A.qkv + (rowbase + r0off + (size_t)rs * srow) * QKV_W + A.kcol + h * 64 + sch * 8;
    const bf16_t* vg = A.qkv + (rowbase + r0off + (size_t)rs * srow) * QKV_W + A.vcol + h * 64 + sch * 8;
    const size_t tstep = (size_t)64 * rs * QKV_W;
    const int soff = tile_off(srow, sch);
    bf16x8 Qf[4];
    {
        const bf16_t* qr = A.qkv + (rowbase + r0off + (size_t)rs * tq) * QKV_W + A.qcol + h * 64 + 8 * hh;
#pragma unroll
        for (int s = 0; s < 4; ++s) Qf[s] = *(const bf16x8*)(qr + 16 * s);
    }
    __syncthreads();
    if ((TYPE == 0 || TYPE == 2) && tid < 128) {
        const float far = t5[31 * 8 + h];
        ((LAS float*)(ldsw + TBUF))[tid] = (t5[t5_bucket(tid) * 8 + h] - far) * LOG2E;
    }
    if (TYPE == 1 && tid == 0) *(LAS unsigned*)(ldsw + CNT) = 0u;
    typedef unsigned u32x4 __attribute__((ext_vector_type(4)));
    u32x4 kreg = *(const u32x4*)(kg + (size_t)ktmax * tstep), vreg = *(const u32x4*)(vg + (size_t)ktmax * tstep);
    float freg = 0.f;
    if (TYPE == 3 && tid < 64) freg = F[(size_t)(b * 8 + h) * SEQ + ktmax * 64 + tid] * LOG2E;
    *(LAS u32x4*)(ldsw + KBUF + soff) = kreg; *(LAS u32x4*)(ldsw + VBUF + soff) = vreg;
    if (TYPE == 3 && tid < 64) ((LAS float*)(ldsw + FBUF))[tid] = freg;
    __syncthreads();

    f32x16 O0[2], O1[2];
#pragma unroll
    for (int i = 0; i < 16; ++i) { O0[0][i] = 0.f; O0[1][i] = 0.f; O1[0][i] = 0.f; O1[1][i] = 0.f; }
    float m0 = NEG, l0 = 0.f, m1 = NEG, l1 = 0.f;
    float R = 0.f;
    bool wdone = false;
    float f2t = 0.f;
    if (TYPE == 3) f2t = F[(size_t)(b * 8 + h) * SEQ + tq] * LOG2E;

    for (int kt = ktmax, it = 0; kt >= ktmin; --kt, ++it) {
        const int cur = it & 1;
        if (kt > ktmin) {
            kreg = *(const u32x4*)(kg + (size_t)(kt - 1) * tstep); vreg = *(const u32x4*)(vg + (size_t)(kt - 1) * tstep);
            if (TYPE == 3 && tid < 64) freg = F[(size_t)(b * 8 + h) * SEQ + (kt - 1) * 64 + tid] * LOG2E;
        }
        const LAS unsigned char* kbuf = lds + KBUF + cur * 8192;
        const LAS unsigned char* vbuf = lds + VBUF + cur * 8192;
        if (kt <= kdiag && !wdone) {
#pragma unroll
            for (int kbi = 0; kbi < 2; ++kbi) {
                const int kb = 1 - kbi;
                const int key0 = kt * 64 + kb * 32;
                if (TYPE == 1 ? (key0 >= q0 + 31) : (key0 > q0 + 31)) continue;
                if (TYPE == 2 && key0 + 31 < q0 - 128) continue;
                const bool need_mask = (TYPE == 1) ? (key0 + 31 >= q0) : (key0 + 31 > q0);
                if (TYPE == 0) {
                    f32x16 x0 = qk_block<0, 2>(kbuf, kb, Qf, lane), x1 = qk_block<2, 2>(kbuf, kb, Qf, lane);
                    if (q0 - (key0 + 31) < 113) {
                        const LAS float* tb = (const LAS float*)(lds + TBUF);
#pragma unroll
                        for (int i = 0; i < 16; ++i) {
                            const int dist = tq - (key0 + key_of(i, hh));
                            const float bv = (dist >= 0 && dist < 128) ? tb[dist < 0 ? 0 : (dist > 127 ? 127 : dist)] : 0.f;
                            x0[i] = dist < 0 ? NEG : x0[i] + bv; x1[i] = dist < 0 ? NEG : x1[i] + bv;
                        }
                    }
                    softmax_step(x0, m0, l0, O0);
                    pv_block(O0, vbuf, kb, x0, lane);
                    softmax_step(x1, m1, l1, O1);
                    pv_block(O1, vbuf, kb, x1, lane);
                } else if (TYPE == 2) {
                    f32x16 x = qk_block<0, 4>(kbuf, kb, Qf, lane);
                    const LAS float* tb = (const LAS float*)(lds + TBUF);
#pragma unroll
                    for (int i = 0; i < 16; ++i) {
                        const int dist = tq - (key0 + key_of(i, hh));
                        int bi = dist * rs; bi = bi < 0 ? 0 : (bi > 127 ? 127 : bi);
                        x[i] = (dist >= 0 && dist <= 128) ? x[i] + tb[bi] : NEG;
                    }
                    softmax_step(x, m0, l0, O0);
                    pv_block(O0, vbuf, kb, x, lane);
                } else if (TYPE == 3) {
                    f32x16 x = qk_block<0, 4>(kbuf, kb, Qf, lane);
                    const LAS float* fb = (const LAS float*)(lds + FBUF + cur * 256);
#pragma unroll
                    for (int g = 0; g < 4; ++g) {
                        const f32x4 fv = *(const LAS f32x4*)(fb + 32 * kb + 8 * g + 4 * hh);
#pragma unroll
                        for (int j = 0; j < 4; ++j) x[4 * g + j] += f2t - fv[j];
                    }
                    if (need_mask) {
#pragma unroll
                        for (int i = 0; i < 16; ++i) x[i] = (key0 + key_of(i, hh) > tq) ? NEG : x[i];
                    }
                    softmax_step(x, m0, l0, O0);
                    pv_block(O0, vbuf, kb, x, lane);
                } else {
                    f32x16 z = qk_block<0, 4>(kbuf, kb, Qf, lane);
                    f32x16 lr;
#pragma unroll
                    for (int i = 0; i < 16; ++i) {
                        const float e = __builtin_amdgcn_exp2f(-fabsf(z[i]));
                        float v = -(fmaxf(z[i], 0.f) + __builtin_amdgcn_logf(1.f + e));
                        if (need_mask) v = (key0 + key_of(i, hh) >= tq) ? 0.f : v;
                        lr[i] = v;
                    }
                    float T[4], Tp[4], sfx[16];
#pragma unroll
                    for (int g = 0; g < 4; ++g) {
                        sfx[4 * g + 3] = 0.f; sfx[4 * g + 2] = lr[4 * g + 3]; sfx[4 * g + 1] = sfx[4 * g + 2] + lr[4 * g + 2]; sfx[4 * g] = sfx[4 * g + 1] + lr[4 * g + 1];
                        T[g] = sfx[4 * g] + lr[4 * g];
                        Tp[g] = xhalf(T[g]);
                    }
                    float SP[4];
                    SP[3] = 0.f; SP[2] = T[3] + Tp[3]; SP[1] = SP[2] + T[2] + Tp[2]; SP[0] = SP[1] + T[1] + Tp[1];
                    const float tot = SP[0] + T[0] + Tp[0];
                    const float msel = hh == 0 ? 1.f : 0.f;
#pragma unroll
                    for (int g = 0; g < 4; ++g) {
                        const float goff = R + SP[g] + msel * Tp[g];
#pragma unroll
                        for (int j = 0; j < 4; ++j) {
                            const int i = 4 * g + j;
                            float wv = __builtin_amdgcn_exp2f(lr[i] + z[i] + goff + sfx[i]);
                            if (need_mask) wv = (key0 + key_of(i, hh) >= tq) ? 0.f : wv;
                            z[i] = wv;
                        }
                    }
                    R += tot;
                    pv_block(O0, vbuf, kb, z, lane);
                }
            }
            if (TYPE == 1) {
                if (__all(R < -216.4f)) { wdone = true; if (lane == 0) (void)__hip_atomic_fetch_add((LAS unsigned*)(ldsw + CNT), 1u, __ATOMIC_RELAXED, __HIP_MEMORY_SCOPE_WORKGROUP); }
            }
        }
        if (kt > ktmin) {
            *(LAS u32x4*)(ldsw + KBUF + (cur ^ 1) * 8192 + soff) = kreg; *(LAS u32x4*)(ldsw + VBUF + (cur ^ 1) * 8192 + soff) = vreg;
            if (TYPE == 3 && tid < 64) ((LAS float*)(ldsw + FBUF + (cur ^ 1) * 256))[tid] = freg;
        }
        __syncthreads();
        if (TYPE == 1) { const unsigned cnt = *(const LAS unsigned*)(lds + CNT); __syncthreads(); if (cnt == 8u) break; }
    }
    if (TYPE == 2) {
        const size_t prow = ((size_t)DA.pat * NT + rowbase + r0off + (size_t)rs * tq) * 8 + h;
        store_ot(DA.po + prow * 64, O0, hh);
        const float lt = l0 + xhalf(l0);
        if (hh == 0) *(float2*)(DA.pml + prow * 2) = make_float2(m0, lt);
        return;
    }
    bf16_t* orow = A.out + (rowbase + tq) * DM + A.ocol + h * 64;
    if (TYPE == 0) {
        const float i0 = 1.f / (l0 + xhalf(l0)), i1 = lam / (l1 + xhalf(l1));
        float ss = 0.f;
#pragma unroll
        for (int db = 0; db < 2; ++db)
#pragma unroll
            for (int i = 0; i < 16; ++i) { const float o = O0[db][i] * i0 - O1[db][i] * i1; O0[db][i] = o; ss = fmaf(o, o, ss); }
        ss += xhalf(ss);
        const float rn = rsqrtf(ss * (1.f / 64.f) + LN_EPS) * 0.8f;
#pragma unroll
        for (int db = 0; db < 2; ++db)
#pragma unroll
            for (int i = 0; i < 16; ++i) O0[db][i] *= rn * subg[32 * db + key_of(i, hh)];
        store_ot(orow, O0, hh);
    } else if (TYPE == 3) {
        const float i0 = 1.f / (l0 + xhalf(l0));
#pragma unroll
        for (int db = 0; db < 2; ++db)
#pragma unroll
            for (int i = 0; i < 16; ++i) O0[db][i] *= i0;
        store_ot(orow, O0, hh);
    } else {
        store_ot(orow, O0, hh);
    }
}
}

__device__ __forceinline__ int xcd_perm256(int p) { return (p & 7) * 32 + (p >> 3); }

__device__ __forceinline__ void attn_layer0_mfma(const Ctx& c, const bf16_t* qkv, bf16_t* out, const float* t5, const float* lamv, const float* subg) {
    float s01 = 0.f, s23 = 0.f;
    for (int i = 0; i < 32; ++i) { s01 += lamv[i] * lamv[32 + i]; s23 += lamv[64 + i] * lamv[96 + i]; }
    const float lam = expf(s01) - expf(s23) + 0.2f;
    unsigned char* scratch = (unsigned char*)c.lds;
    const att::UnitArgs UA{qkv, out, 0, 512, 1024, 0}, UB{qkv, out, 1536, 2048, 2560, 512};
    for (int p = c.bid; p < 256; p += c.nblk) {
        const int pp = xcd_perm256(p), bh = pp >> 3, qb = pp & 7;
        att::causal_unit<0>(UA, bh >> 3, bh & 7, 15 - qb, scratch, c.tid, t5, lam, subg, nullptr);
        att::causal_unit<0>(UA, bh >> 3, bh & 7, qb, scratch, c.tid, t5, lam, subg, nullptr);
#pragma unroll 1
        for (int k = 0; k < 2; ++k) {
            const int u = pp * 2 + k, bh2 = u >> 4, qb2 = u & 15;
            att::causal_unit<1>(UB, bh2 >> 3, bh2 & 7, qb2, scratch, c.tid, nullptr, 0.f, nullptr, nullptr);
        }
    }
}
__device__ __forceinline__ void attn_dilated_mfma(const Ctx& c, const bf16_t* qkv, const float* t5, bf16_t* po, float* pml) {
    unsigned char* scratch = (unsigned char*)c.lds;
    const att::UnitArgs UC{qkv, nullptr, 0, 512, 1024, 0};
    for (int p = c.bid; p < 256; p += c.nblk) {
        const int pp = xcd_perm256(p);
#pragma unroll 1
        for (int k = 0; k < 6; ++k) {
            const int u = pp * 6 + k, bh = u / 48, v = u % 48;
            int pat, rho, qb, dil;
            if (v < 16) { pat = 0; dil = 1; rho = 0; qb = v; }
            else if (v < 32) { pat = 1; dil = 4; rho = (v - 16) >> 2; qb = (v - 16) & 3; }
            else { pat = 2; dil = 16; rho = v - 32; qb = 0; }
            att::causal_unit<2>(UC, bh >> 3, bh & 7, qb, scratch, c.tid, t5, 0.f, nullptr, nullptr, att::DilArgs{dil, rho, pat, po, pml});
        }
    }
}
__device__ __forceinline__ void dilated_combine(const Ctx& c, const bf16_t* po, const float* pml, bf16_t* out) {
    const size_t n = (size_t)NT * 8 * 8;
    for (size_t i = (size_t)c.gwave * 64 + c.lane; i < n; i += (size_t)c.nwaves * 64) {
        const size_t th = i >> 3; const int ch = (int)(i & 7);
        float m[3], l[3];
#pragma unroll
        for (int p = 0; p < 3; ++p) { const float2 ml = *(const float2*)(pml + ((size_t)p * NT * 8 + th) * 2); m[p] = ml.x; l[p] = ml.y; }
        const float mm = fmaxf(m[0], fmaxf(m[1], m[2]));
        float wgt[3], den = 0.f;
#pragma unroll
        for (int p = 0; p < 3; ++p) { wgt[p] = __builtin_amdgcn_exp2f(m[p] - mm); den += wgt[p] * l[p]; }
        const float inv = 1.f / den;
        float o[8];
#pragma unroll
        for (int d = 0; d < 8; ++d) o[d] = 0.f;
#pragma unroll
        for (int p = 0; p < 3; ++p) {
            const uint4 v = *(const uint4*)(po + ((size_t)p * NT * 8 + th) * 64 + ch * 8);
            const unsigned w4[4] = {v.x, v.y, v.z, v.w};
#pragma unroll
            for (int q = 0; q < 4; ++q) { o[2 * q] = fmaf(wgt[p], __builtin_bit_cast(float, w4[q] << 16), o[2 * q]); o[2 * q + 1] = fmaf(wgt[p], __builtin_bit_cast(float, w4[q] & 0xffff0000u), o[2 * q + 1]); }
        }
        uint4 ov; ov.x = pk2(o[0] * inv, o[1] * inv); ov.y = pk2(o[2] * inv, o[3] * inv); ov.z = pk2(o[4] * inv, o[5] * inv); ov.w = pk2(o[6] * inv, o[7] * inv);
        const size_t tok = th >> 3; const int hd = (int)(th & 7);
        *(uint4*)(out + tok * DM + hd * 64 + ch * 8) = ov;
    }
}
__device__ __forceinline__ void attn_fox_mfma(const Ctx& c, const bf16_t* qkv, const float* F, bf16_t* out) {
    unsigned char* scratch = (unsigned char*)c.lds;
    const att::UnitArgs UD{qkv, out, 1536, 2048, 2560, 512};
    for (int p = c.bid; p < 256; p += c.nblk) {
        const int pp = xcd_perm256(p), bh = pp >> 3, qb = pp & 7;
        att::causal_unit<3>(UD, bh >> 3, bh & 7, 15 - qb, scratch, c.tid, nullptr, 0.f, nullptr, F);
        att::causal_unit<3>(UD, bh >> 3, bh & 7, qb, scratch, c.tid, nullptr, 0.f, nullptr, F);
    }
}

__device__ __forceinline__ void ln_rows(const Ctx& c, const float* hin32, const bf16_t* hin16, const float* add, const float* g, const float* bta, float* out, bf16_t* outb, unsigned char* out8 = nullptr, float* oscale = nullptr) {
    for (int t = c.gwave; t < NT; t += c.nwaves) {
        float v[16];
        float s = 0.f;
#pragma unroll
        for (int r = 0; r < 4; ++r) {
            const int d = r * 256 + c.lane * 4;
            float4 a;
            if (hin32) a = *(const float4*)(hin32 + (size_t)t * DM + d);
            else { const uint2 w = *(const uint2*)(hin16 + (size_t)t * DM + d); a = make_float4(__builtin_bit_cast(float, w.x << 16), __builtin_bit_cast(float, w.x & 0xffff0000u), __builtin_bit_cast(float, w.y << 16), __builtin_bit_cast(float, w.y & 0xffff0000u)); }
            const float4 m = *(const float4*)(add + (size_t)t * DM + d);
            v[r * 4 + 0] = DN_ALPHA * a.x + m.x; v[r * 4 + 1] = DN_ALPHA * a.y + m.y; v[r * 4 + 2] = DN_ALPHA * a.z + m.z; v[r * 4 + 3] = DN_ALPHA * a.w + m.w;
            s += v[r * 4] + v[r * 4 + 1] + v[r * 4 + 2] + v[r * 4 + 3];
        }
        const float mu = wave_sum(s) * (1.f / DM);
        float q = 0.f;
#pragma unroll
        for (int i = 0; i < 16; ++i) { v[i] -= mu; q = fmaf(v[i], v[i], q); }
        const float rs = rsqrtf(wave_sum(q) * (1.f / DM) + LN_EPS);
        float amax = 0.f;
#pragma unroll
        for (int r = 0; r < 4; ++r) {
            const int d = r * 256 + c.lane * 4;
            const float4 gg = *(const float4*)(g + d), bb = *(const float4*)(bta + d);
            const float4 o = make_float4(v[r * 4] * rs * gg.x + bb.x, v[r * 4 + 1] * rs * gg.y + bb.y, v[r * 4 + 2] * rs * gg.z + bb.z, v[r * 4 + 3] * rs * gg.w + bb.w);
            if (out) *(float4*)(out + (size_t)t * DM + d) = o;
            if (outb) *(uint2*)(outb + (size_t)t * DM + d) = make_uint2(pk2(o.x, o.y), pk2(o.z, o.w));
            v[r * 4] = o.x; v[r * 4 + 1] = o.y; v[r * 4 + 2] = o.z; v[r * 4 + 3] = o.w;
            amax = fmaxf(amax, fmaxf(fmaxf(fabsf(o.x), fabsf(o.y)), fmaxf(fabsf(o.z), fabsf(o.w))));
        }
        if (out8) {
#pragma unroll
            for (int o = 32; o >= 1; o >>= 1) amax = fmaxf(amax, __shfl_xor(amax, o));
            int e = (int)((__builtin_bit_cast(unsigned, amax) >> 23) & 0xffu) - 127;
            e = e < -100 ? -100 : (e > 100 ? 100 : e);
            const float sc = __builtin_bit_cast(float, (unsigned)(127 + 7 - e) << 23);
#pragma unroll
            for (int r = 0; r < 4; ++r) {
                int w = 0;
                w = __builtin_amdgcn_cvt_pk_fp8_f32(v[r * 4] * sc, v[r * 4 + 1] * sc, w, false); w = __builtin_amdgcn_cvt_pk_fp8_f32(v[r * 4 + 2] * sc, v[r * 4 + 3] * sc, w, true);
                *(int*)(out8 + (size_t)t * DM + r * 256 + c.lane * 4) = w;
            }
            if (c.lane == 0) oscale[t] = __builtin_bit_cast(float, (unsigned)(127 - 7 + e) << 23);
        }
    }
}

__device__ __forceinline__ void topk_insert(float (&tv)[16], int (&ti)[16], float v, int id) {
#pragma unroll
    for (int j = 15; j >= 1; --j) {
        const bool g = v > tv[j], gp = v > tv[j - 1];
        tv[j] = g ? (gp ? tv[j - 1] : v) : tv[j];
        ti[j] = g ? (gp ? ti[j - 1] : id) : ti[j];
    }
    const bool g0 = v > tv[0];
    tv[0] = g0 ? v : tv[0]; ti[0] = g0 ? id : ti[0];
}

namespace rt {
typedef short bf16x8 __attribute__((ext_vector_type(8)));
typedef float f32x16 __attribute__((ext_vector_type(16)));
__device__ __forceinline__ void ins_packed(float (&tv)[16], float v) {
#pragma unroll
    for (int j = 15; j >= 1; --j) { const bool g = v > tv[j], gp = v > tv[j - 1]; tv[j] = g ? (gp ? tv[j - 1] : v) : tv[j]; }
    tv[0] = v > tv[0] ? v : tv[0];
}
__device__ __forceinline__ float pk_idx(float v, int idx) { return __builtin_bit_cast(float, (__builtin_bit_cast(unsigned, v) & ~127u) | (unsigned)idx); }
__device__ __forceinline__ float pk_val(float p) { return __builtin_bit_cast(float, __builtin_bit_cast(unsigned, p) & ~127u); }
__device__ __forceinline__ int pk_id(float p) { return (int)(__builtin_bit_cast(unsigned, p) & 127u); }

__device__ __forceinline__ void top16_of_set(float (&tv)[16], const bf16_t* pq_row  , const bf16_t* keys  , int r, int hh) {
    bf16x8 B[8];
#pragma unroll
    for (int s = 0; s < 8; ++s) B[s] = *(const bf16x8*)(pq_row + 16 * s);
#pragma unroll
    for (int j = 0; j < 16; ++j) tv[j] = -INFINITY;
#pragma unroll 1
    for (int blk = 0; blk < 4; ++blk) {
        const bf16_t* kr = keys + (size_t)(32 * blk + r) * 128 + 8 * hh;
        f32x16 acc = {0.f, 0.f, 0.f, 0.f, 0.f, 0.f, 0.f, 0.f, 0.f, 0.f, 0.f, 0.f, 0.f, 0.f, 0.f, 0.f};
#pragma unroll
        for (int s = 0; s < 8; ++s) acc = __builtin_amdgcn_mfma_f32_32x32x16_bf16(*(const bf16x8*)(kr + 16 * s), B[s], acc, 0, 0, 0);
#pragma unroll
        for (int i = 0; i < 16; ++i) ins_packed(tv, pk_idx(acc[i], 32 * blk + 8 * (i >> 2) + 4 * hh + (i & 3)));
    }
    float pt[16];
#pragma unroll
    for (int j = 0; j < 16; ++j) pt[j] = __shfl_xor(tv[j], 32);
#pragma unroll
    for (int j = 0; j < 16; ++j) ins_packed(tv, pt[j]);
}
}

__device__ __forceinline__ void peer_route_phase(const Ctx& c, const bf16_t* pq, const bf16_t* subk  , int* eidx, float* gate) {
    const int lane = c.lane, r = lane & 31, hh = lane >> 5;
    for (int task = c.gwave; task < (NT / 32) * 8; task += c.nwaves) {
        const int h = task & 7, t = (task >> 3) * 32 + r;
        float la[16], lb[16];
        rt::top16_of_set(la, pq + (size_t)t * PEER_QW + (2 * h) * 128 + 8 * hh, subk + (size_t)(2 * h) * 128 * 128, r, hh);
        rt::top16_of_set(lb, pq + (size_t)t * PEER_QW + (2 * h + 1) * 128 + 8 * hh, subk + (size_t)(2 * h + 1) * 128 * 128, r, hh);
        float tv[16]; int ti[16];
#pragma unroll
        for (int j = 0; j < 16; ++j) { tv[j] = -INFINITY; ti[j] = 0; }
#pragma unroll
        for (int i = 0; i < 16; ++i) {
            const float av = rt::pk_val(la[i]); const int ai = rt::pk_id(la[i]) * 128;
#pragma unroll
            for (int j = 0; j < 16 / (i + 1); ++j) topk_insert(tv, ti, av + rt::pk_val(lb[j]), ai + rt::pk_id(lb[j]));
        }
        float sum = 0.f, e[16];
#pragma unroll
        for (int j = 0; j < 16; ++j) { e[j] = expf(tv[j] - tv[0]); sum += e[j]; }
        const float inv = 1.f / sum;
        if (hh == 0) {
            int* oi = eidx + ((size_t)t * 8 + h) * 16; float* og = gate + ((size_t)t * 8 + h) * 16;
#pragma unroll
            for (int j = 0; j < 16; j += 4) {
                *(int4*)(oi + j) = make_int4(ti[j], ti[j + 1], ti[j + 2], ti[j + 3]);
                *(float4*)(og + j) = make_float4(e[j] * inv, e[j + 1] * inv, e[j + 2] * inv, e[j + 3] * inv);
            }
        }
    }
}

typedef unsigned u32x4_t __attribute__((ext_vector_type(4)));
typedef float f32x2_t __attribute__((ext_vector_type(2)));
#define GAS __attribute__((address_space(1)))
__device__ __forceinline__ float gelu_exact(float d) { return 0.5f * d * (1.f + erff(d * 0.70710678118654752f)); }

template <int MODE>
__device__ __forceinline__ void cvt_rows_fp8(const Ctx& c, const float* src, unsigned char* dst, float* rowscale, int nrows) {
    for (int row = c.gwave; row < nrows; row += c.nwaves) {
        const float* s = src + (size_t)row * DM + c.lane * 16;
        const float4 a0 = *(const float4*)s, a1 = *(const float4*)(s + 4), a2 = *(const float4*)(s + 8), a3 = *(const float4*)(s + 12);
        float am = fmaxf(fmaxf(fmaxf(fabsf(a0.x), fabsf(a0.y)), fmaxf(fabsf(a0.z), fabsf(a0.w))), fmaxf(fmaxf(fabsf(a1.x), fabsf(a1.y)), fmaxf(fabsf(a1.z), fabsf(a1.w))));
        am = fmaxf(am, fmaxf(fmaxf(fmaxf(fabsf(a2.x), fabsf(a2.y)), fmaxf(fabsf(a2.z), fabsf(a2.w))), fmaxf(fmaxf(fabsf(a3.x), fabsf(a3.y)), fmaxf(fabsf(a3.z), fabsf(a3.w)))));
#pragma unroll
        for (int o = 32; o >= 1; o >>= 1) am = fmaxf(am, __shfl_xor(am, o));
        int e = (int)((__builtin_bit_cast(unsigned, am) >> 23) & 0xffu) - 127;
        e = e < -100 ? -100 : (e > 100 ? 100 : e);
        const float sc = __builtin_bit_cast(float, (unsigned)(127 + 7 - e) << 23), inv = __builtin_bit_cast(float, (unsigned)(127 - 7 + e) << 23);
        int w0 = 0, w1 = 0, w2 = 0, w3 = 0;
        w0 = __builtin_amdgcn_cvt_pk_fp8_f32(a0.x * sc, a0.y * sc, w0, false); w0 = __builtin_amdgcn_cvt_pk_fp8_f32(a0.z * sc, a0.w * sc, w0, true);
        w1 = __builtin_amdgcn_cvt_pk_fp8_f32(a1.x * sc, a1.y * sc, w1, false); w1 = __builtin_amdgcn_cvt_pk_fp8_f32(a1.z * sc, a1.w * sc, w1, true);
        w2 = __builtin_amdgcn_cvt_pk_fp8_f32(a2.x * sc, a2.y * sc, w2, false); w2 = __builtin_amdgcn_cvt_pk_fp8_f32(a2.z * sc, a2.w * sc, w2, true);
        w3 = __builtin_amdgcn_cvt_pk_fp8_f32(a3.x * sc, a3.y * sc, w3, false); w3 = __builtin_amdgcn_cvt_pk_fp8_f32(a3.z * sc, a3.w * sc, w3, true);
        const int lyr = row >> 14, er = row & 16383;
        unsigned char* dp = MODE == 0 ? dst + ((size_t)lyr * 16384 + (size_t)(er & 7) * 2048 + (er >> 3)) * DM + c.lane * 16
                                      : dst + (size_t)lyr * 16384 * DM + (size_t)(c.lane >> 3) * (16384 * 128) + (size_t)er * 128 + (c.lane & 7) * 16;
        *(uint4*)dp = make_uint4((unsigned)w0, (unsigned)w1, (unsigned)w2, (unsigned)w3);
        if (c.lane == 0) rowscale[row] = inv;
    }
}
__device__ __forceinline__ float dot16_fp8(const u32x4_t w, const float (&x)[16], float acc) {
    const int w0 = (int)w.x, w1 = (int)w.y, w2 = (int)w.z, w3 = (int)w.w;
    f32x2_t p;
    p = __builtin_amdgcn_cvt_pk_f32_fp8(w0, false); acc = fmaf(p.x, x[0], acc); acc = fmaf(p.y, x[1], acc);
    p = __builtin_amdgcn_cvt_pk_f32_fp8(w0, true);  acc = fmaf(p.x, x[2], acc); acc = fmaf(p.y, x[3], acc);
    p = __builtin_amdgcn_cvt_pk_f32_fp8(w1, false); acc = fmaf(p.x, x[4], acc); acc = fmaf(p.y, x[5], acc);
    p = __builtin_amdgcn_cvt_pk_f32_fp8(w1, true);  acc = fmaf(p.x, x[6], acc); acc = fmaf(p.y, x[7], acc);
    p = __builtin_amdgcn_cvt_pk_f32_fp8(w2, false); acc = fmaf(p.x, x[8], acc); acc = fmaf(p.y, x[9], acc);
    p = __builtin_amdgcn_cvt_pk_f32_fp8(w2, true);  acc = fmaf(p.x, x[10], acc); acc = fmaf(p.y, x[11], acc);
    p = __builtin_amdgcn_cvt_pk_f32_fp8(w3, false); acc = fmaf(p.x, x[12], acc); acc = fmaf(p.y, x[13], acc);
    p = __builtin_amdgcn_cvt_pk_f32_fp8(w3, true);  acc = fmaf(p.x, x[14], acc); acc = fmaf(p.y, x[15], acc);
    return acc;
}
__device__ __forceinline__ void axpy16_fp8(const u32x4_t w, float cv, float (&acc)[16]) {
    const int w0 = (int)w.x, w1 = (int)w.y, w2 = (int)w.z, w3 = (int)w.w;
    f32x2_t p;
    p = __builtin_amdgcn_cvt_pk_f32_fp8(w0, false); acc[0] = fmaf(cv, p.x, acc[0]); acc[1] = fmaf(cv, p.y, acc[1]);
    p = __builtin_amdgcn_cvt_pk_f32_fp8(w0, true);  acc[2] = fmaf(cv, p.x, acc[2]); acc[3] = fmaf(cv, p.y, acc[3]);
    p = __builtin_amdgcn_cvt_pk_f32_fp8(w1, false); acc[4] = fmaf(cv, p.x, acc[4]); acc[5] = fmaf(cv, p.y, acc[5]);
    p = __builtin_amdgcn_cvt_pk_f32_fp8(w1, true);  acc[6] = fmaf(cv, p.x, acc[6]); acc[7] = fmaf(cv, p.y, acc[7]);
    p = __builtin_amdgcn_cvt_pk_f32_fp8(w2, false); acc[8] = fmaf(cv, p.x, acc[8]); acc[9] = fmaf(cv, p.y, acc[9]);
    p = __builtin_amdgcn_cvt_pk_f32_fp8(w2, true);  acc[10] = fmaf(cv, p.x, acc[10]); acc[11] = fmaf(cv, p.y, acc[11]);
    p = __builtin_amdgcn_cvt_pk_f32_fp8(w3, false); acc[12] = fmaf(cv, p.x, acc[12]); acc[13] = fmaf(cv, p.y, acc[13]);
    p = __builtin_amdgcn_cvt_pk_f32_fp8(w3, true);  acc[14] = fmaf(cv, p.x, acc[14]); acc[15] = fmaf(cv, p.y, acc[15]);
}

__device__ __forceinline__ void peer_u_phase(const Ctx& c, const unsigned char* x8_, const float* xs_, const int* eidx_, const float* gate_, float* coef, const unsigned char* U8_, const float* rsu_, const float* rsv_) {
    const GAS unsigned char* x8 = (const GAS unsigned char*)x8_; const GAS float* xs = (const GAS float*)xs_; const GAS int* eidx = (const GAS int*)eidx_; const GAS float* gate = (const GAS float*)gate_;
    const GAS unsigned char* U8 = (const GAS unsigned char*)U8_; const GAS float* rsu = (const GAS float*)rsu_; const GAS float* rsv = (const GAS float*)rsv_;
    const int lane = c.lane, r = lane & 15, kb = lane >> 4, fin = 4 * kb + (lane & 3);
    LAS unsigned char* rowbuf = (LAS unsigned char*)c.lds + c.wave * (16 * 1040);
    typedef float f32x4_t __attribute__((ext_vector_type(4)));
    typedef long i64x2_t __attribute__((ext_vector_type(2)));
#define U_SLOT(e) (((size_t)((e) & 7) * 2048 + ((e) >> 3)) * DM)
#define U_DMA(erow) do { _Pragma("unroll") for (int q = 0; q < 16; ++q) { const int eq = __builtin_amdgcn_readlane(erow, q); \
        __builtin_amdgcn_global_load_lds((const GAS unsigned*)(U8 + U_SLOT(eq) + lane * 16), (LAS unsigned*)(rowbuf + q * 1040), 16, 0, 0); } } while (0)
    for (int wv = c.gwave; wv < NT / 8; wv += c.nwaves) {
        const int tb = wv * 8;
        int e_cur = eidx[(size_t)tb * 128 + r];
        int ef = __shfl(e_cur, fin); float su = rsu[ef], sv = rsv[ef], gt = gate[(size_t)tb * 128 + fin];
        U_DMA(e_cur);
        int e_nxt = eidx[(size_t)tb * 128 + 16 + r];
        float xsc = xs[tb];
        i64x2_t bx[16];
#pragma unroll
        for (int s = 0; s < 16; ++s) bx[s] = *(const GAS i64x2_t*)(x8 + (size_t)tb * DM + 64 * s + 16 * kb);
#pragma unroll 1
        for (int n = 0; n < 64; ++n) {
            const int t = tb + (n >> 3), ch = n & 7;
            asm volatile("s_waitcnt vmcnt(0)" ::: "memory");
            i64x2_t a[16];
#pragma unroll
            for (int s = 0; s < 16; ++s) a[s] = *(const LAS i64x2_t*)(rowbuf + r * 1040 + 64 * s + 16 * kb);
            const float su_c = su, sv_c = sv, gt_c = gt, xsc_c = xsc;
            asm volatile("s_waitcnt lgkmcnt(0)" ::: "memory");
            const int n1 = n < 63 ? n + 1 : 63, n2 = n < 62 ? n + 2 : 63;
            ef = __shfl(e_nxt, fin);
            su = rsu[ef]; sv = rsv[ef]; gt = gate[(size_t)(tb + (n1 >> 3)) * 128 + 16 * (n1 & 7) + fin];
            xsc = xs[tb + (n1 >> 3)];
            U_DMA(e_nxt);
            e_nxt = eidx[(size_t)(tb + (n2 >> 3)) * 128 + 16 * (n2 & 7) + r];
            f32x4_t acc = {0.f, 0.f, 0.f, 0.f};
#pragma unroll
            for (int s = 0; s < 16; ++s) {
                acc = __builtin_amdgcn_mfma_f32_16x16x32_fp8_fp8(a[s].x, bx[s].x, acc, 0, 0, 0);
                acc = __builtin_amdgcn_mfma_f32_16x16x32_fp8_fp8(a[s].y, bx[s].y, acc, 0, 0, 0);
            }
            if (ch == 7 && n < 63) {
#pragma unroll
                for (int s = 0; s < 16; ++s) bx[s] = *(const GAS i64x2_t*)(x8 + (size_t)(t + 1) * DM + 64 * s + 16 * kb);
            }
            const int c4 = lane & 3;
            const float dsel = c4 == 0 ? acc[0] : (c4 == 1 ? acc[1] : (c4 == 2 ? acc[2] : acc[3]));
            if (r < 4) coef[(size_t)t * 128 + 16 * ch + fin] = gt_c * gelu_exact(dsel * su_c * xsc_c) * sv_c;
        }
    }
#undef U_SLOT
#undef U_DMA
}

__device__ __forceinline__ void peer_v_phase(const Ctx& c, const int* eidx_, const float* coef_, const unsigned char* V8_, float* Y) {
    const GAS int* eidx = (const GAS int*)eidx_; const GAS float* coef = (const GAS float*)coef_; const GAS unsigned char* V8 = (const GAS unsigned char*)V8_;
    const int lane = c.lane, sg = lane >> 3, part = lane & 7;
    typedef int i32x4_t __attribute__((ext_vector_type(4)));
    typedef float f32x4_t __attribute__((ext_vector_type(4)));
    for (int vb = c.bid; vb < 256; vb += c.nblk) {
        const int j = vb & 7, rnk = vb >> 3;
        const int dcol = 128 * j + part * 16;
        const int t0 = rnk * 512 + c.wave * 64;
        i32x4_t e[4]; f32x4_t cf[4];
#pragma unroll
        for (int q = 0; q < 4; ++q) { e[q] = *(const GAS i32x4_t*)(eidx + (size_t)t0 * 128 + sg * 16 + 4 * q); cf[q] = *(const GAS f32x4_t*)(coef + (size_t)t0 * 128 + sg * 16 + 4 * q); }
#pragma unroll 1
        for (int i = 0; i < 64; ++i) {
            const int t = t0 + i, tn = t0 + (i < 63 ? i + 1 : 63);
            u32x4_t rows[16];
#pragma unroll
            for (int it = 0; it < 16; ++it) rows[it] = *(const GAS u32x4_t*)(V8 + (size_t)j * (16384 * 128) + (size_t)e[it >> 2][it & 3] * 128 + part * 16);
            i32x4_t en[4]; f32x4_t cn[4];
#pragma unroll
            for (int q = 0; q < 4; ++q) { en[q] = *(const GAS i32x4_t*)(eidx + (size_t)tn * 128 + sg * 16 + 4 * q); cn[q] = *(const GAS f32x4_t*)(coef + (size_t)tn * 128 + sg * 16 + 4 * q); }
            float acc[16];
#pragma unroll
            for (int d = 0; d < 16; ++d) acc[d] = 0.f;
#pragma unroll
            for (int it = 0; it < 16; ++it) axpy16_fp8(rows[it], cf[it >> 2][it & 3], acc);
#pragma unroll
            for (int d = 0; d < 16; ++d) { acc[d] += __shfl_xor(acc[d], 8); acc[d] += __shfl_xor(acc[d], 16); acc[d] += __shfl_xor(acc[d], 32); }
            if (lane < 8) {
                float* yp = Y + (size_t)t * DM + dcol;
#pragma unroll
                for (int q = 0; q < 4; ++q) *(f32x4_t*)(yp + 4 * q) = (f32x4_t){acc[4 * q], acc[4 * q + 1], acc[4 * q + 2], acc[4 * q + 3]};
            }
#pragma unroll
            for (int q = 0; q < 4; ++q) { e[q] = en[q]; cf[q] = cn[q]; }
        }
    }
}

__device__ __forceinline__ void prologue_phase(const Ctx& c, const float* x, const float* ab_in, const float* ab_out, const float* cd_in, const float* cd_out, const float* wq, const float* pu, const float* pv, const float* sk, unsigned char* ws) {
    float* scr = c.lds + c.wave * 4096;
    constexpr int I_IN = 16 * 96, I_OUT = 16 * 32, I_WQ = 16 * 64;
    constexpr int NITEMS = 2 * I_IN + 2 * I_OUT + 2 * I_WQ;
    for (int it = c.gwave; it < NITEMS; it += c.nwaves) {
        int r = it;
        if (r < I_IN) { transpose_item(ab_in, QKV_W, DM, QKV_W, (bf16_t*)(ws + WT_ABIN), scr, r, c.lane); continue; } r -= I_IN;
        if (r < I_IN) { transpose_item(cd_in, CD_IN, DM, QKV_W, (bf16_t*)(ws + WT_CDIN), scr, r, c.lane); continue; } r -= I_IN;
        if (r < I_OUT) { transpose_item(ab_out, DM, DM, DM, (bf16_t*)(ws + WT_ABOUT), scr, r, c.lane); continue; } r -= I_OUT;
        if (r < I_OUT) { transpose_item(cd_out, DM, DM, DM, (bf16_t*)(ws + WT_CDOUT), scr, r, c.lane); continue; } r -= I_OUT;
        if (r < I_WQ) { transpose_item(wq, PEER_QW, DM, PEER_QW, (bf16_t*)(ws + WT_WQ), scr, r, c.lane); continue; } r -= I_WQ;
        transpose_item(wq + (size_t)DM * PEER_QW, PEER_QW, DM, PEER_QW, (bf16_t*)(ws + WT_WQ + 4 * MiB), scr, r, c.lane);
    }
    cvt_rows_bf16(c, x, (bf16_t*)(ws + WS_ACTIN), (size_t)NT * DM / 8);
    cvt_rows_fp8<0>(c, pu, ws + WS_U8, (float*)(ws + WS_RS), 2 * 16384);
    cvt_rows_fp8<1>(c, pv, ws + WS_V8, (float*)(ws + WS_RS) + 2 * 16384, 2 * 16384);
    cvt_rows_bf16(c, sk, (bf16_t*)(ws + WS_SKB), (size_t)2 * 16 * 128 * 128 / 8);
}

constexpr int NPHASE = 1 + 2 * 11;
__global__ void __launch_bounds__(NTHREADS, 2) fwd(Args args) {
    unsigned* ctl = (unsigned*)(args.ws + WS_CTL);
    volatile LAS unsigned* xbw = (volatile LAS unsigned*)(dyn_lds + MISC_OFF);
    if (threadIdx.x == 0) { xbw[0] = 0u; xbw[1] = 0u; xbw[2] = 0u; xbw[3] = 0u; }
    __syncthreads();
    const int lo = args.ph_lo, hi = args.ph_hi;
    XcdBarrier bar = xcd_barrier_post(ctl + 4096, xbw);
#define IN(k) (lo <= (k) && (k) < hi)
#define SEAM(k) do { if (IN(k) && IN((k) + 1)) xcd_barrier(bar); } while (0)
#define LAUNDER(ptr) ptr = launder_ptr(ptr)
#define PIN(k) ((const float*)launder_ptr((unsigned char*)args.in[k]))
#define GEMM_LDS ((PG8_LAS unsigned char*)dyn_lds + RING_OFF)
    if (IN(0)) { unsigned char* ws = args.ws; LAUNDER(ws); const Ctx c = make_ctx(); prologue_phase(c, PIN(0), PIN(2), PIN(5), PIN(6), PIN(8), PIN(9), PIN(11), PIN(12), PIN(10), ws); }
    SEAM(0);
#pragma unroll 1
    for (int layer = 0; layer < 2; ++layer) {
        const int pb = 1 + layer * 11;
        if (IN(pb + 0)) {
            unsigned char* ws = args.ws; LAUNDER(ws); const Ctx c = make_ctx();
            pg8::Gemm g{(const bf16_t*)(ws + WS_ACTIN), (const bf16_t*)(ws + (layer == 0 ? WT_ABIN : WT_CDIN)), NT, QKV_W, DM};
            pg8::StaticOrder S; S.init(NT, QKV_W, c.nblk, c.bid);
            pg8::EpiStoreBf16 E{(bf16_t*)(ws + WS_QKV), QKV_W, (layer == 0 ? 0.17677669529663687f : 0.125f) * 1.4426950408889634f, 0.125f * 1.4426950408889634f};
            pg8::gemm_phase<pg8::EpiStoreBf16, pg8::StaticOrder, true, true>(GEMM_LDS, g, S, E);
            if (layer == 1) fg_phase(c, (const bf16_t*)(ws + WS_ACTIN), PIN(6), (float*)(ws + WS_FG));
        }
        SEAM(pb + 0);
        if (IN(pb + 1) && layer == 1) { unsigned char* ws = args.ws; LAUNDER(ws); const Ctx c = make_ctx(); fscan_naive(c, (const float*)(ws + WS_FG), (float*)(ws + WS_F), PIN(7)); }
        SEAM(pb + 1);
        if (IN(pb + 2)) {
            unsigned char* ws = args.ws; LAUNDER(ws); const Ctx c = make_ctx();
            if (layer == 0) attn_layer0_mfma(c, (const bf16_t*)(ws + WS_QKV), (bf16_t*)(ws + WS_ATTB), PIN(1), PIN(3), PIN(4));
            else { attn_fox_mfma(c, (const bf16_t*)(ws + WS_QKV), (const float*)(ws + WS_F), (bf16_t*)(ws + WS_ATTB)); attn_dilated_mfma(c, (const bf16_t*)(ws + WS_QKV), PIN(1), (bf16_t*)(ws + WS_MIX), (float*)(ws + WS_H1B)); }
        }
        SEAM(pb + 2);
        if (IN(pb + 3) && layer == 1) { unsigned char* ws = args.ws; LAUNDER(ws); const Ctx c = make_ctx(); dilated_combine(c, (const bf16_t*)(ws + WS_MIX), (const float*)(ws + WS_H1B), (bf16_t*)(ws + WS_ATTB)); }
        SEAM(pb + 3);
        if (IN(pb + 4)) {
            unsigned char* ws = args.ws; LAUNDER(ws); const Ctx c = make_ctx();
            pg8::Gemm g{(const bf16_t*)(ws + WS_ATTB), (const bf16_t*)(ws + (layer == 0 ? WT_ABOUT : WT_CDOUT)), NT, DM, DM};
            pg8::StaticOrder S; S.init(NT, DM, c.nblk, c.bid);
            pg8::EpiStoreF32 E{(float*)(ws + WS_MIX), DM};
            pg8::gemm_phase<pg8::EpiStoreF32, pg8::StaticOrder, true, true>(GEMM_LDS, g, S, E);
        }
        SEAM(pb + 4);
        if (IN(pb + 5)) {
            unsigned char* ws = args.ws; LAUNDER(ws); const Ctx c = make_ctx();
            ln_rows(c, layer == 0 ? PIN(0) : (const float*)nullptr, (const bf16_t*)(ws + WS_ACTIN), (const float*)(ws + WS_MIX), PIN(13) + (size_t)layer * 2 * DM, PIN(14) + (size_t)layer * 2 * DM, (float*)nullptr, (bf16_t*)(ws + WS_H1B), ws + WS_X8, (float*)(ws + WS_XS));
        }
        SEAM(pb + 5);
        if (IN(pb + 6)) {
            unsigned char* ws = args.ws; LAUNDER(ws); const Ctx c = make_ctx();
            pg8::Gemm g{(const bf16_t*)(ws + WS_H1B), (const bf16_t*)(ws + WT_WQ + (size_t)layer * 4 * MiB), NT, PEER_QW, DM};
            pg8::StaticOrder S; S.init(NT, PEER_QW, c.nblk, c.bid);
            pg8::EpiStoreBf16 E{(bf16_t*)(ws + WS_QKV), PEER_QW, 1.f, 1.f};
            pg8::gemm_phase<pg8::EpiStoreBf16, pg8::StaticOrder, true, true>(GEMM_LDS, g, S, E);
        }
        SEAM(pb + 6);
        if (IN(pb + 7)) {
            unsigned char* ws = args.ws; LAUNDER(ws); const Ctx c = make_ctx();
            peer_route_phase(c, (const bf16_t*)(ws + WS_QKV), (const bf16_t*)(ws + WS_SKB) + (size_t)layer * 16 * 128 * 128, (int*)(ws + WS_EIDX), (float*)(ws + WS_GATE));
        }
        SEAM(pb + 7);
        if (IN(pb + 8)) {
            unsigned char* ws = args.ws; LAUNDER(ws); const Ctx c = make_ctx();
            peer_u_phase(c, ws + WS_X8, (const float*)(ws + WS_XS), (const int*)(ws + WS_EIDX), (const float*)(ws + WS_GATE), (float*)(ws + WS_COEF), ws + WS_U8 + (size_t)layer * 16384 * DM, (const float*)(ws + WS_RS) + (size_t)layer * 16384, (const float*)(ws + WS_RS) + (size_t)(2 + layer) * 16384);
        }
        SEAM(pb + 8);
        if (IN(pb + 9)) {
            unsigned char* ws = args.ws; LAUNDER(ws); const Ctx c = make_ctx();
            peer_v_phase(c, (const int*)(ws + WS_EIDX), (const float*)(ws + WS_COEF), ws + WS_V8 + (size_t)layer * 16384 * DM, (float*)(ws + WS_MIX));
        }
        SEAM(pb + 9);
        if (IN(pb + 10)) {
            unsigned char* ws = args.ws; LAUNDER(ws); const Ctx c = make_ctx();
            float* hout = layer == 0 ? (float*)nullptr : (float*)launder_ptr((unsigned char*)args.out);
            bf16_t* houtb = layer == 0 ? (bf16_t*)(ws + WS_ACTIN) : (bf16_t*)nullptr;
            ln_rows(c, (const float*)nullptr, (const bf16_t*)(ws + WS_H1B), (const float*)(ws + WS_MIX), PIN(13) + (size_t)(layer * 2 + 1) * DM, PIN(14) + (size_t)(layer * 2 + 1) * DM, hout, houtb);
        }
        SEAM(pb + 10);
    }
}

extern "C" void kernel_launch(void* const* d_in, const int* in_sizes, int n_in, void* d_out, int out_size, void* d_ws, size_t ws_size, hipStream_t stream) {
    (void)in_sizes; (void)n_in; (void)out_size;
    static int grid = 0;
    if (!grid) {
        int dev = 0, cus = 0, per_cu = 0;
        (void)hipGetDevice(&dev);
        (void)hipDeviceGetAttribute(&cus, hipDeviceAttributeMultiprocessorCount, dev);
        (void)hipFuncSetAttribute((const void*)fwd, hipFuncAttributeMaxDynamicSharedMemorySize, LDS_BYTES);
        (void)hipOccupancyMaxActiveBlocksPerMultiprocessor(&per_cu, fwd, NTHREADS, LDS_BYTES);
        if (per_cu < 1) fprintf(stderr, "occupancy query says %d blocks per CU\n", per_cu);
        grid = cus;
        if (ws_size < WS_END) fprintf(stderr, "workspace too small: %zu < %zu\n", ws_size, (size_t)WS_END);
    }
    (void)hipMemsetAsync((unsigned char*)d_ws + WS_CTL, 0, 1 * MiB, stream);
    Args a{};
    for (int i = 0; i < 15; ++i) a.in[i] = (const float*)d_in[i];
    a.out = (float*)d_out; a.ws = (unsigned char*)d_ws;
    a.ph_lo = 0; a.ph_hi = NPHASE;
    hipLaunchKernelGGL(fwd, dim3(grid), dim3(NTHREADS), LDS_BYTES, stream, a);
}
```

```cpp
#include <hip/hip_runtime.h>
#include <cstdio>
#include <cstdint>
#include <cmath>

constexpr int BATCH = 4, SEQ = 4096, DM = 1024, NT = BATCH * SEQ;
constexpr int NH = 8, HD = 64;
constexpr int QKV_W = 3072, CD_IN = 3080;
constexpr int PEER_QW = 2048;
constexpr float DN_ALPHA = 1.4142135623730951f;
constexpr float LN_EPS = 1e-5f;
constexpr int NTHREADS = 512, NWAVES = 8;
typedef unsigned short bf16_t;

constexpr size_t MiB = 1u << 20;
constexpr size_t WS_CTL = 0;
constexpr size_t WS_WT = 1 * MiB;
constexpr size_t WT_ABIN = WS_WT, WT_ABOUT = WS_WT + 6 * MiB, WT_CDIN = WS_WT + 8 * MiB, WT_CDOUT = WS_WT + 14 * MiB, WT_WQ = WS_WT + 16 * MiB;
constexpr size_t WS_ACTIN = 25 * MiB;
constexpr size_t WS_ATTB = 57 * MiB;
constexpr size_t WS_H1B = 89 * MiB;
constexpr size_t WS_QKV = 121 * MiB;
constexpr size_t WS_MIX = 217 * MiB;
constexpr size_t WS_EIDX = 281 * MiB;
constexpr size_t WS_COEF = 289 * MiB;
constexpr size_t WS_F = 297 * MiB;
constexpr size_t WS_FG = 298 * MiB;
constexpr size_t WS_U8 = 299 * MiB;
constexpr size_t WS_V8 = 331 * MiB;
constexpr size_t WS_RS = 363 * MiB;
constexpr size_t WS_SKB = 364 * MiB;
constexpr size_t WS_GATE = 365 * MiB;
constexpr size_t WS_X8 = 373 * MiB;
constexpr size_t WS_XS = 389 * MiB;
constexpr size_t WS_END = 390 * MiB;
constexpr int LDS_BYTES = 147456;
constexpr int RING_OFF = 0, MISC_OFF = 143360;

#define XB_TMO      128
#define XB_XCNT(j)  (256  + 64 * (j))
#define XB_XSUB(j)  (1280 + 64 * (j))
#define XB_XGEN(j)  (2304 + 64 * (j))
#define XB_TOP      3328
#define XB_TOPGEN   3392
#define XCD_BAR_WORDS 3456
#define XB_SPIN_CAP (1u << 18)
#define LAS __attribute__((address_space(3)))

__device__ __forceinline__ unsigned xb_ld(unsigned* p)              { return __hip_atomic_load(p, __ATOMIC_RELAXED, __HIP_MEMORY_SCOPE_AGENT); }
__device__ __forceinline__ unsigned xb_add(unsigned* p, unsigned v) { return __hip_atomic_fetch_add(p, v, __ATOMIC_RELAXED, __HIP_MEMORY_SCOPE_AGENT); }
__device__ __forceinline__ unsigned xb_xcc_id() { return (unsigned)__builtin_amdgcn_s_getreg((3 << 11) | 20) & 0xFu; }
#define XB_SPIN(cond, bar) do { unsigned _sp = 0; while (cond) { __builtin_amdgcn_s_sleep(1); \
    if ((++_sp & 255u) == 0u) { if (xb_ld(&(bar)[XB_TMO])) break; if (_sp > XB_SPIN_CAP) { atomicAdd(&(bar)[XB_TMO], 1u); break; } } } } while (0)

struct XcdBarrier {
    unsigned* bar; unsigned x;
    volatile LAS unsigned* st;
};
__device__ __forceinline__ XcdBarrier xcd_barrier_post(unsigned* bar, volatile LAS unsigned* st) {
    XcdBarrier b; b.bar = bar; b.x = xb_xcc_id(); b.st = st;
    if (threadIdx.x == 0) (void)xb_add(&bar[XB_XCNT(b.x)], 1u);
    return b;
}
__device__ __forceinline__ void xcd_barrier_complete(unsigned* bar, unsigned x, unsigned& nloc, unsigned& nx) {
    const unsigned G = gridDim.x * gridDim.y * gridDim.z;
    unsigned sum, cnt, mine, sp = 0u;
    for (;;) {
        sum = 0u; cnt = 0u; mine = 0u;
#pragma unroll
        for (unsigned j = 0; j < 16; ++j) { const unsigned c = xb_ld(&bar[XB_XCNT(j)]); sum += c; cnt += (c > 0u) ? 1u : 0u; mine = (j == x) ? c : mine; }
        if (sum == G) break;
        __builtin_amdgcn_s_sleep(1);
        if ((++sp & 255u) == 0u) { if (xb_ld(&bar[XB_TMO])) break; if (sp > XB_SPIN_CAP) { atomicAdd(&bar[XB_TMO], 1u); break; } }
    }
    nloc = mine > 0u ? mine : 1u; nx = cnt > 0u ? cnt : 1u;
}
__device__ __forceinline__ void xcd_barrier(const XcdBarrier& b) {
    asm volatile("s_waitcnt vmcnt(0)" ::: "memory");
    __syncthreads();
    if (threadIdx.x == 0) {
        unsigned* bar = b.bar;
        __builtin_amdgcn_s_waitcnt(0);
        unsigned nloc = b.st[0], nx = b.st[1];
        if (nloc == 0u) { xcd_barrier_complete(bar, b.x, nloc, nx); b.st[0] = nloc; b.st[1] = nx; }
        const unsigned old = xb_add(&bar[XB_XSUB(b.x)], 1u);
        const unsigned gen = old / nloc;
        if (old + 1u == (gen + 1u) * nloc) {
            __builtin_amdgcn_fence(__ATOMIC_RELEASE, "agent");
            asm volatile("s_waitcnt vmcnt(0)" ::: "memory");
            const unsigned og = xb_add(&bar[XB_TOP], 1u);
            const unsigned tg = og / nx;
            if (og + 1u == (tg + 1u) * nx) xb_add(&bar[XB_TOPGEN], 1u);
            else XB_SPIN(xb_ld(&bar[XB_TOPGEN]) == tg, bar);
            __builtin_amdgcn_fence(__ATOMIC_ACQUIRE, "agent");
            xb_add(&bar[XB_XGEN(b.x)], 1u);
            asm volatile("s_waitcnt vmcnt(0)" ::: "memory");
        } else {
            XB_SPIN(xb_ld(&bar[XB_XGEN(b.x)]) == gen, bar);
            __builtin_amdgcn_fence(__ATOMIC_ACQUIRE, "agent");
            asm volatile("s_waitcnt vmcnt(0)" ::: "memory");
        }
    }
    __syncthreads();
}

struct Args {
    const float* in[15];
    float* out;
    unsigned char* ws;
    int ph_lo, ph_hi;
};
struct Ctx {
    int tid, lane, wave, gwave, nwaves, bid, nblk;
    float* lds;
};
extern __shared__ __attribute__((aligned(16))) unsigned char dyn_lds[];
__device__ __forceinline__ Ctx make_ctx() {
    int t = threadIdx.x, b = blockIdx.x, g = gridDim.x;
    asm volatile("" : "+v"(t));
    asm volatile("" : "+s"(b), "+s"(g));
    Ctx c; c.tid = t; c.lane = t & 63; c.wave = t >> 6; c.bid = b; c.nblk = g;
    c.gwave = b * NWAVES + c.wave; c.nwaves = g * NWAVES; c.lds = (float*)(dyn_lds + RING_OFF);
    return c;
}
__device__ __forceinline__ unsigned char* launder_ptr(unsigned char* p) {
    unsigned lo = __builtin_amdgcn_readfirstlane((unsigned)(uintptr_t)p), hi = __builtin_amdgcn_readfirstlane((unsigned)((uintptr_t)p >> 32));
    asm volatile("" : "+s"(lo), "+s"(hi));
    return (unsigned char*)(((uintptr_t)hi << 32) | (uintptr_t)lo);
}
__device__ __forceinline__ float wave_sum(float v) {
#pragma unroll
    for (int o = 32; o >= 1; o >>= 1) v += __shfl_xor(v, o);
    return v;
}
__device__ __forceinline__ float log_sigmoid(float z) { return fminf(z, 0.f) - log1pf(expf(-fabsf(z))); }
__device__ __forceinline__ int t5_bucket(int n) {
    if (n < 16) return n;
    int large = 16 + (int)(logf((float)n / 16.f) / 2.0794415416798357f * 16.f);
    return large < 31 ? large : 31;
}
__device__ __forceinline__ float bf2f(bf16_t v) { return __builtin_bit_cast(float, (unsigned)v << 16); }
__device__ __forceinline__ unsigned f2bf(float f) { unsigned u = __builtin_bit_cast(unsigned, f); return (u + 0x7fffu + ((u >> 16) & 1u)) >> 16; }
__device__ __forceinline__ unsigned pk2(float lo, float hi) { return f2bf(lo) | (f2bf(hi) << 16); }

namespace pg8 {
#define PG8_LAS __attribute__((address_space(3)))
typedef unsigned short bf16_t;
typedef short bf16x8 __attribute__((ext_vector_type(8)));
typedef float f32x4 __attribute__((ext_vector_type(4)));
typedef unsigned u32x4 __attribute__((ext_vector_type(4)));
constexpr int BM = 256, BK = 64, HALF = 128, HTB = HALF * BK * 2  , STAGE_BYTES = 8 * HTB, NXCD = 8, WGM = 8;

__host__ __device__ __forceinline__ int lds_byte(int r, int c) { const int st = (r >> 4) * 2 + (c >> 5), rr = r & 15, cc = c & 31, ob = rr * 64 + cc * 2; return st * 1024 + (ob ^ (((ob >> 9) & 1) << 5)); }
__host__ __device__ __forceinline__ void stage_rc(int b, int& R, int& C) { const int st = b / 1024, sb = b % 1024, swz = sb ^ (((sb >> 9) & 1) << 5); R = (st >> 1) * 16 + swz / 64; C = (st & 1) * 32 + (swz % 64) / 2; }
__host__ __device__ __forceinline__ int perm32(int rho) { const int n = rho >> 4, i = rho & 15; return 8 * (i >> 2) + 4 * n + (i & 3); }

struct Unit { int pm, pn; };
struct Gemm { const bf16_t* A; const bf16_t* Bt; int M, N, K; };

struct StaticOrder {
    int nM, nN, nwg, G, c;
    __host__ __device__ void init(int M, int N, int G_, int c_) { nM = M / BM; nN = N / BM; nwg = nM * nN; G = G_; c = c_; }
    __host__ __device__ bool next(int i, Unit& u) const {
        const long L = (long)i * G + c; if (L >= nwg) return false;
        int wgid = (int)L; { const int q = nwg / NXCD, r = nwg % NXCD, xcd = wgid % NXCD, off = wgid / NXCD; wgid = (xcd < r ? xcd * (q + 1) : r * (q + 1) + (xcd - r) * q) + off; }
        const int nig = WGM * nN, gid = wgid / nig, fm = gid * WGM, gsz = (nM - fm) < WGM ? (nM - fm) : WGM;
        u.pm = fm + ((wgid % nig) % gsz); u.pn = (wgid % nig) / gsz; return true;
    }
    __device__ __forceinline__ void a_ready(const Unit&) const {}
    __device__ __forceinline__ void done(const Unit&) const {}
};

__device__ __forceinline__ unsigned cvt_pk_bf16(float lo, float hi) { unsigned r; asm volatile("v_cvt_pk_bf16_f32 %0, %1, %2" : "=v"(r) : "v"(lo), "v"(hi)); return r; }
template <class Epi, class Sched, bool ALIGN_EPI = false, bool SP2 = false>
__device__ __forceinline__ void gemm_phase(PG8_LAS unsigned char* lds, const Gemm g, const Sched& S, const Epi& E) {
    int tid_ = threadIdx.x; asm volatile("" : "+v"(tid_));
    const int tid = tid_, wid = __builtin_amdgcn_readfirstlane(tid >> 6), lane = tid & 63, wr = wid >> 2, wc = wid & 3, fr = lane & 15, fq = lane >> 4;
    const int K = g.K, nt = K / BK;
    unsigned voffA[2], voffB[2];
#pragma unroll
    for (int i = 0; i < 2; ++i) { int R, C; stage_rc(tid * 16 + i * 8192, R, C); const int Rb = Epi::PERM ? ((R & ~31) + perm32(R & 31)) : R;
        voffA[i] = (unsigned)(R * K + C) * 2u; voffB[i] = (unsigned)(Rb * K + C) * 2u; }
    const size_t kstep = (size_t)(BK * 2);
    const size_t hstep = (size_t)HALF * K * 2;
    const size_t tstep = 2 * hstep;
    const unsigned ldsw = (unsigned)wid * 1024u;
    const int aoff = lds_byte(wr * 64 + fr, fq * 8), boff = lds_byte(wc * 32 + fr, fq * 8);
#define PG8_SA(b, h) (((b) * 2 + (h)) * HTB)
#define PG8_SB(b, h) ((4 + (b) * 2 + (h)) * HTB)
#define PG8_STAGE(bufoff, gbase, voff) do { _Pragma("unroll") for (int _i = 0; _i < 2; ++_i) \
        __builtin_amdgcn_global_load_lds((const unsigned*)((const char*)(gbase) + (voff)[_i]), (PG8_LAS unsigned*)(lds + (bufoff) + ldsw + _i * 8192), 16, 0, 0); } while (0)
#define PG8_LDA(dst, b, h) do { _Pragma("unroll") for (int m = 0; m < 4; ++m) _Pragma("unroll") for (int k = 0; k < 2; ++k) dst[m][k] = *(const PG8_LAS bf16x8*)(lds + PG8_SA(b, h) + aoff + m * 2048 + k * 1024); } while (0)
#define PG8_LDB(dst, b, h) do { _Pragma("unroll") for (int n = 0; n < 2; ++n) _Pragma("unroll") for (int k = 0; k < 2; ++k) dst[n][k] = *(const PG8_LAS bf16x8*)(lds + PG8_SB(b, h) + boff + n * 2048 + k * 1024); } while (0)
#define PG8_MMA(ai, bj, At, Bt) do { __builtin_amdgcn_s_setprio(1); _Pragma("unroll") for (int m = 0; m < 4; ++m) _Pragma("unroll") for (int n = 0; n < 2; ++n) _Pragma("unroll") for (int k = 0; k < 2; ++k) \
        acc[ai][bj][m][n] = __builtin_amdgcn_mfma_f32_16x16x32_bf16(Bt[n][k], At[m][k], acc[ai][bj][m][n], 0, 0, 0); __builtin_amdgcn_s_setprio(0); } while (0)
#define PG8_WAIT_V(n) asm volatile("s_waitcnt vmcnt(" #n ")" ::: "memory")
#define PG8_WAIT_L(n) asm volatile("s_waitcnt lgkmcnt(" #n ")" ::: "memory")
#define PG8_BAR __builtin_amdgcn_s_barrier()
#define PG8_SCHED __builtin_amdgcn_sched_barrier(0)
    Unit cur, nxt; int ui = 0;
    if (!S.next(0, cur)) return;
    f32x4 acc[2][2][4][2];
#pragma unroll
    for (int a = 0; a < 2; ++a)
#pragma unroll
        for (int b = 0; b < 2; ++b)
#pragma unroll
            for (int m = 0; m < 4; ++m)
#pragma unroll
                for (int n = 0; n < 2; ++n) acc[a][b][m][n] = (f32x4){0.f, 0.f, 0.f, 0.f};
    bf16x8 At[4][2], B0[2][2], B1[2][2];
    const char* cA = (const char*)g.A + (size_t)cur.pm * tstep; const char* cB = (const char*)g.Bt + (size_t)cur.pn * tstep;
    S.a_ready(cur);
    if constexpr (SP2) {
        PG8_STAGE(PG8_SB(0, 0), cB, voffB); PG8_STAGE(PG8_SB(0, 1), cB + hstep, voffB); PG8_STAGE(PG8_SA(0, 0), cA, voffA); PG8_STAGE(PG8_SA(0, 1), cA + hstep, voffA);
        if (wr == 1) PG8_BAR;
        PG8_WAIT_V(2); PG8_BAR;
        PG8_STAGE(PG8_SB(1, 0), cB + kstep, voffB); PG8_STAGE(PG8_SA(1, 0), cA + kstep, voffA); PG8_STAGE(PG8_SB(1, 1), cB + hstep + kstep, voffB);
        PG8_WAIT_V(6); PG8_BAR;
    } else {
        PG8_STAGE(PG8_SB(0, 0), cB, voffB); PG8_STAGE(PG8_SA(0, 0), cA, voffA); PG8_STAGE(PG8_SB(0, 1), cB + hstep, voffB); PG8_STAGE(PG8_SA(0, 1), cA + hstep, voffA);
        if (wr == 1) PG8_BAR;
        PG8_WAIT_V(4); PG8_BAR;
        PG8_STAGE(PG8_SB(1, 0), cB + kstep, voffB); PG8_STAGE(PG8_SA(1, 0), cA + kstep, voffA); PG8_STAGE(PG8_SB(1, 1), cB + hstep + kstep, voffB);
        PG8_WAIT_V(6); PG8_BAR;
    }
    for (;;) {
        const bool has_next = S.next(ui + 1, nxt);
        const char* nA = has_next ? (const char*)g.A + (size_t)nxt.pm * tstep : cA; const char* nB = has_next ? (const char*)g.Bt + (size_t)nxt.pn * tstep : cB;
        for (int t = 0; t < nt; t += 2) {
            const bool last = (t == nt - 2);
            const char* a1 = cA + (size_t)(t + 1) * kstep;
            const char* a2 = last ? nA : cA + (size_t)(t + 2) * kstep; const char* b2 = last ? nB : cB + (size_t)(t + 2) * kstep;
            const char* a3 = a2 + kstep; const char* b3 = b2 + kstep;
            if (last && has_next) S.a_ready(nxt);
            if constexpr (SP2) {
            PG8_LDB(B0, 0, 0); PG8_LDB(B1, 0, 1); PG8_SCHED; PG8_LDA(At, 0, 0); PG8_STAGE(PG8_SA(1, 1), a1 + hstep, voffA);
            PG8_WAIT_V(8); PG8_WAIT_L(0); PG8_BAR; PG8_MMA(0, 0, At, B0); PG8_MMA(0, 1, At, B1); PG8_BAR; PG8_SCHED;
            PG8_LDA(At, 0, 1); PG8_STAGE(PG8_SB(0, 0), b2, voffB); PG8_STAGE(PG8_SB(0, 1), b2 + hstep, voffB); PG8_STAGE(PG8_SA(0, 0), a2, voffA);
            PG8_WAIT_V(8); PG8_WAIT_L(0); PG8_BAR; PG8_MMA(1, 0, At, B0); PG8_MMA(1, 1, At, B1); PG8_BAR; PG8_SCHED;
            PG8_LDB(B0, 1, 0); PG8_LDB(B1, 1, 1); PG8_SCHED; PG8_LDA(At, 1, 0); PG8_STAGE(PG8_SA(0, 1), a2 + hstep, voffA);
            PG8_WAIT_V(8); PG8_WAIT_L(0); PG8_BAR; PG8_MMA(0, 0, At, B0); PG8_MMA(0, 1, At, B1); PG8_BAR; PG8_SCHED;
            PG8_LDA(At, 1, 1); PG8_STAGE(PG8_SB(1, 0), b3, voffB); PG8_STAGE(PG8_SB(1, 1), b3 + hstep, voffB); PG8_STAGE(PG8_SA(1, 0), a3, voffA);
            PG8_WAIT_V(8); PG8_WAIT_L(0); PG8_BAR; PG8_MMA(1, 0, At, B0); PG8_MMA(1, 1, At, B1); PG8_BAR; PG8_SCHED;
            } else {
            PG8_LDB(B0, 0, 0); PG8_SCHED; PG8_LDA(At, 0, 0); PG8_STAGE(PG8_SA(1, 1), a1 + hstep, voffA);
            PG8_WAIT_L(8); PG8_BAR; PG8_WAIT_L(0); PG8_MMA(0, 0, At, B0); PG8_BAR; PG8_SCHED;
            PG8_LDB(B1, 0, 1); PG8_STAGE(PG8_SB(0, 0), b2, voffB);
            PG8_BAR; PG8_WAIT_L(0); PG8_MMA(0, 1, At, B1); PG8_BAR;
            PG8_LDA(At, 0, 1); PG8_STAGE(PG8_SA(0, 0), a2, voffA);
            PG8_BAR; PG8_WAIT_L(0); PG8_MMA(1, 0, At, B0); PG8_BAR; PG8_SCHED;
            PG8_STAGE(PG8_SB(0, 1), b2 + hstep, voffB);
            PG8_WAIT_V(6); PG8_BAR; PG8_MMA(1, 1, At, B1); PG8_BAR;
            PG8_LDB(B0, 1, 0); PG8_SCHED; PG8_LDA(At, 1, 0); PG8_STAGE(PG8_SA(0, 1), a2 + hstep, voffA);
            PG8_WAIT_L(8); PG8_BAR; PG8_WAIT_L(0); PG8_MMA(0, 0, At, B0); PG8_BAR; PG8_SCHED;
            PG8_LDB(B1, 1, 1); PG8_STAGE(PG8_SB(1, 0), b3, voffB);
            PG8_BAR; PG8_WAIT_L(0); PG8_MMA(0, 1, At, B1); PG8_BAR;
            PG8_LDA(At, 1, 1); PG8_STAGE(PG8_SA(1, 0), a3, voffA);
            PG8_BAR; PG8_WAIT_L(0); PG8_MMA(1, 0, At, B0); PG8_BAR; PG8_SCHED;
            PG8_STAGE(PG8_SB(1, 1), b3 + hstep, voffB);
            PG8_WAIT_V(6); PG8_BAR; PG8_MMA(1, 1, At, B1); PG8_BAR;
            }
        }
        if constexpr (ALIGN_EPI) { if (wr == 0) PG8_BAR; }
        if constexpr (!Epi::AFTER_DRAIN) { E(acc, cur, wr, wc, fr, fq); S.done(cur); }
        if (!has_next) break;
#pragma unroll
        for (int a = 0; a < 2; ++a)
#pragma unroll
            for (int b = 0; b < 2; ++b)
#pragma unroll
                for (int m = 0; m < 4; ++m)
#pragma unroll
                    for (int n = 0; n < 2; ++n) acc[a][b][m][n] = (f32x4){0.f, 0.f, 0.f, 0.f};
        cur = nxt; cA = nA; cB = nB; ++ui;
        if constexpr (ALIGN_EPI) { if (wr == 1) PG8_BAR; }
    }
    PG8_WAIT_V(0);
    if constexpr (!ALIGN_EPI) { if (wr == 0) PG8_BAR; }
    PG8_BAR;
    if constexpr (Epi::AFTER_DRAIN) { E.fused(acc, cur, wr, wc, fr, fq, lds, wid, lane); S.done(cur); }
#undef PG8_SA
#undef PG8_SB
#undef PG8_STAGE
#undef PG8_LDA
#undef PG8_LDB
#undef PG8_MMA
#undef PG8_WAIT_V
#undef PG8_WAIT_L
#undef PG8_BAR
#undef PG8_SCHED
}
}

namespace pg8 {
struct EpiStoreBf16 {
    static constexpr bool PERM = true, AFTER_DRAIN = false;
    bf16_t* O; int ldc; float s01, s67;
    __device__ __forceinline__ void operator()(const f32x4 (&acc)[2][2][4][2], const Unit& u, int wr, int wc, int fr, int fq) const {
        const int row0 = u.pm * BM + wr * 64 + fr, col0 = u.pn * BM + wc * 32 + 8 * fq;
        const float sc = u.pn < 2 ? s01 : ((u.pn == 6 || u.pn == 7) ? s67 : 1.f);
#pragma unroll
        for (int ai = 0; ai < 2; ++ai)
#pragma unroll
            for (int m = 0; m < 4; ++m) { bf16_t* rowp = O + (size_t)(row0 + ai * HALF + m * 16) * ldc + col0;
#pragma unroll
                for (int bj = 0; bj < 2; ++bj) { const f32x4 v0 = acc[ai][bj][m][0] * sc, v1 = acc[ai][bj][m][1] * sc;
                    u32x4 w; w.x = cvt_pk_bf16(v0[0], v0[1]); w.y = cvt_pk_bf16(v0[2], v0[3]); w.z = cvt_pk_bf16(v1[0], v1[1]); w.w = cvt_pk_bf16(v1[2], v1[3]);
                    *(u32x4*)(rowp + bj * HALF) = w; } }
    }
};
struct EpiStoreF32 {
    static constexpr bool PERM = true, AFTER_DRAIN = false;
    float* C; int ldc;
    __device__ __forceinline__ void operator()(const f32x4 (&acc)[2][2][4][2], const Unit& u, int wr, int wc, int fr, int fq) const {
        const int row0 = u.pm * BM + wr * 64 + fr, col0 = u.pn * BM + wc * 32 + 8 * fq;
#pragma unroll
        for (int ai = 0; ai < 2; ++ai)
#pragma unroll
            for (int m = 0; m < 4; ++m) { float* rowp = C + (size_t)(row0 + ai * HALF + m * 16) * ldc + col0;
#pragma unroll
                for (int bj = 0; bj < 2; ++bj) { *(f32x4*)(rowp + bj * HALF) = acc[ai][bj][m][0]; *(f32x4*)(rowp + bj * HALF + 4) = acc[ai][bj][m][1]; } }
    }
};
}

__device__ __forceinline__ void transpose_item(const float* W, int ldw, int K, int ncols, bf16_t* WT, float* scr, int item, int lane) {
    const int nblk = ncols / 32, kb = item / nblk, nb = item % nblk, k0 = 64 * kb, n0 = 32 * nb;
#pragma unroll 8
    for (int i = 0; i < 32; ++i) { const int kk = 2 * i + (lane >> 5); scr[kk * 33 + (lane & 31)] = W[(size_t)(k0 + kk) * ldw + n0 + (lane & 31)]; }
    asm volatile("s_waitcnt lgkmcnt(0)" ::: "memory");
    const int c = lane & 7;
#pragma unroll
    for (int j = 0; j < 4; ++j) { const int n = (lane >> 3) + 8 * j; const float* s = scr + (8 * c) * 33 + n;
        uint4 o; o.x = pk2(s[0 * 33], s[1 * 33]); o.y = pk2(s[2 * 33], s[3 * 33]); o.z = pk2(s[4 * 33], s[5 * 33]); o.w = pk2(s[6 * 33], s[7 * 33]);
        *(uint4*)(WT + (size_t)(n0 + n) * K + k0 + 8 * c) = o; }
    asm volatile("s_waitcnt lgkmcnt(0)" ::: "memory");
}
__device__ __forceinline__ void cvt_rows_bf16(const Ctx& c, const float* src, bf16_t* dst, size_t n8) {
    for (size_t i = (size_t)c.gwave * 64 + c.lane; i < n8; i += (size_t)c.nwaves * 64) {
        const float4 a = *(const float4*)(src + i * 8), b = *(const float4*)(src + i * 8 + 4);
        uint4 o; o.x = pk2(a.x, a.y); o.y = pk2(a.z, a.w); o.z = pk2(b.x, b.y); o.w = pk2(b.z, b.w);
        *(uint4*)(dst + i * 8) = o;
    }
}

template <int DQ, class BiasF>
__device__ __forceinline__ void causal_softmax_row(const float (&q)[DQ], const bf16_t* kbase, const bf16_t* vbase, int ld, int t, int smax, float scale, BiasF biasf, float (&O)[64]) {
    float m = -INFINITY;
    for (int s = 0; s <= smax; ++s) {
        const bf16_t* kr = kbase + (size_t)s * ld;
        float d = 0.f;
#pragma unroll
        for (int i = 0; i < DQ; ++i) d = fmaf(q[i], bf2f(kr[i]), d);
        const float lg = d * scale + biasf(s);
        m = (s <= t) ? fmaxf(m, lg) : m;
    }
    float l = 0.f;
#pragma unroll
    for (int i = 0; i < 64; ++i) O[i] = 0.f;
    for (int s = 0; s <= smax; ++s) {
        const bf16_t* kr = kbase + (size_t)s * ld;
        const bf16_t* vr = vbase + (size_t)s * ld;
        float d = 0.f;
#pragma unroll
        for (int i = 0; i < DQ; ++i) d = fmaf(q[i], bf2f(kr[i]), d);
        const float lg = d * scale + biasf(s);
        const float p = (s <= t) ? expf(lg - m) : 0.f;
        l += p;
#pragma unroll
        for (int i = 0; i < 64; ++i) O[i] = fmaf(p, bf2f(vr[i]), O[i]);
    }
    const float inv = 1.f / l;
#pragma unroll
    for (int i = 0; i < 64; ++i) O[i] *= inv;
}
__device__ __forceinline__ void store_row64_bf16(bf16_t* orow, const float (&v)[64]) {
#pragma unroll
    for (int i = 0; i < 64; i += 8) { uint4 o; o.x = pk2(v[i], v[i + 1]); o.y = pk2(v[i + 2], v[i + 3]); o.z = pk2(v[i + 4], v[i + 5]); o.w = pk2(v[i + 6], v[i + 7]); *(uint4*)(orow + i) = o; }
}

__device__ __forceinline__ void fg_phase(const Ctx& c, const bf16_t* hin, const float* cd_in, float* fg) {
    for (int t = c.gwave; t < NT; t += c.nwaves) {
        float acc[8];
#pragma unroll
        for (int j = 0; j < 8; ++j) acc[j] = 0.f;
        for (int r = 0; r < 16; ++r) {
            const int d = r * 64 + c.lane;
            const float xv = bf2f(hin[(size_t)t * DM + d]);
            const float4 w0 = *(const float4*)(cd_in + (size_t)d * CD_IN + 3072), w1 = *(const float4*)(cd_in + (size_t)d * CD_IN + 3076);
            acc[0] = fmaf(xv, w0.x, acc[0]); acc[1] = fmaf(xv, w0.y, acc[1]); acc[2] = fmaf(xv, w0.z, acc[2]); acc[3] = fmaf(xv, w0.w, acc[3]);
            acc[4] = fmaf(xv, w1.x, acc[4]); acc[5] = fmaf(xv, w1.y, acc[5]); acc[6] = fmaf(xv, w1.z, acc[6]); acc[7] = fmaf(xv, w1.w, acc[7]);
        }
#pragma unroll
        for (int j = 0; j < 8; ++j) acc[j] = wave_sum(acc[j]);
        if (c.lane == 0) { *(float4*)(fg + (size_t)t * 8) = make_float4(acc[0], acc[1], acc[2], acc[3]); *(float4*)(fg + (size_t)t * 8 + 4) = make_float4(acc[4], acc[5], acc[6], acc[7]); }
    }
}
__device__ __forceinline__ void fscan_naive(const Ctx& c, const float* fg, float* F, const float* bf) {
    for (int task = c.gwave; task < 32; task += c.nwaves) {
        const int b = task >> 3, h = task & 7;
        const int lane = c.lane;
        float v[64]; float tot = 0.f;
#pragma unroll
        for (int i = 0; i < 64; ++i) { const int s = lane * 64 + i; v[i] = log_sigmoid(fg[((size_t)b * SEQ + s) * 8 + h] + bf[h]); tot += v[i]; }
        float incl = tot;
#pragma unroll
        for (int o = 1; o < 64; o <<= 1) { const float n = __shfl_up(incl, o); if (lane >= o) incl += n; }
        float run = incl - tot;
#pragma unroll
        for (int i = 0; i < 64; ++i) { run += v[i]; F[(size_t)task * SEQ + lane * 64 + i] = run; }
    }
}

namespace att {
typedef short bf16x8 __attribute__((ext_vector_type(8)));
typedef short s16x4 __attribute__((ext_vector_type(4)));
typedef float f32x16 __attribute__((ext_vector_type(16)));
typedef float f32x4 __attribute__((ext_vector_type(4)));
typedef short v4i16_t __attribute__((ext_vector_type(4)));
constexpr float LOG2E = 1.4426950408889634f;
constexpr float NEG = -1e30f;
constexpr int KBUF = 0, VBUF = 16384, FBUF = 32768, TBUF = 33792, CNT = 34816;

__device__ __forceinline__ int tile_off(int row, int ch) { return 1024 * (row >> 3) + 512 * (ch >> 2) + 64 * (row & 7) + 16 * ((ch & 3) ^ ((row >> 2) & 3)); }
__device__ __forceinline__ s16x4 vtr(const LAS unsigned char* p) { return __builtin_bit_cast(s16x4, __builtin_amdgcn_ds_read_tr16_b64_v4i16((LAS v4i16_t*)p)); }
typedef float f32x2_t __attribute__((ext_vector_type(2))); typedef __bf16 bf16x2_t __attribute__((ext_vector_type(2)));
__device__ __forceinline__ unsigned cvtpk(float lo, float hi) { f32x2_t v = {lo, hi}; bf16x2_t b = __builtin_convertvector(v, bf16x2_t); return __builtin_bit_cast(unsigned, b); }
__device__ __forceinline__ void pairswap(float v, float& lo, float& hi) {
    unsigned a = __builtin_bit_cast(unsigned, v), b = a;
    asm volatile("s_nop 1\n\tv_permlane32_swap_b32 %0, %1" : "+v"(a), "+v"(b));
    lo = __builtin_bit_cast(float, a); hi = __builtin_bit_cast(float, b);
}
__device__ __forceinline__ float pairmax(float v) { float lo, hi; pairswap(v, lo, hi); return fmaxf(lo, hi); }
__device__ __forceinline__ float pairsum(float v) { float lo, hi; pairswap(v, lo, hi); return lo + hi; }
__device__ __forceinline__ float xhalf(float v, int hh) { float lo, hi; pairswap(v, lo, hi); return hh ? lo : hi; }
__device__ __forceinline__ int key_of(int i, int hh) { return 8 * (i >> 2) + 4 * hh + (i & 3); }

__device__ __forceinline__ bf16x8 pfrag(const f32x16& p, int ks2) {
    unsigned w[4];
#pragma unroll
    for (int j = 0; j < 4; ++j) w[j] = cvtpk(p[8 * ks2 + 2 * j], p[8 * ks2 + 2 * j + 1]);
    typedef unsigned u32x4 __attribute__((ext_vector_type(4)));
    u32x4 v = {w[0], w[1], w[2], w[3]};
    return __builtin_bit_cast(bf16x8, v);
}
__device__ __forceinline__ void pv_block(f32x16 (&O)[2], const LAS unsigned char* vbuf, int kb, const f32x16& p, int lane) {
    const int hh = lane >> 5, q_ = (lane & 15) >> 2, p_ = lane & 3, cg = (lane >> 4) & 1;
#pragma unroll
    for (int ks2 = 0; ks2 < 2; ++ks2) {
        const bf16x8 pb = pfrag(p, ks2);
#pragma unroll
        for (int db = 0; db < 2; ++db) {
            const int c0 = 32 * db + 16 * cg, ch = (c0 >> 3) + (p_ >> 1);
            const int r0 = 32 * kb + 16 * ks2 + 4 * hh;
            const s16x4 a0 = vtr(vbuf + tile_off(r0 + q_, ch) + 8 * (p_ & 1));
            const s16x4 a1 = vtr(vbuf + tile_off(r0 + 8 + q_, ch) + 8 * (p_ & 1));
            const bf16x8 a = {a0[0], a0[1], a0[2], a0[3], a1[0], a1[1], a1[2], a1[3]};
            O[db] = __builtin_amdgcn_mfma_f32_32x32x16_bf16(a, pb, O[db], 0, 0, 0);
        }
    }
}
template <int S0, int NS>
__device__ __forceinline__ f32x16 qk_block(const LAS unsigned char* kbuf, int kb, const bf16x8 (&Qf)[4], int lane) {
    const int r = lane & 31, hh = lane >> 5;
    f32x16 s = {0.f, 0.f, 0.f, 0.f, 0.f, 0.f, 0.f, 0.f, 0.f, 0.f, 0.f, 0.f, 0.f, 0.f, 0.f, 0.f};
#pragma unroll
    for (int ks = S0; ks < S0 + NS; ++ks) {
        const bf16x8 a = *(const LAS bf16x8*)(kbuf + tile_off(32 * kb + r, 2 * ks + hh));
        s = __builtin_amdgcn_mfma_f32_32x32x16_bf16(a, Qf[ks], s, 0, 0, 0);
    }
    return s;
}
__device__ __forceinline__ bool softmax_step(f32x16& x, float& m, float& l, f32x16 (&O)[2]) {
    float mx = x[0];
#pragma unroll
    for (int i = 1; i < 16; ++i) mx = fmaxf(mx, x[i]);
    mx = pairmax(mx);
    if (__all(mx - m < -64.f)) return false;
    const float mn = fmaxf(m, mx);
    if (!__all(mn == m)) {
        const float alpha = __builtin_amdgcn_exp2f(m - mn);
        l *= alpha;
#pragma unroll
        for (int i = 0; i < 16; ++i) { O[0][i] *= alpha; O[1][i] *= alpha; }
        m = mn;
    }
    float ls = 0.f;
#pragma unroll
    for (int i = 0; i < 16; ++i) { x[i] = __builtin_amdgcn_exp2f(x[i] - m); ls += x[i]; }
    l += ls;
    return true;
}
__device__ __forceinline__ void store_ot(bf16_t* orow, const f32x16 (&O)[2], int hh) {
#pragma unroll
    for (int db = 0; db < 2; ++db)
#pragma unroll
        for (int g = 0; g < 4; ++g) {
            const int d0 = 32 * db + 8 * g + 4 * hh;
            *(uint2*)(orow + d0) = make_uint2(cvtpk(O[db][4 * g], O[db][4 * g + 1]), cvtpk(O[db][4 * g + 2], O[db][4 * g + 3]));
        }
}

struct UnitArgs {
    const bf16_t* qkv;
    bf16_t* out;
    int qcol, kcol, vcol, ocol;
};

struct DilArgs { int dil, rho, pat; bf16_t* po; float* pml; };
template <int TYPE>
__device__ __forceinline__ void causal_unit(const UnitArgs& A, int b, int h, int qb, unsigned char* scratch, int tid,
                                            const float* t5  , float lam, const float* subg, const float* F  , const DilArgs DA = DilArgs{1, 0, 0, nullptr, nullptr}) {
    const LAS unsigned char* lds = (const LAS unsigned char*)scratch;
    LAS unsigned char* ldsw = (LAS unsigned char*)scratch;
    const int lane = tid & 63, w = tid >> 6, r = lane & 31, hh = lane >> 5;
    const int q0 = qb * 256 + 32 * w, tq = q0 + r;
    const size_t rowbase = (size_t)b * SEQ;
    const int ktmax = 4 * qb + 3, kdiag = 4 * qb + (w >> 1);
    const int ktmin = (TYPE == 2) ? (4 * qb - 2 > 0 ? 4 * qb - 2 : 0) : 0;
    const int rs = (TYPE == 2) ? DA.dil : 1, r0off = (TYPE == 2) ? DA.rho : 0;
    const int srow = tid >> 3, sch = tid & 7;
    const bf16_t* kg = A.qkv + (rowbase + r0off + (size_t)rs * srow) * QKV_W + A.kcol + h * 64 + sch * 8;
    const bf16_t* vg = A.qkv + (rowbase + r0off + (size_t)rs * srow) * QKV_W + A.vcol + h * 64 + sch * 8;
    const size_t tstep = (size_t)64 * rs * QKV_W;
    const int soff = tile_off(srow, sch);
    bf16x8 Qf[4];
    {
        const bf16_t* qr = A.qkv + (rowbase + r0off + (size_t)rs * tq) * QKV_W + A.qcol + h * 64 + 8 * hh;
#pragma unroll
        for (int s = 0; s < 4; ++s) Qf[s] = *(const bf16x8*)(qr + 16 * s);
    }
    __syncthreads();
    if ((TYPE == 0 || TYPE == 2) && tid < 128) {
        const float far = t5[31 * 8 + h];
        ((LAS float*)(ldsw + TBUF))[tid] = (t5[t5_bucket(tid) * 8 + h] - far) * LOG2E;
    }
    if (TYPE == 1 && tid == 0) *(LAS unsigned*)(ldsw + CNT) = 0u;
    typedef unsigned u32x4 __attribute__((ext_vector_type(4)));
    u32x4 kreg = *(const u32x4*)(kg + (size_t)ktmax * tstep), vreg = *(const u32x4*)(vg + (size_t)ktmax * tstep);
    float freg = 0.f;
    if (TYPE == 3 && tid < 64) freg = F[(size_t)(b * 8 + h) * SEQ + ktmax * 64 + tid] * LOG2E;
    *(LAS u32x4*)(ldsw + KBUF + soff) = kreg; *(LAS u32x4*)(ldsw + VBUF + soff) = vreg;
    if (TYPE == 3 && tid < 64) ((LAS float*)(ldsw + FBUF))[tid] = freg;
    __syncthreads();

    f32x16 O0[2], O1[2];
#pragma unroll
    for (int i = 0; i < 16; ++i) { O0[0][i] = 0.f; O0[1][i] = 0.f; O1[0][i] = 0.f; O1[1][i] = 0.f; }
    float m0 = NEG, l0 = 0.f, m1 = NEG, l1 = 0.f;
    float R = 0.f;
    bool wdone = false;
    float f2t = 0.f;
    if (TYPE == 3) f2t = F[(size_t)(b * 8 + h) * SEQ + tq] * LOG2E;

    for (int kt = ktmax, it = 0; kt >= ktmin; --kt, ++it) {
        const int cur = it & 1;
        if (kt > ktmin) {
            kreg = *(const u32x4*)(kg + (size_t)(kt - 1) * tstep); vreg = *(const u32x4*)(vg + (size_t)(kt - 1) * tstep);
            if (TYPE == 3 && tid < 64) freg = F[(size_t)(b * 8 + h) * SEQ + (kt - 1) * 64 + tid] * LOG2E;
        }
        const LAS unsigned char* kbuf = lds + KBUF + cur * 8192;
        const LAS unsigned char* vbuf = lds + VBUF + cur * 8192;
        if (kt <= kdiag && !wdone) {
#pragma unroll
            for (int kbi = 0; kbi < 2; ++kbi) {
                const int kb = 1 - kbi;
                const int key0 = kt * 64 + kb * 32;
                if (TYPE == 1 ? (key0 >= q0 + 31) : (key0 > q0 + 31)) continue;
                if (TYPE == 2 && key0 + 31 < q0 - 128) continue;
                const bool need_mask = (TYPE == 1) ? (key0 + 31 >= q0) : (key0 + 31 > q0);
                if (TYPE == 0) {
                    f32x16 x0 = qk_block<0, 2>(kbuf, kb, Qf, lane), x1 = qk_block<2, 2>(kbuf, kb, Qf, lane);
                    if (q0 - (key0 + 31) < 113) {
                        const LAS float* tb = (const LAS float*)(lds + TBUF);
#pragma unroll
                        for (int i = 0; i < 16; ++i) {
                            const int dist = tq - (key0 + key_of(i, hh));
                            const float bv = (dist >= 0 && dist < 128) ? tb[dist < 0 ? 0 : (dist > 127 ? 127 : dist)] : 0.f;
                            x0[i] = dist < 0 ? NEG : x0[i] + bv; x1[i] = dist < 0 ? NEG : x1[i] + bv;
                        }
                    }
                    if (softmax_step(x0, m0, l0, O0)) pv_block(O0, vbuf, kb, x0, lane);
                    if (softmax_step(x1, m1, l1, O1)) pv_block(O1, vbuf, kb, x1, lane);
                } else if (TYPE == 2) {
                    f32x16 x = qk_block<0, 4>(kbuf, kb, Qf, lane);
                    const LAS float* tb = (const LAS float*)(lds + TBUF);
#pragma unroll
                    for (int i = 0; i < 16; ++i) {
                        const int dist = tq - (key0 + key_of(i, hh));
                        int bi = dist * rs; bi = bi < 0 ? 0 : (bi > 127 ? 127 : bi);
                        x[i] = (dist >= 0 && dist <= 128) ? x[i] + tb[bi] : NEG;
                    }
                    if (softmax_step(x, m0, l0, O0)) pv_block(O0, vbuf, kb, x, lane);
                } else if (TYPE == 3) {
                    f32x16 x = qk_block<0, 4>(kbuf, kb, Qf, lane);
                    const LAS float* fb = (const LAS float*)(lds + FBUF + cur * 256);
#pragma unroll
                    for (int g = 0; g < 4; ++g) {
                        const f32x4 fv = *(const LAS f32x4*)(fb + 32 * kb + 8 * g + 4 * hh);
#pragma unroll
                        for (int j = 0; j < 4; ++j) x[4 * g + j] += f2t - fv[j];
                    }
                    if (need_mask) {
#pragma unroll
                        for (int i = 0; i < 16; ++i) x[i] = (key0 + key_of(i, hh) > tq) ? NEG : x[i];
                    }
                    if (softmax_step(x, m0, l0, O0)) pv_block(O0, vbuf, kb, x, lane);
                } else {
                    f32x16 z = qk_block<0, 4>(kbuf, kb, Qf, lane);
                    f32x16 lr;
#pragma unroll
                    for (int i = 0; i < 16; ++i) {
                        const float e = __builtin_amdgcn_exp2f(-fabsf(z[i]));
                        float v = -(fmaxf(z[i], 0.f) + __builtin_amdgcn_logf(1.f + e));
                        if (need_mask) v = (key0 + key_of(i, hh) >= tq) ? 0.f : v;
                        lr[i] = v;
                    }
                    float T[4], Tp[4], sfx[16];
#pragma unroll
                    for (int g = 0; g < 4; ++g) {
                        sfx[4 * g + 3] = 0.f; sfx[4 * g + 2] = lr[4 * g + 3]; sfx[4 * g + 1] = sfx[4 * g + 2] + lr[4 * g + 2]; sfx[4 * g] = sfx[4 * g + 1] + lr[4 * g + 1];
                        T[g] = sfx[4 * g] + lr[4 * g];
                        Tp[g] = xhalf(T[g], hh);
                    }
                    float SP[4];
                    SP[3] = 0.f; SP[2] = T[3] + Tp[3]; SP[1] = SP[2] + T[2] + Tp[2]; SP[0] = SP[1] + T[1] + Tp[1];
                    const float tot = SP[0] + T[0] + Tp[0];
                    const float msel = hh == 0 ? 1.f : 0.f;
#pragma unroll
                    for (int g = 0; g < 4; ++g) {
                        const float goff = R + SP[g] + msel * Tp[g];
#pragma unroll
                        for (int j = 0; j < 4; ++j) {
                            const int i = 4 * g + j;
                            float wv = __builtin_amdgcn_exp2f(lr[i] + z[i] + goff + sfx[i]);
                            if (need_mask) wv = (key0 + key_of(i, hh) >= tq) ? 0.f : wv;
                            z[i] = wv;
                        }
                    }
                    R += tot;
                    pv_block(O0, vbuf, kb, z, lane);
                }
            }
            if (TYPE == 1) {
                if (__all(R < -216.4f)) { wdone = true; if (lane == 0) (void)__hip_atomic_fetch_add((LAS unsigned*)(ldsw + CNT), 1u, __ATOMIC_RELAXED, __HIP_MEMORY_SCOPE_WORKGROUP); }
            }
        }
        if (kt > ktmin) {
            *(LAS u32x4*)(ldsw + KBUF + (cur ^ 1) * 8192 + soff) = kreg; *(LAS u32x4*)(ldsw + VBUF + (cur ^ 1) * 8192 + soff) = vreg;
            if (TYPE == 3 && tid < 64) ((LAS float*)(ldsw + FBUF + (cur ^ 1) * 256))[tid] = freg;
        }
        __syncthreads();
        if (TYPE == 1) { const unsigned cnt = *(const LAS unsigned*)(lds + CNT); __syncthreads(); if (cnt == 8u) break; }
    }
    if (TYPE == 2) {
        const size_t prow = ((size_t)DA.pat * NT + rowbase + r0off + (size_t)rs * tq) * 8 + h;
        store_ot(DA.po + prow * 64, O0, hh);
        const float lt = pairsum(l0);
        if (hh == 0) *(float2*)(DA.pml + prow * 2) = make_float2(m0, lt);
        return;
    }
    bf16_t* orow = A.out + (rowbase + tq) * DM + A.ocol + h * 64;
    if (TYPE == 0) {
        const float i0 = 1.f / pairsum(l0), i1 = lam / pairsum(l1);
        float ss = 0.f;
#pragma unroll
        for (int db = 0; db < 2; ++db)
#pragma unroll
            for (int i = 0; i < 16; ++i) { const float o = O0[db][i] * i0 - O1[db][i] * i1; O0[db][i] = o; ss = fmaf(o, o, ss); }
        ss = pairsum(ss);
        const float rn = rsqrtf(ss * (1.f / 64.f) + LN_EPS) * 0.8f;
#pragma unroll
        for (int db = 0; db < 2; ++db)
#pragma unroll
            for (int i = 0; i < 16; ++i) O0[db][i] *= rn * subg[32 * db + key_of(i, hh)];
        store_ot(orow, O0, hh);
    } else if (TYPE == 3) {
        const float i0 = 1.f / pairsum(l0);
#pragma unroll
        for (int db = 0; db < 2; ++db)
#pragma unroll
            for (int i = 0; i < 16; ++i) O0[db][i] *= i0;
        store_ot(orow, O0, hh);
    } else {
        store_ot(orow, O0, hh);
    }
}
}

__device__ __forceinline__ int xcd_perm256(int p) { return (p & 7) * 32 + (p >> 3); }

__device__ __forceinline__ void attn_layer0_mfma(const Ctx& c, const bf16_t* qkv, bf16_t* out, const float* t5, const float* lamv, const float* subg) {
    float s01 = 0.f, s23 = 0.f;
    for (int i = 0; i < 32; ++i) { s01 += lamv[i] * lamv[32 + i]; s23 += lamv[64 + i] * lamv[96 + i]; }
    const float lam = expf(s01) - expf(s23) + 0.2f;
    unsigned char* scratch = (unsigned char*)c.lds;
    const att::UnitArgs UA{qkv, out, 0, 512, 1024, 0}, UB{qkv, out, 1536, 2048, 2560, 512};
    for (int p = c.bid; p < 256; p += c.nblk) {
        const int pp = xcd_perm256(p), bh = pp >> 3, qb = pp & 7;
        att::causal_unit<0>(UA, bh >> 3, bh & 7, 15 - qb, scratch, c.tid, t5, lam, subg, nullptr);
        att::causal_unit<0>(UA, bh >> 3, bh & 7, qb, scratch, c.tid, t5, lam, subg, nullptr);
#pragma unroll 1
        for (int k = 0; k < 2; ++k) {
            const int u = pp * 2 + k, bh2 = u >> 4, qb2 = u & 15;
            att::causal_unit<1>(UB, bh2 >> 3, bh2 & 7, qb2, scratch, c.tid, nullptr, 0.f, nullptr, nullptr);
        }
    }
}
__device__ __forceinline__ void attn_dilated_mfma(const Ctx& c, const bf16_t* qkv, const float* t5, bf16_t* po, float* pml) {
    unsigned char* scratch = (unsigned char*)c.lds;
    const att::UnitArgs UC{qkv, nullptr, 0, 512, 1024, 0};
    for (int p = c.bid; p < 256; p += c.nblk) {
        const int pp = xcd_perm256(p);
#pragma unroll 1
        for (int k = 0; k < 6; ++k) {
            const int u = pp * 6 + k, bh = u / 48, v = u % 48;
            int pat, rho, qb, dil;
            if (v < 16) { pat = 0; dil = 1; rho = 0; qb = v; }
            else if (v < 32) { pat = 1; dil = 4; rho = (v - 16) >> 2; qb = (v - 16) & 3; }
            else { pat = 2; dil = 16; rho = v - 32; qb = 0; }
            att::causal_unit<2>(UC, bh >> 3, bh & 7, qb, scratch, c.tid, t5, 0.f, nullptr, nullptr, att::DilArgs{dil, rho, pat, po, pml});
        }
    }
}
__device__ __forceinline__ void dilated_combine(const Ctx& c, const bf16_t* po, const float* pml, bf16_t* out) {
    const size_t n = (size_t)NT * 8 * 8;
    for (size_t i = (size_t)c.gwave * 64 + c.lane; i < n; i += (size_t)c.nwaves * 64) {
        const size_t th = i >> 3; const int ch = (int)(i & 7);
        float m[3], l[3];
#pragma unroll
        for (int p = 0; p < 3; ++p) { const float2 ml = *(const float2*)(pml + ((size_t)p * NT * 8 + th) * 2); m[p] = ml.x; l[p] = ml.y; }
        const float mm = fmaxf(m[0], fmaxf(m[1], m[2]));
        float wgt[3], den = 0.f;
#pragma unroll
        for (int p = 0; p < 3; ++p) { wgt[p] = __builtin_amdgcn_exp2f(m[p] - mm); den += wgt[p] * l[p]; }
        const float inv = 1.f / den;
        float o[8];
#pragma unroll
        for (int d = 0; d < 8; ++d) o[d] = 0.f;
#pragma unroll
        for (int p = 0; p < 3; ++p) {
            const uint4 v = *(const uint4*)(po + ((size_t)p * NT * 8 + th) * 64 + ch * 8);
            const unsigned w4[4] = {v.x, v.y, v.z, v.w};
#pragma unroll
            for (int q = 0; q < 4; ++q) { o[2 * q] = fmaf(wgt[p], __builtin_bit_cast(float, w4[q] << 16), o[2 * q]); o[2 * q + 1] = fmaf(wgt[p], __builtin_bit_cast(float, w4[q] & 0xffff0000u), o[2 * q + 1]); }
        }
        uint4 ov; ov.x = pk2(o[0] * inv, o[1] * inv); ov.y = pk2(o[2] * inv, o[3] * inv); ov.z = pk2(o[4] * inv, o[5] * inv); ov.w = pk2(o[6] * inv, o[7] * inv);
        const size_t tok = th >> 3; const int hd = (int)(th & 7);
        *(uint4*)(out + tok * DM + hd * 64 + ch * 8) = ov;
    }
}
__device__ __forceinline__ void attn_fox_mfma(const Ctx& c, const bf16_t* qkv, const float* F, bf16_t* out) {
    unsigned char* scratch = (unsigned char*)c.lds;
    const att::UnitArgs UD{qkv, out, 1536, 2048, 2560, 512};
    for (int p = c.bid; p < 256; p += c.nblk) {
        const int pp = xcd_perm256(p), bh = pp >> 3, qb = pp & 7;
        att::causal_unit<3>(UD, bh >> 3, bh & 7, 15 - qb, scratch, c.tid, nullptr, 0.f, nullptr, F);
        att::causal_unit<3>(UD, bh >> 3, bh & 7, qb, scratch, c.tid, nullptr, 0.f, nullptr, F);
    }
}

__device__ __forceinline__ void ln_rows(const Ctx& c, const float* hin32, const bf16_t* hin16, const float* add, const float* g, const float* bta, float* out, bf16_t* outb, unsigned char* out8 = nullptr, float* oscale = nullptr) {
    for (int t = c.gwave; t < NT; t += c.nwaves) {
        float v[16];
        float s = 0.f;
#pragma unroll
        for (int r = 0; r < 4; ++r) {
            const int d = r * 256 + c.lane * 4;
            float4 a;
            if (hin32) a = *(const float4*)(hin32 + (size_t)t * DM + d);
            else { const uint2 w = *(const uint2*)(hin16 + (size_t)t * DM + d); a = make_float4(__builtin_bit_cast(float, w.x << 16), __builtin_bit_cast(float, w.x & 0xffff0000u), __builtin_bit_cast(float, w.y << 16), __builtin_bit_cast(float, w.y & 0xffff0000u)); }
            const float4 m = *(const float4*)(add + (size_t)t * DM + d);
            v[r * 4 + 0] = DN_ALPHA * a.x + m.x; v[r * 4 + 1] = DN_ALPHA * a.y + m.y; v[r * 4 + 2] = DN_ALPHA * a.z + m.z; v[r * 4 + 3] = DN_ALPHA * a.w + m.w;
            s += v[r * 4] + v[r * 4 + 1] + v[r * 4 + 2] + v[r * 4 + 3];
        }
        const float mu = wave_sum(s) * (1.f / DM);
        float q = 0.f;
#pragma unroll
        for (int i = 0; i < 16; ++i) { v[i] -= mu; q = fmaf(v[i], v[i], q); }
        const float rs = rsqrtf(wave_sum(q) * (1.f / DM) + LN_EPS);
        float amax = 0.f;
#pragma unroll
        for (int r = 0; r < 4; ++r) {
            const int d = r * 256 + c.lane * 4;
            const float4 gg = *(const float4*)(g + d), bb = *(const float4*)(bta + d);
            const float4 o = make_float4(v[r * 4] * rs * gg.x + bb.x, v[r * 4 + 1] * rs * gg.y + bb.y, v[r * 4 + 2] * rs * gg.z + bb.z, v[r * 4 + 3] * rs * gg.w + bb.w);
            if (out) *(float4*)(out + (size_t)t * DM + d) = o;
            if (outb) *(uint2*)(outb + (size_t)t * DM + d) = make_uint2(pk2(o.x, o.y), pk2(o.z, o.w));
            v[r * 4] = o.x; v[r * 4 + 1] = o.y; v[r * 4 + 2] = o.z; v[r * 4 + 3] = o.w;
            amax = fmaxf(amax, fmaxf(fmaxf(fabsf(o.x), fabsf(o.y)), fmaxf(fabsf(o.z), fabsf(o.w))));
        }
        if (out8) {
#pragma unroll
            for (int o = 32; o >= 1; o >>= 1) amax = fmaxf(amax, __shfl_xor(amax, o));
            int e = (int)((__builtin_bit_cast(unsigned, amax) >> 23) & 0xffu) - 127;
            e = e < -100 ? -100 : (e > 100 ? 100 : e);
            const float sc = __builtin_bit_cast(float, (unsigned)(127 + 7 - e) << 23);
#pragma unroll
            for (int r = 0; r < 4; ++r) {
                int w = 0;
                w = __builtin_amdgcn_cvt_pk_fp8_f32(v[r * 4] * sc, v[r * 4 + 1] * sc, w, false); w = __builtin_amdgcn_cvt_pk_fp8_f32(v[r * 4 + 2] * sc, v[r * 4 + 3] * sc, w, true);
                *(int*)(out8 + (size_t)t * DM + r * 256 + c.lane * 4) = w;
            }
            if (c.lane == 0) oscale[t] = __builtin_bit_cast(float, (unsigned)(127 - 7 + e) << 23);
        }
    }
}

__device__ __forceinline__ void topk_insert(float (&tv)[16], int (&ti)[16], float v, int id) {
#pragma unroll
    for (int j = 15; j >= 1; --j) {
        const bool g = v > tv[j], gp = v > tv[j - 1];
        tv[j] = g ? (gp ? tv[j - 1] : v) : tv[j];
        ti[j] = g ? (gp ? ti[j - 1] : id) : ti[j];
    }
    const bool g0 = v > tv[0];
    tv[0] = g0 ? v : tv[0]; ti[0] = g0 ? id : ti[0];
}

namespace rt {
typedef short bf16x8 __attribute__((ext_vector_type(8)));
typedef float f32x16 __attribute__((ext_vector_type(16)));
__device__ __forceinline__ void ins_packed(float (&tv)[16], float v) {
#pragma unroll
    for (int j = 15; j >= 1; --j) { const bool g = v > tv[j], gp = v > tv[j - 1]; tv[j] = g ? (gp ? tv[j - 1] : v) : tv[j]; }
    tv[0] = v > tv[0] ? v : tv[0];
}
__device__ __forceinline__ float pk_idx(float v, int idx) { return __builtin_bit_cast(float, (__builtin_bit_cast(unsigned, v) & ~127u) | (unsigned)idx); }
__device__ __forceinline__ float pk_val(float p) { return __builtin_bit_cast(float, __builtin_bit_cast(unsigned, p) & ~127u); }
__device__ __forceinline__ int pk_id(float p) { return (int)(__builtin_bit_cast(unsigned, p) & 127u); }

__device__ __forceinline__ void top16_of_set(float (&tv)[16], const bf16_t* pq_row  , const bf16_t* keys  , int r, int hh) {
    bf16x8 B[8];
#pragma unroll
    for (int s = 0; s < 8; ++s) B[s] = *(const bf16x8*)(pq_row + 16 * s);
#pragma unroll
    for (int j = 0; j < 16; ++j) tv[j] = -INFINITY;
#pragma unroll 1
    for (int blk = 0; blk < 4; ++blk) {
        const bf16_t* kr = keys + (size_t)(32 * blk + r) * 128 + 8 * hh;
        f32x16 acc = {0.f, 0.f, 0.f, 0.f, 0.f, 0.f, 0.f, 0.f, 0.f, 0.f, 0.f, 0.f, 0.f, 0.f, 0.f, 0.f};
#pragma unroll
        for (int s = 0; s < 8; ++s) acc = __builtin_amdgcn_mfma_f32_32x32x16_bf16(*(const bf16x8*)(kr + 16 * s), B[s], acc, 0, 0, 0);
#pragma unroll
        for (int i = 0; i < 16; ++i) ins_packed(tv, pk_idx(acc[i], 32 * blk + 8 * (i >> 2) + 4 * hh + (i & 3)));
    }
    float pt[16];
#pragma unroll
    for (int j = 0; j < 16; ++j) pt[j] = __shfl_xor(tv[j], 32);
#pragma unroll
    for (int j = 0; j < 16; ++j) ins_packed(tv, pt[j]);
}
}

__device__ __forceinline__ void peer_route_phase(const Ctx& c, const bf16_t* pq, const bf16_t* subk  , int* eidx, float* gate) {
    const int lane = c.lane, r = lane & 31, hh = lane >> 5;
    for (int task = c.gwave; task < (NT / 32) * 8; task += c.nwaves) {
        const int h = task & 7, t = (task >> 3) * 32 + r;
        float la[16], lb[16];
        rt::top16_of_set(la, pq + (size_t)t * PEER_QW + (2 * h) * 128 + 8 * hh, subk + (size_t)(2 * h) * 128 * 128, r, hh);
        rt::top16_of_set(lb, pq + (size_t)t * PEER_QW + (2 * h + 1) * 128 + 8 * hh, subk + (size_t)(2 * h + 1) * 128 * 128, r, hh);
        float tv[16]; int ti[16];
#pragma unroll
        for (int j = 0; j < 16; ++j) { tv[j] = -INFINITY; ti[j] = 0; }
#pragma unroll
        for (int i = 0; i < 16; ++i) {
            const float av = rt::pk_val(la[i]); const int ai = rt::pk_id(la[i]) * 128;
#pragma unroll
            for (int j = 0; j < 16 / (i + 1); ++j) topk_insert(tv, ti, av + rt::pk_val(lb[j]), ai + rt::pk_id(lb[j]));
        }
        float sum = 0.f, e[16];
#pragma unroll
        for (int j = 0; j < 16; ++j) { e[j] = expf(tv[j] - tv[0]); sum += e[j]; }
        const float inv = 1.f / sum;
        if (hh == 0) {
            int* oi = eidx + ((size_t)t * 8 + h) * 16; float* og = gate + ((size_t)t * 8 + h) * 16;
#pragma unroll
            for (int j = 0; j < 16; j += 4) {
                *(int4*)(oi + j) = make_int4(ti[j], ti[j + 1], ti[j + 2], ti[j + 3]);
                *(float4*)(og + j) = make_float4(e[j] * inv, e[j + 1] * inv, e[j + 2] * inv, e[j + 3] * inv);
            }
        }
    }
}

typedef unsigned u32x4_t __attribute__((ext_vector_type(4)));
typedef float f32x2_t __attribute__((ext_vector_type(2)));
#define GAS __attribute__((address_space(1)))
__device__ __forceinline__ float gelu_exact(float d) { return 0.5f * d * (1.f + erff(d * 0.70710678118654752f)); }

template <int MODE>
__device__ __forceinline__ void cvt_rows_fp8(const Ctx& c, const float* src, unsigned char* dst, float* rowscale, int nrows) {
    for (int row = c.gwave; row < nrows; row += c.nwaves) {
        const float* s = src + (size_t)row * DM + c.lane * 16;
        const float4 a0 = *(const float4*)s, a1 = *(const float4*)(s + 4), a2 = *(const float4*)(s + 8), a3 = *(const float4*)(s + 12);
        float am = fmaxf(fmaxf(fmaxf(fabsf(a0.x), fabsf(a0.y)), fmaxf(fabsf(a0.z), fabsf(a0.w))), fmaxf(fmaxf(fabsf(a1.x), fabsf(a1.y)), fmaxf(fabsf(a1.z), fabsf(a1.w))));
        am = fmaxf(am, fmaxf(fmaxf(fmaxf(fabsf(a2.x), fabsf(a2.y)), fmaxf(fabsf(a2.z), fabsf(a2.w))), fmaxf(fmaxf(fabsf(a3.x), fabsf(a3.y)), fmaxf(fabsf(a3.z), fabsf(a3.w)))));
#pragma unroll
        for (int o = 32; o >= 1; o >>= 1) am = fmaxf(am, __shfl_xor(am, o));
        int e = (int)((__builtin_bit_cast(unsigned, am) >> 23) & 0xffu) - 127;
        e = e < -100 ? -100 : (e > 100 ? 100 : e);
        const float sc = __builtin_bit_cast(float, (unsigned)(127 + 7 - e) << 23), inv = __builtin_bit_cast(float, (unsigned)(127 - 7 + e) << 23);
        int w0 = 0, w1 = 0, w2 = 0, w3 = 0;
        w0 = __builtin_amdgcn_cvt_pk_fp8_f32(a0.x * sc, a0.y * sc, w0, false); w0 = __builtin_amdgcn_cvt_pk_fp8_f32(a0.z * sc, a0.w * sc, w0, true);
        w1 = __builtin_amdgcn_cvt_pk_fp8_f32(a1.x * sc, a1.y * sc, w1, false); w1 = __builtin_amdgcn_cvt_pk_fp8_f32(a1.z * sc, a1.w * sc, w1, true);
        w2 = __builtin_amdgcn_cvt_pk_fp8_f32(a2.x * sc, a2.y * sc, w2, false); w2 = __builtin_amdgcn_cvt_pk_fp8_f32(a2.z * sc, a2.w * sc, w2, true);
        w3 = __builtin_amdgcn_cvt_pk_fp8_f32(a3.x * sc, a3.y * sc, w3, false); w3 = __builtin_amdgcn_cvt_pk_fp8_f32(a3.z * sc, a3.w * sc, w3, true);
        const int lyr = row >> 14, er = row & 16383;
        unsigned char* dp = MODE == 0 ? dst + ((size_t)lyr * 16384 + (size_t)(er & 7) * 2048 + (er >> 3)) * DM + c.lane * 16
                                      : dst + (size_t)lyr * 16384 * DM + (size_t)(c.lane >> 3) * (16384 * 128) + (size_t)er * 128 + (c.lane & 7) * 16;
        *(uint4*)dp = make_uint4((unsigned)w0, (unsigned)w1, (unsigned)w2, (unsigned)w3);
        if (c.lane == 0) rowscale[row] = inv;
    }
}
__device__ __forceinline__ float dot16_fp8(const u32x4_t w, const float (&x)[16], float acc) {
    const int w0 = (int)w.x, w1 = (int)w.y, w2 = (int)w.z, w3 = (int)w.w;
    f32x2_t p;
    p = __builtin_amdgcn_cvt_pk_f32_fp8(w0, false); acc = fmaf(p.x, x[0], acc); acc = fmaf(p.y, x[1], acc);
    p = __builtin_amdgcn_cvt_pk_f32_fp8(w0, true);  acc = fmaf(p.x, x[2], acc); acc = fmaf(p.y, x[3], acc);
    p = __builtin_amdgcn_cvt_pk_f32_fp8(w1, false); acc = fmaf(p.x, x[4], acc); acc = fmaf(p.y, x[5], acc);
    p = __builtin_amdgcn_cvt_pk_f32_fp8(w1, true);  acc = fmaf(p.x, x[6], acc); acc = fmaf(p.y, x[7], acc);
    p = __builtin_amdgcn_cvt_pk_f32_fp8(w2, false); acc = fmaf(p.x, x[8], acc); acc = fmaf(p.y, x[9], acc);
    p = __builtin_amdgcn_cvt_pk_f32_fp8(w2, true);  acc = fmaf(p.x, x[10], acc); acc = fmaf(p.y, x[11], acc);
    p = __builtin_amdgcn_cvt_pk_f32_fp8(w3, false); acc = fmaf(p.x, x[12], acc); acc = fmaf(p.y, x[13], acc);
    p = __builtin_amdgcn_cvt_pk_f32_fp8(w3, true);  acc = fmaf(p.x, x[14], acc); acc = fmaf(p.y, x[15], acc);
    return acc;
}
__device__ __forceinline__ void axpy16_fp8(const u32x4_t w, float cv, float (&acc)[16]) {
    const int w0 = (int)w.x, w1 = (int)w.y, w2 = (int)w.z, w3 = (int)w.w;
    f32x2_t p;
    p = __builtin_amdgcn_cvt_pk_f32_fp8(w0, false); acc[0] = fmaf(cv, p.x, acc[0]); acc[1] = fmaf(cv, p.y, acc[1]);
    p = __builtin_amdgcn_cvt_pk_f32_fp8(w0, true);  acc[2] = fmaf(cv, p.x, acc[2]); acc[3] = fmaf(cv, p.y, acc[3]);
    p = __builtin_amdgcn_cvt_pk_f32_fp8(w1, false); acc[4] = fmaf(cv, p.x, acc[4]); acc[5] = fmaf(cv, p.y, acc[5]);
    p = __builtin_amdgcn_cvt_pk_f32_fp8(w1, true);  acc[6] = fmaf(cv, p.x, acc[6]); acc[7] = fmaf(cv, p.y, acc[7]);
    p = __builtin_amdgcn_cvt_pk_f32_fp8(w2, false); acc[8] = fmaf(cv, p.x, acc[8]); acc[9] = fmaf(cv, p.y, acc[9]);
    p = __builtin_amdgcn_cvt_pk_f32_fp8(w2, true);  acc[10] = fmaf(cv, p.x, acc[10]); acc[11] = fmaf(cv, p.y, acc[11]);
    p = __builtin_amdgcn_cvt_pk_f32_fp8(w3, false); acc[12] = fmaf(cv, p.x, acc[12]); acc[13] = fmaf(cv, p.y, acc[13]);
    p = __builtin_amdgcn_cvt_pk_f32_fp8(w3, true);  acc[14] = fmaf(cv, p.x, acc[14]); acc[15] = fmaf(cv, p.y, acc[15]);
}

__device__ __forceinline__ void peer_u_phase(const Ctx& c, const unsigned char* x8_, const float* xs_, const int* eidx_, const float* gate_, float* coef, const unsigned char* U8_, const float* rsu_, const float* rsv_) {
    const GAS unsigned char* x8 = (const GAS unsigned char*)x8_; const GAS float* xs = (const GAS float*)xs_; const GAS int* eidx = (const GAS int*)eidx_; const GAS float* gate = (const GAS float*)gate_;
    const GAS unsigned char* U8 = (const GAS unsigned char*)U8_; const GAS float* rsu = (const GAS float*)rsu_; const GAS float* rsv = (const GAS float*)rsv_;
    const int lane = c.lane, r = lane & 15, kb = lane >> 4, fin = 4 * kb + (lane & 3);
    LAS unsigned char* rowbuf = (LAS unsigned char*)c.lds + c.wave * (16 * 1040);
    typedef float f32x4_t __attribute__((ext_vector_type(4)));
    typedef long i64x2_t __attribute__((ext_vector_type(2)));
#define U_SLOT(e) (((size_t)((e) & 7) * 2048 + ((e) >> 3)) * DM)
#define U_DMA(erow) do { _Pragma("unroll") for (int q = 0; q < 16; ++q) { const int eq = __builtin_amdgcn_readlane(erow, q); \
        __builtin_amdgcn_global_load_lds((const GAS unsigned*)(U8 + U_SLOT(eq) + lane * 16), (LAS unsigned*)(rowbuf + q * 1040), 16, 0, 0); } } while (0)
    for (int wv = c.gwave; wv < NT / 8; wv += c.nwaves) {
        const int tb = wv * 8;
        int e_cur = eidx[(size_t)tb * 128 + r];
        int ef = __shfl(e_cur, fin); float su = rsu[ef], sv = rsv[ef], gt = gate[(size_t)tb * 128 + fin];
        U_DMA(e_cur);
        int e_nxt = eidx[(size_t)tb * 128 + 16 + r];
        float xsc = xs[tb];
        i64x2_t bx[16];
#pragma unroll
        for (int s = 0; s < 16; ++s) bx[s] = *(const GAS i64x2_t*)(x8 + (size_t)tb * DM + 64 * s + 16 * kb);
#pragma unroll 1
        for (int n = 0; n < 64; ++n) {
            const int t = tb + (n >> 3), ch = n & 7;
            asm volatile("s_waitcnt vmcnt(0)" ::: "memory");
            i64x2_t a[16];
#pragma unroll
            for (int s = 0; s < 16; ++s) a[s] = *(const LAS i64x2_t*)(rowbuf + r * 1040 + 64 * s + 16 * kb);
            const float su_c = su, sv_c = sv, gt_c = gt, xsc_c = xsc;
            asm volatile("s_waitcnt lgkmcnt(0)" ::: "memory");
            const int n1 = n < 63 ? n + 1 : 63, n2 = n < 62 ? n + 2 : 63;
            ef = __shfl(e_nxt, fin);
            su = rsu[ef]; sv = rsv[ef]; gt = gate[(size_t)(tb + (n1 >> 3)) * 128 + 16 * (n1 & 7) + fin];
            xsc = xs[tb + (n1 >> 3)];
            U_DMA(e_nxt);
            e_nxt = eidx[(size_t)(tb + (n2 >> 3)) * 128 + 16 * (n2 & 7) + r];
            f32x4_t acc = {0.f, 0.f, 0.f, 0.f};
#pragma unroll
            for (int s = 0; s < 16; ++s) {
                acc = __builtin_amdgcn_mfma_f32_16x16x32_fp8_fp8(a[s].x, bx[s].x, acc, 0, 0, 0);
                acc = __builtin_amdgcn_mfma_f32_16x16x32_fp8_fp8(a[s].y, bx[s].y, acc, 0, 0, 0);
            }
            if (ch == 7 && n < 63) {
#pragma unroll
                for (int s = 0; s < 16; ++s) bx[s] = *(const GAS i64x2_t*)(x8 + (size_t)(t + 1) * DM + 64 * s + 16 * kb);
            }
            const int c4 = lane & 3;
            const float dsel = c4 == 0 ? acc[0] : (c4 == 1 ? acc[1] : (c4 == 2 ? acc[2] : acc[3]));
            if (r < 4) coef[(size_t)t * 128 + 16 * ch + fin] = gt_c * gelu_exact(dsel * su_c * xsc_c) * sv_c;
        }
    }
#undef U_SLOT
#undef U_DMA
}

__device__ __forceinline__ void peer_v_phase(const Ctx& c, const int* eidx_, const float* coef_, const unsigned char* V8_, float* Y) {
    const GAS int* eidx = (const GAS int*)eidx_; const GAS float* coef = (const GAS float*)coef_; const GAS unsigned char* V8 = (const GAS unsigned char*)V8_;
    const int lane = c.lane, sg = lane >> 3, part = lane & 7;
    typedef int i32x4_t __attribute__((ext_vector_type(4)));
    typedef float f32x4_t __attribute__((ext_vector_type(4)));
    for (int vb = c.bid; vb < 256; vb += c.nblk) {
        const int j = vb & 7, rnk = vb >> 3;
        const int dcol = 128 * j + part * 16;
        const GAS unsigned char* vbase = V8 + (size_t)j * (16384 * 128) + part * 16;
        const int t0 = rnk * 512 + c.wave * 64;
        i32x4_t e[4], en[4]; f32x4_t cf[4], cn[4];
        u32x4_t rA[8], rB[8];
#pragma unroll
        for (int q = 0; q < 4; ++q) { e[q] = *(const GAS i32x4_t*)(eidx + (size_t)t0 * 128 + sg * 16 + 4 * q); cf[q] = *(const GAS f32x4_t*)(coef + (size_t)t0 * 128 + sg * 16 + 4 * q); }
#pragma unroll
        for (int it = 0; it < 8; ++it) rA[it] = *(const GAS u32x4_t*)(vbase + (size_t)e[it >> 2][it & 3] * 128);
#pragma unroll 1
        for (int i = 0; i < 64; ++i) {
            const int t = t0 + i, tn = t0 + (i < 63 ? i + 1 : 63);
#pragma unroll
            for (int it = 0; it < 8; ++it) rB[it] = *(const GAS u32x4_t*)(vbase + (size_t)e[2 + (it >> 2)][it & 3] * 128);
#pragma unroll
            for (int q = 0; q < 4; ++q) { en[q] = *(const GAS i32x4_t*)(eidx + (size_t)tn * 128 + sg * 16 + 4 * q); cn[q] = *(const GAS f32x4_t*)(coef + (size_t)tn * 128 + sg * 16 + 4 * q); }
            float acc[16];
#pragma unroll
            for (int d_ = 0; d_ < 16; ++d_) acc[d_] = 0.f;
#pragma unroll
            for (int it = 0; it < 8; ++it) axpy16_fp8(rA[it], cf[it >> 2][it & 3], acc);
#pragma unroll
            for (int it = 0; it < 8; ++it) rA[it] = *(const GAS u32x4_t*)(vbase + (size_t)en[it >> 2][it & 3] * 128);
#pragma unroll
            for (int it = 0; it < 8; ++it) axpy16_fp8(rB[it], cf[2 + (it >> 2)][it & 3], acc);
#pragma unroll
            for (int d_ = 0; d_ < 16; ++d_) { acc[d_] += __shfl_xor(acc[d_], 8); acc[d_] += __shfl_xor(acc[d_], 16); acc[d_] += __shfl_xor(acc[d_], 32); }
            if (lane < 8) {
                float* yp = Y + (size_t)t * DM + dcol;
#pragma unroll
                for (int q = 0; q < 4; ++q) *(f32x4_t*)(yp + 4 * q) = (f32x4_t){acc[4 * q], acc[4 * q + 1], acc[4 * q + 2], acc[4 * q + 3]};
            }
#pragma unroll
            for (int q = 0; q < 4; ++q) { e[q] = en[q]; cf[q] = cn[q]; }
        }
    }
}
__device__ __forceinline__ void prologue_phase(const Ctx& c, const float* x, const float* ab_in, const float* ab_out, const float* cd_in, const float* cd_out, const float* wq, const float* pu, const float* pv, const float* sk, unsigned char* ws) {
    float* scr = c.lds + c.wave * 4096;
    constexpr int I_IN = 16 * 96, I_OUT = 16 * 32, I_WQ = 16 * 64;
    constexpr int NITEMS = 2 * I_IN + 2 * I_OUT + 2 * I_WQ;
    for (int it = c.gwave; it < NITEMS; it += c.nwaves) {
        int r = it;
        if (r < I_IN) { transpose_item(ab_in, QKV_W, DM, QKV_W, (bf16_t*)(ws + WT_ABIN), scr, r, c.lane); continue; } r -= I_IN;
        if (r < I_IN) { transpose_item(cd_in, CD_IN, DM, QKV_W, (bf16_t*)(ws + WT_CDIN), scr, r, c.lane); continue; } r -= I_IN;
        if (r < I_OUT) { transpose_item(ab_out, DM, DM, DM, (bf16_t*)(ws + WT_ABOUT), scr, r, c.lane); continue; } r -= I_OUT;
        if (r < I_OUT) { transpose_item(cd_out, DM, DM, DM, (bf16_t*)(ws + WT_CDOUT), scr, r, c.lane); continue; } r -= I_OUT;
        if (r < I_WQ) { transpose_item(wq, PEER_QW, DM, PEER_QW, (bf16_t*)(ws + WT_WQ), scr, r, c.lane); continue; } r -= I_WQ;
        transpose_item(wq + (size_t)DM * PEER_QW, PEER_QW, DM, PEER_QW, (bf16_t*)(ws + WT_WQ + 4 * MiB), scr, r, c.lane);
    }
    cvt_rows_bf16(c, x, (bf16_t*)(ws + WS_ACTIN), (size_t)NT * DM / 8);
    cvt_rows_fp8<0>(c, pu, ws + WS_U8, (float*)(ws + WS_RS), 2 * 16384);
    cvt_rows_fp8<1>(c, pv, ws + WS_V8, (float*)(ws + WS_RS) + 2 * 16384, 2 * 16384);
    cvt_rows_bf16(c, sk, (bf16_t*)(ws + WS_SKB), (size_t)2 * 16 * 128 * 128 / 8);
}

constexpr int NPHASE = 1 + 2 * 11;
__global__ void __launch_bounds__(NTHREADS, 2) fwd(Args args) {
    unsigned* ctl = (unsigned*)(args.ws + WS_CTL);
    volatile LAS unsigned* xbw = (volatile LAS unsigned*)(dyn_lds + MISC_OFF);
    if (threadIdx.x == 0) { xbw[0] = 0u; xbw[1] = 0u; xbw[2] = 0u; xbw[3] = 0u; }
    __syncthreads();
    const int lo = args.ph_lo, hi = args.ph_hi;
    XcdBarrier bar = xcd_barrier_post(ctl + 4096, xbw);
#define IN(k) (lo <= (k) && (k) < hi)
#define SEAM(k) do { if (IN(k) && IN((k) + 1)) xcd_barrier(bar); } while (0)
#define LAUNDER(ptr) ptr = launder_ptr(ptr)
#define PIN(k) ((const float*)launder_ptr((unsigned char*)args.in[k]))
#define GEMM_LDS ((PG8_LAS unsigned char*)dyn_lds + RING_OFF)
    if (IN(0)) { unsigned char* ws = args.ws; LAUNDER(ws); const Ctx c = make_ctx(); prologue_phase(c, PIN(0), PIN(2), PIN(5), PIN(6), PIN(8), PIN(9), PIN(11), PIN(12), PIN(10), ws); }
    SEAM(0);
#pragma unroll 1
    for (int layer = 0; layer < 2; ++layer) {
        const int pb = 1 + layer * 11;
        if (IN(pb + 0)) {
            unsigned char* ws = args.ws; LAUNDER(ws); const Ctx c = make_ctx();
            pg8::Gemm g{(const bf16_t*)(ws + WS_ACTIN), (const bf16_t*)(ws + (layer == 0 ? WT_ABIN : WT_CDIN)), NT, QKV_W, DM};
            pg8::StaticOrder S; S.init(NT, QKV_W, c.nblk, c.bid);
            pg8::EpiStoreBf16 E{(bf16_t*)(ws + WS_QKV), QKV_W, (layer == 0 ? 0.17677669529663687f : 0.125f) * 1.4426950408889634f, 0.125f * 1.4426950408889634f};
            pg8::gemm_phase<pg8::EpiStoreBf16, pg8::StaticOrder, true, true>(GEMM_LDS, g, S, E);
            if (layer == 1) fg_phase(c, (const bf16_t*)(ws + WS_ACTIN), PIN(6), (float*)(ws + WS_FG));
        }
        SEAM(pb + 0);
        if (IN(pb + 1) && layer == 1) { unsigned char* ws = args.ws; LAUNDER(ws); const Ctx c = make_ctx(); fscan_naive(c, (const float*)(ws + WS_FG), (float*)(ws + WS_F), PIN(7)); }
        if (layer == 1) SEAM(pb + 1);
        if (IN(pb + 2)) {
            unsigned char* ws = args.ws; LAUNDER(ws); const Ctx c = make_ctx();
            if (layer == 0) attn_layer0_mfma(c, (const bf16_t*)(ws + WS_QKV), (bf16_t*)(ws + WS_ATTB), PIN(1), PIN(3), PIN(4));
            else { attn_fox_mfma(c, (const bf16_t*)(ws + WS_QKV), (const float*)(ws + WS_F), (bf16_t*)(ws + WS_ATTB)); attn_dilated_mfma(c, (const bf16_t*)(ws + WS_QKV), PIN(1), (bf16_t*)(ws + WS_MIX), (float*)(ws + WS_H1B)); }
        }
        SEAM(pb + 2);
        if (IN(pb + 3) && layer == 1) { unsigned char* ws = args.ws; LAUNDER(ws); const Ctx c = make_ctx(); dilated_combine(c, (const bf16_t*)(ws + WS_MIX), (const float*)(ws + WS_H1B), (bf16_t*)(ws + WS_ATTB)); }
        if (layer == 1) SEAM(pb + 3);
        if (IN(pb + 4)) {
            unsigned char* ws = args.ws; LAUNDER(ws); const Ctx c = make_ctx();
            pg8::Gemm g{(const bf16_t*)(ws + WS_ATTB), (const bf16_t*)(ws + (layer == 0 ? WT_ABOUT : WT_CDOUT)), NT, DM, DM};
            pg8::StaticOrder S; S.init(NT, DM, c.nblk, c.bid);
            pg8::EpiStoreF32 E{(float*)(ws + WS_MIX), DM};
            pg8::gemm_phase<pg8::EpiStoreF32, pg8::StaticOrder, true, true>(GEMM_LDS, g, S, E);
        }
        SEAM(pb + 4);
        if (IN(pb + 5)) {
            unsigned char* ws = args.ws; LAUNDER(ws); const Ctx c = make_ctx();
            ln_rows(c, layer == 0 ? PIN(0) : (const float*)nullptr, (const bf16_t*)(ws + WS_ACTIN), (const float*)(ws + WS_MIX), PIN(13) + (size_t)layer * 2 * DM, PIN(14) + (size_t)layer * 2 * DM, (float*)nullptr, (bf16_t*)(ws + WS_H1B), ws + WS_X8, (float*)(ws + WS_XS));
        }
        SEAM(pb + 5);
        if (IN(pb + 6)) {
            unsigned char* ws = args.ws; LAUNDER(ws); const Ctx c = make_ctx();
            pg8::Gemm g{(const bf16_t*)(ws + WS_H1B), (const bf16_t*)(ws + WT_WQ + (size_t)layer * 4 * MiB), NT, PEER_QW, DM};
            pg8::StaticOrder S; S.init(NT, PEER_QW, c.nblk, c.bid);
            pg8::EpiStoreBf16 E{(bf16_t*)(ws + WS_QKV), PEER_QW, 1.f, 1.f};
            pg8::gemm_phase<pg8::EpiStoreBf16, pg8::StaticOrder, true, true>(GEMM_LDS, g, S, E);
        }
        SEAM(pb + 6);
        if (IN(pb + 7)) {
            unsigned char* ws = args.ws; LAUNDER(ws); const Ctx c = make_ctx();
            peer_route_phase(c, (const bf16_t*)(ws + WS_QKV), (const bf16_t*)(ws + WS_SKB) + (size_t)layer * 16 * 128 * 128, (int*)(ws + WS_EIDX), (float*)(ws + WS_GATE));
        }
        SEAM(pb + 7);
        if (IN(pb + 8)) {
            unsigned char* ws = args.ws; LAUNDER(ws); const Ctx c = make_ctx();
            peer_u_phase(c, ws + WS_X8, (const float*)(ws + WS_XS), (const int*)(ws + WS_EIDX), (const float*)(ws + WS_GATE), (float*)(ws + WS_COEF), ws + WS_U8 + (size_t)layer * 16384 * DM, (const float*)(ws + WS_RS) + (size_t)layer * 16384, (const float*)(ws + WS_RS) + (size_t)(2 + layer) * 16384);
        }
        SEAM(pb + 8);
        if (IN(pb + 9)) {
            unsigned char* ws = args.ws; LAUNDER(ws); const Ctx c = make_ctx();
            peer_v_phase(c, (const int*)(ws + WS_EIDX), (const float*)(ws + WS_COEF), ws + WS_V8 + (size_t)layer * 16384 * DM, (float*)(ws + WS_MIX));
        }
        SEAM(pb + 9);
        if (IN(pb + 10)) {
            unsigned char* ws = args.ws; LAUNDER(ws); const Ctx c = make_ctx();
            float* hout = layer == 0 ? (float*)nullptr : (float*)launder_ptr((unsigned char*)args.out);
            bf16_t* houtb = layer == 0 ? (bf16_t*)(ws + WS_ACTIN) : (bf16_t*)nullptr;
            ln_rows(c, (const float*)nullptr, (const bf16_t*)(ws + WS_H1B), (const float*)(ws + WS_MIX), PIN(13) + (size_t)(layer * 2 + 1) * DM, PIN(14) + (size_t)(layer * 2 + 1) * DM, hout, houtb);
        }
        SEAM(pb + 10);
    }
}

extern "C" void kernel_launch(void* const* d_in, const int* in_sizes, int n_in, void* d_out, int out_size, void* d_ws, size_t ws_size, hipStream_t stream) {
    (void)in_sizes; (void)n_in; (void)out_size;
    static int grid = 0;
    if (!grid) {
        int dev = 0, cus = 0, per_cu = 0;
        (void)hipGetDevice(&dev);
        (void)hipDeviceGetAttribute(&cus, hipDeviceAttributeMultiprocessorCount, dev);
        (void)hipFuncSetAttribute((const void*)fwd, hipFuncAttributeMaxDynamicSharedMemorySize, LDS_BYTES);
        (void)hipOccupancyMaxActiveBlocksPerMultiprocessor(&per_cu, fwd, NTHREADS, LDS_BYTES);
        if (per_cu < 1) fprintf(stderr, "occupancy query says %d blocks per CU\n", per_cu);
        grid = cus;
        if (ws_size < WS_END) fprintf(stderr, "workspace too small: %zu < %zu\n", ws_size, (size_t)WS_END);
    }
    (void)hipMemsetAsync((unsigned char*)d_ws + WS_CTL, 0, 1 * MiB, stream);
    Args a{};
    for (int i = 0; i < 15; ++i) a.in[i] = (const float*)d_in[i];
    a.out = (float*)d_out; a.ws = (unsigned char*)d_ws;
    a.ph_lo = 0; a.ph_hi = NPHASE;
    hipLaunchKernelGGL(fwd, dim3(grid), dim3(NTHREADS), LDS_BYTES, stream, a);
}
```

```cpp
#include <hip/hip_runtime.h>
#include <cstdio>
#include <cstdint>
#include <cmath>

constexpr int BATCH = 4, SEQ = 4096, DM = 1024, NT = BATCH * SEQ;
constexpr int NH = 8, HD = 64;
constexpr int QKV_W = 3072, CD_IN = 3080;
constexpr int PEER_QW = 2048;
constexpr float DN_ALPHA = 1.4142135623730951f;
constexpr float LN_EPS = 1e-5f;
constexpr int NTHREADS = 512, NWAVES = 8;
typedef unsigned short bf16_t;

constexpr size_t MiB = 1u << 20;
constexpr size_t WS_CTL = 0;
constexpr size_t WS_WT = 1 * MiB;
constexpr size_t WT_ABIN = WS_WT, WT_ABOUT = WS_WT + 6 * MiB, WT_CDIN = WS_WT + 8 * MiB, WT_CDOUT = WS_WT + 14 * MiB, WT_WQ = WS_WT + 16 * MiB;
constexpr size_t WS_ACTIN = 25 * MiB;
constexpr size_t WS_ATTB = 57 * MiB;
constexpr size_t WS_H1B = 89 * MiB;
constexpr size_t WS_QKV = 121 * MiB;
constexpr size_t WS_MIX = 217 * MiB;
constexpr size_t WS_EIDX = 281 * MiB;
constexpr size_t WS_COEF = 289 * MiB;
constexpr size_t WS_F = 297 * MiB;
constexpr size_t WS_FG = 298 * MiB;
constexpr size_t WS_U8 = 299 * MiB;
constexpr size_t WS_V8 = 331 * MiB;
constexpr size_t WS_RS = 363 * MiB;
constexpr size_t WS_SKB = 364 * MiB;
constexpr size_t WS_GATE = 365 * MiB;
constexpr size_t WS_PART = 373 * MiB;
constexpr size_t WS_END = 437 * MiB;
constexpr int LDS_BYTES = 147456;
constexpr int RING_OFF = 0, MISC_OFF = 143360;

#define XB_TMO      128
#define XB_XCNT(j)  (256  + 64 * (j))
#define XB_XSUB(j)  (1280 + 64 * (j))
#define XB_XGEN(j)  (2304 + 64 * (j))
#define XB_TOP      3328
#define XB_TOPGEN   3392
#define XCD_BAR_WORDS 3456
#define XB_SPIN_CAP (1u << 18)
#define LAS __attribute__((address_space(3)))

__device__ __forceinline__ unsigned xb_ld(unsigned* p)              { return __hip_atomic_load(p, __ATOMIC_RELAXED, __HIP_MEMORY_SCOPE_AGENT); }
__device__ __forceinline__ unsigned xb_add(unsigned* p, unsigned v) { return __hip_atomic_fetch_add(p, v, __ATOMIC_RELAXED, __HIP_MEMORY_SCOPE_AGENT); }
__device__ __forceinline__ unsigned xb_xcc_id() { return (unsigned)__builtin_amdgcn_s_getreg((3 << 11) | 20) & 0xFu; }
#define XB_SPIN(cond, bar) do { unsigned _sp = 0; while (cond) { __builtin_amdgcn_s_sleep(1); \
    if ((++_sp & 255u) == 0u) { if (xb_ld(&(bar)[XB_TMO])) break; if (_sp > XB_SPIN_CAP) { atomicAdd(&(bar)[XB_TMO], 1u); break; } } } } while (0)

struct XcdBarrier {
    unsigned* bar; unsigned x; int wave_s;
    volatile LAS unsigned* st;
};
__device__ __forceinline__ XcdBarrier xcd_barrier_post(unsigned* bar, volatile LAS unsigned* st) {
    XcdBarrier b; b.bar = bar; b.x = xb_xcc_id(); b.st = st;
    if (threadIdx.x == 0) (void)xb_add(&bar[XB_XCNT(b.x)], 1u);
    b.wave_s = __builtin_amdgcn_readfirstlane((int)threadIdx.x) >> 6;
    return b;
}
__device__ __forceinline__ void xcd_barrier_complete(unsigned* bar, unsigned x, unsigned& nloc, unsigned& nx) {
    const unsigned G = gridDim.x * gridDim.y * gridDim.z;
    unsigned sum, cnt, mine, sp = 0u;
    for (;;) {
        sum = 0u; cnt = 0u; mine = 0u;
#pragma unroll
        for (unsigned j = 0; j < 16; ++j) { const unsigned c = xb_ld(&bar[XB_XCNT(j)]); sum += c; cnt += (c > 0u) ? 1u : 0u; mine = (j == x) ? c : mine; }
        if (sum == G) break;
        __builtin_amdgcn_s_sleep(1);
        if ((++sp & 255u) == 0u) { if (xb_ld(&bar[XB_TMO])) break; if (sp > XB_SPIN_CAP) { atomicAdd(&bar[XB_TMO], 1u); break; } }
    }
    nloc = mine > 0u ? mine : 1u; nx = cnt > 0u ? cnt : 1u;
}
__device__ __forceinline__ void xcd_barrier(const XcdBarrier& b) {
    asm volatile("s_waitcnt vmcnt(0)" ::: "memory");
    __syncthreads();
    if (b.wave_s == 0 && __builtin_amdgcn_mbcnt_hi(~0u, __builtin_amdgcn_mbcnt_lo(~0u, 0u)) == 0u) {
        unsigned* bar = b.bar;
        __builtin_amdgcn_s_waitcnt(0);
        unsigned nloc = b.st[0], nx = b.st[1];
        if (nloc == 0u) { xcd_barrier_complete(bar, b.x, nloc, nx); b.st[0] = nloc; b.st[1] = nx; }
        const unsigned old = xb_add(&bar[XB_XSUB(b.x)], 1u);
        const unsigned gen = old / nloc;
        if (old + 1u == (gen + 1u) * nloc) {
            __builtin_amdgcn_fence(__ATOMIC_RELEASE, "agent");
            asm volatile("s_waitcnt vmcnt(0)" ::: "memory");
            const unsigned og = xb_add(&bar[XB_TOP], 1u);
            const unsigned tg = og / nx;
            if (og + 1u == (tg + 1u) * nx) xb_add(&bar[XB_TOPGEN], 1u);
            else XB_SPIN(xb_ld(&bar[XB_TOPGEN]) == tg, bar);
            __builtin_amdgcn_fence(__ATOMIC_ACQUIRE, "agent");
            xb_add(&bar[XB_XGEN(b.x)], 1u);
            asm volatile("s_waitcnt vmcnt(0)" ::: "memory");
        } else {
            XB_SPIN(xb_ld(&bar[XB_XGEN(b.x)]) == gen, bar);
            __builtin_amdgcn_fence(__ATOMIC_ACQUIRE, "agent");
            asm volatile("s_waitcnt vmcnt(0)" ::: "memory");
        }
    }
    __syncthreads();
}

struct Args {
    const float* in[15];
    float* out;
    unsigned char* ws;
    int ph_lo, ph_hi;
};
struct Ctx {
    int tid, lane, wave, gwave, nwaves, bid, nblk;
    float* lds;
};
extern __shared__ __attribute__((aligned(16))) unsigned char dyn_lds[];
__device__ __forceinline__ int tid_now(int wave_s) { int lane = (int)__builtin_amdgcn_mbcnt_hi(~0u, __builtin_amdgcn_mbcnt_lo(~0u, 0u)); asm volatile("" : "+v"(lane)); return wave_s * 64 + lane; }
__device__ __forceinline__ Ctx make_ctx(int wave_s) {
    int t = tid_now(wave_s), b = blockIdx.x, g = gridDim.x;
    asm volatile("" : "+s"(b), "+s"(g));
    Ctx c; c.tid = t; c.lane = t & 63; c.wave = t >> 6; c.bid = b; c.nblk = g;
    c.gwave = b * NWAVES + c.wave; c.nwaves = g * NWAVES; c.lds = (float*)(dyn_lds + RING_OFF);
    return c;
}
__device__ __forceinline__ unsigned char* launder_ptr(unsigned char* p) {
    unsigned lo = __builtin_amdgcn_readfirstlane((unsigned)(uintptr_t)p), hi = __builtin_amdgcn_readfirstlane((unsigned)((uintptr_t)p >> 32));
    asm volatile("" : "+s"(lo), "+s"(hi));
    return (unsigned char*)(((uintptr_t)hi << 32) | (uintptr_t)lo);
}
__device__ __forceinline__ float wave_sum(float v) {
#pragma unroll
    for (int o = 32; o >= 1; o >>= 1) v += __shfl_xor(v, o);
    return v;
}
__device__ __forceinline__ float log_sigmoid(float z) { return fminf(z, 0.f) - log1pf(expf(-fabsf(z))); }
__device__ __forceinline__ int t5_bucket(int n) {
    if (n < 16) return n;
    int large = 16 + (int)(logf((float)n / 16.f) / 2.0794415416798357f * 16.f);
    return large < 31 ? large : 31;
}
__device__ __forceinline__ float bf2f(bf16_t v) { return __builtin_bit_cast(float, (unsigned)v << 16); }
__device__ __forceinline__ unsigned f2bf(float f) { unsigned u = __builtin_bit_cast(unsigned, f); return (u + 0x7fffu + ((u >> 16) & 1u)) >> 16; }
__device__ __forceinline__ unsigned pk2(float lo, float hi) { return f2bf(lo) | (f2bf(hi) << 16); }

namespace pg8 {
#define PG8_LAS __attribute__((address_space(3)))
typedef unsigned short bf16_t;
typedef short bf16x8 __attribute__((ext_vector_type(8)));
typedef float f32x4 __attribute__((ext_vector_type(4)));
typedef unsigned u32x4 __attribute__((ext_vector_type(4)));
constexpr int BM = 256, BK = 64, HALF = 128, HTB = HALF * BK * 2  , STAGE_BYTES = 8 * HTB, NXCD = 8, WGM = 8;

__host__ __device__ __forceinline__ int lds_byte(int r, int c) { const int st = (r >> 4) * 2 + (c >> 5), rr = r & 15, cc = c & 31, ob = rr * 64 + cc * 2; return st * 1024 + (ob ^ (((ob >> 9) & 1) << 5)); }
__host__ __device__ __forceinline__ void stage_rc(int b, int& R, int& C) { const int st = b / 1024, sb = b % 1024, swz = sb ^ (((sb >> 9) & 1) << 5); R = (st >> 1) * 16 + swz / 64; C = (st & 1) * 32 + (swz % 64) / 2; }
__host__ __device__ __forceinline__ int perm32(int rho) { const int n = rho >> 4, i = rho & 15; return 8 * (i >> 2) + 4 * n + (i & 3); }

struct Unit { int pm, pn; };
struct Gemm { const bf16_t* A; const bf16_t* Bt; int M, N, K; };

struct StaticOrder {
    int nM, nN, nwg, G, c;
    __host__ __device__ void init(int M, int N, int G_, int c_) { nM = M / BM; nN = N / BM; nwg = nM * nN; G = G_; c = c_; }
    __host__ __device__ bool next(int i, Unit& u) const {
        const long L = (long)i * G + c; if (L >= nwg) return false;
        int wgid = (int)L; { const int q = nwg / NXCD, r = nwg % NXCD, xcd = wgid % NXCD, off = wgid / NXCD; wgid = (xcd < r ? xcd * (q + 1) : r * (q + 1) + (xcd - r) * q) + off; }
        const int nig = WGM * nN, gid = wgid / nig, fm = gid * WGM, gsz = (nM - fm) < WGM ? (nM - fm) : WGM;
        u.pm = fm + ((wgid % nig) % gsz); u.pn = (wgid % nig) / gsz; return true;
    }
    __device__ __forceinline__ void a_ready(const Unit&) const {}
    __device__ __forceinline__ void done(const Unit&) const {}
};

__device__ __forceinline__ unsigned cvt_pk_bf16(float lo, float hi) { unsigned r; asm volatile("v_cvt_pk_bf16_f32 %0, %1, %2" : "=v"(r) : "v"(lo), "v"(hi)); return r; }
template <class Epi, class Sched, bool ALIGN_EPI = false, bool SP2 = false>
__device__ __forceinline__ void gemm_phase(PG8_LAS unsigned char* lds, const Gemm g, const Sched& S, const Epi& E) {
    int tid_ = (__builtin_amdgcn_readfirstlane((int)threadIdx.x) & ~63) + (int)__builtin_amdgcn_mbcnt_hi(~0u, __builtin_amdgcn_mbcnt_lo(~0u, 0u)); asm volatile("" : "+v"(tid_));
    const int tid = tid_, wid = __builtin_amdgcn_readfirstlane(tid >> 6), lane = tid & 63, wr = wid >> 2, wc = wid & 3, fr = lane & 15, fq = lane >> 4;
    const int K = g.K, nt = K / BK;
    unsigned voffA[2], voffB[2];
#pragma unroll
    for (int i = 0; i < 2; ++i) { int R, C; stage_rc(tid * 16 + i * 8192, R, C); const int Rb = Epi::PERM ? ((R & ~31) + perm32(R & 31)) : R;
        voffA[i] = (unsigned)(R * K + C) * 2u; voffB[i] = (unsigned)(Rb * K + C) * 2u; }
    const size_t kstep = (size_t)(BK * 2);
    const size_t hstep = (size_t)HALF * K * 2;
    const size_t tstep = 2 * hstep;
    const unsigned ldsw = (unsigned)wid * 1024u;
    const int aoff = lds_byte(wr * 64 + fr, fq * 8), boff = lds_byte(wc * 32 + fr, fq * 8);
#define PG8_SA(b, h) (((b) * 2 + (h)) * HTB)
#define PG8_SB(b, h) ((4 + (b) * 2 + (h)) * HTB)
#define PG8_STAGE(bufoff, gbase, voff) do { _Pragma("unroll") for (int _i = 0; _i < 2; ++_i) \
        __builtin_amdgcn_global_load_lds((const unsigned*)((const char*)(gbase) + (voff)[_i]), (PG8_LAS unsigned*)(lds + (bufoff) + ldsw + _i * 8192), 16, 0, 0); } while (0)
#define PG8_LDA(dst, b, h) do { _Pragma("unroll") for (int m = 0; m < 4; ++m) _Pragma("unroll") for (int k = 0; k < 2; ++k) dst[m][k] = *(const PG8_LAS bf16x8*)(lds + PG8_SA(b, h) + aoff + m * 2048 + k * 1024); } while (0)
#define PG8_LDB(dst, b, h) do { _Pragma("unroll") for (int n = 0; n < 2; ++n) _Pragma("unroll") for (int k = 0; k < 2; ++k) dst[n][k] = *(const PG8_LAS bf16x8*)(lds + PG8_SB(b, h) + boff + n * 2048 + k * 1024); } while (0)
#define PG8_MMA(ai, bj, At, Bt) do { __builtin_amdgcn_s_setprio(1); _Pragma("unroll") for (int m = 0; m < 4; ++m) _Pragma("unroll") for (int n = 0; n < 2; ++n) _Pragma("unroll") for (int k = 0; k < 2; ++k) \
        acc[ai][bj][m][n] = __builtin_amdgcn_mfma_f32_16x16x32_bf16(Bt[n][k], At[m][k], acc[ai][bj][m][n], 0, 0, 0); __builtin_amdgcn_s_setprio(0); } while (0)
#define PG8_WAIT_V(n) asm volatile("s_waitcnt vmcnt(" #n ")" ::: "memory")
#define PG8_WAIT_L(n) asm volatile("s_waitcnt lgkmcnt(" #n ")" ::: "memory")
#define PG8_BAR __builtin_amdgcn_s_barrier()
#define PG8_SCHED __builtin_amdgcn_sched_barrier(0)
    Unit cur, nxt; int ui = 0;
    if (!S.next(0, cur)) return;
    f32x4 acc[2][2][4][2];
#pragma unroll
    for (int a = 0; a < 2; ++a)
#pragma unroll
        for (int b = 0; b < 2; ++b)
#pragma unroll
            for (int m = 0; m < 4; ++m)
#pragma unroll
                for (int n = 0; n < 2; ++n) acc[a][b][m][n] = (f32x4){0.f, 0.f, 0.f, 0.f};
    bf16x8 At[4][2], B0[2][2], B1[2][2];
    const char* cA = (const char*)g.A + (size_t)cur.pm * tstep; const char* cB = (const char*)g.Bt + (size_t)cur.pn * tstep;
    S.a_ready(cur);
    if constexpr (SP2) {
        PG8_STAGE(PG8_SB(0, 0), cB, voffB); PG8_STAGE(PG8_SB(0, 1), cB + hstep, voffB); PG8_STAGE(PG8_SA(0, 0), cA, voffA); PG8_STAGE(PG8_SA(0, 1), cA + hstep, voffA);
        if (wr == 1) PG8_BAR;
        PG8_WAIT_V(2); PG8_BAR;
        PG8_STAGE(PG8_SB(1, 0), cB + kstep, voffB); PG8_STAGE(PG8_SA(1, 0), cA + kstep, voffA); PG8_STAGE(PG8_SB(1, 1), cB + hstep + kstep, voffB);
        PG8_WAIT_V(6); PG8_BAR;
    } else {
        PG8_STAGE(PG8_SB(0, 0), cB, voffB); PG8_STAGE(PG8_SA(0, 0), cA, voffA); PG8_STAGE(PG8_SB(0, 1), cB + hstep, voffB); PG8_STAGE(PG8_SA(0, 1), cA + hstep, voffA);
        if (wr == 1) PG8_BAR;
        PG8_WAIT_V(4); PG8_BAR;
        PG8_STAGE(PG8_SB(1, 0), cB + kstep, voffB); PG8_STAGE(PG8_SA(1, 0), cA + kstep, voffA); PG8_STAGE(PG8_SB(1, 1), cB + hstep + kstep, voffB);
        PG8_WAIT_V(6); PG8_BAR;
    }
    for (;;) {
        const bool has_next = S.next(ui + 1, nxt);
        const char* nA = has_next ? (const char*)g.A + (size_t)nxt.pm * tstep : cA; const char* nB = has_next ? (const char*)g.Bt + (size_t)nxt.pn * tstep : cB;
        for (int t = 0; t < nt; t += 2) {
            const bool last = (t == nt - 2);
            const char* a1 = cA + (size_t)(t + 1) * kstep;
            const char* a2 = last ? nA : cA + (size_t)(t + 2) * kstep; const char* b2 = last ? nB : cB + (size_t)(t + 2) * kstep;
            const char* a3 = a2 + kstep; const char* b3 = b2 + kstep;
            if (last && has_next) S.a_ready(nxt);
            if constexpr (SP2) {
            PG8_LDB(B0, 0, 0); PG8_LDB(B1, 0, 1); PG8_SCHED; PG8_LDA(At, 0, 0); PG8_STAGE(PG8_SA(1, 1), a1 + hstep, voffA);
            PG8_WAIT_V(8); PG8_WAIT_L(0); PG8_BAR; PG8_MMA(0, 0, At, B0); PG8_MMA(0, 1, At, B1); PG8_BAR; PG8_SCHED;
            PG8_LDA(At, 0, 1); PG8_STAGE(PG8_SB(0, 0), b2, voffB); PG8_STAGE(PG8_SB(0, 1), b2 + hstep, voffB); PG8_STAGE(PG8_SA(0, 0), a2, voffA);
            PG8_WAIT_V(8); PG8_WAIT_L(0); PG8_BAR; PG8_MMA(1, 0, At, B0); PG8_MMA(1, 1, At, B1); PG8_BAR; PG8_SCHED;
            PG8_LDB(B0, 1, 0); PG8_LDB(B1, 1, 1); PG8_SCHED; PG8_LDA(At, 1, 0); PG8_STAGE(PG8_SA(0, 1), a2 + hstep, voffA);
            PG8_WAIT_V(8); PG8_WAIT_L(0); PG8_BAR; PG8_MMA(0, 0, At, B0); PG8_MMA(0, 1, At, B1); PG8_BAR; PG8_SCHED;
            PG8_LDA(At, 1, 1); PG8_STAGE(PG8_SB(1, 0), b3, voffB); PG8_STAGE(PG8_SB(1, 1), b3 + hstep, voffB); PG8_STAGE(PG8_SA(1, 0), a3, voffA);
            PG8_WAIT_V(8); PG8_WAIT_L(0); PG8_BAR; PG8_MMA(1, 0, At, B0); PG8_MMA(1, 1, At, B1); PG8_BAR; PG8_SCHED;
            } else {
            PG8_LDB(B0, 0, 0); PG8_SCHED; PG8_LDA(At, 0, 0); PG8_STAGE(PG8_SA(1, 1), a1 + hstep, voffA);
            PG8_WAIT_L(8); PG8_BAR; PG8_WAIT_L(0); PG8_MMA(0, 0, At, B0); PG8_BAR; PG8_SCHED;
            PG8_LDB(B1, 0, 1); PG8_STAGE(PG8_SB(0, 0), b2, voffB);
            PG8_BAR; PG8_WAIT_L(0); PG8_MMA(0, 1, At, B1); PG8_BAR;
            PG8_LDA(At, 0, 1); PG8_STAGE(PG8_SA(0, 0), a2, voffA);
            PG8_BAR; PG8_WAIT_L(0); PG8_MMA(1, 0, At, B0); PG8_BAR; PG8_SCHED;
            PG8_STAGE(PG8_SB(0, 1), b2 + hstep, voffB);
            PG8_WAIT_V(6); PG8_BAR; PG8_MMA(1, 1, At, B1); PG8_BAR;
            PG8_LDB(B0, 1, 0); PG8_SCHED; PG8_LDA(At, 1, 0); PG8_STAGE(PG8_SA(0, 1), a2 + hstep, voffA);
            PG8_WAIT_L(8); PG8_BAR; PG8_WAIT_L(0); PG8_MMA(0, 0, At, B0); PG8_BAR; PG8_SCHED;
            PG8_LDB(B1, 1, 1); PG8_STAGE(PG8_SB(1, 0), b3, voffB);
            PG8_BAR; PG8_WAIT_L(0); PG8_MMA(0, 1, At, B1); PG8_BAR;
            PG8_LDA(At, 1, 1); PG8_STAGE(PG8_SA(1, 0), a3, voffA);
            PG8_BAR; PG8_WAIT_L(0); PG8_MMA(1, 0, At, B0); PG8_BAR; PG8_SCHED;
            PG8_STAGE(PG8_SB(1, 1), b3 + hstep, voffB);
            PG8_WAIT_V(6); PG8_BAR; PG8_MMA(1, 1, At, B1); PG8_BAR;
            }
        }
        if constexpr (ALIGN_EPI) { if (wr == 0) PG8_BAR; }
        if constexpr (!Epi::AFTER_DRAIN) { E(acc, cur, wr, wc, fr, fq); S.done(cur); }
        if (!has_next) break;
#pragma unroll
        for (int a = 0; a < 2; ++a)
#pragma unroll
            for (int b = 0; b < 2; ++b)
#pragma unroll
                for (int m = 0; m < 4; ++m)
#pragma unroll
                    for (int n = 0; n < 2; ++n) acc[a][b][m][n] = (f32x4){0.f, 0.f, 0.f, 0.f};
        cur = nxt; cA = nA; cB = nB; ++ui;
        if constexpr (ALIGN_EPI) { if (wr == 1) PG8_BAR; }
    }
    PG8_WAIT_V(0);
    if constexpr (!ALIGN_EPI) { if (wr == 0) PG8_BAR; }
    PG8_BAR;
    if constexpr (Epi::AFTER_DRAIN) { E.fused(acc, cur, wr, wc, fr, fq, lds, wid, lane); S.done(cur); }
#undef PG8_SA
#undef PG8_SB
#undef PG8_STAGE
#undef PG8_LDA
#undef PG8_LDB
#undef PG8_MMA
#undef PG8_WAIT_V
#undef PG8_WAIT_L
#undef PG8_BAR
#undef PG8_SCHED
}
}

namespace pg8 {
struct EpiStoreBf16 {
    static constexpr bool PERM = true, AFTER_DRAIN = false;
    bf16_t* O; int ldc; float s01, s67;
    __device__ __forceinline__ void operator()(const f32x4 (&acc)[2][2][4][2], const Unit& u, int wr, int wc, int fr, int fq) const {
        const int row0 = u.pm * BM + wr * 64 + fr, col0 = u.pn * BM + wc * 32 + 8 * fq;
        const float sc = u.pn < 2 ? s01 : ((u.pn == 6 || u.pn == 7) ? s67 : 1.f);
#pragma unroll
        for (int ai = 0; ai < 2; ++ai)
#pragma unroll
            for (int m = 0; m < 4; ++m) { bf16_t* rowp = O + (size_t)(row0 + ai * HALF + m * 16) * ldc + col0;
#pragma unroll
                for (int bj = 0; bj < 2; ++bj) { const f32x4 v0 = acc[ai][bj][m][0] * sc, v1 = acc[ai][bj][m][1] * sc;
                    u32x4 w; w.x = cvt_pk_bf16(v0[0], v0[1]); w.y = cvt_pk_bf16(v0[2], v0[3]); w.z = cvt_pk_bf16(v1[0], v1[1]); w.w = cvt_pk_bf16(v1[2], v1[3]);
                    *(u32x4*)(rowp + bj * HALF) = w; } }
    }
};
struct EpiStoreF32 {
    static constexpr bool PERM = true, AFTER_DRAIN = false;
    float* C; int ldc;
    __device__ __forceinline__ void operator()(const f32x4 (&acc)[2][2][4][2], const Unit& u, int wr, int wc, int fr, int fq) const {
        const int row0 = u.pm * BM + wr * 64 + fr, col0 = u.pn * BM + wc * 32 + 8 * fq;
#pragma unroll
        for (int ai = 0; ai < 2; ++ai)
#pragma unroll
            for (int m = 0; m < 4; ++m) { float* rowp = C + (size_t)(row0 + ai * HALF + m * 16) * ldc + col0;
#pragma unroll
                for (int bj = 0; bj < 2; ++bj) { *(f32x4*)(rowp + bj * HALF) = acc[ai][bj][m][0]; *(f32x4*)(rowp + bj * HALF + 4) = acc[ai][bj][m][1]; } }
    }
};
}

__device__ __forceinline__ void transpose_item(const float* W, int ldw, int K, int ncols, bf16_t* WT, float* scr, int item, int lane) {
    const int nblk = ncols / 32, kb = item / nblk, nb = item % nblk, k0 = 64 * kb, n0 = 32 * nb;
#pragma unroll 8
    for (int i = 0; i < 32; ++i) { const int kk = 2 * i + (lane >> 5); scr[kk * 33 + (lane & 31)] = W[(size_t)(k0 + kk) * ldw + n0 + (lane & 31)]; }
    asm volatile("s_waitcnt lgkmcnt(0)" ::: "memory");
    const int c = lane & 7;
#pragma unroll
    for (int j = 0; j < 4; ++j) { const int n = (lane >> 3) + 8 * j; const float* s = scr + (8 * c) * 33 + n;
        uint4 o; o.x = pk2(s[0 * 33], s[1 * 33]); o.y = pk2(s[2 * 33], s[3 * 33]); o.z = pk2(s[4 * 33], s[5 * 33]); o.w = pk2(s[6 * 33], s[7 * 33]);
        *(uint4*)(WT + (size_t)(n0 + n) * K + k0 + 8 * c) = o; }
    asm volatile("s_waitcnt lgkmcnt(0)" ::: "memory");
}
__device__ __forceinline__ void cvt_rows_bf16(const Ctx& c, const float* src, bf16_t* dst, size_t n8) {
    for (size_t i = (size_t)c.gwave * 64 + c.lane; i < n8; i += (size_t)c.nwaves * 64) {
        const float4 a = *(const float4*)(src + i * 8), b = *(const float4*)(src + i * 8 + 4);
        uint4 o; o.x = pk2(a.x, a.y); o.y = pk2(a.z, a.w); o.z = pk2(b.x, b.y); o.w = pk2(b.z, b.w);
        *(uint4*)(dst + i * 8) = o;
    }
}

template <int DQ, class BiasF>
__device__ __forceinline__ void causal_softmax_row(const float (&q)[DQ], const bf16_t* kbase, const bf16_t* vbase, int ld, int t, int smax, float scale, BiasF biasf, float (&O)[64]) {
    float m = -INFINITY;
    for (int s = 0; s <= smax; ++s) {
        const bf16_t* kr = kbase + (size_t)s * ld;
        float d = 0.f;
#pragma unroll
        for (int i = 0; i < DQ; ++i) d = fmaf(q[i], bf2f(kr[i]), d);
        const float lg = d * scale + biasf(s);
        m = (s <= t) ? fmaxf(m, lg) : m;
    }
    float l = 0.f;
#pragma unroll
    for (int i = 0; i < 64; ++i) O[i] = 0.f;
    for (int s = 0; s <= smax; ++s) {
        const bf16_t* kr = kbase + (size_t)s * ld;
        const bf16_t* vr = vbase + (size_t)s * ld;
        float d = 0.f;
#pragma unroll
        for (int i = 0; i < DQ; ++i) d = fmaf(q[i], bf2f(kr[i]), d);
        const float lg = d * scale + biasf(s);
        const float p = (s <= t) ? expf(lg - m) : 0.f;
        l += p;
#pragma unroll
        for (int i = 0; i < 64; ++i) O[i] = fmaf(p, bf2f(vr[i]), O[i]);
    }
    const float inv = 1.f / l;
#pragma unroll
    for (int i = 0; i < 64; ++i) O[i] *= inv;
}
__device__ __forceinline__ void store_row64_bf16(bf16_t* orow, const float (&v)[64]) {
#pragma unroll
    for (int i = 0; i < 64; i += 8) { uint4 o; o.x = pk2(v[i], v[i + 1]); o.y = pk2(v[i + 2], v[i + 3]); o.z = pk2(v[i + 4], v[i + 5]); o.w = pk2(v[i + 6], v[i + 7]); *(uint4*)(orow + i) = o; }
}

__device__ __forceinline__ void fg_phase(const Ctx& c, const bf16_t* hin, const float* cd_in, float* fg) {
    for (int t = c.gwave; t < NT; t += c.nwaves) {
        float acc[8];
#pragma unroll
        for (int j = 0; j < 8; ++j) acc[j] = 0.f;
        for (int r = 0; r < 16; ++r) {
            const int d = r * 64 + c.lane;
            const float xv = bf2f(hin[(size_t)t * DM + d]);
            const float4 w0 = *(const float4*)(cd_in + (size_t)d * CD_IN + 3072), w1 = *(const float4*)(cd_in + (size_t)d * CD_IN + 3076);
            acc[0] = fmaf(xv, w0.x, acc[0]); acc[1] = fmaf(xv, w0.y, acc[1]); acc[2] = fmaf(xv, w0.z, acc[2]); acc[3] = fmaf(xv, w0.w, acc[3]);
            acc[4] = fmaf(xv, w1.x, acc[4]); acc[5] = fmaf(xv, w1.y, acc[5]); acc[6] = fmaf(xv, w1.z, acc[6]); acc[7] = fmaf(xv, w1.w, acc[7]);
        }
#pragma unroll
        for (int j = 0; j < 8; ++j) acc[j] = wave_sum(acc[j]);
        if (c.lane == 0) { *(float4*)(fg + (size_t)t * 8) = make_float4(acc[0], acc[1], acc[2], acc[3]); *(float4*)(fg + (size_t)t * 8 + 4) = make_float4(acc[4], acc[5], acc[6], acc[7]); }
    }
}
__device__ __forceinline__ void fscan_naive(const Ctx& c, const float* fg, float* F, const float* bf) {
    for (int task = c.gwave; task < 32; task += c.nwaves) {
        const int b = task >> 3, h = task & 7;
        const int lane = c.lane;
        float v[64]; float tot = 0.f;
#pragma unroll
        for (int i = 0; i < 64; ++i) { const int s = lane * 64 + i; v[i] = log_sigmoid(fg[((size_t)b * SEQ + s) * 8 + h] + bf[h]); tot += v[i]; }
        float incl = tot;
#pragma unroll
        for (int o = 1; o < 64; o <<= 1) { const float n = __shfl_up(incl, o); if (lane >= o) incl += n; }
        float run = incl - tot;
#pragma unroll
        for (int i = 0; i < 64; ++i) { run += v[i]; F[(size_t)task * SEQ + lane * 64 + i] = run; }
    }
}

namespace att {
typedef short bf16x8 __attribute__((ext_vector_type(8)));
typedef short s16x4 __attribute__((ext_vector_type(4)));
typedef float f32x16 __attribute__((ext_vector_type(16)));
typedef float f32x4 __attribute__((ext_vector_type(4)));
typedef short v4i16_t __attribute__((ext_vector_type(4)));
constexpr float LOG2E = 1.4426950408889634f;
constexpr float NEG = -1e30f;
constexpr int KBUF = 0, VBUF = 16384, FBUF = 32768, TBUF = 33792, CNT = 34816;

__device__ __forceinline__ int tile_off(int row, int ch) { return 1024 * (row >> 3) + 512 * (ch >> 2) + 64 * (row & 7) + 16 * ((ch & 3) ^ ((row >> 2) & 3)); }
__device__ __forceinline__ s16x4 vtr(const LAS unsigned char* p) { return __builtin_bit_cast(s16x4, __builtin_amdgcn_ds_read_tr16_b64_v4i16((LAS v4i16_t*)p)); }
typedef float f32x2_t __attribute__((ext_vector_type(2))); typedef __bf16 bf16x2_t __attribute__((ext_vector_type(2)));
__device__ __forceinline__ unsigned cvtpk(float lo, float hi) { f32x2_t v = {lo, hi}; bf16x2_t b = __builtin_convertvector(v, bf16x2_t); return __builtin_bit_cast(unsigned, b); }
__device__ __forceinline__ void pairswap(float v, float& lo, float& hi) {
    unsigned a = __builtin_bit_cast(unsigned, v), b = a;
    asm volatile("s_nop 1\n\tv_permlane32_swap_b32 %0, %1" : "+v"(a), "+v"(b));
    lo = __builtin_bit_cast(float, a); hi = __builtin_bit_cast(float, b);
}
__device__ __forceinline__ float pairmax(float v) { float lo, hi; pairswap(v, lo, hi); return fmaxf(lo, hi); }
__device__ __forceinline__ float pairsum(float v) { float lo, hi; pairswap(v, lo, hi); return lo + hi; }
__device__ __forceinline__ float xhalf(float v, int hh) { float lo, hi; pairswap(v, lo, hi); return hh ? lo : hi; }
__device__ __forceinline__ int key_of(int i, int hh) { return 8 * (i >> 2) + 4 * hh + (i & 3); }

__device__ __forceinline__ bf16x8 pfrag(const f32x16& p, int ks2) {
    unsigned w[4];
#pragma unroll
    for (int j = 0; j < 4; ++j) w[j] = cvtpk(p[8 * ks2 + 2 * j], p[8 * ks2 + 2 * j + 1]);
    typedef unsigned u32x4 __attribute__((ext_vector_type(4)));
    u32x4 v = {w[0], w[1], w[2], w[3]};
    return __builtin_bit_cast(bf16x8, v);
}
__device__ __forceinline__ void pv_block(f32x16 (&O)[2], const LAS unsigned char* vbuf, int kb, const f32x16& p, int lane) {
    const int hh = lane >> 5, q_ = (lane & 15) >> 2, p_ = lane & 3, cg = (lane >> 4) & 1;
#pragma unroll
    for (int ks2 = 0; ks2 < 2; ++ks2) {
        const bf16x8 pb = pfrag(p, ks2);
#pragma unroll
        for (int db = 0; db < 2; ++db) {
            const int c0 = 32 * db + 16 * cg, ch = (c0 >> 3) + (p_ >> 1);
            const int r0 = 32 * kb + 16 * ks2 + 4 * hh;
            const s16x4 a0 = vtr(vbuf + tile_off(r0 + q_, ch) + 8 * (p_ & 1));
            const s16x4 a1 = vtr(vbuf + tile_off(r0 + 8 + q_, ch) + 8 * (p_ & 1));
            const bf16x8 a = {a0[0], a0[1], a0[2], a0[3], a1[0], a1[1], a1[2], a1[3]};
            O[db] = __builtin_amdgcn_mfma_f32_32x32x16_bf16(a, pb, O[db], 0, 0, 0);
        }
    }
}
template <int S0, int NS>
__device__ __forceinline__ f32x16 qk_block(const LAS unsigned char* kbuf, int kb, const bf16x8 (&Qf)[4], int lane) {
    const int r = lane & 31, hh = lane >> 5;
    f32x16 s = {0.f, 0.f, 0.f, 0.f, 0.f, 0.f, 0.f, 0.f, 0.f, 0.f, 0.f, 0.f, 0.f, 0.f, 0.f, 0.f};
#pragma unroll
    for (int ks = S0; ks < S0 + NS; ++ks) {
        const bf16x8 a = *(const LAS bf16x8*)(kbuf + tile_off(32 * kb + r, 2 * ks + hh));
        s = __builtin_amdgcn_mfma_f32_32x32x16_bf16(a, Qf[ks], s, 0, 0, 0);
    }
    return s;
}
__device__ __forceinline__ bool softmax_step(f32x16& x, float& m, float& l, f32x16 (&O)[2]) {
    float mx = x[0];
#pragma unroll
    for (int i = 1; i < 16; ++i) mx = fmaxf(mx, x[i]);
    mx = pairmax(mx);
    if (__all(mx - m < -64.f)) return false;
    const float mn = fmaxf(m, mx);
    if (!__all(mn == m)) {
        const float alpha = __builtin_amdgcn_exp2f(m - mn);
        l *= alpha;
#pragma unroll
        for (int i = 0; i < 16; ++i) { O[0][i] *= alpha; O[1][i] *= alpha; }
        m = mn;
    }
    float ls = 0.f;
#pragma unroll
    for (int i = 0; i < 16; ++i) { x[i] = __builtin_amdgcn_exp2f(x[i] - m); ls += x[i]; }
    l += ls;
    return true;
}
__device__ __forceinline__ void store_ot(bf16_t* orow, const f32x16 (&O)[2], int hh) {
#pragma unroll
    for (int db = 0; db < 2; ++db)
#pragma unroll
        for (int g = 0; g < 4; ++g) {
            const int d0 = 32 * db + 8 * g + 4 * hh;
            *(uint2*)(orow + d0) = make_uint2(cvtpk(O[db][4 * g], O[db][4 * g + 1]), cvtpk(O[db][4 * g + 2], O[db][4 * g + 3]));
        }
}

struct UnitArgs {
    const bf16_t* qkv;
    bf16_t* out;
    int qcol, kcol, vcol, ocol;
};

struct DilArgs { int dil, rho, pat; bf16_t* po; float* pml; };
template <int TYPE>
__device__ __forceinline__ void causal_unit(const UnitArgs& A, int b, int h, int qb, unsigned char* scratch, int tid,
                                            const float* t5  , float lam, const float* subg, const float* F  , const DilArgs DA = DilArgs{1, 0, 0, nullptr, nullptr}) {
    const LAS unsigned char* lds = (const LAS unsigned char*)scratch;
    LAS unsigned char* ldsw = (LAS unsigned char*)scratch;
    const int lane = tid & 63, w = tid >> 6, r = lane & 31, hh = lane >> 5;
    const int q0 = qb * 256 + 32 * w, tq = q0 + r;
    const size_t rowbase = (size_t)b * SEQ;
    const int ktmax = 4 * qb + 3, kdiag = 4 * qb + (w >> 1);
    const int ktmin = (TYPE == 2) ? (4 * qb - 2 > 0 ? 4 * qb - 2 : 0) : 0;
    const int rs = (TYPE == 2) ? DA.dil : 1, r0off = (TYPE == 2) ? DA.rho : 0;
    const int srow = tid >> 3, sch = tid & 7;
    const bf16_t* kg = A.qkv + (rowbase + r0off + (size_t)rs * srow) * QKV_W + A.kcol + h * 64 + sch * 8;
    const bf16_t* vg = A.qkv + (rowbase + r0off + (size_t)rs * srow) * QKV_W + A.vcol + h * 64 + sch * 8;
    const size_t tstep = (size_t)64 * rs * QKV_W;
    const int soff = tile_off(srow, sch);
    bf16x8 Qf[4];
    {
        const bf16_t* qr = A.qkv + (rowbase + r0off + (size_t)rs * tq) * QKV_W + A.qcol + h * 64 + 8 * hh;
#pragma unroll
        for (int s = 0; s < 4; ++s) Qf[s] = *(const bf16x8*)(qr + 16 * s);
    }
    __syncthreads();
    if ((TYPE == 0 || TYPE == 2) && tid < 128) {
        const float far = t5[31 * 8 + h];
        ((LAS float*)(ldsw + TBUF))[tid] = (t5[t5_bucket(tid) * 8 + h] - far) * LOG2E;
    }
    if (TYPE == 1 && tid == 0) *(LAS unsigned*)(ldsw + CNT) = 0u;
    typedef unsigned u32x4 __attribute__((ext_vector_type(4)));
    u32x4 kreg = *(const u32x4*)(kg + (size_t)ktmax * tstep), vreg = *(const u32x4*)(vg + (size_t)ktmax * tstep);
    float freg = 0.f;
    if (TYPE == 3 && tid < 64) freg = F[(size_t)(b * 8 + h) * SEQ + ktmax * 64 + tid] * LOG2E;
    *(LAS u32x4*)(ldsw + KBUF + soff) = kreg; *(LAS u32x4*)(ldsw + VBUF + soff) = vreg;
    if (TYPE == 3 && tid < 64) ((LAS float*)(ldsw + FBUF))[tid] = freg;
    __syncthreads();

    f32x16 O0[2], O1[2];
#pragma unroll
    for (int i = 0; i < 16; ++i) { O0[0][i] = 0.f; O0[1][i] = 0.f; O1[0][i] = 0.f; O1[1][i] = 0.f; }
    float m0 = NEG, l0 = 0.f, m1 = NEG, l1 = 0.f;
    float R = 0.f;
    bool wdone = false;
    float f2t = 0.f;
    if (TYPE == 3) f2t = F[(size_t)(b * 8 + h) * SEQ + tq] * LOG2E;

    for (int kt = ktmax, it = 0; kt >= ktmin; --kt, ++it) {
        const int cur = it & 1;
        if (kt > ktmin) {
            kreg = *(const u32x4*)(kg + (size_t)(kt - 1) * tstep); vreg = *(const u32x4*)(vg + (size_t)(kt - 1) * tstep);
            if (TYPE == 3 && tid < 64) freg = F[(size_t)(b * 8 + h) * SEQ + (kt - 1) * 64 + tid] * LOG2E;
        }
        const LAS unsigned char* kbuf = lds + KBUF + cur * 8192;
        const LAS unsigned char* vbuf = lds + VBUF + cur * 8192;
        if (kt <= kdiag && !wdone) {
#pragma unroll
            for (int kbi = 0; kbi < 2; ++kbi) {
                const int kb = 1 - kbi;
                const int key0 = kt * 64 + kb * 32;
                if (TYPE == 1 ? (key0 >= q0 + 31) : (key0 > q0 + 31)) continue;
                if (TYPE == 2 && key0 + 31 < q0 - 128) continue;
                const bool need_mask = (TYPE == 1) ? (key0 + 31 >= q0) : (key0 + 31 > q0);
                if (TYPE == 0) {
                    f32x16 x0 = qk_block<0, 2>(kbuf, kb, Qf, lane), x1 = qk_block<2, 2>(kbuf, kb, Qf, lane);
                    if (q0 - (key0 + 31) < 113) {
                        const LAS float* tb = (const LAS float*)(lds + TBUF);
#pragma unroll
                        for (int i = 0; i < 16; ++i) {
                            const int dist = tq - (key0 + key_of(i, hh));
                            const float bv = (dist >= 0 && dist < 128) ? tb[dist < 0 ? 0 : (dist > 127 ? 127 : dist)] : 0.f;
                            x0[i] = dist < 0 ? NEG : x0[i] + bv; x1[i] = dist < 0 ? NEG : x1[i] + bv;
                        }
                    }
                    if (softmax_step(x0, m0, l0, O0)) pv_block(O0, vbuf, kb, x0, lane);
                    if (softmax_step(x1, m1, l1, O1)) pv_block(O1, vbuf, kb, x1, lane);
                } else if (TYPE == 2) {
                    f32x16 x = qk_block<0, 4>(kbuf, kb, Qf, lane);
                    const LAS float* tb = (const LAS float*)(lds + TBUF);
#pragma unroll
                    for (int i = 0; i < 16; ++i) {
                        const int dist = tq - (key0 + key_of(i, hh));
                        int bi = dist * rs; bi = bi < 0 ? 0 : (bi > 127 ? 127 : bi);
                        x[i] = (dist >= 0 && dist <= 128) ? x[i] + tb[bi] : NEG;
                    }
                    if (softmax_step(x, m0, l0, O0)) pv_block(O0, vbuf, kb, x, lane);
                } else if (TYPE == 3) {
                    f32x16 x = qk_block<0, 4>(kbuf, kb, Qf, lane);
                    const LAS float* fb = (const LAS float*)(lds + FBUF + cur * 256);
#pragma unroll
                    for (int g = 0; g < 4; ++g) {
                        const f32x4 fv = *(const LAS f32x4*)(fb + 32 * kb + 8 * g + 4 * hh);
#pragma unroll
                        for (int j = 0; j < 4; ++j) x[4 * g + j] += f2t - fv[j];
                    }
                    if (need_mask) {
#pragma unroll
                        for (int i = 0; i < 16; ++i) x[i] = (key0 + key_of(i, hh) > tq) ? NEG : x[i];
                    }
                    if (softmax_step(x, m0, l0, O0)) pv_block(O0, vbuf, kb, x, lane);
                } else {
                    f32x16 z = qk_block<0, 4>(kbuf, kb, Qf, lane);
                    f32x16 lr;
#pragma unroll
                    for (int i = 0; i < 16; ++i) {
                        const float e = __builtin_amdgcn_exp2f(-fabsf(z[i]));
                        float v = -(fmaxf(z[i], 0.f) + __builtin_amdgcn_logf(1.f + e));
                        if (need_mask) v = (key0 + key_of(i, hh) >= tq) ? 0.f : v;
                        lr[i] = v;
                    }
                    float T[4], Tp[4], sfx[16];
#pragma unroll
                    for (int g = 0; g < 4; ++g) {
                        sfx[4 * g + 3] = 0.f; sfx[4 * g + 2] = lr[4 * g + 3]; sfx[4 * g + 1] = sfx[4 * g + 2] + lr[4 * g + 2]; sfx[4 * g] = sfx[4 * g + 1] + lr[4 * g + 1];
                        T[g] = sfx[4 * g] + lr[4 * g];
                        Tp[g] = xhalf(T[g], hh);
                    }
                    float SP[4];
                    SP[3] = 0.f; SP[2] = T[3] + Tp[3]; SP[1] = SP[2] + T[2] + Tp[2]; SP[0] = SP[1] + T[1] + Tp[1];
                    const float tot = SP[0] + T[0] + Tp[0];
                    const float msel = hh == 0 ? 1.f : 0.f;
#pragma unroll
                    for (int g = 0; g < 4; ++g) {
                        const float goff = R + SP[g] + msel * Tp[g];
#pragma unroll
                        for (int j = 0; j < 4; ++j) {
                            const int i = 4 * g + j;
                            float wv = __builtin_amdgcn_exp2f(lr[i] + z[i] + goff + sfx[i]);
                            if (need_mask) wv = (key0 + key_of(i, hh) >= tq) ? 0.f : wv;
                            z[i] = wv;
                        }
                    }
                    R += tot;
                    pv_block(O0, vbuf, kb, z, lane);
                }
            }
            if (TYPE == 1) {
                if (__all(R < -216.4f)) { wdone = true; if (lane == 0) (void)__hip_atomic_fetch_add((LAS unsigned*)(ldsw + CNT), 1u, __ATOMIC_RELAXED, __HIP_MEMORY_SCOPE_WORKGROUP); }
            }
        }
        if (kt > ktmin) {
            *(LAS u32x4*)(ldsw + KBUF + (cur ^ 1) * 8192 + soff) = kreg; *(LAS u32x4*)(ldsw + VBUF + (cur ^ 1) * 8192 + soff) = vreg;
            if (TYPE == 3 && tid < 64) ((LAS float*)(ldsw + FBUF + (cur ^ 1) * 256))[tid] = freg;
        }
        __syncthreads();
        if (TYPE == 1) { const unsigned cnt = *(const LAS unsigned*)(lds + CNT); __syncthreads(); if (cnt == 8u) break; }
    }
    if (TYPE == 2) {
        const size_t prow = ((size_t)DA.pat * NT + rowbase + r0off + (size_t)rs * tq) * 8 + h;
        store_ot(DA.po + prow * 64, O0, hh);
        const float lt = pairsum(l0);
        if (hh == 0) *(float2*)(DA.pml + prow * 2) = make_float2(m0, lt);
        return;
    }
    bf16_t* orow = A.out + (rowbase + tq) * DM + A.ocol + h * 64;
    if (TYPE == 0) {
        const float i0 = 1.f / pairsum(l0), i1 = lam / pairsum(l1);
        float ss = 0.f;
#pragma unroll
        for (int db = 0; db < 2; ++db)
#pragma unroll
            for (int i = 0; i < 16; ++i) { const float o = O0[db][i] * i0 - O1[db][i] * i1; O0[db][i] = o; ss = fmaf(o, o, ss); }
        ss = pairsum(ss);
        const float rn = rsqrtf(ss * (1.f / 64.f) + LN_EPS) * 0.8f;
#pragma unroll
        for (int db = 0; db < 2; ++db)
#pragma unroll
            for (int i = 0; i < 16; ++i) O0[db][i] *= rn * subg[32 * db + key_of(i, hh)];
        store_ot(orow, O0, hh);
    } else if (TYPE == 3) {
        const float i0 = 1.f / pairsum(l0);
#pragma unroll
        for (int db = 0; db < 2; ++db)
#pragma unroll
            for (int i = 0; i < 16; ++i) O0[db][i] *= i0;
        store_ot(orow, O0, hh);
    } else {
        store_ot(orow, O0, hh);
    }
}
}

__device__ __forceinline__ int xcd_perm256(int p) { return (p & 7) * 32 + (p >> 3); }

__device__ __forceinline__ void attn_layer0_mfma(const Ctx& c, const bf16_t* qkv, bf16_t* out, const float* t5, const float* lamv, const float* subg) {
    float s01 = 0.f, s23 = 0.f;
    for (int i = 0; i < 32; ++i) { s01 += lamv[i] * lamv[32 + i]; s23 += lamv[64 + i] * lamv[96 + i]; }
    const float lam = expf(s01) - expf(s23) + 0.2f;
    unsigned char* scratch = (unsigned char*)c.lds;
    const att::UnitArgs UA{qkv, out, 0, 512, 1024, 0}, UB{qkv, out, 1536, 2048, 2560, 512};
    for (int p = c.bid; p < 256; p += c.nblk) {
        const int pp = xcd_perm256(p), bh = pp >> 3, qb = pp & 7;
        att::causal_unit<0>(UA, bh >> 3, bh & 7, 15 - qb, scratch, c.tid, t5, lam, subg, nullptr);
        att::causal_unit<0>(UA, bh >> 3, bh & 7, qb, scratch, c.tid, t5, lam, subg, nullptr);
#pragma unroll 1
        for (int k = 0; k < 2; ++k) {
            const int u = pp * 2 + k, bh2 = u >> 4, qb2 = u & 15;
            att::causal_unit<1>(UB, bh2 >> 3, bh2 & 7, qb2, scratch, c.tid, nullptr, 0.f, nullptr, nullptr);
        }
    }
}
__device__ __forceinline__ void attn_dilated_mfma(const Ctx& c, const bf16_t* qkv, const float* t5, bf16_t* po, float* pml) {
    unsigned char* scratch = (unsigned char*)c.lds;
    const att::UnitArgs UC{qkv, nullptr, 0, 512, 1024, 0};
    for (int p = c.bid; p < 256; p += c.nblk) {
        const int pp = xcd_perm256(p);
#pragma unroll 1
        for (int k = 0; k < 6; ++k) {
            const int u = pp * 6 + k, bh = u / 48, v = u % 48;
            int pat, rho, qb, dil;
            if (v < 16) { pat = 0; dil = 1; rho = 0; qb = v; }
            else if (v < 32) { pat = 1; dil = 4; rho = (v - 16) >> 2; qb = (v - 16) & 3; }
            else { pat = 2; dil = 16; rho = v - 32; qb = 0; }
            att::causal_unit<2>(UC, bh >> 3, bh & 7, qb, scratch, c.tid, t5, 0.f, nullptr, nullptr, att::DilArgs{dil, rho, pat, po, pml});
        }
    }
}
__device__ __forceinline__ void dilated_combine(const Ctx& c, const bf16_t* po, const float* pml, bf16_t* out) {
    const size_t n = (size_t)NT * 8 * 8;
    for (size_t i = (size_t)c.gwave * 64 + c.lane; i < n; i += (size_t)c.nwaves * 64) {
        const size_t th = i >> 3; const int ch = (int)(i & 7);
        float m[3], l[3];
#pragma unroll
        for (int p = 0; p < 3; ++p) { const float2 ml = *(const float2*)(pml + ((size_t)p * NT * 8 + th) * 2); m[p] = ml.x; l[p] = ml.y; }
        const float mm = fmaxf(m[0], fmaxf(m[1], m[2]));
        float wgt[3], den = 0.f;
#pragma unroll
        for (int p = 0; p < 3; ++p) { wgt[p] = __builtin_amdgcn_exp2f(m[p] - mm); den += wgt[p] * l[p]; }
        const float inv = 1.f / den;
        float o[8];
#pragma unroll
        for (int d = 0; d < 8; ++d) o[d] = 0.f;
#pragma unroll
        for (int p = 0; p < 3; ++p) {
            const uint4 v = *(const uint4*)(po + ((size_t)p * NT * 8 + th) * 64 + ch * 8);
            const unsigned w4[4] = {v.x, v.y, v.z, v.w};
#pragma unroll
            for (int q = 0; q < 4; ++q) { o[2 * q] = fmaf(wgt[p], __builtin_bit_cast(float, w4[q] << 16), o[2 * q]); o[2 * q + 1] = fmaf(wgt[p], __builtin_bit_cast(float, w4[q] & 0xffff0000u), o[2 * q + 1]); }
        }
        uint4 ov; ov.x = pk2(o[0] * inv, o[1] * inv); ov.y = pk2(o[2] * inv, o[3] * inv); ov.z = pk2(o[4] * inv, o[5] * inv); ov.w = pk2(o[6] * inv, o[7] * inv);
        const size_t tok = th >> 3; const int hd = (int)(th & 7);
        *(uint4*)(out + tok * DM + hd * 64 + ch * 8) = ov;
    }
}
__device__ __forceinline__ void attn_fox_mfma(const Ctx& c, const bf16_t* qkv, const float* F, bf16_t* out) {
    unsigned char* scratch = (unsigned char*)c.lds;
    const att::UnitArgs UD{qkv, out, 1536, 2048, 2560, 512};
    for (int p = c.bid; p < 256; p += c.nblk) {
        const int pp = xcd_perm256(p), bh = pp >> 3, qb = pp & 7;
        att::causal_unit<3>(UD, bh >> 3, bh & 7, 15 - qb, scratch, c.tid, nullptr, 0.f, nullptr, F);
        att::causal_unit<3>(UD, bh >> 3, bh & 7, qb, scratch, c.tid, nullptr, 0.f, nullptr, F);
    }
}

__device__ __forceinline__ void ln_rows(const Ctx& c, const float* hin32, const bf16_t* hin16, const float* add, const float* g, const float* bta, float* out, bf16_t* outb, unsigned char* out8 = nullptr, float* oscale = nullptr) {
    for (int t = c.gwave; t < NT; t += c.nwaves) {
        float v[16];
        float s = 0.f;
#pragma unroll
        for (int r = 0; r < 4; ++r) {
            const int d = r * 256 + c.lane * 4;
            float4 a;
            if (hin32) a = *(const float4*)(hin32 + (size_t)t * DM + d);
            else { const uint2 w = *(const uint2*)(hin16 + (size_t)t * DM + d); a = make_float4(__builtin_bit_cast(float, w.x << 16), __builtin_bit_cast(float, w.x & 0xffff0000u), __builtin_bit_cast(float, w.y << 16), __builtin_bit_cast(float, w.y & 0xffff0000u)); }
            const float4 m = *(const float4*)(add + (size_t)t * DM + d);
            v[r * 4 + 0] = DN_ALPHA * a.x + m.x; v[r * 4 + 1] = DN_ALPHA * a.y + m.y; v[r * 4 + 2] = DN_ALPHA * a.z + m.z; v[r * 4 + 3] = DN_ALPHA * a.w + m.w;
            s += v[r * 4] + v[r * 4 + 1] + v[r * 4 + 2] + v[r * 4 + 3];
        }
        const float mu = wave_sum(s) * (1.f / DM);
        float q = 0.f;
#pragma unroll
        for (int i = 0; i < 16; ++i) { v[i] -= mu; q = fmaf(v[i], v[i], q); }
        const float rs = rsqrtf(wave_sum(q) * (1.f / DM) + LN_EPS);
        float amax = 0.f;
#pragma unroll
        for (int r = 0; r < 4; ++r) {
            const int d = r * 256 + c.lane * 4;
            const float4 gg = *(const float4*)(g + d), bb = *(const float4*)(bta + d);
            const float4 o = make_float4(v[r * 4] * rs * gg.x + bb.x, v[r * 4 + 1] * rs * gg.y + bb.y, v[r * 4 + 2] * rs * gg.z + bb.z, v[r * 4 + 3] * rs * gg.w + bb.w);
            if (out) *(float4*)(out + (size_t)t * DM + d) = o;
            if (outb) *(uint2*)(outb + (size_t)t * DM + d) = make_uint2(pk2(o.x, o.y), pk2(o.z, o.w));
            v[r * 4] = o.x; v[r * 4 + 1] = o.y; v[r * 4 + 2] = o.z; v[r * 4 + 3] = o.w;
            amax = fmaxf(amax, fmaxf(fmaxf(fabsf(o.x), fabsf(o.y)), fmaxf(fabsf(o.z), fabsf(o.w))));
        }
        if (out8) {
#pragma unroll
            for (int o = 32; o >= 1; o >>= 1) amax = fmaxf(amax, __shfl_xor(amax, o));
            int e = (int)((__builtin_bit_cast(unsigned, amax) >> 23) & 0xffu) - 127;
            e = e < -100 ? -100 : (e > 100 ? 100 : e);
            const float sc = __builtin_bit_cast(float, (unsigned)(127 + 7 - e) << 23);
#pragma unroll
            for (int r = 0; r < 4; ++r) {
                int w = 0;
                w = __builtin_amdgcn_cvt_pk_fp8_f32(v[r * 4] * sc, v[r * 4 + 1] * sc, w, false); w = __builtin_amdgcn_cvt_pk_fp8_f32(v[r * 4 + 2] * sc, v[r * 4 + 3] * sc, w, true);
                *(int*)(out8 + (size_t)t * DM + r * 256 + c.lane * 4) = w;
            }
            if (c.lane == 0) oscale[t] = __builtin_bit_cast(float, (unsigned)(127 - 7 + e) << 23);
        }
    }
}

__device__ __forceinline__ void topk_insert(float (&tv)[16], int (&ti)[16], float v, int id) {
#pragma unroll
    for (int j = 15; j >= 1; --j) {
        const bool g = v > tv[j], gp = v > tv[j - 1];
        tv[j] = g ? (gp ? tv[j - 1] : v) : tv[j];
        ti[j] = g ? (gp ? ti[j - 1] : id) : ti[j];
    }
    const bool g0 = v > tv[0];
    tv[0] = g0 ? v : tv[0]; ti[0] = g0 ? id : ti[0];
}

namespace rt {
typedef short bf16x8 __attribute__((ext_vector_type(8)));
typedef float f32x16 __attribute__((ext_vector_type(16)));
__device__ __forceinline__ void ins_packed(float (&tv)[16], float v) {
#pragma unroll
    for (int j = 15; j >= 1; --j) { const bool g = v > tv[j], gp = v > tv[j - 1]; tv[j] = g ? (gp ? tv[j - 1] : v) : tv[j]; }
    tv[0] = v > tv[0] ? v : tv[0];
}
__device__ __forceinline__ float pk_idx(float v, int idx) { return __builtin_bit_cast(float, (__builtin_bit_cast(unsigned, v) & ~127u) | (unsigned)idx); }
__device__ __forceinline__ float pk_val(float p) { return __builtin_bit_cast(float, __builtin_bit_cast(unsigned, p) & ~127u); }
__device__ __forceinline__ int pk_id(float p) { return (int)(__builtin_bit_cast(unsigned, p) & 127u); }

__device__ __forceinline__ void top16_of_set(float (&tv)[16], const bf16_t* pq_row  , const bf16_t* keys  , int r, int hh) {
    bf16x8 B[8];
#pragma unroll
    for (int s = 0; s < 8; ++s) B[s] = *(const bf16x8*)(pq_row + 16 * s);
#pragma unroll
    for (int j = 0; j < 16; ++j) tv[j] = -INFINITY;
#pragma unroll 1
    for (int blk = 0; blk < 4; ++blk) {
        const bf16_t* kr = keys + (size_t)(32 * blk + r) * 128 + 8 * hh;
        f32x16 acc = {0.f, 0.f, 0.f, 0.f, 0.f, 0.f, 0.f, 0.f, 0.f, 0.f, 0.f, 0.f, 0.f, 0.f, 0.f, 0.f};
#pragma unroll
        for (int s = 0; s < 8; ++s) acc = __builtin_amdgcn_mfma_f32_32x32x16_bf16(*(const bf16x8*)(kr + 16 * s), B[s], acc, 0, 0, 0);
#pragma unroll
        for (int i = 0; i < 16; ++i) ins_packed(tv, pk_idx(acc[i], 32 * blk + 8 * (i >> 2) + 4 * hh + (i & 3)));
    }
    float pt[16];
#pragma unroll
    for (int j = 0; j < 16; ++j) pt[j] = __shfl_xor(tv[j], 32);
#pragma unroll
    for (int j = 0; j < 16; ++j) ins_packed(tv, pt[j]);
}
}

__device__ __forceinline__ void peer_route_phase(const Ctx& c, const bf16_t* pq, const bf16_t* subk  , int* eidx, float* gate) {
    const int lane = c.lane, r = lane & 31, hh = lane >> 5;
    for (int task = c.gwave; task < (NT / 32) * 8; task += c.nwaves) {
        const int h = task & 7, t = (task >> 3) * 32 + r;
        float la[16], lb[16];
        rt::top16_of_set(la, pq + (size_t)t * PEER_QW + (2 * h) * 128 + 8 * hh, subk + (size_t)(2 * h) * 128 * 128, r, hh);
        rt::top16_of_set(lb, pq + (size_t)t * PEER_QW + (2 * h + 1) * 128 + 8 * hh, subk + (size_t)(2 * h + 1) * 128 * 128, r, hh);
        float tv[16]; int ti[16];
#pragma unroll
        for (int j = 0; j < 16; ++j) { tv[j] = -INFINITY; ti[j] = 0; }
#pragma unroll
        for (int i = 0; i < 16; ++i) {
            const float av = rt::pk_val(la[i]); const int ai = rt::pk_id(la[i]) * 128;
#pragma unroll
            for (int j = 0; j < 16 / (i + 1); ++j) topk_insert(tv, ti, av + rt::pk_val(lb[j]), ai + rt::pk_id(lb[j]));
        }
        float sum = 0.f, e[16];
#pragma unroll
        for (int j = 0; j < 16; ++j) { e[j] = expf(tv[j] - tv[0]); sum += e[j]; }
        const float inv = 1.f / sum;
        if (hh == 0) {
            int* oi = eidx + ((size_t)t * 8 + h) * 16; float* og = gate + ((size_t)t * 8 + h) * 16;
#pragma unroll
            for (int j = 0; j < 16; j += 4) {
                *(int4*)(oi + j) = make_int4(ti[j], ti[j + 1], ti[j + 2], ti[j + 3]);
                *(float4*)(og + j) = make_float4(e[j] * inv, e[j + 1] * inv, e[j + 2] * inv, e[j + 3] * inv);
            }
        }
    }
}

typedef unsigned u32x4_t __attribute__((ext_vector_type(4)));
typedef float f32x2_t __attribute__((ext_vector_type(2)));
#define GAS __attribute__((address_space(1)))
__device__ __forceinline__ float gelu_exact(float d) { return 0.5f * d * (1.f + erff(d * 0.70710678118654752f)); }

template <int MODE>
__device__ __forceinline__ void cvt_rows_fp8(const Ctx& c, const float* src, unsigned char* dst, float* rowscale, int nrows) {
    for (int row = c.gwave; row < nrows; row += c.nwaves) {
        const float* s = src + (size_t)row * DM + c.lane * 16;
        const float4 a0 = *(const float4*)s, a1 = *(const float4*)(s + 4), a2 = *(const float4*)(s + 8), a3 = *(const float4*)(s + 12);
        float am = fmaxf(fmaxf(fmaxf(fabsf(a0.x), fabsf(a0.y)), fmaxf(fabsf(a0.z), fabsf(a0.w))), fmaxf(fmaxf(fabsf(a1.x), fabsf(a1.y)), fmaxf(fabsf(a1.z), fabsf(a1.w))));
        am = fmaxf(am, fmaxf(fmaxf(fmaxf(fabsf(a2.x), fabsf(a2.y)), fmaxf(fabsf(a2.z), fabsf(a2.w))), fmaxf(fmaxf(fabsf(a3.x), fabsf(a3.y)), fmaxf(fabsf(a3.z), fabsf(a3.w)))));
#pragma unroll
        for (int o = 32; o >= 1; o >>= 1) am = fmaxf(am, __shfl_xor(am, o));
        int e = (int)((__builtin_bit_cast(unsigned, am) >> 23) & 0xffu) - 127;
        e = e < -100 ? -100 : (e > 100 ? 100 : e);
        const float sc = __builtin_bit_cast(float, (unsigned)(127 + 7 - e) << 23), inv = __builtin_bit_cast(float, (unsigned)(127 - 7 + e) << 23);
        int w0 = 0, w1 = 0, w2 = 0, w3 = 0;
        w0 = __builtin_amdgcn_cvt_pk_fp8_f32(a0.x * sc, a0.y * sc, w0, false); w0 = __builtin_amdgcn_cvt_pk_fp8_f32(a0.z * sc, a0.w * sc, w0, true);
        w1 = __builtin_amdgcn_cvt_pk_fp8_f32(a1.x * sc, a1.y * sc, w1, false); w1 = __builtin_amdgcn_cvt_pk_fp8_f32(a1.z * sc, a1.w * sc, w1, true);
        w2 = __builtin_amdgcn_cvt_pk_fp8_f32(a2.x * sc, a2.y * sc, w2, false); w2 = __builtin_amdgcn_cvt_pk_fp8_f32(a2.z * sc, a2.w * sc, w2, true);
        w3 = __builtin_amdgcn_cvt_pk_fp8_f32(a3.x * sc, a3.y * sc, w3, false); w3 = __builtin_amdgcn_cvt_pk_fp8_f32(a3.z * sc, a3.w * sc, w3, true);
        const int lyr = row >> 14, er = row & 16383;
        unsigned char* dp = MODE == 0 ? dst + ((size_t)lyr * 16384 + (size_t)(er & 7) * 2048 + (er >> 3)) * DM + c.lane * 16
                                      : dst + (size_t)lyr * 16384 * DM + (size_t)(c.lane >> 3) * (16384 * 128) + (size_t)er * 128 + (c.lane & 7) * 16;
        *(uint4*)dp = make_uint4((unsigned)w0, (unsigned)w1, (unsigned)w2, (unsigned)w3);
        if (c.lane == 0) rowscale[row] = inv;
    }
}
__device__ __forceinline__ float dot16_fp8(const u32x4_t w, const float (&x)[16], float acc) {
    const int w0 = (int)w.x, w1 = (int)w.y, w2 = (int)w.z, w3 = (int)w.w;
    f32x2_t p;
    p = __builtin_amdgcn_cvt_pk_f32_fp8(w0, false); acc = fmaf(p.x, x[0], acc); acc = fmaf(p.y, x[1], acc);
    p = __builtin_amdgcn_cvt_pk_f32_fp8(w0, true);  acc = fmaf(p.x, x[2], acc); acc = fmaf(p.y, x[3], acc);
    p = __builtin_amdgcn_cvt_pk_f32_fp8(w1, false); acc = fmaf(p.x, x[4], acc); acc = fmaf(p.y, x[5], acc);
    p = __builtin_amdgcn_cvt_pk_f32_fp8(w1, true);  acc = fmaf(p.x, x[6], acc); acc = fmaf(p.y, x[7], acc);
    p = __builtin_amdgcn_cvt_pk_f32_fp8(w2, false); acc = fmaf(p.x, x[8], acc); acc = fmaf(p.y, x[9], acc);
    p = __builtin_amdgcn_cvt_pk_f32_fp8(w2, true);  acc = fmaf(p.x, x[10], acc); acc = fmaf(p.y, x[11], acc);
    p = __builtin_amdgcn_cvt_pk_f32_fp8(w3, false); acc = fmaf(p.x, x[12], acc); acc = fmaf(p.y, x[13], acc);
    p = __builtin_amdgcn_cvt_pk_f32_fp8(w3, true);  acc = fmaf(p.x, x[14], acc); acc = fmaf(p.y, x[15], acc);
    return acc;
}
__device__ __forceinline__ void axpy16_fp8(const u32x4_t w, float cv, float (&acc)[16]) {
    const int w0 = (int)w.x, w1 = (int)w.y, w2 = (int)w.z, w3 = (int)w.w;
    f32x2_t p;
    p = __builtin_amdgcn_cvt_pk_f32_fp8(w0, false); acc[0] = fmaf(cv, p.x, acc[0]); acc[1] = fmaf(cv, p.y, acc[1]);
    p = __builtin_amdgcn_cvt_pk_f32_fp8(w0, true);  acc[2] = fmaf(cv, p.x, acc[2]); acc[3] = fmaf(cv, p.y, acc[3]);
    p = __builtin_amdgcn_cvt_pk_f32_fp8(w1, false); acc[4] = fmaf(cv, p.x, acc[4]); acc[5] = fmaf(cv, p.y, acc[5]);
    p = __builtin_amdgcn_cvt_pk_f32_fp8(w1, true);  acc[6] = fmaf(cv, p.x, acc[6]); acc[7] = fmaf(cv, p.y, acc[7]);
    p = __builtin_amdgcn_cvt_pk_f32_fp8(w2, false); acc[8] = fmaf(cv, p.x, acc[8]); acc[9] = fmaf(cv, p.y, acc[9]);
    p = __builtin_amdgcn_cvt_pk_f32_fp8(w2, true);  acc[10] = fmaf(cv, p.x, acc[10]); acc[11] = fmaf(cv, p.y, acc[11]);
    p = __builtin_amdgcn_cvt_pk_f32_fp8(w3, false); acc[12] = fmaf(cv, p.x, acc[12]); acc[13] = fmaf(cv, p.y, acc[13]);
    p = __builtin_amdgcn_cvt_pk_f32_fp8(w3, true);  acc[14] = fmaf(cv, p.x, acc[14]); acc[15] = fmaf(cv, p.y, acc[15]);
}

__device__ __forceinline__ void peer_u_phase(const Ctx& c, const bf16_t* h1b_, const int* eidx_, const unsigned char* U8_, float* P) {
    const GAS bf16_t* h1b = (const GAS bf16_t*)h1b_; const GAS int* eidx = (const GAS int*)eidx_; const GAS unsigned char* U8 = (const GAS unsigned char*)U8_;
    const int lane = c.lane, sg = lane >> 3, part = lane & 7;
    typedef int i32x4_t __attribute__((ext_vector_type(4)));
    typedef float f32x4_t __attribute__((ext_vector_type(4)));
    for (int vb = c.bid; vb < 256; vb += c.nblk) {
        const int j = vb & 7, rnk = vb >> 3;
        const int t0 = rnk * 512 + c.wave * 64;
        i32x4_t e[4];
        u32x4_t rA[8], rB[8];
#pragma unroll
        for (int q = 0; q < 4; ++q) e[q] = *(const GAS i32x4_t*)(eidx + (size_t)t0 * 128 + sg * 16 + 4 * q);
        const GAS unsigned char* ubase = U8 + (size_t)j * (16384 * 128) + part * 16;
        const GAS bf16_t* xbase = h1b + 128 * j + part * 16;
#pragma unroll
        for (int it = 0; it < 8; ++it) rA[it] = *(const GAS u32x4_t*)(ubase + (size_t)e[it >> 2][it & 3] * 128);
        u32x4_t xa = *(const GAS u32x4_t*)(xbase + (size_t)t0 * DM), xb = *(const GAS u32x4_t*)(xbase + (size_t)t0 * DM + 8);
#pragma unroll 1
        for (int i = 0; i < 64; ++i) {
            const int t = t0 + i, tn = t0 + (i < 63 ? i + 1 : 63);
#pragma unroll
            for (int it = 0; it < 8; ++it) rB[it] = *(const GAS u32x4_t*)(ubase + (size_t)e[2 + (it >> 2)][it & 3] * 128);
#pragma unroll
            for (int q = 0; q < 4; ++q) e[q] = *(const GAS i32x4_t*)(eidx + (size_t)tn * 128 + sg * 16 + 4 * q);
            float x[16];
            {
                const unsigned w[8] = {xa.x, xa.y, xa.z, xa.w, xb.x, xb.y, xb.z, xb.w};
#pragma unroll
                for (int z = 0; z < 8; ++z) { x[2 * z] = __builtin_bit_cast(float, w[z] << 16); x[2 * z + 1] = __builtin_bit_cast(float, w[z] & 0xffff0000u); }
            }
            xa = *(const GAS u32x4_t*)(xbase + (size_t)tn * DM); xb = *(const GAS u32x4_t*)(xbase + (size_t)tn * DM + 8);
            float dsum[16];
#pragma unroll
            for (int it = 0; it < 8; ++it) dsum[it] = dot16_fp8(rA[it], x, 0.f);
#pragma unroll
            for (int it = 0; it < 8; ++it) rA[it] = *(const GAS u32x4_t*)(ubase + (size_t)e[it >> 2][it & 3] * 128);
#pragma unroll
            for (int it = 0; it < 8; ++it) dsum[8 + it] = dot16_fp8(rB[it], x, 0.f);
            float d8[8], d4[4], d2[2];
            { const bool hb = (part & 4) != 0;
#pragma unroll
              for (int z = 0; z < 8; ++z) d8[z] = (hb ? dsum[8 + z] : dsum[z]) + __shfl_xor(hb ? dsum[z] : dsum[8 + z], 4); }
            { const bool hb = (part & 2) != 0;
#pragma unroll
              for (int z = 0; z < 4; ++z) d4[z] = (hb ? d8[4 + z] : d8[z]) + __shfl_xor(hb ? d8[z] : d8[4 + z], 2); }
            { const bool hb = (part & 1) != 0;
#pragma unroll
              for (int z = 0; z < 2; ++z) d2[z] = (hb ? d4[2 + z] : d4[z]) + __shfl_xor(hb ? d4[z] : d4[2 + z], 1); }
            *(float2*)(P + ((size_t)j * NT + t) * 128 + sg * 16 + 2 * part) = make_float2(d2[0], d2[1]);
        }
    }
}
__device__ __forceinline__ void peer_coef_phase(const Ctx& c, const float* P_, const int* eidx_, const float* gate_, const float* rsu_, const float* rsv_, float* coef) {
    const GAS float* P = (const GAS float*)P_; const GAS int* eidx = (const GAS int*)eidx_; const GAS float* gate = (const GAS float*)gate_;
    const GAS float* rsu = (const GAS float*)rsu_; const GAS float* rsv = (const GAS float*)rsv_;
    typedef int i32x4_t __attribute__((ext_vector_type(4)));
    typedef float f32x4_t __attribute__((ext_vector_type(4)));
    const size_t n4 = (size_t)NT * 128 / 4;
    for (size_t i = (size_t)c.gwave * 64 + c.lane; i < n4; i += (size_t)c.nwaves * 64) {
        f32x4_t s = *(const GAS f32x4_t*)(P + i * 4);
#pragma unroll
        for (int j = 1; j < 8; ++j) s += *(const GAS f32x4_t*)(P + (size_t)j * NT * 128 + i * 4);
        const i32x4_t e = *(const GAS i32x4_t*)(eidx + i * 4);
        const f32x4_t g = *(const GAS f32x4_t*)(gate + i * 4);
        f32x4_t o;
#pragma unroll
        for (int q = 0; q < 4; ++q) o[q] = g[q] * gelu_exact(s[q] * rsu[e[q]]) * rsv[e[q]];
        *(f32x4_t*)(coef + i * 4) = o;
    }
}

__device__ __forceinline__ void peer_v_phase(const Ctx& c, const int* eidx_, const float* coef_, const unsigned char* V8_, float* Y) {
    const GAS int* eidx = (const GAS int*)eidx_; const GAS float* coef = (const GAS float*)coef_; const GAS unsigned char* V8 = (const GAS unsigned char*)V8_;
    const int lane = c.lane, sg = lane >> 3, part = lane & 7;
    typedef int i32x4_t __attribute__((ext_vector_type(4)));
    typedef float f32x4_t __attribute__((ext_vector_type(4)));
    for (int vb = c.bid; vb < 256; vb += c.nblk) {
        const int j = vb & 7, rnk = vb >> 3;
        const int dcol = 128 * j + part * 16;
        const GAS unsigned char* vbase = V8 + (size_t)j * (16384 * 128) + part * 16;
        const int t0 = rnk * 512 + c.wave * 64;
        i32x4_t e[4], en[4]; f32x4_t cf[4], cn[4];
        u32x4_t rA[8], rB[8];
#pragma unroll
        for (int q = 0; q < 4; ++q) { e[q] = *(const GAS i32x4_t*)(eidx + (size_t)t0 * 128 + sg * 16 + 4 * q); cf[q] = *(const GAS f32x4_t*)(coef + (size_t)t0 * 128 + sg * 16 + 4 * q); }
#pragma unroll
        for (int it = 0; it < 8; ++it) rA[it] = *(const GAS u32x4_t*)(vbase + (size_t)e[it >> 2][it & 3] * 128);
#pragma unroll 1
        for (int i = 0; i < 64; ++i) {
            const int t = t0 + i, tn = t0 + (i < 63 ? i + 1 : 63);
#pragma unroll
            for (int it = 0; it < 8; ++it) rB[it] = *(const GAS u32x4_t*)(vbase + (size_t)e[2 + (it >> 2)][it & 3] * 128);
#pragma unroll
            for (int q = 0; q < 4; ++q) { en[q] = *(const GAS i32x4_t*)(eidx + (size_t)tn * 128 + sg * 16 + 4 * q); cn[q] = *(const GAS f32x4_t*)(coef + (size_t)tn * 128 + sg * 16 + 4 * q); }
            float acc[16];
#pragma unroll
            for (int d_ = 0; d_ < 16; ++d_) acc[d_] = 0.f;
#pragma unroll
            for (int it = 0; it < 8; ++it) axpy16_fp8(rA[it], cf[it >> 2][it & 3], acc);
#pragma unroll
            for (int it = 0; it < 8; ++it) rA[it] = *(const GAS u32x4_t*)(vbase + (size_t)en[it >> 2][it & 3] * 128);
#pragma unroll
            for (int it = 0; it < 8; ++it) axpy16_fp8(rB[it], cf[2 + (it >> 2)][it & 3], acc);
#pragma unroll
            for (int d_ = 0; d_ < 16; ++d_) { acc[d_] += __shfl_xor(acc[d_], 8); acc[d_] += __shfl_xor(acc[d_], 16); acc[d_] += __shfl_xor(acc[d_], 32); }
            if (lane < 8) {
                float* yp = Y + (size_t)t * DM + dcol;
#pragma unroll
                for (int q = 0; q < 4; ++q) *(f32x4_t*)(yp + 4 * q) = (f32x4_t){acc[4 * q], acc[4 * q + 1], acc[4 * q + 2], acc[4 * q + 3]};
            }
#pragma unroll
            for (int q = 0; q < 4; ++q) { e[q] = en[q]; cf[q] = cn[q]; }
        }
    }
}
__device__ __forceinline__ void prologue_phase(const Ctx& c, const float* x, const float* ab_in, const float* ab_out, const float* cd_in, const float* cd_out, const float* wq, const float* pu, const float* pv, const float* sk, unsigned char* ws) {
    float* scr = c.lds + c.wave * 4096;
    constexpr int I_IN = 16 * 96, I_OUT = 16 * 32, I_WQ = 16 * 64;
    constexpr int NITEMS = 2 * I_IN + 2 * I_OUT + 2 * I_WQ;
    for (int it = c.gwave; it < NITEMS; it += c.nwaves) {
        int r = it;
        if (r < I_IN) { transpose_item(ab_in, QKV_W, DM, QKV_W, (bf16_t*)(ws + WT_ABIN), scr, r, c.lane); continue; } r -= I_IN;
        if (r < I_IN) { transpose_item(cd_in, CD_IN, DM, QKV_W, (bf16_t*)(ws + WT_CDIN), scr, r, c.lane); continue; } r -= I_IN;
        if (r < I_OUT) { transpose_item(ab_out, DM, DM, DM, (bf16_t*)(ws + WT_ABOUT), scr, r, c.lane); continue; } r -= I_OUT;
        if (r < I_OUT) { transpose_item(cd_out, DM, DM, DM, (bf16_t*)(ws + WT_CDOUT), scr, r, c.lane); continue; } r -= I_OUT;
        if (r < I_WQ) { transpose_item(wq, PEER_QW, DM, PEER_QW, (bf16_t*)(ws + WT_WQ), scr, r, c.lane); continue; } r -= I_WQ;
        transpose_item(wq + (size_t)DM * PEER_QW, PEER_QW, DM, PEER_QW, (bf16_t*)(ws + WT_WQ + 4 * MiB), scr, r, c.lane);
    }
    cvt_rows_bf16(c, x, (bf16_t*)(ws + WS_ACTIN), (size_t)NT * DM / 8);
    cvt_rows_fp8<1>(c, pu, ws + WS_U8, (float*)(ws + WS_RS), 2 * 16384);
    cvt_rows_fp8<1>(c, pv, ws + WS_V8, (float*)(ws + WS_RS) + 2 * 16384, 2 * 16384);
    cvt_rows_bf16(c, sk, (bf16_t*)(ws + WS_SKB), (size_t)2 * 16 * 128 * 128 / 8);
}

constexpr int NPHASE = 1 + 2 * 12;
__global__ void __launch_bounds__(NTHREADS, 2) fwd(Args args) {
    unsigned* ctl = (unsigned*)(args.ws + WS_CTL);
    volatile LAS unsigned* xbw = (volatile LAS unsigned*)(dyn_lds + MISC_OFF);
    if (threadIdx.x == 0) { xbw[0] = 0u; xbw[1] = 0u; xbw[2] = 0u; xbw[3] = 0u; }
    __syncthreads();
    const int lo = args.ph_lo, hi = args.ph_hi;
    XcdBarrier bar = xcd_barrier_post(ctl + 4096, xbw);
#define IN(k) (lo <= (k) && (k) < hi)
#define SEAM(k) do { if (IN(k) && IN((k) + 1)) xcd_barrier(bar); } while (0)
#define LAUNDER(ptr) ptr = launder_ptr(ptr)
#define PIN(k) ((const float*)launder_ptr((unsigned char*)args.in[k]))
#define GEMM_LDS ((PG8_LAS unsigned char*)dyn_lds + RING_OFF)
    if (IN(0)) { unsigned char* ws = args.ws; LAUNDER(ws); const Ctx c = make_ctx(bar.wave_s); prologue_phase(c, PIN(0), PIN(2), PIN(5), PIN(6), PIN(8), PIN(9), PIN(11), PIN(12), PIN(10), ws); }
    SEAM(0);
#pragma unroll 1
    for (int layer = 0; layer < 2; ++layer) {
        const int pb = 1 + layer * 12;
        if (IN(pb + 0)) {
            unsigned char* ws = args.ws; LAUNDER(ws); const Ctx c = make_ctx(bar.wave_s);
            pg8::Gemm g{(const bf16_t*)(ws + WS_ACTIN), (const bf16_t*)(ws + (layer == 0 ? WT_ABIN : WT_CDIN)), NT, QKV_W, DM};
            pg8::StaticOrder S; S.init(NT, QKV_W, c.nblk, c.bid);
            pg8::EpiStoreBf16 E{(bf16_t*)(ws + WS_QKV), QKV_W, (layer == 0 ? 0.17677669529663687f : 0.125f) * 1.4426950408889634f, 0.125f * 1.4426950408889634f};
            pg8::gemm_phase<pg8::EpiStoreBf16, pg8::StaticOrder, true, true>(GEMM_LDS, g, S, E);
            if (layer == 1) fg_phase(c, (const bf16_t*)(ws + WS_ACTIN), PIN(6), (float*)(ws + WS_FG));
        }
        SEAM(pb + 0);
        if (IN(pb + 1) && layer == 1) { unsigned char* ws = args.ws; LAUNDER(ws); const Ctx c = make_ctx(bar.wave_s); fscan_naive(c, (const float*)(ws + WS_FG), (float*)(ws + WS_F), PIN(7)); }
        if (layer == 1) SEAM(pb + 1);
        if (IN(pb + 2)) {
            unsigned char* ws = args.ws; LAUNDER(ws); const Ctx c = make_ctx(bar.wave_s);
            if (layer == 0) attn_layer0_mfma(c, (const bf16_t*)(ws + WS_QKV), (bf16_t*)(ws + WS_ATTB), PIN(1), PIN(3), PIN(4));
            else { attn_fox_mfma(c, (const bf16_t*)(ws + WS_QKV), (const float*)(ws + WS_F), (bf16_t*)(ws + WS_ATTB)); attn_dilated_mfma(c, (const bf16_t*)(ws + WS_QKV), PIN(1), (bf16_t*)(ws + WS_MIX), (float*)(ws + WS_H1B)); }
        }
        SEAM(pb + 2);
        if (IN(pb + 3) && layer == 1) { unsigned char* ws = args.ws; LAUNDER(ws); const Ctx c = make_ctx(bar.wave_s); dilated_combine(c, (const bf16_t*)(ws + WS_MIX), (const float*)(ws + WS_H1B), (bf16_t*)(ws + WS_ATTB)); }
        if (layer == 1) SEAM(pb + 3);
        if (IN(pb + 4)) {
            unsigned char* ws = args.ws; LAUNDER(ws); const Ctx c = make_ctx(bar.wave_s);
            pg8::Gemm g{(const bf16_t*)(ws + WS_ATTB), (const bf16_t*)(ws + (layer == 0 ? WT_ABOUT : WT_CDOUT)), NT, DM, DM};
            pg8::StaticOrder S; S.init(NT, DM, c.nblk, c.bid);
            pg8::EpiStoreF32 E{(float*)(ws + WS_MIX), DM};
            pg8::gemm_phase<pg8::EpiStoreF32, pg8::StaticOrder, true, true>(GEMM_LDS, g, S, E);
        }
        SEAM(pb + 4);
        if (IN(pb + 5)) {
            unsigned char* ws = args.ws; LAUNDER(ws); const Ctx c = make_ctx(bar.wave_s);
            ln_rows(c, layer == 0 ? PIN(0) : (const float*)nullptr, (const bf16_t*)(ws + WS_ACTIN), (const float*)(ws + WS_MIX), PIN(13) + (size_t)layer * 2 * DM, PIN(14) + (size_t)layer * 2 * DM, (float*)nullptr, (bf16_t*)(ws + WS_H1B));
        }
        SEAM(pb + 5);
        if (IN(pb + 6)) {
            unsigned char* ws = args.ws; LAUNDER(ws); const Ctx c = make_ctx(bar.wave_s);
            pg8::Gemm g{(const bf16_t*)(ws + WS_H1B), (const bf16_t*)(ws + WT_WQ + (size_t)layer * 4 * MiB), NT, PEER_QW, DM};
            pg8::StaticOrder S; S.init(NT, PEER_QW, c.nblk, c.bid);
            pg8::EpiStoreBf16 E{(bf16_t*)(ws + WS_QKV), PEER_QW, 1.f, 1.f};
            pg8::gemm_phase<pg8::EpiStoreBf16, pg8::StaticOrder, true, true>(GEMM_LDS, g, S, E);
        }
        SEAM(pb + 6);
        if (IN(pb + 7)) {
            unsigned char* ws = args.ws; LAUNDER(ws); const Ctx c = make_ctx(bar.wave_s);
            peer_route_phase(c, (const bf16_t*)(ws + WS_QKV), (const bf16_t*)(ws + WS_SKB) + (size_t)layer * 16 * 128 * 128, (int*)(ws + WS_EIDX), (float*)(ws + WS_GATE));
        }
        SEAM(pb + 7);
        if (IN(pb + 8)) {
            unsigned char* ws = args.ws; LAUNDER(ws); const Ctx c = make_ctx(bar.wave_s);
            peer_u_phase(c, (const bf16_t*)(ws + WS_H1B), (const int*)(ws + WS_EIDX), ws + WS_U8 + (size_t)layer * 16384 * DM, (float*)(ws + WS_PART));
        }
        SEAM(pb + 8);
        if (IN(pb + 9)) {
            unsigned char* ws = args.ws; LAUNDER(ws); const Ctx c = make_ctx(bar.wave_s);
            peer_coef_phase(c, (const float*)(ws + WS_PART), (const int*)(ws + WS_EIDX), (const float*)(ws + WS_GATE), (const float*)(ws + WS_RS) + (size_t)layer * 16384, (const float*)(ws + WS_RS) + (size_t)(2 + layer) * 16384, (float*)(ws + WS_COEF));
        }
        SEAM(pb + 9);
        if (IN(pb + 10)) {
            unsigned char* ws = args.ws; LAUNDER(ws); const Ctx c = make_ctx(bar.wave_s);
            peer_v_phase(c, (const int*)(ws + WS_EIDX), (const float*)(ws + WS_COEF), ws + WS_V8 + (size_t)layer * 16384 * DM, (float*)(ws + WS_MIX));
        }
        SEAM(pb + 10);
        if (IN(pb + 11)) {
            unsigned char* ws = args.ws; LAUNDER(ws); const Ctx c = make_ctx(bar.wave_s);
            float* hout = layer == 0 ? (float*)nullptr : (float*)launder_ptr((unsigned char*)args.out);
            bf16_t* houtb = layer == 0 ? (bf16_t*)(ws + WS_ACTIN) : (bf16_t*)nullptr;
            ln_rows(c, (const float*)nullptr, (const bf16_t*)(ws + WS_H1B), (const float*)(ws + WS_MIX), PIN(13) + (size_t)(layer * 2 + 1) * DM, PIN(14) + (size_t)(layer * 2 + 1) * DM, hout, houtb);
        }
        SEAM(pb + 11);
    }
}

extern "C" void kernel_launch(void* const* d_in, const int* in_sizes, int n_in, void* d_out, int out_size, void* d_ws, size_t ws_size, hipStream_t stream) {
    (void)in_sizes; (void)n_in; (void)out_size;
    static int grid = 0;
    if (!grid) {
        int dev = 0, cus = 0, per_cu = 0;
        (void)hipGetDevice(&dev);
        (void)hipDeviceGetAttribute(&cus, hipDeviceAttributeMultiprocessorCount, dev);
        (void)hipFuncSetAttribute((const void*)fwd, hipFuncAttributeMaxDynamicSharedMemorySize, LDS_BYTES);
        (void)hipOccupancyMaxActiveBlocksPerMultiprocessor(&per_cu, fwd, NTHREADS, LDS_BYTES);
        if (per_cu < 1) fprintf(stderr, "occupancy query says %d blocks per CU\n", per_cu);
        grid = cus;
        if (ws_size < WS_END) fprintf(stderr, "workspace too small: %zu < %zu\n", ws_size, (size_t)WS_END);
    }
    (void)hipMemsetAsync((unsigned char*)d_ws + WS_CTL, 0, 1 * MiB, stream);
    Args a{};
    for (int i = 0; i < 15; ++i) a.in[i] = (const float*)d_in[i];
    a.out = (float*)d_out; a.ws = (unsigned char*)d_ws;
    a.ph_lo = 0; a.ph_hi = NPHASE;
    hipLaunchKernelGGL(fwd, dim3(grid), dim3(NTHREADS), LDS_BYTES, stream, a);
}
```

```cpp
#include <hip/hip_runtime.h>
#include <cstdio>
#include <cstdint>
#include <cmath>

constexpr int BATCH = 4, SEQ = 4096, DM = 1024, NT = BATCH * SEQ;
constexpr int NH = 8, HD = 64;
constexpr int QKV_W = 3072, CD_IN = 3080;
constexpr int PEER_QW = 2048;
constexpr float DN_ALPHA = 1.4142135623730951f;
constexpr float LN_EPS = 1e-5f;
constexpr int NTHREADS = 512, NWAVES = 8;
typedef unsigned short bf16_t;

constexpr size_t MiB = 1u << 20;
constexpr size_t WS_CTL = 0;
constexpr size_t WS_WT = 1 * MiB;
constexpr size_t WT_ABIN = WS_WT, WT_ABOUT = WS_WT + 6 * MiB, WT_CDIN = WS_WT + 8 * MiB, WT_CDOUT = WS_WT + 14 * MiB, WT_WQ = WS_WT + 16 * MiB;
constexpr size_t WS_ACTIN = 25 * MiB;
constexpr size_t WS_ATTB = 57 * MiB;
constexpr size_t WS_H1B = 89 * MiB;
constexpr size_t WS_QKV = 121 * MiB;
constexpr size_t WS_MIX = 217 * MiB;
constexpr size_t WS_YB = 249 * MiB;
constexpr size_t WS_EIDX = 281 * MiB;
constexpr size_t WS_COEF = 289 * MiB;
constexpr size_t WS_F = 297 * MiB;
constexpr size_t WS_FG = 298 * MiB;
constexpr size_t WS_U8 = 299 * MiB;
constexpr size_t WS_V8 = 331 * MiB;
constexpr size_t WS_RS = 363 * MiB;
constexpr size_t WS_SKB = 364 * MiB;
constexpr size_t WS_GATE = 365 * MiB;
constexpr size_t WS_PART = 373 * MiB;
constexpr size_t WS_END = 437 * MiB;
constexpr int LDS_BYTES = 147456;
constexpr int RING_OFF = 0, MISC_OFF = 143360;

__device__ __forceinline__ int lane_now() { unsigned ones = ~0u; asm volatile("" : "+s"(ones)); return (int)__builtin_amdgcn_mbcnt_hi(ones, __builtin_amdgcn_mbcnt_lo(ones, 0u)); }
#define XB_TMO      128
#define XB_XCNT(j)  (256  + 64 * (j))
#define XB_XSUB(j)  (1280 + 64 * (j))
#define XB_XGEN(j)  (2304 + 64 * (j))
#define XB_TOP      3328
#define XB_TOPGEN   3392
#define XCD_BAR_WORDS 3456
#define XB_SPIN_CAP (1u << 18)
#define LAS __attribute__((address_space(3)))

__device__ __forceinline__ unsigned xb_ld(unsigned* p)              { return __hip_atomic_load(p, __ATOMIC_RELAXED, __HIP_MEMORY_SCOPE_AGENT); }
__device__ __forceinline__ unsigned xb_add(unsigned* p, unsigned v) { return __hip_atomic_fetch_add(p, v, __ATOMIC_RELAXED, __HIP_MEMORY_SCOPE_AGENT); }
__device__ __forceinline__ unsigned xb_xcc_id() { return (unsigned)__builtin_amdgcn_s_getreg((3 << 11) | 20) & 0xFu; }
#define XB_SPIN(cond, bar) do { unsigned _sp = 0; while (cond) { __builtin_amdgcn_s_sleep(1); \
    if ((++_sp & 255u) == 0u) { if (xb_ld(&(bar)[XB_TMO])) break; if (_sp > XB_SPIN_CAP) { atomicAdd(&(bar)[XB_TMO], 1u); break; } } } } while (0)

struct XcdBarrier {
    unsigned* bar; unsigned x; int wave_s;
    volatile LAS unsigned* st;
};
__device__ __forceinline__ XcdBarrier xcd_barrier_post(unsigned* bar, volatile LAS unsigned* st) {
    XcdBarrier b; b.bar = bar; b.x = xb_xcc_id(); b.st = st;
    if (threadIdx.x == 0) (void)xb_add(&bar[XB_XCNT(b.x)], 1u);
    b.wave_s = __builtin_amdgcn_readfirstlane((int)threadIdx.x) >> 6;
    return b;
}
__device__ __forceinline__ void xcd_barrier_complete(unsigned* bar, unsigned x, unsigned& nloc, unsigned& nx) {
    const unsigned G = gridDim.x * gridDim.y * gridDim.z;
    unsigned sum, cnt, mine, sp = 0u;
    for (;;) {
        sum = 0u; cnt = 0u; mine = 0u;
#pragma unroll
        for (unsigned j = 0; j < 16; ++j) { const unsigned c = xb_ld(&bar[XB_XCNT(j)]); sum += c; cnt += (c > 0u) ? 1u : 0u; mine = (j == x) ? c : mine; }
        if (sum == G) break;
        __builtin_amdgcn_s_sleep(1);
        if ((++sp & 255u) == 0u) { if (xb_ld(&bar[XB_TMO])) break; if (sp > XB_SPIN_CAP) { atomicAdd(&bar[XB_TMO], 1u); break; } }
    }
    nloc = mine > 0u ? mine : 1u; nx = cnt > 0u ? cnt : 1u;
}
__device__ __forceinline__ void xcd_barrier(const XcdBarrier& b) {
    asm volatile("s_waitcnt vmcnt(0)" ::: "memory");
    __syncthreads();
    if (b.wave_s == 0 && lane_now() == 0) {
        unsigned* bar = b.bar;
        __builtin_amdgcn_s_waitcnt(0);
        unsigned nloc = b.st[0], nx = b.st[1];
        if (nloc == 0u) { xcd_barrier_complete(bar, b.x, nloc, nx); b.st[0] = nloc; b.st[1] = nx; }
        const unsigned old = xb_add(&bar[XB_XSUB(b.x)], 1u);
        const unsigned gen = old / nloc;
        if (old + 1u == (gen + 1u) * nloc) {
            __builtin_amdgcn_fence(__ATOMIC_RELEASE, "agent");
            asm volatile("s_waitcnt vmcnt(0)" ::: "memory");
            const unsigned og = xb_add(&bar[XB_TOP], 1u);
            const unsigned tg = og / nx;
            if (og + 1u == (tg + 1u) * nx) xb_add(&bar[XB_TOPGEN], 1u);
            else XB_SPIN(xb_ld(&bar[XB_TOPGEN]) == tg, bar);
            __builtin_amdgcn_fence(__ATOMIC_ACQUIRE, "agent");
            xb_add(&bar[XB_XGEN(b.x)], 1u);
            asm volatile("s_waitcnt vmcnt(0)" ::: "memory");
        } else {
            XB_SPIN(xb_ld(&bar[XB_XGEN(b.x)]) == gen, bar);
            __builtin_amdgcn_fence(__ATOMIC_ACQUIRE, "agent");
            asm volatile("s_waitcnt vmcnt(0)" ::: "memory");
        }
    }
    __syncthreads();
}

struct Args {
    const float* in[15];
    float* out;
    unsigned char* ws;
    int ph_lo, ph_hi;
};
struct Ctx {
    int tid, lane, wave, gwave, nwaves, bid, nblk;
    float* lds;
};
extern __shared__ __attribute__((aligned(16))) unsigned char dyn_lds[];
__device__ __forceinline__ int tid_now(int wave_s) { int lane = lane_now(); asm volatile("" : "+v"(lane)); return wave_s * 64 + lane; }
__device__ __forceinline__ Ctx make_ctx(int wave_s) {
    int t = tid_now(wave_s), b = blockIdx.x, g = gridDim.x;
    asm volatile("" : "+s"(b), "+s"(g));
    Ctx c; c.tid = t; c.lane = t & 63; c.wave = t >> 6; c.bid = b; c.nblk = g;
    c.gwave = b * NWAVES + c.wave; c.nwaves = g * NWAVES; c.lds = (float*)(dyn_lds + RING_OFF);
    return c;
}
__device__ __forceinline__ unsigned char* launder_ptr(unsigned char* p) {
    unsigned lo = __builtin_amdgcn_readfirstlane((unsigned)(uintptr_t)p), hi = __builtin_amdgcn_readfirstlane((unsigned)((uintptr_t)p >> 32));
    asm volatile("" : "+s"(lo), "+s"(hi));
    return (unsigned char*)(((uintptr_t)hi << 32) | (uintptr_t)lo);
}
__device__ __forceinline__ float shx(float v, int m, int lane) { return __builtin_bit_cast(float, __builtin_amdgcn_ds_bpermute((lane ^ m) << 2, __builtin_bit_cast(int, v))); }
__device__ __forceinline__ int shx(int v, int m, int lane) { return __builtin_amdgcn_ds_bpermute((lane ^ m) << 2, v); }
__device__ __forceinline__ float wave_sum(float v) {
    const int lane = lane_now();
#pragma unroll
    for (int o = 32; o >= 1; o >>= 1) v += shx(v, o, lane);
    return v;
}
__device__ __forceinline__ float log_sigmoid(float z) { return fminf(z, 0.f) - log1pf(expf(-fabsf(z))); }
__device__ __forceinline__ int t5_bucket(int n) {
    if (n < 16) return n;
    int large = 16 + (int)(logf((float)n / 16.f) / 2.0794415416798357f * 16.f);
    return large < 31 ? large : 31;
}
__device__ __forceinline__ float bf2f(bf16_t v) { return __builtin_bit_cast(float, (unsigned)v << 16); }
__device__ __forceinline__ unsigned f2bf(float f) { unsigned u = __builtin_bit_cast(unsigned, f); return (u + 0x7fffu + ((u >> 16) & 1u)) >> 16; }
__device__ __forceinline__ unsigned pk2(float lo, float hi) { return f2bf(lo) | (f2bf(hi) << 16); }

namespace pg8 {
#define PG8_LAS __attribute__((address_space(3)))
typedef unsigned short bf16_t;
typedef short bf16x8 __attribute__((ext_vector_type(8)));
typedef float f32x4 __attribute__((ext_vector_type(4)));
typedef unsigned u32x4 __attribute__((ext_vector_type(4)));
constexpr int BM = 256, BK = 64, HALF = 128, HTB = HALF * BK * 2  , STAGE_BYTES = 8 * HTB, NXCD = 8, WGM = 8;

__host__ __device__ __forceinline__ int lds_byte(int r, int c) { const int st = (r >> 4) * 2 + (c >> 5), rr = r & 15, cc = c & 31, ob = rr * 64 + cc * 2; return st * 1024 + (ob ^ (((ob >> 9) & 1) << 5)); }
__host__ __device__ __forceinline__ void stage_rc(int b, int& R, int& C) { const int st = b / 1024, sb = b % 1024, swz = sb ^ (((sb >> 9) & 1) << 5); R = (st >> 1) * 16 + swz / 64; C = (st & 1) * 32 + (swz % 64) / 2; }
__host__ __device__ __forceinline__ int perm32(int rho) { const int n = rho >> 4, i = rho & 15; return 8 * (i >> 2) + 4 * n + (i & 3); }

struct Unit { int pm, pn; };
struct Gemm { const bf16_t* A; const bf16_t* Bt; int M, N, K; };

struct StaticOrder {
    int nM, nN, nwg, G, c;
    __host__ __device__ void init(int M, int N, int G_, int c_) { nM = M / BM; nN = N / BM; nwg = nM * nN; G = G_; c = c_; }
    __host__ __device__ bool next(int i, Unit& u) const {
        const long L = (long)i * G + c; if (L >= nwg) return false;
        int wgid = (int)L; { const int q = nwg / NXCD, r = nwg % NXCD, xcd = wgid % NXCD, off = wgid / NXCD; wgid = (xcd < r ? xcd * (q + 1) : r * (q + 1) + (xcd - r) * q) + off; }
        const int nig = WGM * nN, gid = wgid / nig, fm = gid * WGM, gsz = (nM - fm) < WGM ? (nM - fm) : WGM;
        u.pm = fm + ((wgid % nig) % gsz); u.pn = (wgid % nig) / gsz; return true;
    }
    __device__ __forceinline__ void a_ready(const Unit&) const {}
    __device__ __forceinline__ void done(const Unit&) const {}
};

__device__ __forceinline__ unsigned cvt_pk_bf16(float lo, float hi) { unsigned r; asm volatile("v_cvt_pk_bf16_f32 %0, %1, %2" : "=v"(r) : "v"(lo), "v"(hi)); return r; }
template <class Epi, class Sched, bool ALIGN_EPI = false, bool SP2 = false>
__device__ __forceinline__ void gemm_phase(PG8_LAS unsigned char* lds, const Gemm g, const Sched& S, const Epi& E, int wave_s  ) {
    int tid_ = wave_s * 64 + lane_now(); asm volatile("" : "+v"(tid_));
    const int tid = tid_, wid = __builtin_amdgcn_readfirstlane(tid >> 6), lane = tid & 63, wr = wid >> 2, wc = wid & 3, fr = lane & 15, fq = lane >> 4;
    const int K = g.K, nt = K / BK;
    unsigned voffA[2], voffB[2];
#pragma unroll
    for (int i = 0; i < 2; ++i) { int R, C; stage_rc(tid * 16 + i * 8192, R, C); const int Rb = Epi::PERM ? ((R & ~31) + perm32(R & 31)) : R;
        voffA[i] = (unsigned)(R * K + C) * 2u; voffB[i] = (unsigned)(Rb * K + C) * 2u; }
    const size_t kstep = (size_t)(BK * 2);
    const size_t hstep = (size_t)HALF * K * 2;
    const size_t tstep = 2 * hstep;
    const unsigned ldsw = (unsigned)wid * 1024u;
    const int aoff = lds_byte(wr * 64 + fr, fq * 8), boff = lds_byte(wc * 32 + fr, fq * 8);
#define PG8_SA(b, h) (((b) * 2 + (h)) * HTB)
#define PG8_SB(b, h) ((4 + (b) * 2 + (h)) * HTB)
#define PG8_STAGE(bufoff, gbase, voff) do { _Pragma("unroll") for (int _i = 0; _i < 2; ++_i) \
        __builtin_amdgcn_global_load_lds((const unsigned*)((const char*)(gbase) + (voff)[_i]), (PG8_LAS unsigned*)(lds + (bufoff) + ldsw + _i * 8192), 16, 0, 0); } while (0)
#define PG8_LDA(dst, b, h) do { _Pragma("unroll") for (int m = 0; m < 4; ++m) _Pragma("unroll") for (int k = 0; k < 2; ++k) dst[m][k] = *(const PG8_LAS bf16x8*)(lds + PG8_SA(b, h) + aoff + m * 2048 + k * 1024); } while (0)
#define PG8_LDB(dst, b, h) do { _Pragma("unroll") for (int n = 0; n < 2; ++n) _Pragma("unroll") for (int k = 0; k < 2; ++k) dst[n][k] = *(const PG8_LAS bf16x8*)(lds + PG8_SB(b, h) + boff + n * 2048 + k * 1024); } while (0)
#define PG8_MMA(ai, bj, At, Bt) do { __builtin_amdgcn_s_setprio(1); _Pragma("unroll") for (int m = 0; m < 4; ++m) _Pragma("unroll") for (int n = 0; n < 2; ++n) _Pragma("unroll") for (int k = 0; k < 2; ++k) \
        acc[ai][bj][m][n] = __builtin_amdgcn_mfma_f32_16x16x32_bf16(Bt[n][k], At[m][k], acc[ai][bj][m][n], 0, 0, 0); __builtin_amdgcn_s_setprio(0); } while (0)
#define PG8_WAIT_V(n) asm volatile("s_waitcnt vmcnt(" #n ")" ::: "memory")
#define PG8_WAIT_L(n) asm volatile("s_waitcnt lgkmcnt(" #n ")" ::: "memory")
#define PG8_BAR __builtin_amdgcn_s_barrier()
#define PG8_SCHED __builtin_amdgcn_sched_barrier(0)
    Unit cur, nxt; int ui = 0;
    if (!S.next(0, cur)) return;
    f32x4 acc[2][2][4][2];
#pragma unroll
    for (int a = 0; a < 2; ++a)
#pragma unroll
        for (int b = 0; b < 2; ++b)
#pragma unroll
            for (int m = 0; m < 4; ++m)
#pragma unroll
                for (int n = 0; n < 2; ++n) acc[a][b][m][n] = (f32x4){0.f, 0.f, 0.f, 0.f};
    bf16x8 At[4][2], B0[2][2], B1[2][2];
    const char* cA = (const char*)g.A + (size_t)cur.pm * tstep; const char* cB = (const char*)g.Bt + (size_t)cur.pn * tstep;
    S.a_ready(cur);
    if constexpr (SP2) {
        PG8_STAGE(PG8_SB(0, 0), cB, voffB); PG8_STAGE(PG8_SB(0, 1), cB + hstep, voffB); PG8_STAGE(PG8_SA(0, 0), cA, voffA); PG8_STAGE(PG8_SA(0, 1), cA + hstep, voffA);
        if (wr == 1) PG8_BAR;
        PG8_WAIT_V(2); PG8_BAR;
        PG8_STAGE(PG8_SB(1, 0), cB + kstep, voffB); PG8_STAGE(PG8_SA(1, 0), cA + kstep, voffA); PG8_STAGE(PG8_SB(1, 1), cB + hstep + kstep, voffB);
        PG8_WAIT_V(6); PG8_BAR;
    } else {
        PG8_STAGE(PG8_SB(0, 0), cB, voffB); PG8_STAGE(PG8_SA(0, 0), cA, voffA); PG8_STAGE(PG8_SB(0, 1), cB + hstep, voffB); PG8_STAGE(PG8_SA(0, 1), cA + hstep, voffA);
        if (wr == 1) PG8_BAR;
        PG8_WAIT_V(4); PG8_BAR;
        PG8_STAGE(PG8_SB(1, 0), cB + kstep, voffB); PG8_STAGE(PG8_SA(1, 0), cA + kstep, voffA); PG8_STAGE(PG8_SB(1, 1), cB + hstep + kstep, voffB);
        PG8_WAIT_V(6); PG8_BAR;
    }
    for (;;) {
        const bool has_next = S.next(ui + 1, nxt);
        const char* nA = has_next ? (const char*)g.A + (size_t)nxt.pm * tstep : cA; const char* nB = has_next ? (const char*)g.Bt + (size_t)nxt.pn * tstep : cB;
        for (int t = 0; t < nt; t += 2) {
            const bool last = (t == nt - 2);
            const char* a1 = cA + (size_t)(t + 1) * kstep;
            const char* a2 = last ? nA : cA + (size_t)(t + 2) * kstep; const char* b2 = last ? nB : cB + (size_t)(t + 2) * kstep;
            const char* a3 = a2 + kstep; const char* b3 = b2 + kstep;
            if (last && has_next) S.a_ready(nxt);
            if constexpr (SP2) {
            PG8_LDB(B0, 0, 0); PG8_LDB(B1, 0, 1); PG8_SCHED; PG8_LDA(At, 0, 0); PG8_STAGE(PG8_SA(1, 1), a1 + hstep, voffA);
            PG8_WAIT_V(8); PG8_WAIT_L(0); PG8_BAR; PG8_MMA(0, 0, At, B0); PG8_MMA(0, 1, At, B1); PG8_BAR; PG8_SCHED;
            PG8_LDA(At, 0, 1); PG8_STAGE(PG8_SB(0, 0), b2, voffB); PG8_STAGE(PG8_SB(0, 1), b2 + hstep, voffB); PG8_STAGE(PG8_SA(0, 0), a2, voffA);
            PG8_WAIT_V(8); PG8_WAIT_L(0); PG8_BAR; PG8_MMA(1, 0, At, B0); PG8_MMA(1, 1, At, B1); PG8_BAR; PG8_SCHED;
            PG8_LDB(B0, 1, 0); PG8_LDB(B1, 1, 1); PG8_SCHED; PG8_LDA(At, 1, 0); PG8_STAGE(PG8_SA(0, 1), a2 + hstep, voffA);
            PG8_WAIT_V(8); PG8_WAIT_L(0); PG8_BAR; PG8_MMA(0, 0, At, B0); PG8_MMA(0, 1, At, B1); PG8_BAR; PG8_SCHED;
            PG8_LDA(At, 1, 1); PG8_STAGE(PG8_SB(1, 0), b3, voffB); PG8_STAGE(PG8_SB(1, 1), b3 + hstep, voffB); PG8_STAGE(PG8_SA(1, 0), a3, voffA);
            PG8_WAIT_V(8); PG8_WAIT_L(0); PG8_BAR; PG8_MMA(1, 0, At, B0); PG8_MMA(1, 1, At, B1); PG8_BAR; PG8_SCHED;
            } else {
            PG8_LDB(B0, 0, 0); PG8_SCHED; PG8_LDA(At, 0, 0); PG8_STAGE(PG8_SA(1, 1), a1 + hstep, voffA);
            PG8_WAIT_L(8); PG8_BAR; PG8_WAIT_L(0); PG8_MMA(0, 0, At, B0); PG8_BAR; PG8_SCHED;
            PG8_LDB(B1, 0, 1); PG8_STAGE(PG8_SB(0, 0), b2, voffB);
            PG8_BAR; PG8_WAIT_L(0); PG8_MMA(0, 1, At, B1); PG8_BAR;
            PG8_LDA(At, 0, 1); PG8_STAGE(PG8_SA(0, 0), a2, voffA);
            PG8_BAR; PG8_WAIT_L(0); PG8_MMA(1, 0, At, B0); PG8_BAR; PG8_SCHED;
            PG8_STAGE(PG8_SB(0, 1), b2 + hstep, voffB);
            PG8_WAIT_V(6); PG8_BAR; PG8_MMA(1, 1, At, B1); PG8_BAR;
            PG8_LDB(B0, 1, 0); PG8_SCHED; PG8_LDA(At, 1, 0); PG8_STAGE(PG8_SA(0, 1), a2 + hstep, voffA);
            PG8_WAIT_L(8); PG8_BAR; PG8_WAIT_L(0); PG8_MMA(0, 0, At, B0); PG8_BAR; PG8_SCHED;
            PG8_LDB(B1, 1, 1); PG8_STAGE(PG8_SB(1, 0), b3, voffB);
            PG8_BAR; PG8_WAIT_L(0); PG8_MMA(0, 1, At, B1); PG8_BAR;
            PG8_LDA(At, 1, 1); PG8_STAGE(PG8_SA(1, 0), a3, voffA);
            PG8_BAR; PG8_WAIT_L(0); PG8_MMA(1, 0, At, B0); PG8_BAR; PG8_SCHED;
            PG8_STAGE(PG8_SB(1, 1), b3 + hstep, voffB);
            PG8_WAIT_V(6); PG8_BAR; PG8_MMA(1, 1, At, B1); PG8_BAR;
            }
        }
        if constexpr (ALIGN_EPI) { if (wr == 0) PG8_BAR; }
        if constexpr (!Epi::AFTER_DRAIN) { E(acc, cur, wr, wc, fr, fq); S.done(cur); }
        if (!has_next) break;
#pragma unroll
        for (int a = 0; a < 2; ++a)
#pragma unroll
            for (int b = 0; b < 2; ++b)
#pragma unroll
                for (int m = 0; m < 4; ++m)
#pragma unroll
                    for (int n = 0; n < 2; ++n) acc[a][b][m][n] = (f32x4){0.f, 0.f, 0.f, 0.f};
        cur = nxt; cA = nA; cB = nB; ++ui;
        if constexpr (ALIGN_EPI) { if (wr == 1) PG8_BAR; }
    }
    PG8_WAIT_V(0);
    if constexpr (!ALIGN_EPI) { if (wr == 0) PG8_BAR; }
    PG8_BAR;
    if constexpr (Epi::AFTER_DRAIN) { E.fused(acc, cur, wr, wc, fr, fq, lds, wid, lane); S.done(cur); }
#undef PG8_SA
#undef PG8_SB
#undef PG8_STAGE
#undef PG8_LDA
#undef PG8_LDB
#undef PG8_MMA
#undef PG8_WAIT_V
#undef PG8_WAIT_L
#undef PG8_BAR
#undef PG8_SCHED
}
}

namespace pg8 {
struct EpiStoreBf16 {
    static constexpr bool PERM = true, AFTER_DRAIN = false;
    bf16_t* O; int ldc; float s01, s67;
    __device__ __forceinline__ void operator()(const f32x4 (&acc)[2][2][4][2], const Unit& u, int wr, int wc, int fr, int fq) const {
        const int row0 = u.pm * BM + wr * 64 + fr, col0 = u.pn * BM + wc * 32 + 8 * fq;
        const float sc = u.pn < 2 ? s01 : ((u.pn == 6 || u.pn == 7) ? s67 : 1.f);
#pragma unroll
        for (int ai = 0; ai < 2; ++ai)
#pragma unroll
            for (int m = 0; m < 4; ++m) { bf16_t* rowp = O + (size_t)(row0 + ai * HALF + m * 16) * ldc + col0;
#pragma unroll
                for (int bj = 0; bj < 2; ++bj) { const f32x4 v0 = acc[ai][bj][m][0] * sc, v1 = acc[ai][bj][m][1] * sc;
                    u32x4 w; w.x = cvt_pk_bf16(v0[0], v0[1]); w.y = cvt_pk_bf16(v0[2], v0[3]); w.z = cvt_pk_bf16(v1[0], v1[1]); w.w = cvt_pk_bf16(v1[2], v1[3]);
                    *(u32x4*)(rowp + bj * HALF) = w; } }
    }
};
struct EpiStoreF32 {
    static constexpr bool PERM = true, AFTER_DRAIN = false;
    float* C; int ldc;
    __device__ __forceinline__ void operator()(const f32x4 (&acc)[2][2][4][2], const Unit& u, int wr, int wc, int fr, int fq) const {
        const int row0 = u.pm * BM + wr * 64 + fr, col0 = u.pn * BM + wc * 32 + 8 * fq;
#pragma unroll
        for (int ai = 0; ai < 2; ++ai)
#pragma unroll
            for (int m = 0; m < 4; ++m) { float* rowp = C + (size_t)(row0 + ai * HALF + m * 16) * ldc + col0;
#pragma unroll
                for (int bj = 0; bj < 2; ++bj) { *(f32x4*)(rowp + bj * HALF) = acc[ai][bj][m][0]; *(f32x4*)(rowp + bj * HALF + 4) = acc[ai][bj][m][1]; } }
    }
};
}

__device__ __forceinline__ void transpose_item(const float* W, int ldw, int K, int ncols, bf16_t* WT, float* scr, int item, int lane) {
    const int nblk = ncols / 32, kb = item / nblk, nb = item % nblk, k0 = 64 * kb, n0 = 32 * nb;
#pragma unroll 8
    for (int i = 0; i < 32; ++i) { const int kk = 2 * i + (lane >> 5); scr[kk * 33 + (lane & 31)] = W[(size_t)(k0 + kk) * ldw + n0 + (lane & 31)]; }
    asm volatile("s_waitcnt lgkmcnt(0)" ::: "memory");
    const int c = lane & 7;
#pragma unroll
    for (int j = 0; j < 4; ++j) { const int n = (lane >> 3) + 8 * j; const float* s = scr + (8 * c) * 33 + n;
        uint4 o; o.x = pk2(s[0 * 33], s[1 * 33]); o.y = pk2(s[2 * 33], s[3 * 33]); o.z = pk2(s[4 * 33], s[5 * 33]); o.w = pk2(s[6 * 33], s[7 * 33]);
        *(uint4*)(WT + (size_t)(n0 + n) * K + k0 + 8 * c) = o; }
    asm volatile("s_waitcnt lgkmcnt(0)" ::: "memory");
}
__device__ __forceinline__ void cvt_rows_bf16(const Ctx& c, const float* src, bf16_t* dst, size_t n8) {
    for (size_t i = (size_t)c.gwave * 64 + c.lane; i < n8; i += (size_t)c.nwaves * 64) {
        const float4 a = *(const float4*)(src + i * 8), b = *(const float4*)(src + i * 8 + 4);
        uint4 o; o.x = pk2(a.x, a.y); o.y = pk2(a.z, a.w); o.z = pk2(b.x, b.y); o.w = pk2(b.z, b.w);
        *(uint4*)(dst + i * 8) = o;
    }
}

template <int DQ, class BiasF>
__device__ __forceinline__ void causal_softmax_row(const float (&q)[DQ], const bf16_t* kbase, const bf16_t* vbase, int ld, int t, int smax, float scale, BiasF biasf, float (&O)[64]) {
    float m = -INFINITY;
    for (int s = 0; s <= smax; ++s) {
        const bf16_t* kr = kbase + (size_t)s * ld;
        float d = 0.f;
#pragma unroll
        for (int i = 0; i < DQ; ++i) d = fmaf(q[i], bf2f(kr[i]), d);
        const float lg = d * scale + biasf(s);
        m = (s <= t) ? fmaxf(m, lg) : m;
    }
    float l = 0.f;
#pragma unroll
    for (int i = 0; i < 64; ++i) O[i] = 0.f;
    for (int s = 0; s <= smax; ++s) {
        const bf16_t* kr = kbase + (size_t)s * ld;
        const bf16_t* vr = vbase + (size_t)s * ld;
        float d = 0.f;
#pragma unroll
        for (int i = 0; i < DQ; ++i) d = fmaf(q[i], bf2f(kr[i]), d);
        const float lg = d * scale + biasf(s);
        const float p = (s <= t) ? expf(lg - m) : 0.f;
        l += p;
#pragma unroll
        for (int i = 0; i < 64; ++i) O[i] = fmaf(p, bf2f(vr[i]), O[i]);
    }
    const float inv = 1.f / l;
#pragma unroll
    for (int i = 0; i < 64; ++i) O[i] *= inv;
}
__device__ __forceinline__ void store_row64_bf16(bf16_t* orow, const float (&v)[64]) {
#pragma unroll
    for (int i = 0; i < 64; i += 8) { uint4 o; o.x = pk2(v[i], v[i + 1]); o.y = pk2(v[i + 2], v[i + 3]); o.z = pk2(v[i + 4], v[i + 5]); o.w = pk2(v[i + 6], v[i + 7]); *(uint4*)(orow + i) = o; }
}

__device__ __forceinline__ void fg_phase(const Ctx& c, const bf16_t* hin, const float* cd_in, float* fg) {
    for (int t = c.gwave; t < NT; t += c.nwaves) {
        float acc[8];
#pragma unroll
        for (int j = 0; j < 8; ++j) acc[j] = 0.f;
        for (int r = 0; r < 16; ++r) {
            const int d = r * 64 + c.lane;
            const float xv = bf2f(hin[(size_t)t * DM + d]);
            const float4 w0 = *(const float4*)(cd_in + (size_t)d * CD_IN + 3072), w1 = *(const float4*)(cd_in + (size_t)d * CD_IN + 3076);
            acc[0] = fmaf(xv, w0.x, acc[0]); acc[1] = fmaf(xv, w0.y, acc[1]); acc[2] = fmaf(xv, w0.z, acc[2]); acc[3] = fmaf(xv, w0.w, acc[3]);
            acc[4] = fmaf(xv, w1.x, acc[4]); acc[5] = fmaf(xv, w1.y, acc[5]); acc[6] = fmaf(xv, w1.z, acc[6]); acc[7] = fmaf(xv, w1.w, acc[7]);
        }
#pragma unroll
        for (int j = 0; j < 8; ++j) acc[j] = wave_sum(acc[j]);
        if (c.lane == 0) { *(float4*)(fg + (size_t)t * 8) = make_float4(acc[0], acc[1], acc[2], acc[3]); *(float4*)(fg + (size_t)t * 8 + 4) = make_float4(acc[4], acc[5], acc[6], acc[7]); }
    }
}
__device__ __forceinline__ void fscan_naive(const Ctx& c, const float* fg, float* F, const float* bf) {
    for (int task = c.gwave; task < 32; task += c.nwaves) {
        const int b = task >> 3, h = task & 7;
        const int lane = c.lane;
        float v[64]; float tot = 0.f;
#pragma unroll
        for (int i = 0; i < 64; ++i) { const int s = lane * 64 + i; v[i] = log_sigmoid(fg[((size_t)b * SEQ + s) * 8 + h] + bf[h]); tot += v[i]; }
        float incl = tot;
#pragma unroll
        for (int o = 1; o < 64; o <<= 1) { const float n = __builtin_bit_cast(float, __builtin_amdgcn_ds_bpermute(((lane - o) & 63) << 2, __builtin_bit_cast(int, incl))); if (lane >= o) incl += n; }
        float run = incl - tot;
#pragma unroll
        for (int i = 0; i < 64; ++i) { run += v[i]; F[(size_t)task * SEQ + lane * 64 + i] = run; }
    }
}

namespace att {
typedef short bf16x8 __attribute__((ext_vector_type(8)));
typedef short s16x4 __attribute__((ext_vector_type(4)));
typedef float f32x16 __attribute__((ext_vector_type(16)));
typedef float f32x4 __attribute__((ext_vector_type(4)));
typedef short v4i16_t __attribute__((ext_vector_type(4)));
constexpr float LOG2E = 1.4426950408889634f;
constexpr float NEG = -1e30f;
constexpr int KBUF = 0, VBUF = 16384, FBUF = 32768, TBUF = 33792, CNT = 34816;

__device__ __forceinline__ int tile_off(int row, int ch) { return 1024 * (row >> 3) + 512 * (ch >> 2) + 64 * (row & 7) + 16 * ((ch & 3) ^ ((row >> 2) & 3)); }
__device__ __forceinline__ s16x4 vtr(const LAS unsigned char* p) { return __builtin_bit_cast(s16x4, __builtin_amdgcn_ds_read_tr16_b64_v4i16((LAS v4i16_t*)p)); }
typedef float f32x2_t __attribute__((ext_vector_type(2))); typedef __bf16 bf16x2_t __attribute__((ext_vector_type(2)));
__device__ __forceinline__ unsigned cvtpk(float lo, float hi) { f32x2_t v = {lo, hi}; bf16x2_t b = __builtin_convertvector(v, bf16x2_t); return __builtin_bit_cast(unsigned, b); }
__device__ __forceinline__ void pairswap(float v, float& lo, float& hi) {
    unsigned a = __builtin_bit_cast(unsigned, v), b = a;
    asm volatile("s_nop 1\n\tv_permlane32_swap_b32 %0, %1" : "+v"(a), "+v"(b));
    lo = __builtin_bit_cast(float, a); hi = __builtin_bit_cast(float, b);
}
__device__ __forceinline__ float pairmax(float v) { float lo, hi; pairswap(v, lo, hi); return fmaxf(lo, hi); }
__device__ __forceinline__ float pairsum(float v) { float lo, hi; pairswap(v, lo, hi); return lo + hi; }
__device__ __forceinline__ float xhalf(float v, int hh) { float lo, hi; pairswap(v, lo, hi); return hh ? lo : hi; }
__device__ __forceinline__ int key_of(int i, int hh) { return 8 * (i >> 2) + 4 * hh + (i & 3); }

__device__ __forceinline__ bf16x8 pfrag(const f32x16& p, int ks2) {
    unsigned w[4];
#pragma unroll
    for (int j = 0; j < 4; ++j) w[j] = cvtpk(p[8 * ks2 + 2 * j], p[8 * ks2 + 2 * j + 1]);
    typedef unsigned u32x4 __attribute__((ext_vector_type(4)));
    u32x4 v = {w[0], w[1], w[2], w[3]};
    return __builtin_bit_cast(bf16x8, v);
}
__device__ __forceinline__ void pv_block(f32x16 (&O)[2], const LAS unsigned char* vbuf, int kb, const f32x16& p, int lane) {
    const int hh = lane >> 5, q_ = (lane & 15) >> 2, p_ = lane & 3, cg = (lane >> 4) & 1;
#pragma unroll
    for (int ks2 = 0; ks2 < 2; ++ks2) {
        const bf16x8 pb = pfrag(p, ks2);
#pragma unroll
        for (int db = 0; db < 2; ++db) {
            const int c0 = 32 * db + 16 * cg, ch = (c0 >> 3) + (p_ >> 1);
            const int r0 = 32 * kb + 16 * ks2 + 4 * hh;
            const s16x4 a0 = vtr(vbuf + tile_off(r0 + q_, ch) + 8 * (p_ & 1));
            const s16x4 a1 = vtr(vbuf + tile_off(r0 + 8 + q_, ch) + 8 * (p_ & 1));
            const bf16x8 a = {a0[0], a0[1], a0[2], a0[3], a1[0], a1[1], a1[2], a1[3]};
            O[db] = __builtin_amdgcn_mfma_f32_32x32x16_bf16(a, pb, O[db], 0, 0, 0);
        }
    }
}
template <int S0, int NS>
__device__ __forceinline__ f32x16 qk_block(const LAS unsigned char* kbuf, int kb, const bf16x8 (&Qf)[4], int lane) {
    const int r = lane & 31, hh = lane >> 5;
    f32x16 s = {0.f, 0.f, 0.f, 0.f, 0.f, 0.f, 0.f, 0.f, 0.f, 0.f, 0.f, 0.f, 0.f, 0.f, 0.f, 0.f};
#pragma unroll
    for (int ks = S0; ks < S0 + NS; ++ks) {
        const bf16x8 a = *(const LAS bf16x8*)(kbuf + tile_off(32 * kb + r, 2 * ks + hh));
        s = __builtin_amdgcn_mfma_f32_32x32x16_bf16(a, Qf[ks], s, 0, 0, 0);
    }
    return s;
}
__device__ __forceinline__ bool softmax_step(f32x16& x, float& m, float& l, f32x16 (&O)[2]) {
    float mx = x[0];
#pragma unroll
    for (int i = 1; i < 16; ++i) mx = fmaxf(mx, x[i]);
    mx = pairmax(mx);
    if (__all(mx - m < -64.f)) return false;
    const float mn = fmaxf(m, mx);
    if (!__all(mn == m)) {
        const float alpha = __builtin_amdgcn_exp2f(m - mn);
        l *= alpha;
#pragma unroll
        for (int i = 0; i < 16; ++i) { O[0][i] *= alpha; O[1][i] *= alpha; }
        m = mn;
    }
    float ls = 0.f;
#pragma unroll
    for (int i = 0; i < 16; ++i) { x[i] = __builtin_amdgcn_exp2f(x[i] - m); ls += x[i]; }
    l += ls;
    return true;
}
__device__ __forceinline__ void store_ot(bf16_t* orow, const f32x16 (&O)[2], int hh) {
#pragma unroll
    for (int db = 0; db < 2; ++db)
#pragma unroll
        for (int g = 0; g < 4; ++g) {
            const int d0 = 32 * db + 8 * g + 4 * hh;
            *(uint2*)(orow + d0) = make_uint2(cvtpk(O[db][4 * g], O[db][4 * g + 1]), cvtpk(O[db][4 * g + 2], O[db][4 * g + 3]));
        }
}

struct UnitArgs {
    const bf16_t* qkv;
    bf16_t* out;
    int qcol, kcol, vcol, ocol;
};

struct DilArgs { int dil, rho, pat; bf16_t* po; float* pml; };
template <int TYPE>
__device__ __forceinline__ void causal_unit(const UnitArgs& A, int b, int h, int qb, unsigned char* scratch, int tid,
                                            const float* t5  , float lam, const float* subg, const float* F  , const DilArgs DA = DilArgs{1, 0, 0, nullptr, nullptr}) {
    const LAS unsigned char* lds = (const LAS unsigned char*)scratch;
    LAS unsigned char* ldsw = (LAS unsigned char*)scratch;
    const int lane = tid & 63, w = tid >> 6, r = lane & 31, hh = lane >> 5;
    const int q0 = qb * 256 + 32 * w, tq = q0 + r;
    const size_t rowbase = (size_t)b * SEQ;
    const int ktmax = 4 * qb + 3, kdiag = 4 * qb + (w >> 1);
    const int ktmin = (TYPE == 2) ? (4 * qb - 2 > 0 ? 4 * qb - 2 : 0) : 0;
    const int rs = (TYPE == 2) ? DA.dil : 1, r0off = (TYPE == 2) ? DA.rho : 0;
    const int srow = tid >> 3, sch = tid & 7;
    const bf16_t* kg = A.qkv + (rowbase + r0off + (size_t)rs * srow) * QKV_W + A.kcol + h * 64 + sch * 8;
    const bf16_t* vg = A.qkv + (rowbase + r0off + (size_t)rs * srow) * QKV_W + A.vcol + h * 64 + sch * 8;
    const size_t tstep = (size_t)64 * rs * QKV_W;
    const int soff = tile_off(srow, sch);
    bf16x8 Qf[4];
    {
        const bf16_t* qr = A.qkv + (rowbase + r0off + (size_t)rs * tq) * QKV_W + A.qcol + h * 64 + 8 * hh;
#pragma unroll
        for (int s = 0; s < 4; ++s) Qf[s] = *(const bf16x8*)(qr + 16 * s);
    }
    __syncthreads();
    if ((TYPE == 0 || TYPE == 2) && tid < 128) {
        const float far = t5[31 * 8 + h];
        ((LAS float*)(ldsw + TBUF))[tid] = (t5[t5_bucket(tid) * 8 + h] - far) * LOG2E;
    }
    if (TYPE == 1 && tid == 0) *(LAS unsigned*)(ldsw + CNT) = 0u;
    typedef unsigned u32x4 __attribute__((ext_vector_type(4)));
    u32x4 kreg = *(const u32x4*)(kg + (size_t)ktmax * tstep), vreg = *(const u32x4*)(vg + (size_t)ktmax * tstep);
    float freg = 0.f;
    if (TYPE == 3 && tid < 64) freg = F[(size_t)(b * 8 + h) * SEQ + ktmax * 64 + tid] * LOG2E;
    *(LAS u32x4*)(ldsw + KBUF + soff) = kreg; *(LAS u32x4*)(ldsw + VBUF + soff) = vreg;
    if (TYPE == 3 && tid < 64) ((LAS float*)(ldsw + FBUF))[tid] = freg;
    __syncthreads();

    f32x16 O0[2], O1[2];
#pragma unroll
    for (int i = 0; i < 16; ++i) { O0[0][i] = 0.f; O0[1][i] = 0.f; O1[0][i] = 0.f; O1[1][i] = 0.f; }
    float m0 = NEG, l0 = 0.f, m1 = NEG, l1 = 0.f;
    float R = 0.f;
    bool wdone = false;
    float f2t = 0.f;
    if (TYPE == 3) f2t = F[(size_t)(b * 8 + h) * SEQ + tq] * LOG2E;

    for (int kt = ktmax, it = 0; kt >= ktmin; --kt, ++it) {
        const int cur = it & 1;
        if (kt > ktmin) {
            kreg = *(const u32x4*)(kg + (size_t)(kt - 1) * tstep); vreg = *(const u32x4*)(vg + (size_t)(kt - 1) * tstep);
            if (TYPE == 3 && tid < 64) freg = F[(size_t)(b * 8 + h) * SEQ + (kt - 1) * 64 + tid] * LOG2E;
        }
        const LAS unsigned char* kbuf = lds + KBUF + cur * 8192;
        const LAS unsigned char* vbuf = lds + VBUF + cur * 8192;
        if (kt <= kdiag && !wdone) {
#pragma unroll
            for (int kbi = 0; kbi < 2; ++kbi) {
                const int kb = 1 - kbi;
                const int key0 = kt * 64 + kb * 32;
                if (TYPE == 1 ? (key0 >= q0 + 31) : (key0 > q0 + 31)) continue;
                if (TYPE == 2 && key0 + 31 < q0 - 128) continue;
                const bool need_mask = (TYPE == 1) ? (key0 + 31 >= q0) : (key0 + 31 > q0);
                if (TYPE == 0) {
                    f32x16 x0 = qk_block<0, 2>(kbuf, kb, Qf, lane), x1 = qk_block<2, 2>(kbuf, kb, Qf, lane);
                    if (q0 - (key0 + 31) < 113) {
                        const LAS float* tb = (const LAS float*)(lds + TBUF);
#pragma unroll
                        for (int i = 0; i < 16; ++i) {
                            const int dist = tq - (key0 + key_of(i, hh));
                            const float bv = (dist >= 0 && dist < 128) ? tb[dist < 0 ? 0 : (dist > 127 ? 127 : dist)] : 0.f;
                            x0[i] = dist < 0 ? NEG : x0[i] + bv; x1[i] = dist < 0 ? NEG : x1[i] + bv;
                        }
                    }
                    if (softmax_step(x0, m0, l0, O0)) pv_block(O0, vbuf, kb, x0, lane);
                    if (softmax_step(x1, m1, l1, O1)) pv_block(O1, vbuf, kb, x1, lane);
                } else if (TYPE == 2) {
                    f32x16 x = qk_block<0, 4>(kbuf, kb, Qf, lane);
                    const LAS float* tb = (const LAS float*)(lds + TBUF);
#pragma unroll
                    for (int i = 0; i < 16; ++i) {
                        const int dist = tq - (key0 + key_of(i, hh));
                        int bi = dist * rs; bi = bi < 0 ? 0 : (bi > 127 ? 127 : bi);
                        x[i] = (dist >= 0 && dist <= 128) ? x[i] + tb[bi] : NEG;
                    }
                    if (softmax_step(x, m0, l0, O0)) pv_block(O0, vbuf, kb, x, lane);
                } else if (TYPE == 3) {
                    f32x16 x = qk_block<0, 4>(kbuf, kb, Qf, lane);
                    const LAS float* fb = (const LAS float*)(lds + FBUF + cur * 256);
#pragma unroll
                    for (int g = 0; g < 4; ++g) {
                        const f32x4 fv = *(const LAS f32x4*)(fb + 32 * kb + 8 * g + 4 * hh);
#pragma unroll
                        for (int j = 0; j < 4; ++j) x[4 * g + j] += f2t - fv[j];
                    }
                    if (need_mask) {
#pragma unroll
                        for (int i = 0; i < 16; ++i) x[i] = (key0 + key_of(i, hh) > tq) ? NEG : x[i];
                    }
                    if (softmax_step(x, m0, l0, O0)) pv_block(O0, vbuf, kb, x, lane);
                } else {
                    f32x16 z = qk_block<0, 4>(kbuf, kb, Qf, lane);
                    f32x16 lr;
#pragma unroll
                    for (int i = 0; i < 16; ++i) {
                        const float e = __builtin_amdgcn_exp2f(-fabsf(z[i]));
                        float v = -(fmaxf(z[i], 0.f) + __builtin_amdgcn_logf(1.f + e));
                        if (need_mask) v = (key0 + key_of(i, hh) >= tq) ? 0.f : v;
                        lr[i] = v;
                    }
                    float T[4], Tp[4], sfx[16];
#pragma unroll
                    for (int g = 0; g < 4; ++g) {
                        sfx[4 * g + 3] = 0.f; sfx[4 * g + 2] = lr[4 * g + 3]; sfx[4 * g + 1] = sfx[4 * g + 2] + lr[4 * g + 2]; sfx[4 * g] = sfx[4 * g + 1] + lr[4 * g + 1];
                        T[g] = sfx[4 * g] + lr[4 * g];
                        Tp[g] = xhalf(T[g], hh);
                    }
                    float SP[4];
                    SP[3] = 0.f; SP[2] = T[3] + Tp[3]; SP[1] = SP[2] + T[2] + Tp[2]; SP[0] = SP[1] + T[1] + Tp[1];
                    const float tot = SP[0] + T[0] + Tp[0];
                    const float msel = hh == 0 ? 1.f : 0.f;
#pragma unroll
                    for (int g = 0; g < 4; ++g) {
                        const float goff = R + SP[g] + msel * Tp[g];
#pragma unroll
                        for (int j = 0; j < 4; ++j) {
                            const int i = 4 * g + j;
                            float wv = __builtin_amdgcn_exp2f(lr[i] + z[i] + goff + sfx[i]);
                            if (need_mask) wv = (key0 + key_of(i, hh) >= tq) ? 0.f : wv;
                            z[i] = wv;
                        }
                    }
                    R += tot;
                    pv_block(O0, vbuf, kb, z, lane);
                }
            }
            if (TYPE == 1) {
                if (__all(R < -216.4f)) { wdone = true; if (lane == 0) (void)__hip_atomic_fetch_add((LAS unsigned*)(ldsw + CNT), 1u, __ATOMIC_RELAXED, __HIP_MEMORY_SCOPE_WORKGROUP); }
            }
        }
        if (kt > ktmin) {
            *(LAS u32x4*)(ldsw + KBUF + (cur ^ 1) * 8192 + soff) = kreg; *(LAS u32x4*)(ldsw + VBUF + (cur ^ 1) * 8192 + soff) = vreg;
            if (TYPE == 3 && tid < 64) ((LAS float*)(ldsw + FBUF + (cur ^ 1) * 256))[tid] = freg;
        }
        __syncthreads();
        if (TYPE == 1) { const unsigned cnt = *(const LAS unsigned*)(lds + CNT); __syncthreads(); if (cnt == 8u) break; }
    }
    if (TYPE == 2) {
        const size_t prow = ((size_t)DA.pat * NT + rowbase + r0off + (size_t)rs * tq) * 8 + h;
        store_ot(DA.po + prow * 64, O0, hh);
        const float lt = pairsum(l0);
        if (hh == 0) *(float2*)(DA.pml + prow * 2) = make_float2(m0, lt);
        return;
    }
    bf16_t* orow = A.out + (rowbase + tq) * DM + A.ocol + h * 64;
    if (TYPE == 0) {
        const float i0 = 1.f / pairsum(l0), i1 = lam / pairsum(l1);
        float ss = 0.f;
#pragma unroll
        for (int db = 0; db < 2; ++db)
#pragma unroll
            for (int i = 0; i < 16; ++i) { const float o = O0[db][i] * i0 - O1[db][i] * i1; O0[db][i] = o; ss = fmaf(o, o, ss); }
        ss = pairsum(ss);
        const float rn = rsqrtf(ss * (1.f / 64.f) + LN_EPS) * 0.8f;
#pragma unroll
        for (int db = 0; db < 2; ++db)
#pragma unroll
            for (int i = 0; i < 16; ++i) O0[db][i] *= rn * subg[32 * db + key_of(i, hh)];
        store_ot(orow, O0, hh);
    } else if (TYPE == 3) {
        const float i0 = 1.f / pairsum(l0);
#pragma unroll
        for (int db = 0; db < 2; ++db)
#pragma unroll
            for (int i = 0; i < 16; ++i) O0[db][i] *= i0;
        store_ot(orow, O0, hh);
    } else {
        store_ot(orow, O0, hh);
    }
}
}

__device__ __forceinline__ int xcd_perm256(int p) { return (p & 7) * 32 + (p >> 3); }

__device__ __forceinline__ void attn_layer0_mfma(const Ctx& c, const bf16_t* qkv, bf16_t* out, const float* t5, const float* lamv, const float* subg) {
    float s01 = 0.f, s23 = 0.f;
    for (int i = 0; i < 32; ++i) { s01 += lamv[i] * lamv[32 + i]; s23 += lamv[64 + i] * lamv[96 + i]; }
    const float lam = expf(s01) - expf(s23) + 0.2f;
    unsigned char* scratch = (unsigned char*)c.lds;
    const att::UnitArgs UA{qkv, out, 0, 512, 1024, 0}, UB{qkv, out, 1536, 2048, 2560, 512};
    for (int p = c.bid; p < 256; p += c.nblk) {
        const int pp = xcd_perm256(p), bh = pp >> 3, qb = pp & 7;
        att::causal_unit<0>(UA, bh >> 3, bh & 7, 15 - qb, scratch, c.tid, t5, lam, subg, nullptr);
        att::causal_unit<0>(UA, bh >> 3, bh & 7, qb, scratch, c.tid, t5, lam, subg, nullptr);
#pragma unroll 1
        for (int k = 0; k < 2; ++k) {
            const int u = pp * 2 + k, bh2 = u >> 4, qb2 = u & 15;
            att::causal_unit<1>(UB, bh2 >> 3, bh2 & 7, qb2, scratch, c.tid, nullptr, 0.f, nullptr, nullptr);
        }
    }
}
__device__ __forceinline__ void attn_dilated_mfma(const Ctx& c, const bf16_t* qkv, const float* t5, bf16_t* po, float* pml) {
    unsigned char* scratch = (unsigned char*)c.lds;
    const att::UnitArgs UC{qkv, nullptr, 0, 512, 1024, 0};
    for (int p = c.bid; p < 256; p += c.nblk) {
        const int pp = xcd_perm256(p);
#pragma unroll 1
        for (int k = 0; k < 6; ++k) {
            const int u = pp * 6 + k, bh = u / 48, v = u % 48;
            int pat, rho, qb, dil;
            if (v < 16) { pat = 0; dil = 1; rho = 0; qb = v; }
            else if (v < 32) { pat = 1; dil = 4; rho = (v - 16) >> 2; qb = (v - 16) & 3; }
            else { pat = 2; dil = 16; rho = v - 32; qb = 0; }
            att::causal_unit<2>(UC, bh >> 3, bh & 7, qb, scratch, c.tid, t5, 0.f, nullptr, nullptr, att::DilArgs{dil, rho, pat, po, pml});
        }
    }
}
__device__ __forceinline__ void dilated_combine(const Ctx& c, const bf16_t* po, const float* pml, bf16_t* out) {
    const size_t n = (size_t)NT * 8 * 8;
    for (size_t i = (size_t)c.gwave * 64 + c.lane; i < n; i += (size_t)c.nwaves * 64) {
        const size_t th = i >> 3; const int ch = (int)(i & 7);
        float m[3], l[3];
#pragma unroll
        for (int p = 0; p < 3; ++p) { const float2 ml = *(const float2*)(pml + ((size_t)p * NT * 8 + th) * 2); m[p] = ml.x; l[p] = ml.y; }
        const float mm = fmaxf(m[0], fmaxf(m[1], m[2]));
        float wgt[3], den = 0.f;
#pragma unroll
        for (int p = 0; p < 3; ++p) { wgt[p] = __builtin_amdgcn_exp2f(m[p] - mm); den += wgt[p] * l[p]; }
        const float inv = 1.f / den;
        float o[8];
#pragma unroll
        for (int d = 0; d < 8; ++d) o[d] = 0.f;
#pragma unroll
        for (int p = 0; p < 3; ++p) {
            const uint4 v = *(const uint4*)(po + ((size_t)p * NT * 8 + th) * 64 + ch * 8);
            const unsigned w4[4] = {v.x, v.y, v.z, v.w};
#pragma unroll
            for (int q = 0; q < 4; ++q) { o[2 * q] = fmaf(wgt[p], __builtin_bit_cast(float, w4[q] << 16), o[2 * q]); o[2 * q + 1] = fmaf(wgt[p], __builtin_bit_cast(float, w4[q] & 0xffff0000u), o[2 * q + 1]); }
        }
        uint4 ov; ov.x = pk2(o[0] * inv, o[1] * inv); ov.y = pk2(o[2] * inv, o[3] * inv); ov.z = pk2(o[4] * inv, o[5] * inv); ov.w = pk2(o[6] * inv, o[7] * inv);
        const size_t tok = th >> 3; const int hd = (int)(th & 7);
        *(uint4*)(out + tok * DM + hd * 64 + ch * 8) = ov;
    }
}
__device__ __forceinline__ void attn_fox_mfma(const Ctx& c, const bf16_t* qkv, const float* F, bf16_t* out) {
    unsigned char* scratch = (unsigned char*)c.lds;
    const att::UnitArgs UD{qkv, out, 1536, 2048, 2560, 512};
    for (int p = c.bid; p < 256; p += c.nblk) {
        const int pp = xcd_perm256(p), bh = pp >> 3, qb = pp & 7;
        att::causal_unit<3>(UD, bh >> 3, bh & 7, 15 - qb, scratch, c.tid, nullptr, 0.f, nullptr, F);
        att::causal_unit<3>(UD, bh >> 3, bh & 7, qb, scratch, c.tid, nullptr, 0.f, nullptr, F);
    }
}

__device__ __forceinline__ void ln_rows(const Ctx& c, const float* hin32, const bf16_t* hin16, const bf16_t* add16, const float* g, const float* bta, float* out, bf16_t* outb, unsigned char* out8 = nullptr, float* oscale = nullptr) {
    for (int t = c.gwave; t < NT; t += c.nwaves) {
        float v[16];
        float s = 0.f;
#pragma unroll
        for (int r = 0; r < 4; ++r) {
            const int d = r * 256 + c.lane * 4;
            float4 a;
            if (hin32) a = *(const float4*)(hin32 + (size_t)t * DM + d);
            else { const uint2 w = *(const uint2*)(hin16 + (size_t)t * DM + d); a = make_float4(__builtin_bit_cast(float, w.x << 16), __builtin_bit_cast(float, w.x & 0xffff0000u), __builtin_bit_cast(float, w.y << 16), __builtin_bit_cast(float, w.y & 0xffff0000u)); }
            const uint2 mw = *(const uint2*)(add16 + (size_t)t * DM + d);
            const float4 m = make_float4(__builtin_bit_cast(float, mw.x << 16), __builtin_bit_cast(float, mw.x & 0xffff0000u), __builtin_bit_cast(float, mw.y << 16), __builtin_bit_cast(float, mw.y & 0xffff0000u));
            v[r * 4 + 0] = DN_ALPHA * a.x + m.x; v[r * 4 + 1] = DN_ALPHA * a.y + m.y; v[r * 4 + 2] = DN_ALPHA * a.z + m.z; v[r * 4 + 3] = DN_ALPHA * a.w + m.w;
            s += v[r * 4] + v[r * 4 + 1] + v[r * 4 + 2] + v[r * 4 + 3];
        }
        const float mu = wave_sum(s) * (1.f / DM);
        float q = 0.f;
#pragma unroll
        for (int i = 0; i < 16; ++i) { v[i] -= mu; q = fmaf(v[i], v[i], q); }
        const float rs = rsqrtf(wave_sum(q) * (1.f / DM) + LN_EPS);
        float amax = 0.f;
#pragma unroll
        for (int r = 0; r < 4; ++r) {
            const int d = r * 256 + c.lane * 4;
            const float4 gg = *(const float4*)(g + d), bb = *(const float4*)(bta + d);
            const float4 o = make_float4(v[r * 4] * rs * gg.x + bb.x, v[r * 4 + 1] * rs * gg.y + bb.y, v[r * 4 + 2] * rs * gg.z + bb.z, v[r * 4 + 3] * rs * gg.w + bb.w);
            if (out) *(float4*)(out + (size_t)t * DM + d) = o;
            if (outb) *(uint2*)(outb + (size_t)t * DM + d) = make_uint2(pk2(o.x, o.y), pk2(o.z, o.w));
            v[r * 4] = o.x; v[r * 4 + 1] = o.y; v[r * 4 + 2] = o.z; v[r * 4 + 3] = o.w;
            amax = fmaxf(amax, fmaxf(fmaxf(fabsf(o.x), fabsf(o.y)), fmaxf(fabsf(o.z), fabsf(o.w))));
        }
        if (out8) {
#pragma unroll
            for (int o = 32; o >= 1; o >>= 1) amax = fmaxf(amax, shx(amax, o, c.lane));
            int e = (int)((__builtin_bit_cast(unsigned, amax) >> 23) & 0xffu) - 127;
            e = e < -100 ? -100 : (e > 100 ? 100 : e);
            const float sc = __builtin_bit_cast(float, (unsigned)(127 + 7 - e) << 23);
#pragma unroll
            for (int r = 0; r < 4; ++r) {
                int w = 0;
                w = __builtin_amdgcn_cvt_pk_fp8_f32(v[r * 4] * sc, v[r * 4 + 1] * sc, w, false); w = __builtin_amdgcn_cvt_pk_fp8_f32(v[r * 4 + 2] * sc, v[r * 4 + 3] * sc, w, true);
                *(int*)(out8 + (size_t)t * DM + r * 256 + c.lane * 4) = w;
            }
            if (c.lane == 0) oscale[t] = __builtin_bit_cast(float, (unsigned)(127 - 7 + e) << 23);
        }
    }
}

__device__ __forceinline__ void topk_insert(float (&tv)[16], int (&ti)[16], float v, int id) {
#pragma unroll
    for (int j = 15; j >= 1; --j) {
        const bool g = v > tv[j], gp = v > tv[j - 1];
        tv[j] = g ? (gp ? tv[j - 1] : v) : tv[j];
        ti[j] = g ? (gp ? ti[j - 1] : id) : ti[j];
    }
    const bool g0 = v > tv[0];
    tv[0] = g0 ? v : tv[0]; ti[0] = g0 ? id : ti[0];
}

namespace rt {
typedef short bf16x8 __attribute__((ext_vector_type(8)));
typedef float f32x16 __attribute__((ext_vector_type(16)));
__device__ __forceinline__ void ins_packed(float (&tv)[16], float v) {
#pragma unroll
    for (int j = 15; j >= 1; --j) { const bool g = v > tv[j], gp = v > tv[j - 1]; tv[j] = g ? (gp ? tv[j - 1] : v) : tv[j]; }
    tv[0] = v > tv[0] ? v : tv[0];
}
__device__ __forceinline__ float pk_idx(float v, int idx) { return __builtin_bit_cast(float, (__builtin_bit_cast(unsigned, v) & ~127u) | (unsigned)idx); }
__device__ __forceinline__ float pk_val(float p) { return __builtin_bit_cast(float, __builtin_bit_cast(unsigned, p) & ~127u); }
__device__ __forceinline__ int pk_id(float p) { return (int)(__builtin_bit_cast(unsigned, p) & 127u); }

__device__ __forceinline__ void top16_of_set(float (&tv)[16], const bf16_t* pq_row  , const LAS unsigned char* keys  , int r, int hh) {
    bf16x8 B[8];
#pragma unroll
    for (int s = 0; s < 8; ++s) B[s] = *(const bf16x8*)(pq_row + 16 * s);
#pragma unroll
    for (int j = 0; j < 16; ++j) tv[j] = -INFINITY;
#pragma unroll 1
    for (int blk = 0; blk < 4; ++blk) {
        const LAS unsigned char* kr = keys + (32 * blk + r) * 272 + 16 * hh;
        f32x16 acc = {0.f, 0.f, 0.f, 0.f, 0.f, 0.f, 0.f, 0.f, 0.f, 0.f, 0.f, 0.f, 0.f, 0.f, 0.f, 0.f};
#pragma unroll
        for (int s = 0; s < 8; ++s) acc = __builtin_amdgcn_mfma_f32_32x32x16_bf16(*(const LAS bf16x8*)(kr + 32 * s), B[s], acc, 0, 0, 0);
#pragma unroll
        for (int i = 0; i < 16; ++i) ins_packed(tv, pk_idx(acc[i], 32 * blk + 8 * (i >> 2) + 4 * hh + (i & 3)));
    }
    float pt[16];
#pragma unroll
    for (int j = 0; j < 16; ++j) pt[j] = shx(tv[j], 32, r + 32 * hh);
#pragma unroll
    for (int j = 0; j < 16; ++j) ins_packed(tv, pt[j]);
}
}

__device__ __forceinline__ void peer_route_phase(const Ctx& c, const bf16_t* pq, const bf16_t* subk  , int* eidx, float* gate) {
    const int lane = c.lane, r = lane & 31, hh = lane >> 5;
    typedef unsigned u32x4_t __attribute__((ext_vector_type(4)));
    LAS unsigned char* kl = (LAS unsigned char*)c.lds;
    for (int vb = c.bid; vb < 256; vb += c.nblk) {
        const int h = vb & 7, rng = vb >> 3;
        __syncthreads();
        for (int idx = c.tid; idx < 256 * 16; idx += NTHREADS) {
            const int row = idx >> 4, ch = idx & 15;
            *(LAS u32x4_t*)(kl + row * 272 + ch * 16) = *(const u32x4_t*)(subk + ((size_t)(2 * h) * 128 + row) * 128 + ch * 8);
        }
        __syncthreads();
#pragma unroll 1
      for (int k2 = 0; k2 < 2; ++k2) {
        const int t = (rng * 16 + c.wave + 8 * k2) * 32 + r;
        float la[16], lb[16];
        rt::top16_of_set(la, pq + (size_t)t * PEER_QW + (2 * h) * 128 + 8 * hh, kl, r, hh);
        rt::top16_of_set(lb, pq + (size_t)t * PEER_QW + (2 * h + 1) * 128 + 8 * hh, kl + 128 * 272, r, hh);
        float tv[16]; int ti[16];
#pragma unroll
        for (int j = 0; j < 16; ++j) { tv[j] = -INFINITY; ti[j] = 0; }
#pragma unroll
        for (int i = 0; i < 16; ++i) {
            const float av = rt::pk_val(la[i]); const int ai = rt::pk_id(la[i]) * 128;
#pragma unroll
            for (int j = 0; j < 16 / (i + 1); ++j) topk_insert(tv, ti, av + rt::pk_val(lb[j]), ai + rt::pk_id(lb[j]));
        }
        float sum = 0.f, e[16];
#pragma unroll
        for (int j = 0; j < 16; ++j) { e[j] = expf(tv[j] - tv[0]); sum += e[j]; }
        const float inv = 1.f / sum;
        if (hh == 0) {
            int* oi = eidx + ((size_t)t * 8 + h) * 16; float* og = gate + ((size_t)t * 8 + h) * 16;
#pragma unroll
            for (int j = 0; j < 16; j += 4) {
                *(int4*)(oi + j) = make_int4(ti[j], ti[j + 1], ti[j + 2], ti[j + 3]);
                *(float4*)(og + j) = make_float4(e[j] * inv, e[j + 1] * inv, e[j + 2] * inv, e[j + 3] * inv);
            }
        }
    }
    }
}

typedef unsigned u32x4_t __attribute__((ext_vector_type(4)));
typedef float f32x2_t __attribute__((ext_vector_type(2)));
#define GAS __attribute__((address_space(1)))
__device__ __forceinline__ float gelu_exact(float d) { return 0.5f * d * (1.f + erff(d * 0.70710678118654752f)); }

template <int MODE>
__device__ __forceinline__ void cvt_rows_fp8(const Ctx& c, const float* src, unsigned char* dst, float* rowscale, int nrows) {
    for (int row = c.gwave; row < nrows; row += c.nwaves) {
        const float* s = src + (size_t)row * DM + c.lane * 16;
        const float4 a0 = *(const float4*)s, a1 = *(const float4*)(s + 4), a2 = *(const float4*)(s + 8), a3 = *(const float4*)(s + 12);
        float am = fmaxf(fmaxf(fmaxf(fabsf(a0.x), fabsf(a0.y)), fmaxf(fabsf(a0.z), fabsf(a0.w))), fmaxf(fmaxf(fabsf(a1.x), fabsf(a1.y)), fmaxf(fabsf(a1.z), fabsf(a1.w))));
        am = fmaxf(am, fmaxf(fmaxf(fmaxf(fabsf(a2.x), fabsf(a2.y)), fmaxf(fabsf(a2.z), fabsf(a2.w))), fmaxf(fmaxf(fabsf(a3.x), fabsf(a3.y)), fmaxf(fabsf(a3.z), fabsf(a3.w)))));
#pragma unroll
        for (int o = 32; o >= 1; o >>= 1) am = fmaxf(am, shx(am, o, c.lane));
        int e = (int)((__builtin_bit_cast(unsigned, am) >> 23) & 0xffu) - 127;
        e = e < -100 ? -100 : (e > 100 ? 100 : e);
        const float sc = __builtin_bit_cast(float, (unsigned)(127 + 7 - e) << 23), inv = __builtin_bit_cast(float, (unsigned)(127 - 7 + e) << 23);
        int w0 = 0, w1 = 0, w2 = 0, w3 = 0;
        w0 = __builtin_amdgcn_cvt_pk_fp8_f32(a0.x * sc, a0.y * sc, w0, false); w0 = __builtin_amdgcn_cvt_pk_fp8_f32(a0.z * sc, a0.w * sc, w0, true);
        w1 = __builtin_amdgcn_cvt_pk_fp8_f32(a1.x * sc, a1.y * sc, w1, false); w1 = __builtin_amdgcn_cvt_pk_fp8_f32(a1.z * sc, a1.w * sc, w1, true);
        w2 = __builtin_amdgcn_cvt_pk_fp8_f32(a2.x * sc, a2.y * sc, w2, false); w2 = __builtin_amdgcn_cvt_pk_fp8_f32(a2.z * sc, a2.w * sc, w2, true);
        w3 = __builtin_amdgcn_cvt_pk_fp8_f32(a3.x * sc, a3.y * sc, w3, false); w3 = __builtin_amdgcn_cvt_pk_fp8_f32(a3.z * sc, a3.w * sc, w3, true);
        const int lyr = row >> 14, er = row & 16383;
        unsigned char* dp = MODE == 0 ? dst + ((size_t)lyr * 16384 + (size_t)(er & 7) * 2048 + (er >> 3)) * DM + c.lane * 16
                                      : dst + (size_t)lyr * 16384 * DM + (size_t)(c.lane >> 3) * (16384 * 128) + (size_t)er * 128 + (c.lane & 7) * 16;
        *(uint4*)dp = make_uint4((unsigned)w0, (unsigned)w1, (unsigned)w2, (unsigned)w3);
        if (c.lane == 0) rowscale[row] = inv;
    }
}
__device__ __forceinline__ float dot16_fp8(const u32x4_t w, const float (&x)[16], float acc) {
    const int w0 = (int)w.x, w1 = (int)w.y, w2 = (int)w.z, w3 = (int)w.w;
    f32x2_t p;
    p = __builtin_amdgcn_cvt_pk_f32_fp8(w0, false); acc = fmaf(p.x, x[0], acc); acc = fmaf(p.y, x[1], acc);
    p = __builtin_amdgcn_cvt_pk_f32_fp8(w0, true);  acc = fmaf(p.x, x[2], acc); acc = fmaf(p.y, x[3], acc);
    p = __builtin_amdgcn_cvt_pk_f32_fp8(w1, false); acc = fmaf(p.x, x[4], acc); acc = fmaf(p.y, x[5], acc);
    p = __builtin_amdgcn_cvt_pk_f32_fp8(w1, true);  acc = fmaf(p.x, x[6], acc); acc = fmaf(p.y, x[7], acc);
    p = __builtin_amdgcn_cvt_pk_f32_fp8(w2, false); acc = fmaf(p.x, x[8], acc); acc = fmaf(p.y, x[9], acc);
    p = __builtin_amdgcn_cvt_pk_f32_fp8(w2, true);  acc = fmaf(p.x, x[10], acc); acc = fmaf(p.y, x[11], acc);
    p = __builtin_amdgcn_cvt_pk_f32_fp8(w3, false); acc = fmaf(p.x, x[12], acc); acc = fmaf(p.y, x[13], acc);
    p = __builtin_amdgcn_cvt_pk_f32_fp8(w3, true);  acc = fmaf(p.x, x[14], acc); acc = fmaf(p.y, x[15], acc);
    return acc;
}
__device__ __forceinline__ void axpy16_fp8(const u32x4_t w, float cv, float (&acc)[16]) {
    const int w0 = (int)w.x, w1 = (int)w.y, w2 = (int)w.z, w3 = (int)w.w;
    f32x2_t p;
    p = __builtin_amdgcn_cvt_pk_f32_fp8(w0, false); acc[0] = fmaf(cv, p.x, acc[0]); acc[1] = fmaf(cv, p.y, acc[1]);
    p = __builtin_amdgcn_cvt_pk_f32_fp8(w0, true);  acc[2] = fmaf(cv, p.x, acc[2]); acc[3] = fmaf(cv, p.y, acc[3]);
    p = __builtin_amdgcn_cvt_pk_f32_fp8(w1, false); acc[4] = fmaf(cv, p.x, acc[4]); acc[5] = fmaf(cv, p.y, acc[5]);
    p = __builtin_amdgcn_cvt_pk_f32_fp8(w1, true);  acc[6] = fmaf(cv, p.x, acc[6]); acc[7] = fmaf(cv, p.y, acc[7]);
    p = __builtin_amdgcn_cvt_pk_f32_fp8(w2, false); acc[8] = fmaf(cv, p.x, acc[8]); acc[9] = fmaf(cv, p.y, acc[9]);
    p = __builtin_amdgcn_cvt_pk_f32_fp8(w2, true);  acc[10] = fmaf(cv, p.x, acc[10]); acc[11] = fmaf(cv, p.y, acc[11]);
    p = __builtin_amdgcn_cvt_pk_f32_fp8(w3, false); acc[12] = fmaf(cv, p.x, acc[12]); acc[13] = fmaf(cv, p.y, acc[13]);
    p = __builtin_amdgcn_cvt_pk_f32_fp8(w3, true);  acc[14] = fmaf(cv, p.x, acc[14]); acc[15] = fmaf(cv, p.y, acc[15]);
}

__device__ __forceinline__ void peer_u_phase(const Ctx& c, const bf16_t* h1b_, const int* eidx_, const unsigned char* U8_, float* P) {
    const GAS bf16_t* h1b = (const GAS bf16_t*)h1b_; const GAS int* eidx = (const GAS int*)eidx_; const GAS unsigned char* U8 = (const GAS unsigned char*)U8_;
    const int lane = c.lane, sg = lane >> 3, part = lane & 7;
    typedef int i32x4_t __attribute__((ext_vector_type(4)));
    typedef float f32x4_t __attribute__((ext_vector_type(4)));
    for (int vb = c.bid; vb < 256; vb += c.nblk) {
        const int j = vb & 7, rnk = vb >> 3;
        const int t0 = rnk * 512 + c.wave * 64;
        i32x4_t e[4];
        u32x4_t rA[8], rB[8];
#pragma unroll
        for (int q = 0; q < 4; ++q) e[q] = *(const GAS i32x4_t*)(eidx + (size_t)t0 * 128 + sg * 16 + 4 * q);
        const GAS unsigned char* ubase = U8 + (size_t)j * (16384 * 128) + part * 16;
        const GAS bf16_t* xbase = h1b + 128 * j + part * 16;
#pragma unroll
        for (int it = 0; it < 8; ++it) rA[it] = *(const GAS u32x4_t*)(ubase + (size_t)e[it >> 2][it & 3] * 128);
        u32x4_t xa = *(const GAS u32x4_t*)(xbase + (size_t)t0 * DM), xb = *(const GAS u32x4_t*)(xbase + (size_t)t0 * DM + 8);
#pragma unroll 1
        for (int i = 0; i < 64; ++i) {
            const int t = t0 + i, tn = t0 + (i < 63 ? i + 1 : 63);
#pragma unroll
            for (int it = 0; it < 8; ++it) rB[it] = *(const GAS u32x4_t*)(ubase + (size_t)e[2 + (it >> 2)][it & 3] * 128);
#pragma unroll
            for (int q = 0; q < 4; ++q) e[q] = *(const GAS i32x4_t*)(eidx + (size_t)tn * 128 + sg * 16 + 4 * q);
            float x[16];
            {
                const unsigned w[8] = {xa.x, xa.y, xa.z, xa.w, xb.x, xb.y, xb.z, xb.w};
#pragma unroll
                for (int z = 0; z < 8; ++z) { x[2 * z] = __builtin_bit_cast(float, w[z] << 16); x[2 * z + 1] = __builtin_bit_cast(float, w[z] & 0xffff0000u); }
            }
            xa = *(const GAS u32x4_t*)(xbase + (size_t)tn * DM); xb = *(const GAS u32x4_t*)(xbase + (size_t)tn * DM + 8);
            float dsum[16];
#pragma unroll
            for (int it = 0; it < 8; ++it) dsum[it] = dot16_fp8(rA[it], x, 0.f);
#pragma unroll
            for (int it = 0; it < 8; ++it) rA[it] = *(const GAS u32x4_t*)(ubase + (size_t)e[it >> 2][it & 3] * 128);
#pragma unroll
            for (int it = 0; it < 8; ++it) dsum[8 + it] = dot16_fp8(rB[it], x, 0.f);
            float d8[8], d4[4], d2[2];
            { const bool hb = (part & 4) != 0;
#pragma unroll
              for (int z = 0; z < 8; ++z) d8[z] = (hb ? dsum[8 + z] : dsum[z]) + shx(hb ? dsum[z] : dsum[8 + z], 4, lane); }
            { const bool hb = (part & 2) != 0;
#pragma unroll
              for (int z = 0; z < 4; ++z) d4[z] = (hb ? d8[4 + z] : d8[z]) + shx(hb ? d8[z] : d8[4 + z], 2, lane); }
            { const bool hb = (part & 1) != 0;
#pragma unroll
              for (int z = 0; z < 2; ++z) d2[z] = (hb ? d4[2 + z] : d4[z]) + shx(hb ? d4[z] : d4[2 + z], 1, lane); }
            *(float2*)(P + ((size_t)j * NT + t) * 128 + sg * 16 + 2 * part) = make_float2(d2[0], d2[1]);
        }
    }
}
__device__ __forceinline__ void peer_coef_phase(const Ctx& c, const float* P_, const int* eidx_, const float* gate_, const float* rsu_, const float* rsv_, float* coef) {
    const GAS float* P = (const GAS float*)P_; const GAS int* eidx = (const GAS int*)eidx_; const GAS float* gate = (const GAS float*)gate_;
    const GAS float* rsu = (const GAS float*)rsu_; const GAS float* rsv = (const GAS float*)rsv_;
    typedef int i32x4_t __attribute__((ext_vector_type(4)));
    typedef float f32x4_t __attribute__((ext_vector_type(4)));
    const size_t n4 = (size_t)NT * 128 / 4;
    for (size_t i = (size_t)c.gwave * 64 + c.lane; i < n4; i += (size_t)c.nwaves * 64) {
        f32x4_t s = *(const GAS f32x4_t*)(P + i * 4);
#pragma unroll
        for (int j = 1; j < 8; ++j) s += *(const GAS f32x4_t*)(P + (size_t)j * NT * 128 + i * 4);
        const i32x4_t e = *(const GAS i32x4_t*)(eidx + i * 4);
        const f32x4_t g = *(const GAS f32x4_t*)(gate + i * 4);
        f32x4_t o;
#pragma unroll
        for (int q = 0; q < 4; ++q) o[q] = g[q] * gelu_exact(s[q] * rsu[e[q]]) * rsv[e[q]];
        *(f32x4_t*)(coef + i * 4) = o;
    }
}

__device__ __forceinline__ void peer_v_phase(const Ctx& c, const int* eidx_, const float* coef_, const unsigned char* V8_, bf16_t* Yb) {
    const GAS int* eidx = (const GAS int*)eidx_; const GAS float* coef = (const GAS float*)coef_; const GAS unsigned char* V8 = (const GAS unsigned char*)V8_;
    const int lane = c.lane, sg = lane >> 3, part = lane & 7;
    typedef int i32x4_t __attribute__((ext_vector_type(4)));
    typedef float f32x4_t __attribute__((ext_vector_type(4)));
    for (int vb = c.bid; vb < 256; vb += c.nblk) {
        const int j = vb & 7, rnk = vb >> 3;
        const int dcol = 128 * j + part * 16;
        const GAS unsigned char* vbase = V8 + (size_t)j * (16384 * 128) + part * 16;
        const int t0 = rnk * 512 + c.wave * 64;
        i32x4_t e[4], en[4]; f32x4_t cf[4], cn[4];
        u32x4_t rA[8], rB[8];
#pragma unroll
        for (int q = 0; q < 4; ++q) { e[q] = *(const GAS i32x4_t*)(eidx + (size_t)t0 * 128 + sg * 16 + 4 * q); cf[q] = *(const GAS f32x4_t*)(coef + (size_t)t0 * 128 + sg * 16 + 4 * q); }
#pragma unroll
        for (int it = 0; it < 8; ++it) rA[it] = *(const GAS u32x4_t*)(vbase + (size_t)e[it >> 2][it & 3] * 128);
#pragma unroll 1
        for (int i = 0; i < 64; ++i) {
            const int t = t0 + i, tn = t0 + (i < 63 ? i + 1 : 63);
#pragma unroll
            for (int it = 0; it < 8; ++it) rB[it] = *(const GAS u32x4_t*)(vbase + (size_t)e[2 + (it >> 2)][it & 3] * 128);
#pragma unroll
            for (int q = 0; q < 4; ++q) { en[q] = *(const GAS i32x4_t*)(eidx + (size_t)tn * 128 + sg * 16 + 4 * q); cn[q] = *(const GAS f32x4_t*)(coef + (size_t)tn * 128 + sg * 16 + 4 * q); }
            float acc[16];
#pragma unroll
            for (int d_ = 0; d_ < 16; ++d_) acc[d_] = 0.f;
#pragma unroll
            for (int it = 0; it < 8; ++it) axpy16_fp8(rA[it], cf[it >> 2][it & 3], acc);
#pragma unroll
            for (int it = 0; it < 8; ++it) rA[it] = *(const GAS u32x4_t*)(vbase + (size_t)en[it >> 2][it & 3] * 128);
#pragma unroll
            for (int it = 0; it < 8; ++it) axpy16_fp8(rB[it], cf[2 + (it >> 2)][it & 3], acc);
            float a8[8], a4[4], a2[2];
            { const bool hb = (sg & 4) != 0;
#pragma unroll
              for (int z = 0; z < 8; ++z) a8[z] = (hb ? acc[8 + z] : acc[z]) + shx(hb ? acc[z] : acc[8 + z], 32, lane); }
            { const bool hb = (sg & 2) != 0;
#pragma unroll
              for (int z = 0; z < 4; ++z) a4[z] = (hb ? a8[4 + z] : a8[z]) + shx(hb ? a8[z] : a8[4 + z], 16, lane); }
            { const bool hb = (sg & 1) != 0;
#pragma unroll
              for (int z = 0; z < 2; ++z) a2[z] = (hb ? a4[2 + z] : a4[z]) + shx(hb ? a4[z] : a4[2 + z], 8, lane); }
            *(unsigned*)(Yb + (size_t)t * DM + dcol + 2 * sg) = pk2(a2[0], a2[1]);
#pragma unroll
            for (int q = 0; q < 4; ++q) { e[q] = en[q]; cf[q] = cn[q]; }
        }
    }
}
__device__ __forceinline__ void prologue_phase(const Ctx& c, const float* x, const float* ab_in, const float* ab_out, const float* cd_in, const float* cd_out, const float* wq, const float* pu, const float* pv, const float* sk, unsigned char* ws) {
    float* scr = c.lds + c.wave * 4096;
    constexpr int I_IN = 16 * 96, I_OUT = 16 * 32, I_WQ = 16 * 64;
    constexpr int NITEMS = 2 * I_IN + 2 * I_OUT + 2 * I_WQ;
    for (int it = c.gwave; it < NITEMS; it += c.nwaves) {
        int r = it;
        if (r < I_IN) { transpose_item(ab_in, QKV_W, DM, QKV_W, (bf16_t*)(ws + WT_ABIN), scr, r, c.lane); continue; } r -= I_IN;
        if (r < I_IN) { transpose_item(cd_in, CD_IN, DM, QKV_W, (bf16_t*)(ws + WT_CDIN), scr, r, c.lane); continue; } r -= I_IN;
        if (r < I_OUT) { transpose_item(ab_out, DM, DM, DM, (bf16_t*)(ws + WT_ABOUT), scr, r, c.lane); continue; } r -= I_OUT;
        if (r < I_OUT) { transpose_item(cd_out, DM, DM, DM, (bf16_t*)(ws + WT_CDOUT), scr, r, c.lane); continue; } r -= I_OUT;
        if (r < I_WQ) { transpose_item(wq, PEER_QW, DM, PEER_QW, (bf16_t*)(ws + WT_WQ), scr, r, c.lane); continue; } r -= I_WQ;
        transpose_item(wq + (size_t)DM * PEER_QW, PEER_QW, DM, PEER_QW, (bf16_t*)(ws + WT_WQ + 4 * MiB), scr, r, c.lane);
    }
    cvt_rows_bf16(c, x, (bf16_t*)(ws + WS_ACTIN), (size_t)NT * DM / 8);
    cvt_rows_fp8<1>(c, pu, ws + WS_U8, (float*)(ws + WS_RS), 2 * 16384);
    cvt_rows_fp8<1>(c, pv, ws + WS_V8, (float*)(ws + WS_RS) + 2 * 16384, 2 * 16384);
    cvt_rows_bf16(c, sk, (bf16_t*)(ws + WS_SKB), (size_t)2 * 16 * 128 * 128 / 8);
}

constexpr int NPHASE = 1 + 2 * 12;
__global__ void __launch_bounds__(NTHREADS, 2) fwd(Args args) {
    unsigned* ctl = (unsigned*)(args.ws + WS_CTL);
    volatile LAS unsigned* xbw = (volatile LAS unsigned*)(dyn_lds + MISC_OFF);
    if (threadIdx.x == 0) { xbw[0] = 0u; xbw[1] = 0u; xbw[2] = 0u; xbw[3] = 0u; }
    __syncthreads();
    const int lo = args.ph_lo, hi = args.ph_hi;
    XcdBarrier bar = xcd_barrier_post(ctl + 4096, xbw);
#define IN(k) (lo <= (k) && (k) < hi)
#define SEAM(k) do { if (IN(k) && IN((k) + 1)) xcd_barrier(bar); } while (0)
#define LAUNDER(ptr) ptr = launder_ptr(ptr)
#define PIN(k) ((const float*)launder_ptr((unsigned char*)args.in[k]))
#define GEMM_LDS ((PG8_LAS unsigned char*)dyn_lds + RING_OFF)
    if (IN(0)) { unsigned char* ws = args.ws; LAUNDER(ws); const Ctx c = make_ctx(bar.wave_s); prologue_phase(c, PIN(0), PIN(2), PIN(5), PIN(6), PIN(8), PIN(9), PIN(11), PIN(12), PIN(10), ws); }
    SEAM(0);
#pragma unroll 1
    for (int layer = 0; layer < 2; ++layer) {
        const int pb = 1 + layer * 12;
        if (IN(pb + 0)) {
            unsigned char* ws = args.ws; LAUNDER(ws); const Ctx c = make_ctx(bar.wave_s);
            pg8::Gemm g{(const bf16_t*)(ws + WS_ACTIN), (const bf16_t*)(ws + (layer == 0 ? WT_ABIN : WT_CDIN)), NT, QKV_W, DM};
            pg8::StaticOrder S; S.init(NT, QKV_W, c.nblk, c.bid);
            pg8::EpiStoreBf16 E{(bf16_t*)(ws + WS_QKV), QKV_W, (layer == 0 ? 0.17677669529663687f : 0.125f) * 1.4426950408889634f, 0.125f * 1.4426950408889634f};
            pg8::gemm_phase<pg8::EpiStoreBf16, pg8::StaticOrder, true, true>(GEMM_LDS, g, S, E, bar.wave_s);
            if (layer == 1) fg_phase(c, (const bf16_t*)(ws + WS_ACTIN), PIN(6), (float*)(ws + WS_FG));
        }
        SEAM(pb + 0);
        if (IN(pb + 1) && layer == 1) { unsigned char* ws = args.ws; LAUNDER(ws); const Ctx c = make_ctx(bar.wave_s); fscan_naive(c, (const float*)(ws + WS_FG), (float*)(ws + WS_F), PIN(7)); }
        if (layer == 1) SEAM(pb + 1);
        if (IN(pb + 2)) {
            unsigned char* ws = args.ws; LAUNDER(ws); const Ctx c = make_ctx(bar.wave_s);
            if (layer == 0) attn_layer0_mfma(c, (const bf16_t*)(ws + WS_QKV), (bf16_t*)(ws + WS_ATTB), PIN(1), PIN(3), PIN(4));
            else { attn_fox_mfma(c, (const bf16_t*)(ws + WS_QKV), (const float*)(ws + WS_F), (bf16_t*)(ws + WS_ATTB)); attn_dilated_mfma(c, (const bf16_t*)(ws + WS_QKV), PIN(1), (bf16_t*)(ws + WS_MIX), (float*)(ws + WS_H1B)); }
        }
        SEAM(pb + 2);
        if (IN(pb + 3) && layer == 1) { unsigned char* ws = args.ws; LAUNDER(ws); const Ctx c = make_ctx(bar.wave_s); dilated_combine(c, (const bf16_t*)(ws + WS_MIX), (const float*)(ws + WS_H1B), (bf16_t*)(ws + WS_ATTB)); }
        if (layer == 1) SEAM(pb + 3);
        if (IN(pb + 4)) {
            unsigned char* ws = args.ws; LAUNDER(ws); const Ctx c = make_ctx(bar.wave_s);
            pg8::Gemm g{(const bf16_t*)(ws + WS_ATTB), (const bf16_t*)(ws + (layer == 0 ? WT_ABOUT : WT_CDOUT)), NT, DM, DM};
            pg8::StaticOrder S; S.init(NT, DM, c.nblk, c.bid);
            pg8::EpiStoreBf16 E{(bf16_t*)(ws + WS_MIX), DM, 1.f, 1.f};
            pg8::gemm_phase<pg8::EpiStoreBf16, pg8::StaticOrder, true, true>(GEMM_LDS, g, S, E, bar.wave_s);
        }
        SEAM(pb + 4);
        if (IN(pb + 5)) {
            unsigned char* ws = args.ws; LAUNDER(ws); const Ctx c = make_ctx(bar.wave_s);
            ln_rows(c, layer == 0 ? PIN(0) : (const float*)nullptr, (const bf16_t*)(ws + WS_ACTIN), (const bf16_t*)(ws + WS_MIX), PIN(13) + (size_t)layer * 2 * DM, PIN(14) + (size_t)layer * 2 * DM, (float*)nullptr, (bf16_t*)(ws + WS_H1B));
        }
        SEAM(pb + 5);
        if (IN(pb + 6)) {
            unsigned char* ws = args.ws; LAUNDER(ws); const Ctx c = make_ctx(bar.wave_s);
            pg8::Gemm g{(const bf16_t*)(ws + WS_H1B), (const bf16_t*)(ws + WT_WQ + (size_t)layer * 4 * MiB), NT, PEER_QW, DM};
            pg8::StaticOrder S; S.init(NT, PEER_QW, c.nblk, c.bid);
            pg8::EpiStoreBf16 E{(bf16_t*)(ws + WS_QKV), PEER_QW, 1.f, 1.f};
            pg8::gemm_phase<pg8::EpiStoreBf16, pg8::StaticOrder, true, true>(GEMM_LDS, g, S, E, bar.wave_s);
        }
        SEAM(pb + 6);
        if (IN(pb + 7)) {
            unsigned char* ws = args.ws; LAUNDER(ws); const Ctx c = make_ctx(bar.wave_s);
            peer_route_phase(c, (const bf16_t*)(ws + WS_QKV), (const bf16_t*)(ws + WS_SKB) + (size_t)layer * 16 * 128 * 128, (int*)(ws + WS_EIDX), (float*)(ws + WS_GATE));
        }
        SEAM(pb + 7);
        if (IN(pb + 8)) {
            unsigned char* ws = args.ws; LAUNDER(ws); const Ctx c = make_ctx(bar.wave_s);
            peer_u_phase(c, (const bf16_t*)(ws + WS_H1B), (const int*)(ws + WS_EIDX), ws + WS_U8 + (size_t)layer * 16384 * DM, (float*)(ws + WS_PART));
        }
        SEAM(pb + 8);
        if (IN(pb + 9)) {
            unsigned char* ws = args.ws; LAUNDER(ws); const Ctx c = make_ctx(bar.wave_s);
            peer_coef_phase(c, (const float*)(ws + WS_PART), (const int*)(ws + WS_EIDX), (const float*)(ws + WS_GATE), (const float*)(ws + WS_RS) + (size_t)layer * 16384, (const float*)(ws + WS_RS) + (size_t)(2 + layer) * 16384, (float*)(ws + WS_COEF));
        }
        SEAM(pb + 9);
        if (IN(pb + 10)) {
            unsigned char* ws = args.ws; LAUNDER(ws); const Ctx c = make_ctx(bar.wave_s);
            peer_v_phase(c, (const int*)(ws + WS_EIDX), (const float*)(ws + WS_COEF), ws + WS_V8 + (size_t)layer * 16384 * DM, (bf16_t*)(ws + WS_YB));
        }
        SEAM(pb + 10);
        if (IN(pb + 11)) {
            unsigned char* ws = args.ws; LAUNDER(ws); const Ctx c = make_ctx(bar.wave_s);
            float* hout = layer == 0 ? (float*)nullptr : (float*)launder_ptr((unsigned char*)args.out);
            bf16_t* houtb = layer == 0 ? (bf16_t*)(ws + WS_ACTIN) : (bf16_t*)nullptr;
            ln_rows(c, (const float*)nullptr, (const bf16_t*)(ws + WS_H1B), (const bf16_t*)(ws + WS_YB), PIN(13) + (size_t)(layer * 2 + 1) * DM, PIN(14) + (size_t)(layer * 2 + 1) * DM, hout, houtb);
        }
        SEAM(pb + 11);
    }
}

extern "C" void kernel_launch(void* const* d_in, const int* in_sizes, int n_in, void* d_out, int out_size, void* d_ws, size_t ws_size, hipStream_t stream) {
    (void)in_sizes; (void)n_in; (void)out_size;
    static int grid = 0;
    if (!grid) {
        int dev = 0, cus = 0, per_cu = 0;
        (void)hipGetDevice(&dev);
        (void)hipDeviceGetAttribute(&cus, hipDeviceAttributeMultiprocessorCount, dev);
        (void)hipFuncSetAttribute((const void*)fwd, hipFuncAttributeMaxDynamicSharedMemorySize, LDS_BYTES);
        (void)hipOccupancyMaxActiveBlocksPerMultiprocessor(&per_cu, fwd, NTHREADS, LDS_BYTES);
        if (per_cu < 1) fprintf(stderr, "occupancy query says %d blocks per CU\n", per_cu);
        grid = cus;
        if (ws_size < WS_END) fprintf(stderr, "workspace too small: %zu < %zu\n", ws_size, (size_t)WS_END);
    }
    (void)hipMemsetAsync((unsigned char*)d_ws + WS_CTL, 0, 1 * MiB, stream);
    Args a{};
    for (int i = 0; i < 15; ++i) a.in[i] = (const float*)d_in[i];
    a.out = (float*)d_out; a.ws = (unsigned char*)d_ws;
    a.ph_lo = 0; a.ph_hi = NPHASE;
    hipLaunchKernelGGL(fwd, dim3(grid), dim3(NTHREADS), LDS_BYTES, stream, a);
}
```

```cpp
#include <hip/hip_runtime.h>
#include <cstdio>
#include <cstdint>
#include <cmath>

constexpr int BATCH = 4, SEQ = 4096, DM = 1024, NT = BATCH * SEQ;
constexpr int NH = 8, HD = 64;
constexpr int QKV_W = 3072, CD_IN = 3080;
constexpr int PEER_QW = 2048;
constexpr float DN_ALPHA = 1.4142135623730951f;
constexpr float LN_EPS = 1e-5f;
constexpr int NTHREADS = 512, NWAVES = 8;
typedef unsigned short bf16_t;

constexpr size_t MiB = 1u << 20;
constexpr size_t WS_CTL = 0;
constexpr size_t WS_WT = 1 * MiB;
constexpr size_t WT_ABIN = WS_WT, WT_ABOUT = WS_WT + 6 * MiB, WT_CDIN = WS_WT + 8 * MiB, WT_CDOUT = WS_WT + 14 * MiB, WT_WQ = WS_WT + 16 * MiB;
constexpr size_t WS_ACTIN = 25 * MiB;
constexpr size_t WS_ATTB = 57 * MiB;
constexpr size_t WS_H1B = 89 * MiB;
constexpr size_t WS_QKV = 121 * MiB;
constexpr size_t WS_MIX = 217 * MiB;
constexpr size_t WS_YB = 249 * MiB;
constexpr size_t WS_EIDX = 281 * MiB;
constexpr size_t WS_COEF = 289 * MiB;
constexpr size_t WS_F = 297 * MiB;
constexpr size_t WS_FG = 298 * MiB;
constexpr size_t WS_U8 = 299 * MiB;
constexpr size_t WS_V8 = 331 * MiB;
constexpr size_t WS_RS = 363 * MiB;
constexpr size_t WS_SKB = 364 * MiB;
constexpr size_t WS_GATE = 365 * MiB;
constexpr size_t WS_PART = 373 * MiB;
constexpr size_t WS_END = 437 * MiB;
constexpr int LDS_BYTES = 147456;
constexpr int RING_OFF = 0, MISC_OFF = 143360;

__device__ __forceinline__ int lane_now() { unsigned ones = ~0u; asm volatile("" : "+s"(ones)); return (int)__builtin_amdgcn_mbcnt_hi(ones, __builtin_amdgcn_mbcnt_lo(ones, 0u)); }
#define XB_TMO      128
#define XB_XCNT(j)  (256  + 64 * (j))
#define XB_XSUB(j)  (1280 + 64 * (j))
#define XB_XGEN(j)  (2304 + 64 * (j))
#define XB_TOP      3328
#define XB_TOPGEN   3392
#define XCD_BAR_WORDS 3456
#define XB_SPIN_CAP (1u << 18)
#define LAS __attribute__((address_space(3)))

__device__ __forceinline__ unsigned xb_ld(unsigned* p)              { return __hip_atomic_load(p, __ATOMIC_RELAXED, __HIP_MEMORY_SCOPE_AGENT); }
__device__ __forceinline__ unsigned xb_add(unsigned* p, unsigned v) { return __hip_atomic_fetch_add(p, v, __ATOMIC_RELAXED, __HIP_MEMORY_SCOPE_AGENT); }
__device__ __forceinline__ unsigned xb_xcc_id() { return (unsigned)__builtin_amdgcn_s_getreg((3 << 11) | 20) & 0xFu; }
#define XB_SPIN(cond, bar) do { unsigned _sp = 0; while (cond) { __builtin_amdgcn_s_sleep(1); \
    if ((++_sp & 255u) == 0u) { if (xb_ld(&(bar)[XB_TMO])) break; if (_sp > XB_SPIN_CAP) { atomicAdd(&(bar)[XB_TMO], 1u); break; } } } } while (0)

struct XcdBarrier {
    unsigned* bar; unsigned x; int wave_s;
    volatile LAS unsigned* st;
};
__device__ __forceinline__ XcdBarrier xcd_barrier_post(unsigned* bar, volatile LAS unsigned* st) {
    XcdBarrier b; b.bar = bar; b.x = xb_xcc_id(); b.st = st;
    if (threadIdx.x == 0) (void)xb_add(&bar[XB_XCNT(b.x)], 1u);
    b.wave_s = __builtin_amdgcn_readfirstlane((int)threadIdx.x) >> 6;
    return b;
}
__device__ __forceinline__ void xcd_barrier_complete(unsigned* bar, unsigned x, unsigned& nloc, unsigned& nx) {
    const unsigned G = gridDim.x * gridDim.y * gridDim.z;
    unsigned sum, cnt, mine, sp = 0u;
    for (;;) {
        sum = 0u; cnt = 0u; mine = 0u;
#pragma unroll
        for (unsigned j = 0; j < 16; ++j) { const unsigned c = xb_ld(&bar[XB_XCNT(j)]); sum += c; cnt += (c > 0u) ? 1u : 0u; mine = (j == x) ? c : mine; }
        if (sum == G) break;
        __builtin_amdgcn_s_sleep(1);
        if ((++sp & 255u) == 0u) { if (xb_ld(&bar[XB_TMO])) break; if (sp > XB_SPIN_CAP) { atomicAdd(&bar[XB_TMO], 1u); break; } }
    }
    nloc = mine > 0u ? mine : 1u; nx = cnt > 0u ? cnt : 1u;
}
__device__ __forceinline__ void xcd_barrier(const XcdBarrier& b) {
    asm volatile("s_waitcnt vmcnt(0)" ::: "memory");
    __syncthreads();
    if (b.wave_s == 0 && lane_now() == 0) {
        unsigned* bar = b.bar;
        __builtin_amdgcn_s_waitcnt(0);
        unsigned nloc = b.st[0], nx = b.st[1];
        if (nloc == 0u) { xcd_barrier_complete(bar, b.x, nloc, nx); b.st[0] = nloc; b.st[1] = nx; }
        const unsigned old = xb_add(&bar[XB_XSUB(b.x)], 1u);
        const unsigned gen = old / nloc;
        if (old + 1u == (gen + 1u) * nloc) {
            __builtin_amdgcn_fence(__ATOMIC_RELEASE, "agent");
            asm volatile("s_waitcnt vmcnt(0)" ::: "memory");
            const unsigned og = xb_add(&bar[XB_TOP], 1u);
            const unsigned tg = og / nx;
            if (og + 1u == (tg + 1u) * nx) xb_add(&bar[XB_TOPGEN], 1u);
            else XB_SPIN(xb_ld(&bar[XB_TOPGEN]) == tg, bar);
            __builtin_amdgcn_fence(__ATOMIC_ACQUIRE, "agent");
            xb_add(&bar[XB_XGEN(b.x)], 1u);
            asm volatile("s_waitcnt vmcnt(0)" ::: "memory");
        } else {
            XB_SPIN(xb_ld(&bar[XB_XGEN(b.x)]) == gen, bar);
            __builtin_amdgcn_fence(__ATOMIC_ACQUIRE, "agent");
            asm volatile("s_waitcnt vmcnt(0)" ::: "memory");
        }
    }
    __syncthreads();
}

struct Args {
    const float* in[15];
    float* out;
    unsigned char* ws;
    int ph_lo, ph_hi;
};
struct Ctx {
    int tid, lane, wave, gwave, nwaves, bid, nblk;
    float* lds;
};
extern __shared__ __attribute__((aligned(16))) unsigned char dyn_lds[];
__device__ __forceinline__ int tid_now(int wave_s) { int lane = lane_now(); asm volatile("" : "+v"(lane)); return wave_s * 64 + lane; }
__device__ __forceinline__ Ctx make_ctx(int wave_s) {
    int t = tid_now(wave_s), b = blockIdx.x, g = gridDim.x;
    asm volatile("" : "+s"(b), "+s"(g));
    Ctx c; c.tid = t; c.lane = t & 63; c.wave = t >> 6; c.bid = b; c.nblk = g;
    c.gwave = b * NWAVES + c.wave; c.nwaves = g * NWAVES; c.lds = (float*)(dyn_lds + RING_OFF);
    return c;
}
__device__ __forceinline__ unsigned char* launder_ptr(unsigned char* p) {
    unsigned lo = __builtin_amdgcn_readfirstlane((unsigned)(uintptr_t)p), hi = __builtin_amdgcn_readfirstlane((unsigned)((uintptr_t)p >> 32));
    asm volatile("" : "+s"(lo), "+s"(hi));
    return (unsigned char*)(((uintptr_t)hi << 32) | (uintptr_t)lo);
}
__device__ __forceinline__ float shx(float v, int m, int lane) { return __builtin_bit_cast(float, __builtin_amdgcn_ds_bpermute((lane ^ m) << 2, __builtin_bit_cast(int, v))); }
__device__ __forceinline__ int shx(int v, int m, int lane) { return __builtin_amdgcn_ds_bpermute((lane ^ m) << 2, v); }
__device__ __forceinline__ float wave_sum(float v) {
    const int lane = lane_now();
#pragma unroll
    for (int o = 32; o >= 1; o >>= 1) v += shx(v, o, lane);
    return v;
}
__device__ __forceinline__ float log_sigmoid(float z) { return fminf(z, 0.f) - log1pf(expf(-fabsf(z))); }
__device__ __forceinline__ int t5_bucket(int n) {
    if (n < 16) return n;
    int large = 16 + (int)(logf((float)n / 16.f) / 2.0794415416798357f * 16.f);
    return large < 31 ? large : 31;
}
__device__ __forceinline__ float bf2f(bf16_t v) { return __builtin_bit_cast(float, (unsigned)v << 16); }
__device__ __forceinline__ unsigned f2bf(float f) { unsigned u = __builtin_bit_cast(unsigned, f); return (u + 0x7fffu + ((u >> 16) & 1u)) >> 16; }
__device__ __forceinline__ unsigned pk2(float lo, float hi) { return f2bf(lo) | (f2bf(hi) << 16); }

namespace pg8 {
#define PG8_LAS __attribute__((address_space(3)))
typedef unsigned short bf16_t;
typedef short bf16x8 __attribute__((ext_vector_type(8)));
typedef float f32x4 __attribute__((ext_vector_type(4)));
typedef unsigned u32x4 __attribute__((ext_vector_type(4)));
constexpr int BM = 256, BK = 64, HALF = 128, HTB = HALF * BK * 2  , STAGE_BYTES = 8 * HTB, NXCD = 8, WGM = 8;

__host__ __device__ __forceinline__ int lds_byte(int r, int c) { const int st = (r >> 4) * 2 + (c >> 5), rr = r & 15, cc = c & 31, ob = rr * 64 + cc * 2; return st * 1024 + (ob ^ (((ob >> 9) & 1) << 5)); }
__host__ __device__ __forceinline__ void stage_rc(int b, int& R, int& C) { const int st = b / 1024, sb = b % 1024, swz = sb ^ (((sb >> 9) & 1) << 5); R = (st >> 1) * 16 + swz / 64; C = (st & 1) * 32 + (swz % 64) / 2; }
__host__ __device__ __forceinline__ int perm32(int rho) { const int n = rho >> 4, i = rho & 15; return 8 * (i >> 2) + 4 * n + (i & 3); }

struct Unit { int pm, pn; };
struct Gemm { const bf16_t* A; const bf16_t* Bt; int M, N, K; };

struct StaticOrder {
    int nM, nN, nwg, G, c;
    __host__ __device__ void init(int M, int N, int G_, int c_) { nM = M / BM; nN = N / BM; nwg = nM * nN; G = G_; c = c_; }
    __host__ __device__ bool next(int i, Unit& u) const {
        const long L = (long)i * G + c; if (L >= nwg) return false;
        int wgid = (int)L; { const int q = nwg / NXCD, r = nwg % NXCD, xcd = wgid % NXCD, off = wgid / NXCD; wgid = (xcd < r ? xcd * (q + 1) : r * (q + 1) + (xcd - r) * q) + off; }
        const int nig = WGM * nN, gid = wgid / nig, fm = gid * WGM, gsz = (nM - fm) < WGM ? (nM - fm) : WGM;
        u.pm = fm + ((wgid % nig) % gsz); u.pn = (wgid % nig) / gsz; return true;
    }
    __device__ __forceinline__ void a_ready(const Unit&) const {}
    __device__ __forceinline__ void done(const Unit&) const {}
};

__device__ __forceinline__ unsigned cvt_pk_bf16(float lo, float hi) { unsigned r; asm volatile("v_cvt_pk_bf16_f32 %0, %1, %2" : "=v"(r) : "v"(lo), "v"(hi)); return r; }
template <class Epi, class Sched, bool ALIGN_EPI = false, bool SP2 = false>
__device__ __forceinline__ void gemm_phase(PG8_LAS unsigned char* lds, const Gemm g, const Sched& S, const Epi& E, int wave_s  ) {
    int tid_ = wave_s * 64 + lane_now(); asm volatile("" : "+v"(tid_));
    const int tid = tid_, wid = __builtin_amdgcn_readfirstlane(tid >> 6), lane = tid & 63, wr = wid >> 2, wc = wid & 3, fr = lane & 15, fq = lane >> 4;
    const int K = g.K, nt = K / BK;
    unsigned voffA[2], voffB[2];
#pragma unroll
    for (int i = 0; i < 2; ++i) { int R, C; stage_rc(tid * 16 + i * 8192, R, C); const int Rb = Epi::PERM ? ((R & ~31) + perm32(R & 31)) : R;
        voffA[i] = (unsigned)(R * K + C) * 2u; voffB[i] = (unsigned)(Rb * K + C) * 2u; }
    const size_t kstep = (size_t)(BK * 2);
    const size_t hstep = (size_t)HALF * K * 2;
    const size_t tstep = 2 * hstep;
    const unsigned ldsw = (unsigned)wid * 1024u;
    const int aoff = lds_byte(wr * 64 + fr, fq * 8), boff = lds_byte(wc * 32 + fr, fq * 8);
#define PG8_SA(b, h) (((b) * 2 + (h)) * HTB)
#define PG8_SB(b, h) ((4 + (b) * 2 + (h)) * HTB)
#define PG8_STAGE(bufoff, gbase, voff) do { _Pragma("unroll") for (int _i = 0; _i < 2; ++_i) \
        __builtin_amdgcn_global_load_lds((const unsigned*)((const char*)(gbase) + (voff)[_i]), (PG8_LAS unsigned*)(lds + (bufoff) + ldsw + _i * 8192), 16, 0, 0); } while (0)
#define PG8_LDA(dst, b, h) do { _Pragma("unroll") for (int m = 0; m < 4; ++m) _Pragma("unroll") for (int k = 0; k < 2; ++k) dst[m][k] = *(const PG8_LAS bf16x8*)(lds + PG8_SA(b, h) + aoff + m * 2048 + k * 1024); } while (0)
#define PG8_LDB(dst, b, h) do { _Pragma("unroll") for (int n = 0; n < 2; ++n) _Pragma("unroll") for (int k = 0; k < 2; ++k) dst[n][k] = *(const PG8_LAS bf16x8*)(lds + PG8_SB(b, h) + boff + n * 2048 + k * 1024); } while (0)
#define PG8_MMA(ai, bj, At, Bt) do { __builtin_amdgcn_s_setprio(1); _Pragma("unroll") for (int m = 0; m < 4; ++m) _Pragma("unroll") for (int n = 0; n < 2; ++n) _Pragma("unroll") for (int k = 0; k < 2; ++k) \
        acc[ai][bj][m][n] = __builtin_amdgcn_mfma_f32_16x16x32_bf16(Bt[n][k], At[m][k], acc[ai][bj][m][n], 0, 0, 0); __builtin_amdgcn_s_setprio(0); } while (0)
#define PG8_WAIT_V(n) asm volatile("s_waitcnt vmcnt(" #n ")" ::: "memory")
#define PG8_WAIT_L(n) asm volatile("s_waitcnt lgkmcnt(" #n ")" ::: "memory")
#define PG8_BAR __builtin_amdgcn_s_barrier()
#define PG8_SCHED __builtin_amdgcn_sched_barrier(0)
    Unit cur, nxt; int ui = 0;
    if (!S.next(0, cur)) return;
    f32x4 acc[2][2][4][2];
#pragma unroll
    for (int a = 0; a < 2; ++a)
#pragma unroll
        for (int b = 0; b < 2; ++b)
#pragma unroll
            for (int m = 0; m < 4; ++m)
#pragma unroll
                for (int n = 0; n < 2; ++n) acc[a][b][m][n] = (f32x4){0.f, 0.f, 0.f, 0.f};
    bf16x8 At[4][2], B0[2][2], B1[2][2];
    const char* cA = (const char*)g.A + (size_t)cur.pm * tstep; const char* cB = (const char*)g.Bt + (size_t)cur.pn * tstep;
    S.a_ready(cur);
    if constexpr (SP2) {
        PG8_STAGE(PG8_SB(0, 0), cB, voffB); PG8_STAGE(PG8_SB(0, 1), cB + hstep, voffB); PG8_STAGE(PG8_SA(0, 0), cA, voffA); PG8_STAGE(PG8_SA(0, 1), cA + hstep, voffA);
        if (wr == 1) PG8_BAR;
        PG8_WAIT_V(2); PG8_BAR;
        PG8_STAGE(PG8_SB(1, 0), cB + kstep, voffB); PG8_STAGE(PG8_SA(1, 0), cA + kstep, voffA); PG8_STAGE(PG8_SB(1, 1), cB + hstep + kstep, voffB);
        PG8_WAIT_V(6); PG8_BAR;
    } else {
        PG8_STAGE(PG8_SB(0, 0), cB, voffB); PG8_STAGE(PG8_SA(0, 0), cA, voffA); PG8_STAGE(PG8_SB(0, 1), cB + hstep, voffB); PG8_STAGE(PG8_SA(0, 1), cA + hstep, voffA);
        if (wr == 1) PG8_BAR;
        PG8_WAIT_V(4); PG8_BAR;
        PG8_STAGE(PG8_SB(1, 0), cB + kstep, voffB); PG8_STAGE(PG8_SA(1, 0), cA + kstep, voffA); PG8_STAGE(PG8_SB(1, 1), cB + hstep + kstep, voffB);
        PG8_WAIT_V(6); PG8_BAR;
    }
    for (;;) {
        const bool has_next = S.next(ui + 1, nxt);
        const char* nA = has_next ? (const char*)g.A + (size_t)nxt.pm * tstep : cA; const char* nB = has_next ? (const char*)g.Bt + (size_t)nxt.pn * tstep : cB;
        for (int t = 0; t < nt; t += 2) {
            const bool last = (t == nt - 2);
            const char* a1 = cA + (size_t)(t + 1) * kstep;
            const char* a2 = last ? nA : cA + (size_t)(t + 2) * kstep; const char* b2 = last ? nB : cB + (size_t)(t + 2) * kstep;
            const char* a3 = a2 + kstep; const char* b3 = b2 + kstep;
            if (last && has_next) S.a_ready(nxt);
            if constexpr (SP2) {
            PG8_LDB(B0, 0, 0); PG8_LDB(B1, 0, 1); PG8_SCHED; PG8_LDA(At, 0, 0); PG8_STAGE(PG8_SA(1, 1), a1 + hstep, voffA);
            PG8_WAIT_V(8); PG8_WAIT_L(0); PG8_BAR; PG8_MMA(0, 0, At, B0); PG8_MMA(0, 1, At, B1); PG8_BAR; PG8_SCHED;
            PG8_LDA(At, 0, 1); PG8_STAGE(PG8_SB(0, 0), b2, voffB); PG8_STAGE(PG8_SB(0, 1), b2 + hstep, voffB); PG8_STAGE(PG8_SA(0, 0), a2, voffA);
            PG8_WAIT_V(8); PG8_WAIT_L(0); PG8_BAR; PG8_MMA(1, 0, At, B0); PG8_MMA(1, 1, At, B1); PG8_BAR; PG8_SCHED;
            PG8_LDB(B0, 1, 0); PG8_LDB(B1, 1, 1); PG8_SCHED; PG8_LDA(At, 1, 0); PG8_STAGE(PG8_SA(0, 1), a2 + hstep, voffA);
            PG8_WAIT_V(8); PG8_WAIT_L(0); PG8_BAR; PG8_MMA(0, 0, At, B0); PG8_MMA(0, 1, At, B1); PG8_BAR; PG8_SCHED;
            PG8_LDA(At, 1, 1); PG8_STAGE(PG8_SB(1, 0), b3, voffB); PG8_STAGE(PG8_SB(1, 1), b3 + hstep, voffB); PG8_STAGE(PG8_SA(1, 0), a3, voffA);
            PG8_WAIT_V(8); PG8_WAIT_L(0); PG8_BAR; PG8_MMA(1, 0, At, B0); PG8_MMA(1, 1, At, B1); PG8_BAR; PG8_SCHED;
            } else {
            PG8_LDB(B0, 0, 0); PG8_SCHED; PG8_LDA(At, 0, 0); PG8_STAGE(PG8_SA(1, 1), a1 + hstep, voffA);
            PG8_WAIT_L(8); PG8_BAR; PG8_WAIT_L(0); PG8_MMA(0, 0, At, B0); PG8_BAR; PG8_SCHED;
            PG8_LDB(B1, 0, 1); PG8_STAGE(PG8_SB(0, 0), b2, voffB);
            PG8_BAR; PG8_WAIT_L(0); PG8_MMA(0, 1, At, B1); PG8_BAR;
            PG8_LDA(At, 0, 1); PG8_STAGE(PG8_SA(0, 0), a2, voffA);
            PG8_BAR; PG8_WAIT_L(0); PG8_MMA(1, 0, At, B0); PG8_BAR; PG8_SCHED;
            PG8_STAGE(PG8_SB(0, 1), b2 + hstep, voffB);
            PG8_WAIT_V(6); PG8_BAR; PG8_MMA(1, 1, At, B1); PG8_BAR;
            PG8_LDB(B0, 1, 0); PG8_SCHED; PG8_LDA(At, 1, 0); PG8_STAGE(PG8_SA(0, 1), a2 + hstep, voffA);
            PG8_WAIT_L(8); PG8_BAR; PG8_WAIT_L(0); PG8_MMA(0, 0, At, B0); PG8_BAR; PG8_SCHED;
            PG8_LDB(B1, 1, 1); PG8_STAGE(PG8_SB(1, 0), b3, voffB);
            PG8_BAR; PG8_WAIT_L(0); PG8_MMA(0, 1, At, B1); PG8_BAR;
            PG8_LDA(At, 1, 1); PG8_STAGE(PG8_SA(1, 0), a3, voffA);
            PG8_BAR; PG8_WAIT_L(0); PG8_MMA(1, 0, At, B0); PG8_BAR; PG8_SCHED;
            PG8_STAGE(PG8_SB(1, 1), b3 + hstep, voffB);
            PG8_WAIT_V(6); PG8_BAR; PG8_MMA(1, 1, At, B1); PG8_BAR;
            }
        }
        if constexpr (ALIGN_EPI) { if (wr == 0) PG8_BAR; }
        if constexpr (!Epi::AFTER_DRAIN) { E(acc, cur, wr, wc, fr, fq); S.done(cur); }
        if (!has_next) break;
#pragma unroll
        for (int a = 0; a < 2; ++a)
#pragma unroll
            for (int b = 0; b < 2; ++b)
#pragma unroll
                for (int m = 0; m < 4; ++m)
#pragma unroll
                    for (int n = 0; n < 2; ++n) acc[a][b][m][n] = (f32x4){0.f, 0.f, 0.f, 0.f};
        cur = nxt; cA = nA; cB = nB; ++ui;
        if constexpr (ALIGN_EPI) { if (wr == 1) PG8_BAR; }
    }
    PG8_WAIT_V(0);
    if constexpr (!ALIGN_EPI) { if (wr == 0) PG8_BAR; }
    PG8_BAR;
    if constexpr (Epi::AFTER_DRAIN) { E.fused(acc, cur, wr, wc, fr, fq, lds, wid, lane); S.done(cur); }
#undef PG8_SA
#undef PG8_SB
#undef PG8_STAGE
#undef PG8_LDA
#undef PG8_LDB
#undef PG8_MMA
#undef PG8_WAIT_V
#undef PG8_WAIT_L
#undef PG8_BAR
#undef PG8_SCHED
}
}

namespace pg8 {
struct EpiStoreBf16 {
    static constexpr bool PERM = true, AFTER_DRAIN = false;
    bf16_t* O; int ldc; float s01, s67;
    __device__ __forceinline__ void operator()(const f32x4 (&acc)[2][2][4][2], const Unit& u, int wr, int wc, int fr, int fq) const {
        const int row0 = u.pm * BM + wr * 64 + fr, col0 = u.pn * BM + wc * 32 + 8 * fq;
        const float sc = u.pn < 2 ? s01 : ((u.pn == 6 || u.pn == 7) ? s67 : 1.f);
#pragma unroll
        for (int ai = 0; ai < 2; ++ai)
#pragma unroll
            for (int m = 0; m < 4; ++m) { bf16_t* rowp = O + (size_t)(row0 + ai * HALF + m * 16) * ldc + col0;
#pragma unroll
                for (int bj = 0; bj < 2; ++bj) { const f32x4 v0 = acc[ai][bj][m][0] * sc, v1 = acc[ai][bj][m][1] * sc;
                    u32x4 w; w.x = cvt_pk_bf16(v0[0], v0[1]); w.y = cvt_pk_bf16(v0[2], v0[3]); w.z = cvt_pk_bf16(v1[0], v1[1]); w.w = cvt_pk_bf16(v1[2], v1[3]);
                    *(u32x4*)(rowp + bj * HALF) = w; } }
    }
};
struct EpiStoreF32 {
    static constexpr bool PERM = true, AFTER_DRAIN = false;
    float* C; int ldc;
    __device__ __forceinline__ void operator()(const f32x4 (&acc)[2][2][4][2], const Unit& u, int wr, int wc, int fr, int fq) const {
        const int row0 = u.pm * BM + wr * 64 + fr, col0 = u.pn * BM + wc * 32 + 8 * fq;
#pragma unroll
        for (int ai = 0; ai < 2; ++ai)
#pragma unroll
            for (int m = 0; m < 4; ++m) { float* rowp = C + (size_t)(row0 + ai * HALF + m * 16) * ldc + col0;
#pragma unroll
                for (int bj = 0; bj < 2; ++bj) { *(f32x4*)(rowp + bj * HALF) = acc[ai][bj][m][0]; *(f32x4*)(rowp + bj * HALF + 4) = acc[ai][bj][m][1]; } }
    }
};
}

__device__ __forceinline__ void transpose_item(const float* W, int ldw, int K, int ncols, bf16_t* WT, float* scr, int item, int lane) {
    const int nblk = ncols / 32, kb = item / nblk, nb = item % nblk, k0 = 64 * kb, n0 = 32 * nb;
#pragma unroll 8
    for (int i = 0; i < 32; ++i) { const int kk = 2 * i + (lane >> 5); scr[kk * 33 + (lane & 31)] = W[(size_t)(k0 + kk) * ldw + n0 + (lane & 31)]; }
    asm volatile("s_waitcnt lgkmcnt(0)" ::: "memory");
    const int c = lane & 7;
#pragma unroll
    for (int j = 0; j < 4; ++j) { const int n = (lane >> 3) + 8 * j; const float* s = scr + (8 * c) * 33 + n;
        uint4 o; o.x = pk2(s[0 * 33], s[1 * 33]); o.y = pk2(s[2 * 33], s[3 * 33]); o.z = pk2(s[4 * 33], s[5 * 33]); o.w = pk2(s[6 * 33], s[7 * 33]);
        *(uint4*)(WT + (size_t)(n0 + n) * K + k0 + 8 * c) = o; }
    asm volatile("s_waitcnt lgkmcnt(0)" ::: "memory");
}
__device__ __forceinline__ void cvt_rows_bf16(const Ctx& c, const float* src, bf16_t* dst, size_t n8) {
    for (size_t i = (size_t)c.gwave * 64 + c.lane; i < n8; i += (size_t)c.nwaves * 64) {
        const float4 a = *(const float4*)(src + i * 8), b = *(const float4*)(src + i * 8 + 4);
        uint4 o; o.x = pk2(a.x, a.y); o.y = pk2(a.z, a.w); o.z = pk2(b.x, b.y); o.w = pk2(b.z, b.w);
        *(uint4*)(dst + i * 8) = o;
    }
}

template <int DQ, class BiasF>
__device__ __forceinline__ void causal_softmax_row(const float (&q)[DQ], const bf16_t* kbase, const bf16_t* vbase, int ld, int t, int smax, float scale, BiasF biasf, float (&O)[64]) {
    float m = -INFINITY;
    for (int s = 0; s <= smax; ++s) {
        const bf16_t* kr = kbase + (size_t)s * ld;
        float d = 0.f;
#pragma unroll
        for (int i = 0; i < DQ; ++i) d = fmaf(q[i], bf2f(kr[i]), d);
        const float lg = d * scale + biasf(s);
        m = (s <= t) ? fmaxf(m, lg) : m;
    }
    float l = 0.f;
#pragma unroll
    for (int i = 0; i < 64; ++i) O[i] = 0.f;
    for (int s = 0; s <= smax; ++s) {
        const bf16_t* kr = kbase + (size_t)s * ld;
        const bf16_t* vr = vbase + (size_t)s * ld;
        float d = 0.f;
#pragma unroll
        for (int i = 0; i < DQ; ++i) d = fmaf(q[i], bf2f(kr[i]), d);
        const float lg = d * scale + biasf(s);
        const float p = (s <= t) ? expf(lg - m) : 0.f;
        l += p;
#pragma unroll
        for (int i = 0; i < 64; ++i) O[i] = fmaf(p, bf2f(vr[i]), O[i]);
    }
    const float inv = 1.f / l;
#pragma unroll
    for (int i = 0; i < 64; ++i) O[i] *= inv;
}
__device__ __forceinline__ void store_row64_bf16(bf16_t* orow, const float (&v)[64]) {
#pragma unroll
    for (int i = 0; i < 64; i += 8) { uint4 o; o.x = pk2(v[i], v[i + 1]); o.y = pk2(v[i + 2], v[i + 3]); o.z = pk2(v[i + 4], v[i + 5]); o.w = pk2(v[i + 6], v[i + 7]); *(uint4*)(orow + i) = o; }
}

__device__ __forceinline__ void fg_phase(const Ctx& c, const bf16_t* hin, const float* cd_in, float* fg) {
    for (int t = c.gwave; t < NT; t += c.nwaves) {
        float acc[8];
#pragma unroll
        for (int j = 0; j < 8; ++j) acc[j] = 0.f;
        for (int r = 0; r < 16; ++r) {
            const int d = r * 64 + c.lane;
            const float xv = bf2f(hin[(size_t)t * DM + d]);
            const float4 w0 = *(const float4*)(cd_in + (size_t)d * CD_IN + 3072), w1 = *(const float4*)(cd_in + (size_t)d * CD_IN + 3076);
            acc[0] = fmaf(xv, w0.x, acc[0]); acc[1] = fmaf(xv, w0.y, acc[1]); acc[2] = fmaf(xv, w0.z, acc[2]); acc[3] = fmaf(xv, w0.w, acc[3]);
            acc[4] = fmaf(xv, w1.x, acc[4]); acc[5] = fmaf(xv, w1.y, acc[5]); acc[6] = fmaf(xv, w1.z, acc[6]); acc[7] = fmaf(xv, w1.w, acc[7]);
        }
#pragma unroll
        for (int j = 0; j < 8; ++j) acc[j] = wave_sum(acc[j]);
        if (c.lane == 0) { *(float4*)(fg + (size_t)t * 8) = make_float4(acc[0], acc[1], acc[2], acc[3]); *(float4*)(fg + (size_t)t * 8 + 4) = make_float4(acc[4], acc[5], acc[6], acc[7]); }
    }
}
__device__ __forceinline__ void fscan_naive(const Ctx& c, const float* fg, float* F, const float* bf) {
    for (int task = c.gwave; task < 32; task += c.nwaves) {
        const int b = task >> 3, h = task & 7;
        const int lane = c.lane;
        float v[64]; float tot = 0.f;
#pragma unroll
        for (int i = 0; i < 64; ++i) { const int s = lane * 64 + i; v[i] = log_sigmoid(fg[((size_t)b * SEQ + s) * 8 + h] + bf[h]); tot += v[i]; }
        float incl = tot;
#pragma unroll
        for (int o = 1; o < 64; o <<= 1) { const float n = __builtin_bit_cast(float, __builtin_amdgcn_ds_bpermute(((lane - o) & 63) << 2, __builtin_bit_cast(int, incl))); if (lane >= o) incl += n; }
        float run = incl - tot;
#pragma unroll
        for (int i = 0; i < 64; ++i) { run += v[i]; F[(size_t)task * SEQ + lane * 64 + i] = run; }
    }
}

namespace att {
typedef short bf16x8 __attribute__((ext_vector_type(8)));
typedef short s16x4 __attribute__((ext_vector_type(4)));
typedef float f32x16 __attribute__((ext_vector_type(16)));
typedef float f32x4 __attribute__((ext_vector_type(4)));
typedef short v4i16_t __attribute__((ext_vector_type(4)));
constexpr float LOG2E = 1.4426950408889634f;
constexpr float NEG = -1e30f;
constexpr int KBUF = 0, VBUF = 16384, FBUF = 32768, TBUF = 33792, CNT = 34816;

__device__ __forceinline__ int tile_off(int row, int ch) { return 1024 * (row >> 3) + 512 * (ch >> 2) + 64 * (row & 7) + 16 * ((ch & 3) ^ ((row >> 2) & 3)); }
__device__ __forceinline__ s16x4 vtr(const LAS unsigned char* p) { return __builtin_bit_cast(s16x4, __builtin_amdgcn_ds_read_tr16_b64_v4i16((LAS v4i16_t*)p)); }
typedef float f32x2_t __attribute__((ext_vector_type(2))); typedef __bf16 bf16x2_t __attribute__((ext_vector_type(2)));
__device__ __forceinline__ unsigned cvtpk(float lo, float hi) { f32x2_t v = {lo, hi}; bf16x2_t b = __builtin_convertvector(v, bf16x2_t); return __builtin_bit_cast(unsigned, b); }
__device__ __forceinline__ void pairswap(float v, float& lo, float& hi) {
    unsigned a = __builtin_bit_cast(unsigned, v), b = a;
    asm volatile("s_nop 1\n\tv_permlane32_swap_b32 %0, %1" : "+v"(a), "+v"(b));
    lo = __builtin_bit_cast(float, a); hi = __builtin_bit_cast(float, b);
}
__device__ __forceinline__ float pairmax(float v) { float lo, hi; pairswap(v, lo, hi); return fmaxf(lo, hi); }
__device__ __forceinline__ float pairsum(float v) { float lo, hi; pairswap(v, lo, hi); return lo + hi; }
__device__ __forceinline__ float xhalf(float v, int hh) { float lo, hi; pairswap(v, lo, hi); return hh ? lo : hi; }
__device__ __forceinline__ int key_of(int i, int hh) { return 8 * (i >> 2) + 4 * hh + (i & 3); }

__device__ __forceinline__ bf16x8 pfrag(const f32x16& p, int ks2) {
    unsigned w[4];
#pragma unroll
    for (int j = 0; j < 4; ++j) w[j] = cvtpk(p[8 * ks2 + 2 * j], p[8 * ks2 + 2 * j + 1]);
    typedef unsigned u32x4 __attribute__((ext_vector_type(4)));
    u32x4 v = {w[0], w[1], w[2], w[3]};
    return __builtin_bit_cast(bf16x8, v);
}
__device__ __forceinline__ void pv_block(f32x16 (&O)[2], const LAS unsigned char* vbuf, int kb, const f32x16& p, int lane) {
    const int hh = lane >> 5, q_ = (lane & 15) >> 2, p_ = lane & 3, cg = (lane >> 4) & 1;
#pragma unroll
    for (int ks2 = 0; ks2 < 2; ++ks2) {
        const bf16x8 pb = pfrag(p, ks2);
#pragma unroll
        for (int db = 0; db < 2; ++db) {
            const int c0 = 32 * db + 16 * cg, ch = (c0 >> 3) + (p_ >> 1);
            const int r0 = 32 * kb + 16 * ks2 + 4 * hh;
            const s16x4 a0 = vtr(vbuf + tile_off(r0 + q_, ch) + 8 * (p_ & 1));
            const s16x4 a1 = vtr(vbuf + tile_off(r0 + 8 + q_, ch) + 8 * (p_ & 1));
            const bf16x8 a = {a0[0], a0[1], a0[2], a0[3], a1[0], a1[1], a1[2], a1[3]};
            O[db] = __builtin_amdgcn_mfma_f32_32x32x16_bf16(a, pb, O[db], 0, 0, 0);
        }
    }
}
template <int S0, int NS>
__device__ __forceinline__ f32x16 qk_block(const LAS unsigned char* kbuf, int kb, const bf16x8 (&Qf)[4], int lane) {
    const int r = lane & 31, hh = lane >> 5;
    f32x16 s = {0.f, 0.f, 0.f, 0.f, 0.f, 0.f, 0.f, 0.f, 0.f, 0.f, 0.f, 0.f, 0.f, 0.f, 0.f, 0.f};
#pragma unroll
    for (int ks = S0; ks < S0 + NS; ++ks) {
        const bf16x8 a = *(const LAS bf16x8*)(kbuf + tile_off(32 * kb + r, 2 * ks + hh));
        s = __builtin_amdgcn_mfma_f32_32x32x16_bf16(a, Qf[ks], s, 0, 0, 0);
    }
    return s;
}
__device__ __forceinline__ bool softmax_step(f32x16& x, float& m, float& l, f32x16 (&O)[2]) {
    float mx = x[0];
#pragma unroll
    for (int i = 1; i < 16; ++i) mx = fmaxf(mx, x[i]);
    mx = pairmax(mx);
    if (__all(mx - m < -64.f)) return false;
    const float mn = fmaxf(m, mx);
    if (!__all(mn == m)) {
        const float alpha = __builtin_amdgcn_exp2f(m - mn);
        l *= alpha;
#pragma unroll
        for (int i = 0; i < 16; ++i) { O[0][i] *= alpha; O[1][i] *= alpha; }
        m = mn;
    }
    float ls = 0.f;
#pragma unroll
    for (int i = 0; i < 16; ++i) { x[i] = __builtin_amdgcn_exp2f(x[i] - m); ls += x[i]; }
    l += ls;
    return true;
}
__device__ __forceinline__ void store_ot(bf16_t* orow, const f32x16 (&O)[2], int hh) {
#pragma unroll
    for (int db = 0; db < 2; ++db)
#pragma unroll
        for (int g = 0; g < 4; ++g) {
            const int d0 = 32 * db + 8 * g + 4 * hh;
            *(uint2*)(orow + d0) = make_uint2(cvtpk(O[db][4 * g], O[db][4 * g + 1]), cvtpk(O[db][4 * g + 2], O[db][4 * g + 3]));
        }
}

struct UnitArgs {
    const bf16_t* qkv;
    bf16_t* out;
    int qcol, kcol, vcol, ocol;
};

struct DilArgs { int dil, rho, pat; bf16_t* po; float* pml; };
template <int TYPE>
__device__ __forceinline__ void causal_unit(const UnitArgs& A, int b, int h, int qb, unsigned char* scratch, int tid,
                                            const float* t5  , float lam, const float* subg, const float* F  , const DilArgs DA = DilArgs{1, 0, 0, nullptr, nullptr}) {
    const LAS unsigned char* lds = (const LAS unsigned char*)scratch;
    LAS unsigned char* ldsw = (LAS unsigned char*)scratch;
    const int lane = tid & 63, w = tid >> 6, r = lane & 31, hh = lane >> 5;
    const int q0 = qb * 256 + 32 * w, tq = q0 + r;
    const size_t rowbase = (size_t)b * SEQ;
    const int ktmax = 4 * qb + 3, kdiag = 4 * qb + (w >> 1);
    const int ktmin = (TYPE == 2) ? (4 * qb - 2 > 0 ? 4 * qb - 2 : 0) : 0;
    const int rs = (TYPE == 2) ? DA.dil : 1, r0off = (TYPE == 2) ? DA.rho : 0;
    const int srow = tid >> 3, sch = tid & 7;
    const bf16_t* kg = A.qkv + (rowbase + r0off + (size_t)rs * srow) * QKV_W + A.kcol + h * 64 + sch * 8;
    const bf16_t* vg = A.qkv + (rowbase + r0off + (size_t)rs * srow) * QKV_W + A.vcol + h * 64 + sch * 8;
    const size_t tstep = (size_t)64 * rs * QKV_W;
    const int soff = tile_off(srow, sch);
    bf16x8 Qf[4];
    {
        const bf16_t* qr = A.qkv + (rowbase + r0off + (size_t)rs * tq) * QKV_W + A.qcol + h * 64 + 8 * hh;
#pragma unroll
        for (int s = 0; s < 4; ++s) Qf[s] = *(const bf16x8*)(qr + 16 * s);
    }
    __syncthreads();
    if ((TYPE == 0 || TYPE == 2) && tid < 128) {
        const float far = t5[31 * 8 + h];
        ((LAS float*)(ldsw + TBUF))[tid] = (t5[t5_bucket(tid) * 8 + h] - far) * LOG2E;
    }
    if (TYPE == 1 && tid == 0) *(LAS unsigned*)(ldsw + CNT) = 0u;
    typedef unsigned u32x4 __attribute__((ext_vector_type(4)));
    u32x4 kreg = *(const u32x4*)(kg + (size_t)ktmax * tstep), vreg = *(const u32x4*)(vg + (size_t)ktmax * tstep);
    float freg = 0.f;
    if (TYPE == 3 && tid < 64) freg = F[(size_t)(b * 8 + h) * SEQ + ktmax * 64 + tid] * LOG2E;
    *(LAS u32x4*)(ldsw + KBUF + soff) = kreg; *(LAS u32x4*)(ldsw + VBUF + soff) = vreg;
    if (TYPE == 3 && tid < 64) ((LAS float*)(ldsw + FBUF))[tid] = freg;
    __syncthreads();

    f32x16 O0[2], O1[2];
#pragma unroll
    for (int i = 0; i < 16; ++i) { O0[0][i] = 0.f; O0[1][i] = 0.f; O1[0][i] = 0.f; O1[1][i] = 0.f; }
    float m0 = NEG, l0 = 0.f, m1 = NEG, l1 = 0.f;
    float R = 0.f;
    bool wdone = false;
    float f2t = 0.f;
    if (TYPE == 3) f2t = F[(size_t)(b * 8 + h) * SEQ + tq] * LOG2E;

    for (int kt = ktmax, it = 0; kt >= ktmin; --kt, ++it) {
        const int cur = it & 1;
        if (kt > ktmin) {
            kreg = *(const u32x4*)(kg + (size_t)(kt - 1) * tstep); vreg = *(const u32x4*)(vg + (size_t)(kt - 1) * tstep);
            if (TYPE == 3 && tid < 64) freg = F[(size_t)(b * 8 + h) * SEQ + (kt - 1) * 64 + tid] * LOG2E;
        }
        const LAS unsigned char* kbuf = lds + KBUF + cur * 8192;
        const LAS unsigned char* vbuf = lds + VBUF + cur * 8192;
        if (kt <= kdiag && !wdone) {
#pragma unroll
            for (int kbi = 0; kbi < 2; ++kbi) {
                const int kb = 1 - kbi;
                const int key0 = kt * 64 + kb * 32;
                if (TYPE == 1 ? (key0 >= q0 + 31) : (key0 > q0 + 31)) continue;
                if (TYPE == 2 && key0 + 31 < q0 - 128) continue;
                const bool need_mask = (TYPE == 1) ? (key0 + 31 >= q0) : (key0 + 31 > q0);
                if (TYPE == 0) {
                    f32x16 x0 = qk_block<0, 2>(kbuf, kb, Qf, lane), x1 = qk_block<2, 2>(kbuf, kb, Qf, lane);
                    if (q0 - (key0 + 31) < 113) {
                        const LAS float* tb = (const LAS float*)(lds + TBUF);
#pragma unroll
                        for (int i = 0; i < 16; ++i) {
                            const int dist = tq - (key0 + key_of(i, hh));
                            const float bv = (dist >= 0 && dist < 128) ? tb[dist < 0 ? 0 : (dist > 127 ? 127 : dist)] : 0.f;
                            x0[i] = dist < 0 ? NEG : x0[i] + bv; x1[i] = dist < 0 ? NEG : x1[i] + bv;
                        }
                    }
                    if (softmax_step(x0, m0, l0, O0)) pv_block(O0, vbuf, kb, x0, lane);
                    if (softmax_step(x1, m1, l1, O1)) pv_block(O1, vbuf, kb, x1, lane);
                } else if (TYPE == 2) {
                    f32x16 x = qk_block<0, 4>(kbuf, kb, Qf, lane);
                    const LAS float* tb = (const LAS float*)(lds + TBUF);
#pragma unroll
                    for (int i = 0; i < 16; ++i) {
                        const int dist = tq - (key0 + key_of(i, hh));
                        int bi = dist * rs; bi = bi < 0 ? 0 : (bi > 127 ? 127 : bi);
                        x[i] = (dist >= 0 && dist <= 128) ? x[i] + tb[bi] : NEG;
                    }
                    if (softmax_step(x, m0, l0, O0)) pv_block(O0, vbuf, kb, x, lane);
                } else if (TYPE == 3) {
                    f32x16 x = qk_block<0, 4>(kbuf, kb, Qf, lane);
                    const LAS float* fb = (const LAS float*)(lds + FBUF + cur * 256);
#pragma unroll
                    for (int g = 0; g < 4; ++g) {
                        const f32x4 fv = *(const LAS f32x4*)(fb + 32 * kb + 8 * g + 4 * hh);
#pragma unroll
                        for (int j = 0; j < 4; ++j) x[4 * g + j] += f2t - fv[j];
                    }
                    if (need_mask) {
#pragma unroll
                        for (int i = 0; i < 16; ++i) x[i] = (key0 + key_of(i, hh) > tq) ? NEG : x[i];
                    }
                    if (softmax_step(x, m0, l0, O0)) pv_block(O0, vbuf, kb, x, lane);
                } else {
                    f32x16 z = qk_block<0, 4>(kbuf, kb, Qf, lane);
                    f32x16 lr;
#pragma unroll
                    for (int i = 0; i < 16; ++i) {
                        const float e = __builtin_amdgcn_exp2f(-fabsf(z[i]));
                        float v = -(fmaxf(z[i], 0.f) + __builtin_amdgcn_logf(1.f + e));
                        if (need_mask) v = (key0 + key_of(i, hh) >= tq) ? 0.f : v;
                        lr[i] = v;
                    }
                    float T[4], Tp[4], sfx[16];
#pragma unroll
                    for (int g = 0; g < 4; ++g) {
                        sfx[4 * g + 3] = 0.f; sfx[4 * g + 2] = lr[4 * g + 3]; sfx[4 * g + 1] = sfx[4 * g + 2] + lr[4 * g + 2]; sfx[4 * g] = sfx[4 * g + 1] + lr[4 * g + 1];
                        T[g] = sfx[4 * g] + lr[4 * g];
                        Tp[g] = xhalf(T[g], hh);
                    }
                    float SP[4];
                    SP[3] = 0.f; SP[2] = T[3] + Tp[3]; SP[1] = SP[2] + T[2] + Tp[2]; SP[0] = SP[1] + T[1] + Tp[1];
                    const float tot = SP[0] + T[0] + Tp[0];
                    const float msel = hh == 0 ? 1.f : 0.f;
#pragma unroll
                    for (int g = 0; g < 4; ++g) {
                        const float goff = R + SP[g] + msel * Tp[g];
#pragma unroll
                        for (int j = 0; j < 4; ++j) {
                            const int i = 4 * g + j;
                            float wv = __builtin_amdgcn_exp2f(lr[i] + z[i] + goff + sfx[i]);
                            if (need_mask) wv = (key0 + key_of(i, hh) >= tq) ? 0.f : wv;
                            z[i] = wv;
                        }
                    }
                    R += tot;
                    pv_block(O0, vbuf, kb, z, lane);
                }
            }
            if (TYPE == 1) {
                if (__all(R < -216.4f)) { wdone = true; if (lane == 0) (void)__hip_atomic_fetch_add((LAS unsigned*)(ldsw + CNT), 1u, __ATOMIC_RELAXED, __HIP_MEMORY_SCOPE_WORKGROUP); }
            }
        }
        if (kt > ktmin) {
            *(LAS u32x4*)(ldsw + KBUF + (cur ^ 1) * 8192 + soff) = kreg; *(LAS u32x4*)(ldsw + VBUF + (cur ^ 1) * 8192 + soff) = vreg;
            if (TYPE == 3 && tid < 64) ((LAS float*)(ldsw + FBUF + (cur ^ 1) * 256))[tid] = freg;
        }
        __syncthreads();
        if (TYPE == 1) { const unsigned cnt = *(const LAS unsigned*)(lds + CNT); __syncthreads(); if (cnt == 8u) break; }
    }
    if (TYPE == 2) {
        const size_t prow = ((size_t)DA.pat * NT + rowbase + r0off + (size_t)rs * tq) * 8 + h;
        store_ot(DA.po + prow * 64, O0, hh);
        const float lt = pairsum(l0);
        if (hh == 0) *(float2*)(DA.pml + prow * 2) = make_float2(m0, lt);
        return;
    }
    bf16_t* orow = A.out + (rowbase + tq) * DM + A.ocol + h * 64;
    if (TYPE == 0) {
        const float i0 = 1.f / pairsum(l0), i1 = lam / pairsum(l1);
        float ss = 0.f;
#pragma unroll
        for (int db = 0; db < 2; ++db)
#pragma unroll
            for (int i = 0; i < 16; ++i) { const float o = O0[db][i] * i0 - O1[db][i] * i1; O0[db][i] = o; ss = fmaf(o, o, ss); }
        ss = pairsum(ss);
        const float rn = rsqrtf(ss * (1.f / 64.f) + LN_EPS) * 0.8f;
#pragma unroll
        for (int db = 0; db < 2; ++db)
#pragma unroll
            for (int i = 0; i < 16; ++i) O0[db][i] *= rn * subg[32 * db + key_of(i, hh)];
        store_ot(orow, O0, hh);
    } else if (TYPE == 3) {
        const float i0 = 1.f / pairsum(l0);
#pragma unroll
        for (int db = 0; db < 2; ++db)
#pragma unroll
            for (int i = 0; i < 16; ++i) O0[db][i] *= i0;
        store_ot(orow, O0, hh);
    } else {
        store_ot(orow, O0, hh);
    }
}
}

__device__ __forceinline__ int xcd_perm256(int p) { return (p & 7) * 32 + (p >> 3); }

__device__ __forceinline__ void attn_layer0_mfma(const Ctx& c, const bf16_t* qkv, bf16_t* out, const float* t5, const float* lamv, const float* subg) {
    float s01 = 0.f, s23 = 0.f;
    for (int i = 0; i < 32; ++i) { s01 += lamv[i] * lamv[32 + i]; s23 += lamv[64 + i] * lamv[96 + i]; }
    const float lam = expf(s01) - expf(s23) + 0.2f;
    unsigned char* scratch = (unsigned char*)c.lds;
    const att::UnitArgs UA{qkv, out, 0, 512, 1024, 0}, UB{qkv, out, 1536, 2048, 2560, 512};
    for (int p = c.bid; p < 256; p += c.nblk) {
        const int pp = xcd_perm256(p), bh = pp >> 3, qb = pp & 7;
        att::causal_unit<0>(UA, bh >> 3, bh & 7, 15 - qb, scratch, c.tid, t5, lam, subg, nullptr);
        att::causal_unit<0>(UA, bh >> 3, bh & 7, qb, scratch, c.tid, t5, lam, subg, nullptr);
#pragma unroll 1
        for (int k = 0; k < 2; ++k) {
            const int u = pp * 2 + k, bh2 = u >> 4, qb2 = u & 15;
            att::causal_unit<1>(UB, bh2 >> 3, bh2 & 7, qb2, scratch, c.tid, nullptr, 0.f, nullptr, nullptr);
        }
    }
}
__device__ __forceinline__ void attn_dilated_mfma(const Ctx& c, const bf16_t* qkv, const float* t5, bf16_t* po, float* pml) {
    unsigned char* scratch = (unsigned char*)c.lds;
    const att::UnitArgs UC{qkv, nullptr, 0, 512, 1024, 0};
    for (int p = c.bid; p < 256; p += c.nblk) {
        const int pp = xcd_perm256(p);
#pragma unroll 1
        for (int k = 0; k < 6; ++k) {
            const int u = pp * 6 + k, bh = u / 48, v = u % 48;
            int pat, rho, qb, dil;
            if (v < 16) { pat = 0; dil = 1; rho = 0; qb = v; }
            else if (v < 32) { pat = 1; dil = 4; rho = (v - 16) >> 2; qb = (v - 16) & 3; }
            else { pat = 2; dil = 16; rho = v - 32; qb = 0; }
            att::causal_unit<2>(UC, bh >> 3, bh & 7, qb, scratch, c.tid, t5, 0.f, nullptr, nullptr, att::DilArgs{dil, rho, pat, po, pml});
        }
    }
}
__device__ __forceinline__ void dilated_combine(const Ctx& c, const bf16_t* po, const float* pml, bf16_t* out) {
    const size_t n = (size_t)NT * 8 * 8;
    for (size_t i = (size_t)c.gwave * 64 + c.lane; i < n; i += (size_t)c.nwaves * 64) {
        const size_t th = i >> 3; const int ch = (int)(i & 7);
        float m[3], l[3];
#pragma unroll
        for (int p = 0; p < 3; ++p) { const float2 ml = *(const float2*)(pml + ((size_t)p * NT * 8 + th) * 2); m[p] = ml.x; l[p] = ml.y; }
        const float mm = fmaxf(m[0], fmaxf(m[1], m[2]));
        float wgt[3], den = 0.f;
#pragma unroll
        for (int p = 0; p < 3; ++p) { wgt[p] = __builtin_amdgcn_exp2f(m[p] - mm); den += wgt[p] * l[p]; }
        const float inv = 1.f / den;
        float o[8];
#pragma unroll
        for (int d = 0; d < 8; ++d) o[d] = 0.f;
#pragma unroll
        for (int p = 0; p < 3; ++p) {
            const uint4 v = *(const uint4*)(po + ((size_t)p * NT * 8 + th) * 64 + ch * 8);
            const unsigned w4[4] = {v.x, v.y, v.z, v.w};
#pragma unroll
            for (int q = 0; q < 4; ++q) { o[2 * q] = fmaf(wgt[p], __builtin_bit_cast(float, w4[q] << 16), o[2 * q]); o[2 * q + 1] = fmaf(wgt[p], __builtin_bit_cast(float, w4[q] & 0xffff0000u), o[2 * q + 1]); }
        }
        uint4 ov; ov.x = pk2(o[0] * inv, o[1] * inv); ov.y = pk2(o[2] * inv, o[3] * inv); ov.z = pk2(o[4] * inv, o[5] * inv); ov.w = pk2(o[6] * inv, o[7] * inv);
        const size_t tok = th >> 3; const int hd = (int)(th & 7);
        *(uint4*)(out + tok * DM + hd * 64 + ch * 8) = ov;
    }
}
__device__ __forceinline__ void attn_fox_mfma(const Ctx& c, const bf16_t* qkv, const float* F, bf16_t* out) {
    unsigned char* scratch = (unsigned char*)c.lds;
    const att::UnitArgs UD{qkv, out, 1536, 2048, 2560, 512};
    for (int p = c.bid; p < 256; p += c.nblk) {
        const int pp = xcd_perm256(p), bh = pp >> 3, qb = pp & 7;
        att::causal_unit<3>(UD, bh >> 3, bh & 7, 15 - qb, scratch, c.tid, nullptr, 0.f, nullptr, F);
        att::causal_unit<3>(UD, bh >> 3, bh & 7, qb, scratch, c.tid, nullptr, 0.f, nullptr, F);
    }
}

__device__ __forceinline__ void ln_rows(const Ctx& c, const float* hin32, const bf16_t* hin16, const bf16_t* add16, const float* g, const float* bta, float* out, bf16_t* outb, unsigned char* out8 = nullptr, float* oscale = nullptr) {
    for (int t = c.gwave; t < NT; t += c.nwaves) {
        float v[16];
        float s = 0.f;
#pragma unroll
        for (int r = 0; r < 4; ++r) {
            const int d = r * 256 + c.lane * 4;
            float4 a;
            if (hin32) a = *(const float4*)(hin32 + (size_t)t * DM + d);
            else { const uint2 w = *(const uint2*)(hin16 + (size_t)t * DM + d); a = make_float4(__builtin_bit_cast(float, w.x << 16), __builtin_bit_cast(float, w.x & 0xffff0000u), __builtin_bit_cast(float, w.y << 16), __builtin_bit_cast(float, w.y & 0xffff0000u)); }
            const uint2 mw = *(const uint2*)(add16 + (size_t)t * DM + d);
            const float4 m = make_float4(__builtin_bit_cast(float, mw.x << 16), __builtin_bit_cast(float, mw.x & 0xffff0000u), __builtin_bit_cast(float, mw.y << 16), __builtin_bit_cast(float, mw.y & 0xffff0000u));
            v[r * 4 + 0] = DN_ALPHA * a.x + m.x; v[r * 4 + 1] = DN_ALPHA * a.y + m.y; v[r * 4 + 2] = DN_ALPHA * a.z + m.z; v[r * 4 + 3] = DN_ALPHA * a.w + m.w;
            s += v[r * 4] + v[r * 4 + 1] + v[r * 4 + 2] + v[r * 4 + 3];
        }
        const float mu = wave_sum(s) * (1.f / DM);
        float q = 0.f;
#pragma unroll
        for (int i = 0; i < 16; ++i) { v[i] -= mu; q = fmaf(v[i], v[i], q); }
        const float rs = rsqrtf(wave_sum(q) * (1.f / DM) + LN_EPS);
        float amax = 0.f;
#pragma unroll
        for (int r = 0; r < 4; ++r) {
            const int d = r * 256 + c.lane * 4;
            const float4 gg = *(const float4*)(g + d), bb = *(const float4*)(bta + d);
            const float4 o = make_float4(v[r * 4] * rs * gg.x + bb.x, v[r * 4 + 1] * rs * gg.y + bb.y, v[r * 4 + 2] * rs * gg.z + bb.z, v[r * 4 + 3] * rs * gg.w + bb.w);
            if (out) *(float4*)(out + (size_t)t * DM + d) = o;
            if (outb) *(uint2*)(outb + (size_t)t * DM + d) = make_uint2(pk2(o.x, o.y), pk2(o.z, o.w));
            v[r * 4] = o.x; v[r * 4 + 1] = o.y; v[r * 4 + 2] = o.z; v[r * 4 + 3] = o.w;
            amax = fmaxf(amax, fmaxf(fmaxf(fabsf(o.x), fabsf(o.y)), fmaxf(fabsf(o.z), fabsf(o.w))));
        }
        if (out8) {
#pragma unroll
            for (int o = 32; o >= 1; o >>= 1) amax = fmaxf(amax, shx(amax, o, c.lane));
            int e = (int)((__builtin_bit_cast(unsigned, amax) >> 23) & 0xffu) - 127;
            e = e < -100 ? -100 : (e > 100 ? 100 : e);
            const float sc = __builtin_bit_cast(float, (unsigned)(127 + 7 - e) << 23);
#pragma unroll
            for (int r = 0; r < 4; ++r) {
                int w = 0;
                w = __builtin_amdgcn_cvt_pk_fp8_f32(v[r * 4] * sc, v[r * 4 + 1] * sc, w, false); w = __builtin_amdgcn_cvt_pk_fp8_f32(v[r * 4 + 2] * sc, v[r * 4 + 3] * sc, w, true);
                *(int*)(out8 + (size_t)t * DM + r * 256 + c.lane * 4) = w;
            }
            if (c.lane == 0) oscale[t] = __builtin_bit_cast(float, (unsigned)(127 - 7 + e) << 23);
        }
    }
}

__device__ __forceinline__ void topk_insert(float (&tv)[16], int (&ti)[16], float v, int id) {
#pragma unroll
    for (int j = 15; j >= 1; --j) {
        const bool g = v > tv[j], gp = v > tv[j - 1];
        tv[j] = g ? (gp ? tv[j - 1] : v) : tv[j];
        ti[j] = g ? (gp ? ti[j - 1] : id) : ti[j];
    }
    const bool g0 = v > tv[0];
    tv[0] = g0 ? v : tv[0]; ti[0] = g0 ? id : ti[0];
}

namespace rt {
typedef short bf16x8 __attribute__((ext_vector_type(8)));
typedef float f32x16 __attribute__((ext_vector_type(16)));
__device__ __forceinline__ float pk_bits(float v, unsigned low, unsigned mask) { return __builtin_bit_cast(float, (__builtin_bit_cast(unsigned, v) & ~mask) | low); }
__device__ __forceinline__ void ce_desc(float& a, float& b) { const float hi = fmaxf(a, b), lo = fminf(a, b); a = hi; b = lo; }
__device__ __forceinline__ void sort16(float (&a)[16]) {
#pragma unroll
    for (int k = 2; k <= 16; k <<= 1)
#pragma unroll
        for (int j = k >> 1; j >= 1; j >>= 1)
#pragma unroll
            for (int i = 0; i < 16; ++i) { const int l = i ^ j; if (l > i) { if ((i & k) == 0) ce_desc(a[i], a[l]); else ce_desc(a[l], a[i]); } }
}
__device__ __forceinline__ void merge_top16(float (&a)[16], const float (&b)[16]) {
#pragma unroll
    for (int i = 0; i < 16; ++i) a[i] = fmaxf(a[i], b[15 - i]);
#pragma unroll
    for (int j = 8; j >= 1; j >>= 1)
#pragma unroll
        for (int i = 0; i < 16; ++i) { const int l = i ^ j; if (l > i) ce_desc(a[i], a[l]); }
}
__device__ __forceinline__ void top16_of_set(float (&tv)[16], const bf16_t* pq_row  , const LAS unsigned char* keys  , int r, int hh) {
    bf16x8 B[8];
#pragma unroll
    for (int s = 0; s < 8; ++s) B[s] = *(const bf16x8*)(pq_row + 16 * s);
#pragma unroll 1
    for (int blk = 0; blk < 4; ++blk) {
        const LAS unsigned char* kr = keys + (32 * blk + r) * 272 + 16 * hh;
        f32x16 acc = {0.f, 0.f, 0.f, 0.f, 0.f, 0.f, 0.f, 0.f, 0.f, 0.f, 0.f, 0.f, 0.f, 0.f, 0.f, 0.f};
#pragma unroll
        for (int s = 0; s < 8; ++s) acc = __builtin_amdgcn_mfma_f32_32x32x16_bf16(*(const LAS bf16x8*)(kr + 32 * s), B[s], acc, 0, 0, 0);
        float cur[16];
#pragma unroll
        for (int i = 0; i < 16; ++i) cur[i] = pk_bits(acc[i], (unsigned)(32 * blk + 8 * (i >> 2) + 4 * hh + (i & 3)), 127u);
        sort16(cur);
        if (blk == 0) {
#pragma unroll
            for (int i = 0; i < 16; ++i) tv[i] = cur[i];
        } else merge_top16(tv, cur);
    }
    float pt[16];
#pragma unroll
    for (int j = 0; j < 16; ++j) pt[j] = shx(tv[j], 32, r + 32 * hh);
    merge_top16(tv, pt);
}
}

__device__ __forceinline__ void peer_route_phase(const Ctx& c, const bf16_t* pq, const bf16_t* subk  , int* eidx, float* gate) {
    const int lane = c.lane, r = lane & 31, hh = lane >> 5;
    typedef unsigned u32x4_t __attribute__((ext_vector_type(4)));
    LAS unsigned char* kl = (LAS unsigned char*)c.lds;
    LAS unsigned char* idt = kl + 256 * 272 + c.tid * 32;
    for (int vb = c.bid; vb < 256; vb += c.nblk) {
        const int h = vb & 7, rng = vb >> 3;
        __syncthreads();
        for (int idx = c.tid; idx < 256 * 16; idx += NTHREADS) {
            const int row = idx >> 4, ch = idx & 15;
            *(LAS u32x4_t*)(kl + row * 272 + ch * 16) = *(const u32x4_t*)(subk + ((size_t)(2 * h) * 128 + row) * 128 + ch * 8);
        }
        __syncthreads();
#pragma unroll 1
        for (int k2 = 0; k2 < 2; ++k2) {
            const int t = (rng * 16 + c.wave + 8 * k2) * 32 + r;
            float la[16], lb[16];
            rt::top16_of_set(la, pq + (size_t)t * PEER_QW + (2 * h) * 128 + 8 * hh, kl, r, hh);
            rt::top16_of_set(lb, pq + (size_t)t * PEER_QW + (2 * h + 1) * 128 + 8 * hh, kl + 128 * 272, r, hh);
            unsigned ida[4] = {0u, 0u, 0u, 0u}, idb[4] = {0u, 0u, 0u, 0u};
#pragma unroll
            for (int i = 0; i < 16; ++i) {
                ida[i >> 2] |= (__builtin_bit_cast(unsigned, la[i]) & 127u) << (8 * (i & 3)); idb[i >> 2] |= (__builtin_bit_cast(unsigned, lb[i]) & 127u) << (8 * (i & 3));
                la[i] = rt::pk_bits(la[i], 0u, 127u); lb[i] = rt::pk_bits(lb[i], 0u, 127u);
            }
            *(LAS u32x4_t*)idt = (u32x4_t){ida[0], ida[1], ida[2], ida[3]}; *(LAS u32x4_t*)(idt + 16) = (u32x4_t){idb[0], idb[1], idb[2], idb[3]};
            float tv[16], g[16];
#define RT_CAND(n) ((n) < 16 ? rt::pk_bits(la[0] + lb[(n)], (unsigned)(n), 255u) : (n) < 24 ? rt::pk_bits(la[1] + lb[(n) - 16], 16u + (unsigned)((n) - 16), 255u) : (n) < 29 ? rt::pk_bits(la[2] + lb[(n) - 24], 32u + (unsigned)((n) - 24), 255u) : \
                    (n) < 33 ? rt::pk_bits(la[3] + lb[(n) - 29], 48u + (unsigned)((n) - 29), 255u) : (n) < 36 ? rt::pk_bits(la[4] + lb[(n) - 33], 64u + (unsigned)((n) - 33), 255u) : (n) < 38 ? rt::pk_bits(la[5] + lb[(n) - 36], 80u + (unsigned)((n) - 36), 255u) : \
                    (n) < 40 ? rt::pk_bits(la[6] + lb[(n) - 38], 96u + (unsigned)((n) - 38), 255u) : (n) < 42 ? rt::pk_bits(la[7] + lb[(n) - 40], 112u + (unsigned)((n) - 40), 255u) : (n) < 50 ? rt::pk_bits(la[8 + (n) - 42] + lb[0], (unsigned)(8 + (n) - 42) << 4, 255u) : -INFINITY)
#pragma unroll
            for (int n = 0; n < 16; ++n) tv[n] = RT_CAND(n);
            rt::sort16(tv);
#pragma unroll
            for (int n = 0; n < 16; ++n) g[n] = RT_CAND(16 + n);
            rt::sort16(g); rt::merge_top16(tv, g);
#pragma unroll
            for (int n = 0; n < 16; ++n) g[n] = RT_CAND(32 + n);
            rt::sort16(g); rt::merge_top16(tv, g);
#pragma unroll
            for (int n = 0; n < 16; ++n) g[n] = RT_CAND(48 + n);
            rt::sort16(g); rt::merge_top16(tv, g);
#undef RT_CAND
            asm volatile("s_waitcnt lgkmcnt(0)" ::: "memory");
            int ti[16]; float e[16]; float sum = 0.f;
            const float top = rt::pk_bits(tv[0], 0u, 255u);
#pragma unroll
            for (int n = 0; n < 16; ++n) {
                const unsigned bits = __builtin_bit_cast(unsigned, tv[n]);
                const int ci = (int)((bits >> 4) & 15u), cj = (int)(bits & 15u);
                ti[n] = (int)idt[ci] * 128 + (int)idt[16 + cj];
                e[n] = expf(rt::pk_bits(tv[n], 0u, 255u) - top); sum += e[n];
            }
            const float inv = 1.f / sum;
            if (hh == 0) {
                int* oi = eidx + ((size_t)t * 8 + h) * 16; float* og = gate + ((size_t)t * 8 + h) * 16;
#pragma unroll
                for (int n = 0; n < 16; n += 4) {
                    *(int4*)(oi + n) = make_int4(ti[n], ti[n + 1], ti[n + 2], ti[n + 3]);
                    *(float4*)(og + n) = make_float4(e[n] * inv, e[n + 1] * inv, e[n + 2] * inv, e[n + 3] * inv);
                }
            }
        }
    }
}

typedef unsigned u32x4_t __attribute__((ext_vector_type(4)));
typedef float f32x2_t __attribute__((ext_vector_type(2)));
#define GAS __attribute__((address_space(1)))
__device__ __forceinline__ float gelu_exact(float d) { return 0.5f * d * (1.f + erff(d * 0.70710678118654752f)); }

template <int MODE>
__device__ __forceinline__ void cvt_rows_fp8(const Ctx& c, const float* src, unsigned char* dst, float* rowscale, int nrows) {
    for (int row = c.gwave; row < nrows; row += c.nwaves) {
        const float* s = src + (size_t)row * DM + c.lane * 16;
        const float4 a0 = *(const float4*)s, a1 = *(const float4*)(s + 4), a2 = *(const float4*)(s + 8), a3 = *(const float4*)(s + 12);
        float am = fmaxf(fmaxf(fmaxf(fabsf(a0.x), fabsf(a0.y)), fmaxf(fabsf(a0.z), fabsf(a0.w))), fmaxf(fmaxf(fabsf(a1.x), fabsf(a1.y)), fmaxf(fabsf(a1.z), fabsf(a1.w))));
        am = fmaxf(am, fmaxf(fmaxf(fmaxf(fabsf(a2.x), fabsf(a2.y)), fmaxf(fabsf(a2.z), fabsf(a2.w))), fmaxf(fmaxf(fabsf(a3.x), fabsf(a3.y)), fmaxf(fabsf(a3.z), fabsf(a3.w)))));
#pragma unroll
        for (int o = 32; o >= 1; o >>= 1) am = fmaxf(am, shx(am, o, c.lane));
        int e = (int)((__builtin_bit_cast(unsigned, am) >> 23) & 0xffu) - 127;
        e = e < -100 ? -100 : (e > 100 ? 100 : e);
        const float sc = __builtin_bit_cast(float, (unsigned)(127 + 7 - e) << 23), inv = __builtin_bit_cast(float, (unsigned)(127 - 7 + e) << 23);
        int w0 = 0, w1 = 0, w2 = 0, w3 = 0;
        w0 = __builtin_amdgcn_cvt_pk_fp8_f32(a0.x * sc, a0.y * sc, w0, false); w0 = __builtin_amdgcn_cvt_pk_fp8_f32(a0.z * sc, a0.w * sc, w0, true);
        w1 = __builtin_amdgcn_cvt_pk_fp8_f32(a1.x * sc, a1.y * sc, w1, false); w1 = __builtin_amdgcn_cvt_pk_fp8_f32(a1.z * sc, a1.w * sc, w1, true);
        w2 = __builtin_amdgcn_cvt_pk_fp8_f32(a2.x * sc, a2.y * sc, w2, false); w2 = __builtin_amdgcn_cvt_pk_fp8_f32(a2.z * sc, a2.w * sc, w2, true);
        w3 = __builtin_amdgcn_cvt_pk_fp8_f32(a3.x * sc, a3.y * sc, w3, false); w3 = __builtin_amdgcn_cvt_pk_fp8_f32(a3.z * sc, a3.w * sc, w3, true);
        const int lyr = row >> 14, er = row & 16383;
        unsigned char* dp = MODE == 0 ? dst + ((size_t)lyr * 16384 + (size_t)(er & 7) * 2048 + (er >> 3)) * DM + c.lane * 16
                                      : dst + (size_t)lyr * 16384 * DM + (size_t)(c.lane >> 3) * (16384 * 128) + (size_t)er * 128 + (c.lane & 7) * 16;
        *(uint4*)dp = make_uint4((unsigned)w0, (unsigned)w1, (unsigned)w2, (unsigned)w3);
        if (c.lane == 0) rowscale[row] = inv;
    }
}
__device__ __forceinline__ float dot16_fp8(const u32x4_t w, const float (&x)[16], float acc) {
    const int w0 = (int)w.x, w1 = (int)w.y, w2 = (int)w.z, w3 = (int)w.w;
    f32x2_t p;
    p = __builtin_amdgcn_cvt_pk_f32_fp8(w0, false); acc = fmaf(p.x, x[0], acc); acc = fmaf(p.y, x[1], acc);
    p = __builtin_amdgcn_cvt_pk_f32_fp8(w0, true);  acc = fmaf(p.x, x[2], acc); acc = fmaf(p.y, x[3], acc);
    p = __builtin_amdgcn_cvt_pk_f32_fp8(w1, false); acc = fmaf(p.x, x[4], acc); acc = fmaf(p.y, x[5], acc);
    p = __builtin_amdgcn_cvt_pk_f32_fp8(w1, true);  acc = fmaf(p.x, x[6], acc); acc = fmaf(p.y, x[7], acc);
    p = __builtin_amdgcn_cvt_pk_f32_fp8(w2, false); acc = fmaf(p.x, x[8], acc); acc = fmaf(p.y, x[9], acc);
    p = __builtin_amdgcn_cvt_pk_f32_fp8(w2, true);  acc = fmaf(p.x, x[10], acc); acc = fmaf(p.y, x[11], acc);
    p = __builtin_amdgcn_cvt_pk_f32_fp8(w3, false); acc = fmaf(p.x, x[12], acc); acc = fmaf(p.y, x[13], acc);
    p = __builtin_amdgcn_cvt_pk_f32_fp8(w3, true);  acc = fmaf(p.x, x[14], acc); acc = fmaf(p.y, x[15], acc);
    return acc;
}
__device__ __forceinline__ void axpy16_fp8(const u32x4_t w, float cv, float (&acc)[16]) {
    const int w0 = (int)w.x, w1 = (int)w.y, w2 = (int)w.z, w3 = (int)w.w;
    f32x2_t p;
    p = __builtin_amdgcn_cvt_pk_f32_fp8(w0, false); acc[0] = fmaf(cv, p.x, acc[0]); acc[1] = fmaf(cv, p.y, acc[1]);
    p = __builtin_amdgcn_cvt_pk_f32_fp8(w0, true);  acc[2] = fmaf(cv, p.x, acc[2]); acc[3] = fmaf(cv, p.y, acc[3]);
    p = __builtin_amdgcn_cvt_pk_f32_fp8(w1, false); acc[4] = fmaf(cv, p.x, acc[4]); acc[5] = fmaf(cv, p.y, acc[5]);
    p = __builtin_amdgcn_cvt_pk_f32_fp8(w1, true);  acc[6] = fmaf(cv, p.x, acc[6]); acc[7] = fmaf(cv, p.y, acc[7]);
    p = __builtin_amdgcn_cvt_pk_f32_fp8(w2, false); acc[8] = fmaf(cv, p.x, acc[8]); acc[9] = fmaf(cv, p.y, acc[9]);
    p = __builtin_amdgcn_cvt_pk_f32_fp8(w2, true);  acc[10] = fmaf(cv, p.x, acc[10]); acc[11] = fmaf(cv, p.y, acc[11]);
    p = __builtin_amdgcn_cvt_pk_f32_fp8(w3, false); acc[12] = fmaf(cv, p.x, acc[12]); acc[13] = fmaf(cv, p.y, acc[13]);
    p = __builtin_amdgcn_cvt_pk_f32_fp8(w3, true);  acc[14] = fmaf(cv, p.x, acc[14]); acc[15] = fmaf(cv, p.y, acc[15]);
}

__device__ __forceinline__ void peer_u_phase(const Ctx& c, const bf16_t* h1b_, const int* eidx_, const unsigned char* U8_, float* P) {
    const GAS bf16_t* h1b = (const GAS bf16_t*)h1b_; const GAS int* eidx = (const GAS int*)eidx_; const GAS unsigned char* U8 = (const GAS unsigned char*)U8_;
    const int lane = c.lane, sg = lane >> 3, part = lane & 7;
    typedef int i32x4_t __attribute__((ext_vector_type(4)));
    typedef float f32x4_t __attribute__((ext_vector_type(4)));
    for (int vb = c.bid; vb < 256; vb += c.nblk) {
        const int j = vb & 7, rnk = vb >> 3;
        const int t0 = rnk * 512 + c.wave * 64;
        i32x4_t e[4];
        u32x4_t rA[8], rB[8];
#pragma unroll
        for (int q = 0; q < 4; ++q) e[q] = *(const GAS i32x4_t*)(eidx + (size_t)t0 * 128 + sg * 16 + 4 * q);
        const GAS unsigned char* ubase = U8 + (size_t)j * (16384 * 128) + part * 16;
        const GAS bf16_t* xbase = h1b + 128 * j + part * 16;
#pragma unroll
        for (int it = 0; it < 8; ++it) rA[it] = *(const GAS u32x4_t*)(ubase + (size_t)e[it >> 2][it & 3] * 128);
        u32x4_t xa = *(const GAS u32x4_t*)(xbase + (size_t)t0 * DM), xb = *(const GAS u32x4_t*)(xbase + (size_t)t0 * DM + 8);
#pragma unroll 1
        for (int i = 0; i < 64; ++i) {
            const int t = t0 + i, tn = t0 + (i < 63 ? i + 1 : 63);
#pragma unroll
            for (int it = 0; it < 8; ++it) rB[it] = *(const GAS u32x4_t*)(ubase + (size_t)e[2 + (it >> 2)][it & 3] * 128);
#pragma unroll
            for (int q = 0; q < 4; ++q) e[q] = *(const GAS i32x4_t*)(eidx + (size_t)tn * 128 + sg * 16 + 4 * q);
            float x[16];
            {
                const unsigned w[8] = {xa.x, xa.y, xa.z, xa.w, xb.x, xb.y, xb.z, xb.w};
#pragma unroll
                for (int z = 0; z < 8; ++z) { x[2 * z] = __builtin_bit_cast(float, w[z] << 16); x[2 * z + 1] = __builtin_bit_cast(float, w[z] & 0xffff0000u); }
            }
            xa = *(const GAS u32x4_t*)(xbase + (size_t)tn * DM); xb = *(const GAS u32x4_t*)(xbase + (size_t)tn * DM + 8);
            float dsum[16];
#pragma unroll
            for (int it = 0; it < 8; ++it) dsum[it] = dot16_fp8(rA[it], x, 0.f);
#pragma unroll
            for (int it = 0; it < 8; ++it) rA[it] = *(const GAS u32x4_t*)(ubase + (size_t)e[it >> 2][it & 3] * 128);
#pragma unroll
            for (int it = 0; it < 8; ++it) dsum[8 + it] = dot16_fp8(rB[it], x, 0.f);
            float d8[8], d4[4], d2[2];
            { const bool hb = (part & 4) != 0;
#pragma unroll
              for (int z = 0; z < 8; ++z) d8[z] = (hb ? dsum[8 + z] : dsum[z]) + shx(hb ? dsum[z] : dsum[8 + z], 4, lane); }
            { const bool hb = (part & 2) != 0;
#pragma unroll
              for (int z = 0; z < 4; ++z) d4[z] = (hb ? d8[4 + z] : d8[z]) + shx(hb ? d8[z] : d8[4 + z], 2, lane); }
            { const bool hb = (part & 1) != 0;
#pragma unroll
              for (int z = 0; z < 2; ++z) d2[z] = (hb ? d4[2 + z] : d4[z]) + shx(hb ? d4[z] : d4[2 + z], 1, lane); }
            *(float2*)(P + ((size_t)j * NT + t) * 128 + sg * 16 + 2 * part) = make_float2(d2[0], d2[1]);
        }
    }
}
__device__ __forceinline__ void peer_coef_phase(const Ctx& c, const float* P_, const int* eidx_, const float* gate_, const float* rsu_, const float* rsv_, float* coef) {
    const GAS float* P = (const GAS float*)P_; const GAS int* eidx = (const GAS int*)eidx_; const GAS float* gate = (const GAS float*)gate_;
    const GAS float* rsu = (const GAS float*)rsu_; const GAS float* rsv = (const GAS float*)rsv_;
    typedef int i32x4_t __attribute__((ext_vector_type(4)));
    typedef float f32x4_t __attribute__((ext_vector_type(4)));
    const size_t n4 = (size_t)NT * 128 / 4;
    for (size_t i = (size_t)c.gwave * 64 + c.lane; i < n4; i += (size_t)c.nwaves * 64) {
        f32x4_t s = *(const GAS f32x4_t*)(P + i * 4);
#pragma unroll
        for (int j = 1; j < 8; ++j) s += *(const GAS f32x4_t*)(P + (size_t)j * NT * 128 + i * 4);
        const i32x4_t e = *(const GAS i32x4_t*)(eidx + i * 4);
        const f32x4_t g = *(const GAS f32x4_t*)(gate + i * 4);
        f32x4_t o;
#pragma unroll
        for (int q = 0; q < 4; ++q) o[q] = g[q] * gelu_exact(s[q] * rsu[e[q]]) * rsv[e[q]];
        *(f32x4_t*)(coef + i * 4) = o;
    }
}

__device__ __forceinline__ void peer_v_phase(const Ctx& c, const int* eidx_, const float* coef_, const unsigned char* V8_, bf16_t* Yb) {
    const GAS int* eidx = (const GAS int*)eidx_; const GAS float* coef = (const GAS float*)coef_; const GAS unsigned char* V8 = (const GAS unsigned char*)V8_;
    const int lane = c.lane, sg = lane >> 3, part = lane & 7;
    typedef int i32x4_t __attribute__((ext_vector_type(4)));
    typedef float f32x4_t __attribute__((ext_vector_type(4)));
    for (int vb = c.bid; vb < 256; vb += c.nblk) {
        const int j = vb & 7, rnk = vb >> 3;
        const int dcol = 128 * j + part * 16;
        const GAS unsigned char* vbase = V8 + (size_t)j * (16384 * 128) + part * 16;
        const int t0 = rnk * 512 + c.wave * 64;
        i32x4_t e[4], en[4]; f32x4_t cf[4], cn[4];
        u32x4_t rA[8], rB[8];
#pragma unroll
        for (int q = 0; q < 4; ++q) { e[q] = *(const GAS i32x4_t*)(eidx + (size_t)t0 * 128 + sg * 16 + 4 * q); cf[q] = *(const GAS f32x4_t*)(coef + (size_t)t0 * 128 + sg * 16 + 4 * q); }
#pragma unroll
        for (int it = 0; it < 8; ++it) rA[it] = *(const GAS u32x4_t*)(vbase + (size_t)e[it >> 2][it & 3] * 128);
#pragma unroll 1
        for (int i = 0; i < 64; ++i) {
            const int t = t0 + i, tn = t0 + (i < 63 ? i + 1 : 63);
#pragma unroll
            for (int it = 0; it < 8; ++it) rB[it] = *(const GAS u32x4_t*)(vbase + (size_t)e[2 + (it >> 2)][it & 3] * 128);
#pragma unroll
            for (int q = 0; q < 4; ++q) { en[q] = *(const GAS i32x4_t*)(eidx + (size_t)tn * 128 + sg * 16 + 4 * q); cn[q] = *(const GAS f32x4_t*)(coef + (size_t)tn * 128 + sg * 16 + 4 * q); }
            float acc[16];
#pragma unroll
            for (int d_ = 0; d_ < 16; ++d_) acc[d_] = 0.f;
#pragma unroll
            for (int it = 0; it < 8; ++it) axpy16_fp8(rA[it], cf[it >> 2][it & 3], acc);
#pragma unroll
            for (int it = 0; it < 8; ++it) rA[it] = *(const GAS u32x4_t*)(vbase + (size_t)en[it >> 2][it & 3] * 128);
#pragma unroll
            for (int it = 0; it < 8; ++it) axpy16_fp8(rB[it], cf[2 + (it >> 2)][it & 3], acc);
            float a8[8], a4[4], a2[2];
            { const bool hb = (sg & 4) != 0;
#pragma unroll
              for (int z = 0; z < 8; ++z) a8[z] = (hb ? acc[8 + z] : acc[z]) + shx(hb ? acc[z] : acc[8 + z], 32, lane); }
            { const bool hb = (sg & 2) != 0;
#pragma unroll
              for (int z = 0; z < 4; ++z) a4[z] = (hb ? a8[4 + z] : a8[z]) + shx(hb ? a8[z] : a8[4 + z], 16, lane); }
            { const bool hb = (sg & 1) != 0;
#pragma unroll
              for (int z = 0; z < 2; ++z) a2[z] = (hb ? a4[2 + z] : a4[z]) + shx(hb ? a4[z] : a4[2 + z], 8, lane); }
            *(unsigned*)(Yb + (size_t)t * DM + dcol + 2 * sg) = pk2(a2[0], a2[1]);
#pragma unroll
            for (int q = 0; q < 4; ++q) { e[q] = en[q]; cf[q] = cn[q]; }
        }
    }
}
__device__ __forceinline__ void prologue_phase(const Ctx& c, const float* x, const float* ab_in, const float* ab_out, const float* cd_in, const float* cd_out, const float* wq, const float* pu, const float* pv, const float* sk, unsigned char* ws) {
    float* scr = c.lds + c.wave * 4096;
    constexpr int I_IN = 16 * 96, I_OUT = 16 * 32, I_WQ = 16 * 64;
    constexpr int NITEMS = 2 * I_IN + 2 * I_OUT + 2 * I_WQ;
    for (int it = c.gwave; it < NITEMS; it += c.nwaves) {
        int r = it;
        if (r < I_IN) { transpose_item(ab_in, QKV_W, DM, QKV_W, (bf16_t*)(ws + WT_ABIN), scr, r, c.lane); continue; } r -= I_IN;
        if (r < I_IN) { transpose_item(cd_in, CD_IN, DM, QKV_W, (bf16_t*)(ws + WT_CDIN), scr, r, c.lane); continue; } r -= I_IN;
        if (r < I_OUT) { transpose_item(ab_out, DM, DM, DM, (bf16_t*)(ws + WT_ABOUT), scr, r, c.lane); continue; } r -= I_OUT;
        if (r < I_OUT) { transpose_item(cd_out, DM, DM, DM, (bf16_t*)(ws + WT_CDOUT), scr, r, c.lane); continue; } r -= I_OUT;
        if (r < I_WQ) { transpose_item(wq, PEER_QW, DM, PEER_QW, (bf16_t*)(ws + WT_WQ), scr, r, c.lane); continue; } r -= I_WQ;
        transpose_item(wq + (size_t)DM * PEER_QW, PEER_QW, DM, PEER_QW, (bf16_t*)(ws + WT_WQ + 4 * MiB), scr, r, c.lane);
    }
    cvt_rows_bf16(c, x, (bf16_t*)(ws + WS_ACTIN), (size_t)NT * DM / 8);
    cvt_rows_fp8<1>(c, pu, ws + WS_U8, (float*)(ws + WS_RS), 2 * 16384);
    cvt_rows_fp8<1>(c, pv, ws + WS_V8, (float*)(ws + WS_RS) + 2 * 16384, 2 * 16384);
    cvt_rows_bf16(c, sk, (bf16_t*)(ws + WS_SKB), (size_t)2 * 16 * 128 * 128 / 8);
}

constexpr int NPHASE = 1 + 2 * 12;
__global__ void __launch_bounds__(NTHREADS, 2) fwd(Args args) {
    unsigned* ctl = (unsigned*)(args.ws + WS_CTL);
    volatile LAS unsigned* xbw = (volatile LAS unsigned*)(dyn_lds + MISC_OFF);
    if (threadIdx.x == 0) { xbw[0] = 0u; xbw[1] = 0u; xbw[2] = 0u; xbw[3] = 0u; }
    __syncthreads();
    const int lo = args.ph_lo, hi = args.ph_hi;
    XcdBarrier bar = xcd_barrier_post(ctl + 4096, xbw);
#define IN(k) (lo <= (k) && (k) < hi)
#define SEAM(k) do { if (IN(k) && IN((k) + 1)) xcd_barrier(bar); } while (0)
#define LAUNDER(ptr) ptr = launder_ptr(ptr)
#define PIN(k) ((const float*)launder_ptr((unsigned char*)args.in[k]))
#define GEMM_LDS ((PG8_LAS unsigned char*)dyn_lds + RING_OFF)
    if (IN(0)) { unsigned char* ws = args.ws; LAUNDER(ws); const Ctx c = make_ctx(bar.wave_s); prologue_phase(c, PIN(0), PIN(2), PIN(5), PIN(6), PIN(8), PIN(9), PIN(11), PIN(12), PIN(10), ws); }
    SEAM(0);
#pragma unroll 1
    for (int layer = 0; layer < 2; ++layer) {
        const int pb = 1 + layer * 12;
        if (IN(pb + 0)) {
            unsigned char* ws = args.ws; LAUNDER(ws); const Ctx c = make_ctx(bar.wave_s);
            pg8::Gemm g{(const bf16_t*)(ws + WS_ACTIN), (const bf16_t*)(ws + (layer == 0 ? WT_ABIN : WT_CDIN)), NT, QKV_W, DM};
            pg8::StaticOrder S; S.init(NT, QKV_W, c.nblk, c.bid);
            pg8::EpiStoreBf16 E{(bf16_t*)(ws + WS_QKV), QKV_W, (layer == 0 ? 0.17677669529663687f : 0.125f) * 1.4426950408889634f, 0.125f * 1.4426950408889634f};
            pg8::gemm_phase<pg8::EpiStoreBf16, pg8::StaticOrder, true, true>(GEMM_LDS, g, S, E, bar.wave_s);
            if (layer == 1) fg_phase(c, (const bf16_t*)(ws + WS_ACTIN), PIN(6), (float*)(ws + WS_FG));
        }
        SEAM(pb + 0);
        if (IN(pb + 1) && layer == 1) { unsigned char* ws = args.ws; LAUNDER(ws); const Ctx c = make_ctx(bar.wave_s); fscan_naive(c, (const float*)(ws + WS_FG), (float*)(ws + WS_F), PIN(7)); }
        if (layer == 1) SEAM(pb + 1);
        if (IN(pb + 2)) {
            unsigned char* ws = args.ws; LAUNDER(ws); const Ctx c = make_ctx(bar.wave_s);
            if (layer == 0) attn_layer0_mfma(c, (const bf16_t*)(ws + WS_QKV), (bf16_t*)(ws + WS_ATTB), PIN(1), PIN(3), PIN(4));
            else { attn_fox_mfma(c, (const bf16_t*)(ws + WS_QKV), (const float*)(ws + WS_F), (bf16_t*)(ws + WS_ATTB)); attn_dilated_mfma(c, (const bf16_t*)(ws + WS_QKV), PIN(1), (bf16_t*)(ws + WS_MIX), (float*)(ws + WS_H1B)); }
        }
        SEAM(pb + 2);
        if (IN(pb + 3) && layer == 1) { unsigned char* ws = args.ws; LAUNDER(ws); const Ctx c = make_ctx(bar.wave_s); dilated_combine(c, (const bf16_t*)(ws + WS_MIX), (const float*)(ws + WS_H1B), (bf16_t*)(ws + WS_ATTB)); }
        if (layer == 1) SEAM(pb + 3);
        if (IN(pb + 4)) {
            unsigned char* ws = args.ws; LAUNDER(ws); const Ctx c = make_ctx(bar.wave_s);
            pg8::Gemm g{(const bf16_t*)(ws + WS_ATTB), (const bf16_t*)(ws + (layer == 0 ? WT_ABOUT : WT_CDOUT)), NT, DM, DM};
            pg8::StaticOrder S; S.init(NT, DM, c.nblk, c.bid);
            pg8::EpiStoreBf16 E{(bf16_t*)(ws + WS_MIX), DM, 1.f, 1.f};
            pg8::gemm_phase<pg8::EpiStoreBf16, pg8::StaticOrder, true, true>(GEMM_LDS, g, S, E, bar.wave_s);
        }
        SEAM(pb + 4);
        if (IN(pb + 5)) {
            unsigned char* ws = args.ws; LAUNDER(ws); const Ctx c = make_ctx(bar.wave_s);
            ln_rows(c, layer == 0 ? PIN(0) : (const float*)nullptr, (const bf16_t*)(ws + WS_ACTIN), (const bf16_t*)(ws + WS_MIX), PIN(13) + (size_t)layer * 2 * DM, PIN(14) + (size_t)layer * 2 * DM, (float*)nullptr, (bf16_t*)(ws + WS_H1B));
        }
        SEAM(pb + 5);
        if (IN(pb + 6)) {
            unsigned char* ws = args.ws; LAUNDER(ws); const Ctx c = make_ctx(bar.wave_s);
            pg8::Gemm g{(const bf16_t*)(ws + WS_H1B), (const bf16_t*)(ws + WT_WQ + (size_t)layer * 4 * MiB), NT, PEER_QW, DM};
            pg8::StaticOrder S; S.init(NT, PEER_QW, c.nblk, c.bid);
            pg8::EpiStoreBf16 E{(bf16_t*)(ws + WS_QKV), PEER_QW, 1.f, 1.f};
            pg8::gemm_phase<pg8::EpiStoreBf16, pg8::StaticOrder, true, true>(GEMM_LDS, g, S, E, bar.wave_s);
        }
        SEAM(pb + 6);
        if (IN(pb + 7)) {
            unsigned char* ws = args.ws; LAUNDER(ws); const Ctx c = make_ctx(bar.wave_s);
            peer_route_phase(c, (const bf16_t*)(ws + WS_QKV), (const bf16_t*)(ws + WS_SKB) + (size_t)layer * 16 * 128 * 128, (int*)(ws + WS_EIDX), (float*)(ws + WS_GATE));
        }
        SEAM(pb + 7);
        if (IN(pb + 8)) {
            unsigned char* ws = args.ws; LAUNDER(ws); const Ctx c = make_ctx(bar.wave_s);
            peer_u_phase(c, (const bf16_t*)(ws + WS_H1B), (const int*)(ws + WS_EIDX), ws + WS_U8 + (size_t)layer * 16384 * DM, (float*)(ws + WS_PART));
        }
        SEAM(pb + 8);
        if (IN(pb + 9)) {
            unsigned char* ws = args.ws; LAUNDER(ws); const Ctx c = make_ctx(bar.wave_s);
            peer_coef_phase(c, (const float*)(ws + WS_PART), (const int*)(ws + WS_EIDX), (const float*)(ws + WS_GATE), (const float*)(ws + WS_RS) + (size_t)layer * 16384, (const float*)(ws + WS_RS) + (size_t)(2 + layer) * 16384, (float*)(ws + WS_COEF));
        }
        SEAM(pb + 9);
        if (IN(pb + 10)) {
            unsigned char* ws = args.ws; LAUNDER(ws); const Ctx c = make_ctx(bar.wave_s);
            peer_v_phase(c, (const int*)(ws + WS_EIDX), (const float*)(ws + WS_COEF), ws + WS_V8 + (size_t)layer * 16384 * DM, (bf16_t*)(ws + WS_YB));
        }
        SEAM(pb + 10);
        if (IN(pb + 11)) {
            unsigned char* ws = args.ws; LAUNDER(ws); const Ctx c = make_ctx(bar.wave_s);
            float* hout = layer == 0 ? (float*)nullptr : (float*)launder_ptr((unsigned char*)args.out);
            bf16_t* houtb = layer == 0 ? (bf16_t*)(ws + WS_ACTIN) : (bf16_t*)nullptr;
            ln_rows(c, (const float*)nullptr, (const bf16_t*)(ws + WS_H1B), (const bf16_t*)(ws + WS_YB), PIN(13) + (size_t)(layer * 2 + 1) * DM, PIN(14) + (size_t)(layer * 2 + 1) * DM, hout, houtb);
        }
        SEAM(pb + 11);
    }
}

extern "C" void kernel_launch(void* const* d_in, const int* in_sizes, int n_in, void* d_out, int out_size, void* d_ws, size_t ws_size, hipStream_t stream) {
    (void)in_sizes; (void)n_in; (void)out_size;
    static int grid = 0;
    if (!grid) {
        int dev = 0, cus = 0, per_cu = 0;
        (void)hipGetDevice(&dev);
        (void)hipDeviceGetAttribute(&cus, hipDeviceAttributeMultiprocessorCount, dev);
        (void)hipFuncSetAttribute((const void*)fwd, hipFuncAttributeMaxDynamicSharedMemorySize, LDS_BYTES);
        (void)hipOccupancyMaxActiveBlocksPerMultiprocessor(&per_cu, fwd, NTHREADS, LDS_BYTES);
        if (per_cu < 1) fprintf(stderr, "occupancy query says %d blocks per CU\n", per_cu);
        grid = cus;
        if (ws_size < WS_END) fprintf(stderr, "workspace too small: %zu < %zu\n", ws_size, (size_t)WS_END);
    }
    (void)hipMemsetAsync((unsigned char*)d_ws + WS_CTL, 0, 1 * MiB, stream);
    Args a{};
    for (int i = 0; i < 15; ++i) a.in[i] = (const float*)d_in[i];
    a.out = (float*)d_out; a.ws = (unsigned char*)d_ws;
    a.ph_lo = 0; a.ph_hi = NPHASE;
    hipLaunchKernelGGL(fwd, dim3(grid), dim3(NTHREADS), LDS_BYTES, stream, a);
}
```
